# Optimizing an MI355X kernel written in HIP

```python
import math
import jax, jax.numpy as jnp
from jax import lax
import numpy as np

D_MODEL = 1024
BATCH = 16
SEQ = 2048
DEPTH = 2

EPS = 1e-6
A_HEADS = 4
A_DK = 48
A_DV = 96
A_LOWRANK = 16
A_GATE_TAU = 16.0
A_CHUNK = 64
B_HEADS = 6
B_HEAD_DIM = 64
IDX_HEADS = 4
IDX_DIM = 32
B_TOPK_MAX = 256
B_QBLOCK = 32
C_HEADS = 6
C_HEAD_DIM = 64
C_PATTERNS = ((128, 1), (512, 4), (2048, 16))
C_QBLOCK = 128
D_WIDTH = 384
D_BLOCKS = 8
D_CONV = 4
D_C = 8.0
REL_BUCKETS = 32
REL_MAX_DIST = 2048
N_SOFTMAX_HEADS = B_HEADS + C_HEADS
N_BRANCH = 4
BRANCH_WIDTH = 384
MOE_GROUPS = 4
MOE_EXPERTS_PER_GROUP = 4
N_EXPERTS = MOE_GROUPS * MOE_EXPERTS_PER_GROUP
MOE_TOPK = 2
MOE_HIDDEN = 512

IN_SPLITS = (A_HEADS * A_DK, A_HEADS * A_DK, A_HEADS * A_DV, A_HEADS * A_DV, A_LOWRANK,
             B_HEADS * B_HEAD_DIM, B_HEADS * B_HEAD_DIM, B_HEADS * B_HEAD_DIM,
             IDX_HEADS * IDX_DIM, IDX_DIM, IDX_HEADS,
             C_HEADS * C_HEAD_DIM, C_HEADS * C_HEAD_DIM, C_HEADS * C_HEAD_DIM,
             D_WIDTH, D_WIDTH)
IN_TOTAL = sum(IN_SPLITS)

kernel_name = "hybrid_gla_dsa_dilated_rglru_hmoe"


def rms_norm(x, gain):
    xf = x.astype(jnp.float32)
    y = xf * lax.rsqrt(jnp.mean(xf * xf, axis=-1, keepdims=True) + EPS)
    return (y * gain.astype(jnp.float32)).astype(x.dtype)


def rel_bucket(dist):
    max_exact = REL_BUCKETS // 2
    n = jnp.maximum(dist, 0)
    nf = jnp.maximum(n, 1).astype(jnp.float32)
    large = max_exact + (jnp.log(nf / max_exact) / math.log(REL_MAX_DIST / max_exact)
                         * (REL_BUCKETS - max_exact)).astype(jnp.int32)
    large = jnp.minimum(large, REL_BUCKETS - 1)
    return jnp.where(n < max_exact, n, large)


def gla_mixer(q, k, v, g, a_lr, w_a2, b_a2, gain):
    f32 = jnp.float32
    bsz, T, _ = q.shape
    n = T // A_CHUNK
    log_a = jax.nn.log_sigmoid((a_lr @ w_a2 + b_a2).astype(f32)) / A_GATE_TAU
    shp_k = (bsz, n, A_CHUNK, A_HEADS, A_DK)
    qf = q.astype(f32).reshape(shp_k) * A_DK ** -0.5
    kf = k.astype(f32).reshape(shp_k)
    vf = v.astype(f32).reshape(bsz, n, A_CHUNK, A_HEADS, A_DV)
    b = jnp.cumsum(log_a.reshape(shp_k), axis=2)
    b_last = b[:, :, -1:]
    q_dec = qf * jnp.exp(b)
    k_dec = kf * jnp.exp(-b)
    k_end = kf * jnp.exp(b_last - b)
    causal = jnp.tril(jnp.ones((A_CHUNK, A_CHUNK), dtype=bool))
    att = jnp.where(causal, jnp.einsum('bnchk,bnshk->bnhcs', q_dec, k_dec), 0.0)
    o_intra = jnp.einsum('bnhcs,bnshv->bnchv', att, vf)
    u = jnp.einsum('bnshk,bnshv->bnhkv', k_end, vf)
    decay = jnp.exp(b_last[:, :, 0])

    def step(S, inp):
        d, uu = inp
        return d[..., None] * S + uu, S

    S0 = jnp.zeros((bsz, A_HEADS, A_DK, A_DV), f32)
    _, S_prev = lax.scan(step, S0, (jnp.moveaxis(decay, 1, 0), jnp.moveaxis(u, 1, 0)))
    S_prev = jnp.moveaxis(S_prev, 0, 1)
    o = o_intra + jnp.einsum('bnchk,bnhkv->bnchv', q_dec, S_prev)
    o = o.reshape(bsz, T, A_HEADS, A_DV)
    o = o * lax.rsqrt(jnp.mean(o * o, axis=-1, keepdims=True) + EPS)
    o = o * gain.astype(f32).reshape(A_HEADS, A_DV)
    o = o.reshape(bsz, T, A_HEADS * A_DV) * jax.nn.silu(g.astype(f32))
    return o.astype(q.dtype)


def dsa_mixer(q, k, v, iq, ik, iw, bias_tab):
    f32 = jnp.float32
    bsz, T, _ = q.shape
    k_sel = min(B_TOPK_MAX, T // 4)
    nb = T // B_QBLOCK
    iqf = iq.astype(f32).reshape(bsz, T, IDX_HEADS, IDX_DIM) * IDX_DIM ** -0.5
    ikf = ik.astype(f32)
    iwf = iw.astype(f32) * IDX_HEADS ** -0.5
    qh = q.astype(f32).reshape(bsz, T, B_HEADS, B_HEAD_DIM) * B_HEAD_DIM ** -0.5
    kh = k.reshape(bsz, T, B_HEADS, B_HEAD_DIM)
    vh = v.reshape(bsz, T, B_HEADS, B_HEAD_DIM)
    key_pos = jnp.arange(T)

    def block(i):
        start = i * B_QBLOCK
        q_pos = start + jnp.arange(B_QBLOCK)
        iq_b = lax.dynamic_slice_in_dim(iqf, start, B_QBLOCK, axis=1)
        iw_b = lax.dynamic_slice_in_dim(iwf, start, B_QBLOCK, axis=1)
        q_b = lax.dynamic_slice_in_dim(qh, start, B_QBLOCK, axis=1)
        s = jax.nn.relu(jnp.einsum('bqhd,bsd->bqhs', iq_b, ikf))
        score = jnp.einsum('bqh,bqhs->bqs', iw_b, s)
        score = jnp.where(key_pos[None, :] <= q_pos[:, None], score, -jnp.inf)
        _, idx = lax.top_k(score, k_sel)
        valid = idx <= q_pos[None, :, None]
        k_g = jax.vmap(lambda kk, ii: kk[ii])(kh, idx).astype(f32)
        v_g = jax.vmap(lambda vv, ii: vv[ii])(vh, idx).astype(f32)
        logits = jnp.einsum('bqhd,bqkhd->bqhk', q_b, k_g)
        bias = bias_tab[rel_bucket(q_pos[None, :, None] - idx)].astype(f32)
        logits = logits + jnp.moveaxis(bias, -1, 2)
        logits = jnp.where(valid[:, :, None, :], logits, -jnp.inf)
        p = jax.nn.softmax(logits, axis=-1)
        return jnp.einsum('bqhk,bqkhd->bqhd', p, v_g).astype(q.dtype)

    out = lax.map(block, jnp.arange(nb))
    return jnp.moveaxis(out, 0, 1).reshape(bsz, T, B_HEADS * B_HEAD_DIM)


def _dilated_window(qh, kh, vh, window, dil, bias_tab):
    bsz, T, H, Dh = qh.shape
    n = T // dil
    span = window // dil
    c = math.gcd(C_QBLOCK, n)
    nb = n // c

    def to_sub(t):
        return t.reshape(bsz, n, dil, H, Dh).transpose(0, 2, 1, 3, 4).reshape(bsz * dil, n, H, Dh)

    pad = ((0, 0), (span, 0), (0, 0), (0, 0))
    qs = to_sub(qh).reshape(bsz * dil, nb, c, H, Dh)
    ks = jnp.pad(to_sub(kh), pad)
    vs = jnp.pad(to_sub(vh), pad)
    kidx = (jnp.arange(nb) * c)[:, None] + jnp.arange(c + span)[None, :]
    kb = ks[:, kidx]
    vb = vs[:, kidx]
    rel = jnp.arange(c)[:, None] - jnp.arange(c + span)[None, :] + span
    kpos = kidx - span
    valid = ((rel >= 0) & (rel <= span))[None] & (kpos >= 0)[:, None, :]
    bias = jnp.transpose(bias_tab[rel_bucket(rel * dil)].astype(jnp.float32), (2, 0, 1))
    logits = jnp.einsum('bnqhd,bnkhd->bnhqk', qs, kb) + bias[None, None]
    logits = jnp.where(valid[None, :, None], logits, -jnp.inf)
    m = jnp.max(logits, axis=-1, keepdims=True)
    p = jnp.exp(logits - m)
    l = jnp.sum(p, axis=-1, keepdims=True)
    o = jnp.einsum('bnhqk,bnkhd->bnqhd', p / l, vb)
    lse = (m + jnp.log(l))[..., 0]
    o = o.reshape(bsz, dil, n, H, Dh).transpose(0, 2, 1, 3, 4).reshape(bsz, T, H, Dh)
    lse = lse.transpose(0, 1, 3, 2).reshape(bsz, dil, n, H).transpose(0, 2, 1, 3).reshape(bsz, T, H)
    return o, lse


def dilated_mixer(q, k, v, bias_tab):
    f32 = jnp.float32
    bsz, T, _ = q.shape
    qh = q.astype(f32).reshape(bsz, T, C_HEADS, C_HEAD_DIM) * C_HEAD_DIM ** -0.5
    kh = k.astype(f32).reshape(bsz, T, C_HEADS, C_HEAD_DIM)
    vh = v.astype(f32).reshape(bsz, T, C_HEADS, C_HEAD_DIM)
    outs, lses = [], []
    for window, dil in C_PATTERNS:
        o, lse = _dilated_window(qh, kh, vh, window, dil, bias_tab)
        outs.append(o)
        lses.append(lse)
    w = jax.nn.softmax(jnp.stack(lses, axis=0), axis=0)
    o = jnp.einsum('pbth,pbthd->bthd', w, jnp.stack(outs, axis=0))
    return o.reshape(bsz, T, C_HEADS * C_HEAD_DIM).astype(q.dtype)


def rglru_mixer(y_in, x_in, conv_w, conv_b, w_r, b_r, w_i, b_i, lam):
    f32 = jnp.float32
    bsz, T, W = x_in.shape
    xc = lax.conv_general_dilated(x_in.astype(f32), conv_w.astype(f32)[:, None, :],
                                  window_strides=(1,), padding=[(D_CONV - 1, 0)],
                                  dimension_numbers=('NWC', 'WIO', 'NWC'),
                                  feature_group_count=W) + conv_b.astype(f32)
    xb = xc.reshape(bsz, T, D_BLOCKS, W // D_BLOCKS)
    r = jax.nn.sigmoid(jnp.einsum('btnc,ncd->btnd', xb, w_r.astype(f32)).reshape(bsz, T, W) + b_r.astype(f32))
    i = jax.nn.sigmoid(jnp.einsum('btnc,ncd->btnd', xb, w_i.astype(f32)).reshape(bsz, T, W) + b_i.astype(f32))
    log_a = -D_C * r * jax.nn.softplus(-lam.astype(f32))
    a = jnp.exp(log_a)
    u = jnp.sqrt(-jnp.expm1(2.0 * log_a)) * (i * xc)

    def combine(left, right):
        a1, b1 = left
        a2, b2 = right
        return a1 * a2, a2 * b1 + b2

    _, h = lax.associative_scan(combine, (a, u), axis=1)
    return (jax.nn.gelu(y_in.astype(f32)) * h).astype(x_in.dtype)


def mixer_block(xn, w_in, a_w2, a_b2, a_gain, conv_w, conv_b, lru_wr, lru_br, lru_wi, lru_bi,
                lru_lambda, w_gate, b_gate, w_branch, w_out, rel_bias):
    proj = xn @ w_in
    offsets = np.cumsum(IN_SPLITS)[:-1].tolist()
    (aq, ak, av, ag, alr, bq, bk, bv, iq, ik, iw, cq, ck, cv, dy, dx) = jnp.split(proj, offsets, axis=-1)
    o_a = gla_mixer(aq, ak, av, ag, alr, a_w2, a_b2, a_gain)
    o_b = dsa_mixer(bq, bk, bv, iq, ik, iw, rel_bias[:, :B_HEADS])
    o_c = dilated_mixer(cq, ck, cv, rel_bias[:, B_HEADS:])
    o_d = rglru_mixer(dy, dx, conv_w, conv_b, lru_wr, lru_br, lru_wi, lru_bi, lru_lambda)
    merged = None
    for gi, ob in enumerate((o_a, o_b, o_c, o_d)):
        gate = jax.nn.sigmoid(xn @ w_gate[gi] + b_gate[gi])
        term = gate * (ob @ w_branch[gi])
        merged = term if merged is None else merged + term
    return merged @ w_out


def hier_moe(x, w_rg, b_rg, w_re, b_re, w_g, w_u, w_d):
    f32 = jnp.float32
    bsz, T, Dm = x.shape
    xt = x.reshape(-1, Dm)
    g_logits = (xt @ w_rg).astype(f32) + b_rg.astype(f32)
    g_prob = jax.nn.softmax(g_logits, axis=-1)
    g_sel = jnp.argmax(g_logits, axis=-1)
    g_w = jnp.take_along_axis(g_prob, g_sel[:, None], axis=-1)
    e_logits = ((xt @ w_re).astype(f32) + b_re.astype(f32)).reshape(-1, MOE_GROUPS, MOE_EXPERTS_PER_GROUP)
    e_in = jnp.take_along_axis(e_logits, g_sel[:, None, None], axis=1)[:, 0]
    top_v, top_i = lax.top_k(e_in, MOE_TOPK)
    top_w = jax.nn.softmax(top_v, axis=-1) * g_w
    expert_id = g_sel[:, None] * MOE_EXPERTS_PER_GROUP + top_i
    gates = jnp.sum(jax.nn.one_hot(expert_id, N_EXPERTS, dtype=f32) * top_w[..., None], axis=1)
    out = jnp.zeros(xt.shape, f32)
    for e in range(N_EXPERTS):
        h = jax.nn.silu(xt @ w_g[e]) * (xt @ w_u[e])
        out = out + gates[:, e:e + 1] * (h @ w_d[e]).astype(f32)
    return out.astype(x.dtype).reshape(bsz, T, Dm)


def setup_inputs(seed: int = 0) -> dict:
    key = jax.random.key(seed)
    ks = jax.random.split(key, 32)
    f32 = jnp.float32

    def nrm(k, shape, fan_in, scale=1.0):
        return jax.random.normal(k, shape, f32) * (scale * fan_in ** -0.5)

    def small(k, shape, s):
        return jax.random.normal(k, shape, f32) * s

    bw = D_WIDTH // D_BLOCKS
    u = jax.random.uniform(ks[11], (DEPTH, D_WIDTH), f32, 0.9, 0.999)
    a0 = u ** (1.0 / D_C)
    return {
        "x": jax.random.normal(ks[0], (BATCH, SEQ, D_MODEL), f32),
        "w_in": nrm(ks[1], (DEPTH, D_MODEL, IN_TOTAL), D_MODEL),
        "a_w2": nrm(ks[2], (DEPTH, A_LOWRANK, A_HEADS * A_DK), A_LOWRANK),
        "a_b2": small(ks[3], (DEPTH, A_HEADS * A_DK), 0.1),
        "a_gain": 1.0 + small(ks[4], (DEPTH, A_HEADS * A_DV), 0.02),
        "conv_w": nrm(ks[5], (DEPTH, D_CONV, D_WIDTH), D_CONV),
        "conv_b": small(ks[6], (DEPTH, D_WIDTH), 0.01),
        "lru_wr": nrm(ks[7], (DEPTH, D_BLOCKS, bw, bw), bw),
        "lru_br": small(ks[8], (DEPTH, D_WIDTH), 0.1),
        "lru_wi": nrm(ks[9], (DEPTH, D_BLOCKS, bw, bw), bw),
        "lru_bi": small(ks[10], (DEPTH, D_WIDTH), 0.1),
        "lru_lambda": jnp.log(a0) - jnp.log1p(-a0),
        "w_gate": nrm(ks[12], (DEPTH, N_BRANCH, D_MODEL, D_MODEL), D_MODEL),
        "b_gate": small(ks[13], (DEPTH, N_BRANCH, D_MODEL), 0.02),
        "w_branch": nrm(ks[14], (DEPTH, N_BRANCH, BRANCH_WIDTH, D_MODEL), BRANCH_WIDTH),
        "w_out": nrm(ks[15], (DEPTH, D_MODEL, D_MODEL), D_MODEL, 0.5),
        "rel_bias": small(ks[16], (REL_BUCKETS, N_SOFTMAX_HEADS), 0.1),
        "norm1": 1.0 + small(ks[17], (DEPTH, D_MODEL), 0.02),
        "norm2": 1.0 + small(ks[18], (DEPTH, D_MODEL), 0.02),
        "norm_f": 1.0 + small(ks[19], (D_MODEL,), 0.02),
        "moe_wrg": nrm(ks[20], (DEPTH, D_MODEL, MOE_GROUPS), D_MODEL),
        "moe_brg": small(ks[21], (DEPTH, MOE_GROUPS), 0.01),
        "moe_wre": nrm(ks[22], (DEPTH, D_MODEL, N_EXPERTS), D_MODEL),
        "moe_bre": small(ks[23], (DEPTH, N_EXPERTS), 0.01),
        "moe_wg": nrm(ks[24], (DEPTH, N_EXPERTS, D_MODEL, MOE_HIDDEN), D_MODEL),
        "moe_wu": nrm(ks[25], (DEPTH, N_EXPERTS, D_MODEL, MOE_HIDDEN), D_MODEL),
        "moe_wd": nrm(ks[26], (DEPTH, N_EXPERTS, MOE_HIDDEN, D_MODEL), MOE_HIDDEN),
    }


def reference(x, w_in, a_w2, a_b2, a_gain, conv_w, conv_b, lru_wr, lru_br, lru_wi, lru_bi,
              lru_lambda, w_gate, b_gate, w_branch, w_out, rel_bias, norm1, norm2, norm_f,
              moe_wrg, moe_brg, moe_wre, moe_bre, moe_wg, moe_wu, moe_wd):
    h = x
    for l in range(DEPTH):
        xn = rms_norm(h, norm1[l])
        h = h + mixer_block(xn, w_in[l], a_w2[l], a_b2[l], a_gain[l], conv_w[l], conv_b[l],
                            lru_wr[l], lru_br[l], lru_wi[l], lru_bi[l], lru_lambda[l],
                            w_gate[l], b_gate[l], w_branch[l], w_out[l], rel_bias)
        h = h + hier_moe(rms_norm(h, norm2[l]), moe_wrg[l], moe_brg[l], moe_wre[l], moe_bre[l],
                         moe_wg[l], moe_wu[l], moe_wd[l])
    return rms_norm(h, norm_f)
```

```cpp
#include <hip/hip_runtime.h>
#include <stdint.h>

typedef unsigned short bf16_t;
typedef short bf16x8 __attribute__((ext_vector_type(8)));
typedef float f32x4 __attribute__((ext_vector_type(4)));
typedef unsigned u32x4 __attribute__((ext_vector_type(4)));

constexpr int NTOK = 32768, TSEQ = 2048, NBATCH = 16, DM = 1024, DEPTH = 2;
constexpr int NP = 4608;
constexpr int NT = 512;
constexpr int C_AQ = 0, C_AK = 192, C_AV = 384, C_AG = 768, C_BQ = 1152, C_CQ = 1536, C_DY = 1920, C_BK = 2304, C_BV = 2688,
              C_CK = 3072, C_CV = 3456, C_DX = 3840, C_IQ = 4224, C_IK = 4352, C_ALR = 4384, C_IW = 4400;
constexpr int C_OB = 768;
constexpr int C_MG = 2304;
constexpr float EPS = 1e-6f;
constexpr int NCLS = 24, MAXRT = 152;

enum { I_X = 0, I_WIN, I_AW2, I_AB2, I_AGAIN, I_CONVW, I_CONVB, I_WR, I_BR, I_WI, I_BI, I_LAM, I_WGATE, I_BGATE, I_WBR, I_WOUT, I_RELB,
       I_N1, I_N2, I_NF, I_WRG, I_BRG, I_WRE, I_BRE, I_MWG, I_MWU, I_MWD, N_IN };

struct Params {
    const float* in[N_IN];
    float* h;
    bf16_t* Bt_in;
    bf16_t* Bt_gate;
    bf16_t* Bt_br;
    bf16_t* Bt_out;
    bf16_t* Wgu;
    bf16_t* WdT;
    bf16_t* hb;
    bf16_t* proj;
    bf16_t* Hbuf;
    float* part;
    float* biasB;
    float* biasC;
    float* tokw;
    int* perm;
    int* cnt;
    unsigned* bar;
};

__device__ __forceinline__ bf16_t f2bf(float f) { unsigned u = __float_as_uint(f); u += 0x7FFFu + ((u >> 16) & 1u); return (bf16_t)(u >> 16); }
__device__ __forceinline__ float bf2f(bf16_t b) { return __uint_as_float(((unsigned)b) << 16); }
__device__ __forceinline__ float wave_sum(float v) {
#pragma unroll
    for (int o = 32; o > 0; o >>= 1) v += __shfl_xor(v, o);
    return v;
}
__device__ __forceinline__ float wave_max(float v) {
#pragma unroll
    for (int o = 32; o > 0; o >>= 1) v = fmaxf(v, __shfl_xor(v, o));
    return v;
}
__device__ __forceinline__ int wave_sum_i(int v) {
#pragma unroll
    for (int o = 32; o > 0; o >>= 1) v += __shfl_xor(v, o);
    return v;
}
__device__ __forceinline__ float sigmoidf_(float x) { return 1.0f / (1.0f + __expf(-x)); }
__device__ __forceinline__ float siluf_(float x) { return x / (1.0f + __expf(-x)); }
__device__ __forceinline__ float rstd_of(const float* part, int row) {
    const f32x4* p = (const f32x4*)(part + (size_t)row * 16);
    f32x4 a = p[0], b = p[1], c = p[2], d = p[3];
    float s = ((a[0] + a[1]) + (a[2] + a[3])) + ((b[0] + b[1]) + (b[2] + b[3])) + ((c[0] + c[1]) + (c[2] + c[3])) + ((d[0] + d[1]) + (d[2] + d[3]));
    return rsqrtf(s * (1.0f / 1024.0f) + EPS);
}
__device__ __forceinline__ int map_in_col(int c) {
    if (c < 1152) return c;
    if (c < 1536) return 1168 + (c - 1152);
    if (c < 1920) return 2484 + (c - 1536);
    if (c < 2304) return 3636 + (c - 1920);
    if (c < 2688) return 1552 + (c - 2304);
    if (c < 3072) return 1936 + (c - 2688);
    if (c < 3456) return 2868 + (c - 3072);
    if (c < 3840) return 3252 + (c - 3456);
    if (c < 4224) return 4020 + (c - 3840);
    if (c < 4352) return 2320 + (c - 4224);
    if (c < 4384) return 2448 + (c - 4352);
    if (c < 4400) return 1152 + (c - 4384);
    if (c < 4404) return 2480 + (c - 4400);
    return -1;
}
__device__ __forceinline__ int rel_bucket(int n) {
    if (n < 16) return n;
    float v = logf((float)n / 16.0f) / 4.852030263919617f * 16.0f;
    int b = 16 + (int)v;
    return b < 31 ? b : 31;
}

template <class MapF>
__device__ __forceinline__ void conv_wT(const float* __restrict__ src, int ldsrc, int K, bf16_t* __restrict__ dst, int nrows, MapF colmap,
                                        const float* __restrict__ scale, int bid, int nb, float* tile) {
    const int tid = threadIdx.x, nkt = K / 64, ntile = (nrows / 64) * nkt;
    for (int t = bid; t < ntile; t += nb) {
        const int r0 = (t / nkt) * 64, k0 = (t % nkt) * 64;
#pragma unroll
        for (int i = 0; i < 8; ++i) {
            const int e = tid + NT * i, kk = e >> 6, rr = e & 63;
            const int c = colmap(r0 + rr);
            float v = 0.f;
            if (c >= 0) { v = src[(size_t)(k0 + kk) * ldsrc + c]; if (scale) v *= scale[k0 + kk]; }
            tile[kk * 65 + rr] = v;
        }
        __syncthreads();
#pragma unroll
        for (int i = 0; i < 8; ++i) {
            const int e = tid + NT * i, rr = e >> 6, kk = e & 63;
            dst[(size_t)(r0 + rr) * K + k0 + kk] = f2bf(tile[kk * 65 + rr]);
        }
        __syncthreads();
    }
}

__device__ void phase_weights(const Params& p, int l, int bid, int nb, unsigned char* lds) {
    float* tile = (float*)lds;
    const float* n1 = p.in[I_N1] + l * DM;
    const float* n2 = p.in[I_N2] + l * DM;
    conv_wT(p.in[I_WIN] + (size_t)l * DM * 4404, 4404, DM, p.Bt_in, NP, [](int r) { return map_in_col(r); }, n1, bid, nb, tile);
    for (int i = 0; i < 4; ++i) {
        conv_wT(p.in[I_WGATE] + ((size_t)l * 4 + i) * DM * DM, DM, DM, p.Bt_gate + (size_t)i * DM * DM, DM, [](int r) { return r; }, n1, bid, nb, tile);
        conv_wT(p.in[I_WBR] + ((size_t)l * 4 + i) * 384 * DM, DM, 384, p.Bt_br + (size_t)i * DM * 384, DM, [](int r) { return r; }, nullptr, bid, nb, tile);
    }
    conv_wT(p.in[I_WOUT] + (size_t)l * DM * DM, DM, DM, p.Bt_out, DM, [](int r) { return r; }, nullptr, bid, nb, tile);
    for (int e = 0; e < 16; ++e) {
        const float* wg = p.in[I_MWG] + ((size_t)l * 16 + e) * DM * 512;
        const float* wu = p.in[I_MWU] + ((size_t)l * 16 + e) * DM * 512;
        bf16_t* dst = p.Wgu + (size_t)e * DM * DM;
        {
            const int tid = threadIdx.x;
            for (int t = bid; t < 16 * 16; t += nb) {
                const int r0 = (t / 16) * 64, k0 = (t % 16) * 64;
#pragma unroll
                for (int i = 0; i < 8; ++i) {
                    const int ee = tid + NT * i, kk = ee >> 6, rr = ee & 63, rho = r0 + rr;
                    const int T = rho >> 7, wc = (rho >> 6) & 1, q = (rho >> 5) & 1, ii = rho & 31, hcol = 64 * T + 32 * wc + ii;
                    const float* s = q ? wu : wg;
                    tile[kk * 65 + rr] = s[(size_t)(k0 + kk) * 512 + hcol] * n2[k0 + kk];
                }
                __syncthreads();
#pragma unroll
                for (int i = 0; i < 8; ++i) {
                    const int ee = tid + NT * i, rr = ee >> 6, kk = ee & 63;
                    dst[(size_t)(r0 + rr) * DM + k0 + kk] = f2bf(tile[kk * 65 + rr]);
                }
                __syncthreads();
            }
        }
        conv_wT(p.in[I_MWD] + ((size_t)l * 16 + e) * 512 * DM, DM, 512, p.WdT + (size_t)e * DM * 512, DM, [](int r) { return r; }, nullptr, bid, nb, tile);
    }
}

__device__ void phase_prep(const Params& p, int bid, int nb) {
    const int tid = threadIdx.x, wave = tid >> 6, lane = tid & 63;
    const float* x = p.in[I_X];
    for (int row = bid * 8 + wave; row < NTOK; row += nb * 8) {
        const float* xr = x + (size_t)row * DM;
        float s = 0.f;
#pragma unroll
        for (int i = 0; i < 4; ++i) {
            const f32x4 v = *(const f32x4*)(xr + i * 256 + lane * 4);
            s += v[0] * v[0] + v[1] * v[1] + v[2] * v[2] + v[3] * v[3];
            const unsigned lo = (unsigned)f2bf(v[0]) | ((unsigned)f2bf(v[1]) << 16), hi = (unsigned)f2bf(v[2]) | ((unsigned)f2bf(v[3]) << 16);
            *(uint2*)(p.hb + (size_t)row * DM + i * 256 + lane * 4) = make_uint2(lo, hi);
        }
        s = wave_sum(s);
        if (lane < 16) p.part[(size_t)row * 16 + lane] = (lane == 0) ? s : 0.f;
    }
    const float* rb = p.in[I_RELB];
    for (int i = bid * NT + tid; i < 6 * 2048; i += nb * NT) {
        const int h = i / 2048, d = i % 2048, bk = rel_bucket(d);
        p.biasB[i] = rb[bk * 12 + h];
        const int m = (d <= 128 ? 1 : 0) + ((d % 4 == 0 && d <= 512) ? 1 : 0) + ((d % 16 == 0) ? 1 : 0);
        p.biasC[i] = rb[bk * 12 + 6 + h] + (m > 0 ? logf((float)m) : -1e30f);
    }
    for (int i = bid * NT + tid; i < DEPTH * 32; i += nb * NT) p.cnt[i] = 0;
}

constexpr int G_LDS = 256 * 32 * 2 + 128 * 32 * 2;
struct GemmCtx { int tid, wid, lane, wr, wc, fr, fq; };
__device__ __forceinline__ GemmCtx gemm_ctx() { GemmCtx c; c.tid = threadIdx.x; c.wid = c.tid >> 6; c.lane = c.tid & 63; c.wr = c.wid >> 1; c.wc = c.wid & 1; c.fr = c.lane & 15; c.fq = c.lane >> 4; return c; }
__device__ __forceinline__ void acc_zero(f32x4 (&acc)[4][4]) {
#pragma unroll
    for (int m = 0; m < 4; ++m)
#pragma unroll
        for (int n = 0; n < 4; ++n) acc[m][n] = (f32x4){0.f, 0.f, 0.f, 0.f};
}
__device__ __forceinline__ void gemm_kloop(f32x4 (&acc)[4][4], const bf16_t* a0, const bf16_t* a1, const bf16_t* b0, int nkt, unsigned char* lds, const GemmCtx& c) {
    bf16_t* SA = (bf16_t*)lds; bf16_t* SB = (bf16_t*)(lds + 256 * 32 * 2);
    const int cc = (c.tid & 3) * 8;
    for (int t = 0; t < nkt; ++t) {
        __builtin_amdgcn_global_load_lds((const unsigned*)(a0 + t * 32 + cc), (unsigned*)((char*)SA + c.tid * 16), 16, 0, 0);
        __builtin_amdgcn_global_load_lds((const unsigned*)(a1 + t * 32 + cc), (unsigned*)((char*)SA + c.tid * 16 + 8192), 16, 0, 0);
        __builtin_amdgcn_global_load_lds((const unsigned*)(b0 + t * 32 + cc), (unsigned*)((char*)SB + c.tid * 16), 16, 0, 0);
        asm volatile("s_waitcnt vmcnt(0)" ::: "memory");
        __syncthreads();
        bf16x8 At[4], Bt[4];
#pragma unroll
        for (int m = 0; m < 4; ++m) At[m] = *reinterpret_cast<const bf16x8*>((char*)SA + (c.wr * 64 + m * 16 + c.fr) * 64 + c.fq * 16);
#pragma unroll
        for (int n = 0; n < 4; ++n) Bt[n] = *reinterpret_cast<const bf16x8*>((char*)SB + (c.wc * 64 + n * 16 + c.fr) * 64 + c.fq * 16);
        asm volatile("s_waitcnt lgkmcnt(0)" ::: "memory");
        __builtin_amdgcn_sched_barrier(0);
#pragma unroll
        for (int m = 0; m < 4; ++m)
#pragma unroll
            for (int n = 0; n < 4; ++n) acc[m][n] = __builtin_amdgcn_mfma_f32_16x16x32_bf16(At[m], Bt[n], acc[m][n], 0, 0, 0);
        __syncthreads();
    }
}

__device__ void phase_inproj(const Params& p, int bid, int nb, unsigned char* lds) {
    const GemmCtx c = gemm_ctx();
    float* srstd = (float*)(lds + G_LDS);
    constexpr int NCT = NP / 128, NU = (NTOK / 256) * NCT;
    for (int u = bid; u < NU; u += nb) {
        const int rt = u / NCT, ct = u % NCT, brow = rt * 256, bcol = ct * 128;
        if (c.tid < 256) srstd[c.tid] = rstd_of(p.part, brow + c.tid);
        f32x4 acc[4][4]; acc_zero(acc);
        const int r = c.tid >> 2;
        gemm_kloop(acc, p.hb + (size_t)(brow + r) * DM, p.hb + (size_t)(brow + r + 128) * DM, p.Bt_in + (size_t)(bcol + r) * DM, DM / 32, lds, c);
#pragma unroll
        for (int m = 0; m < 4; ++m)
#pragma unroll
            for (int j = 0; j < 4; ++j) {
                const int rl = c.wr * 64 + m * 16 + c.fq * 4 + j; const float rs = srstd[rl];
                bf16_t* o = p.proj + (size_t)(brow + rl) * NP + bcol + c.wc * 64 + c.fr;
#pragma unroll
                for (int n = 0; n < 4; ++n) o[n * 16] = f2bf(acc[m][n][j] * rs);
            }
        __syncthreads();
    }
}

constexpr int GLA_LDS = (48 * 96 + 3 * 64 * 48 + 64 * 96 + 64 * 64 + 64 * 48 + 64 * 96) * 4;
__device__ void phase_gla(const Params& p, int l, int bid, int nb, unsigned char* lds) {
    float* S = (float*)lds;
    float* qd = S + 48 * 96;
    float* kd = qd + 64 * 48;
    float* ke = kd + 64 * 48;
    float* vv = ke + 64 * 48;
    float* att = vv + 64 * 96;
    float* bc = att + 64 * 64;
    float* oo = bc + 64 * 48;
    const int tid = threadIdx.x, wave = tid >> 6, lane = tid & 63;
    const float* w2 = p.in[I_AW2] + (size_t)l * 16 * 192;
    const float* b2 = p.in[I_AB2] + l * 192;
    const float* gain = p.in[I_AGAIN] + l * 384;
    for (int u = bid; u < NBATCH * 4; u += nb) {
        const int b = u >> 2, h = u & 3;
        for (int i = tid; i < 48 * 96; i += NT) S[i] = 0.f;
        __syncthreads();
        for (int n = 0; n < 32; ++n) {
            const size_t row0 = (size_t)b * TSEQ + n * 64;
            for (int e = tid; e < 64 * 48; e += NT) {
                const int t = e / 48, k = e % 48;
                const bf16_t* al = p.proj + (row0 + t) * NP + C_ALR;
                float z = b2[h * 48 + k];
#pragma unroll
                for (int r = 0; r < 16; ++r) z += bf2f(al[r]) * w2[r * 192 + h * 48 + k];
                const float ls = fminf(z, 0.f) - log1pf(__expf(-fabsf(z)));
                bc[e] = ls * (1.0f / 16.0f);
            }
            __syncthreads();
            if (tid < 48) { float s = 0.f; for (int t = 0; t < 64; ++t) { s += bc[t * 48 + tid]; bc[t * 48 + tid] = s; } }
            __syncthreads();
            for (int e = tid; e < 64 * 48; e += NT) {
                const int t = e / 48, k = e % 48;
                const float bb = bc[e], bl = bc[63 * 48 + k];
                const float q = bf2f(p.proj[(row0 + t) * NP + C_AQ + h * 48 + k]) * 0.14433756729740643f;
                const float kk = bf2f(p.proj[(row0 + t) * NP + C_AK + h * 48 + k]);
                qd[e] = q * __expf(bb); kd[e] = kk * __expf(-bb); ke[e] = kk * __expf(bl - bb);
            }
            for (int e = tid; e < 64 * 96; e += NT) { const int t = e / 96, v = e % 96; vv[e] = bf2f(p.proj[(row0 + t) * NP + C_AV + h * 96 + v]); }
            __syncthreads();
            for (int e = tid; e < 64 * 64; e += NT) {
                const int cq = e >> 6, s = e & 63; float a = 0.f;
                if (cq >= s) { for (int k = 0; k < 48; ++k) a += qd[cq * 48 + k] * kd[s * 48 + k]; }
                att[e] = a;
            }
            __syncthreads();
            for (int e = tid; e < 64 * 96; e += NT) {
                const int cq = e / 96, v = e % 96; float a = 0.f;
                for (int s = 0; s <= cq; ++s) a += att[cq * 64 + s] * vv[s * 96 + v];
                for (int k = 0; k < 48; ++k) a += qd[cq * 48 + k] * S[k * 96 + v];
                oo[e] = a;
            }
            __syncthreads();
            for (int e = tid; e < 48 * 96; e += NT) {
                const int k = e / 96, v = e % 96; float a = __expf(bc[63 * 48 + k]) * S[e];
                for (int s = 0; s < 64; ++s) a += ke[s * 48 + k] * vv[s * 96 + v];
                S[e] = a;
            }
            for (int t = wave; t < 64; t += 8) {
                const float o0 = oo[t * 96 + lane], o1 = lane < 32 ? oo[t * 96 + 64 + lane] : 0.f;
                const float ms = wave_sum(o0 * o0 + o1 * o1) * (1.0f / 96.0f);
                const float rs = rsqrtf(ms + EPS);
                bf16_t* g = p.proj + (row0 + t) * NP + C_AG + h * 96;
                { const float gv = bf2f(g[lane]); g[lane] = f2bf(o0 * rs * gain[h * 96 + lane] * siluf_(gv)); }
                if (lane < 32) { const float gv = bf2f(g[64 + lane]); g[64 + lane] = f2bf(o1 * rs * gain[h * 96 + 64 + lane] * siluf_(gv)); }
            }
            __syncthreads();
        }
    }
}

constexpr int LRU_LDS = (67 * 48 + 3 * 64 * 48 + 2 * 48 * 48 + 48) * 4;
__device__ __forceinline__ float gelu_tanh(float x) { const float u = 0.7978845608028654f * (x + 0.044715f * x * x * x); return 0.5f * x * (1.0f + tanhf(u)); }
__device__ void phase_lru(const Params& p, int l, int bid, int nb, unsigned char* lds) {
    float* xin = (float*)lds;
    float* xc = xin + 67 * 48;
    float* aa = xc + 64 * 48;
    float* uu = aa + 64 * 48;
    float* wr = uu + 64 * 48;
    float* wi = wr + 48 * 48;
    float* hs = wi + 48 * 48;
    const int tid = threadIdx.x;
    for (int u = bid; u < NBATCH * 8; u += nb) {
        const int b = u >> 3, nblk = u & 7, ch0 = nblk * 48;
        for (int i = tid; i < 48 * 48; i += NT) { wr[i] = p.in[I_WR][((size_t)l * 8 + nblk) * 2304 + i]; wi[i] = p.in[I_WI][((size_t)l * 8 + nblk) * 2304 + i]; }
        if (tid < 48) hs[tid] = 0.f;
        __syncthreads();
        for (int tt = 0; tt < TSEQ / 64; ++tt) {
            const int t0 = tt * 64;
            for (int e = tid; e < 67 * 48; e += NT) {
                const int r = e / 48, cidx = e % 48, t = t0 - 3 + r;
                xin[e] = t >= 0 ? bf2f(p.proj[((size_t)b * TSEQ + t) * NP + C_DX + ch0 + cidx]) : 0.f;
            }
            __syncthreads();
            for (int e = tid; e < 64 * 48; e += NT) {
                const int t = e / 48, cidx = e % 48; float a = p.in[I_CONVB][l * 384 + ch0 + cidx];
#pragma unroll
                for (int j = 0; j < 4; ++j) a += p.in[I_CONVW][((size_t)l * 4 + j) * 384 + ch0 + cidx] * xin[(t + j) * 48 + cidx];
                xc[e] = a;
            }
            __syncthreads();
            for (int e = tid; e < 64 * 48; e += NT) {
                const int t = e / 48, d = e % 48;
                float rr = p.in[I_BR][l * 384 + ch0 + d], ii = p.in[I_BI][l * 384 + ch0 + d];
                for (int cidx = 0; cidx < 48; ++cidx) { const float xv = xc[t * 48 + cidx]; rr += xv * wr[cidx * 48 + d]; ii += xv * wi[cidx * 48 + d]; }
                const float r = sigmoidf_(rr), ig = sigmoidf_(ii);
                const float lam = p.in[I_LAM][l * 384 + ch0 + d];
                const float sp = log1pf(__expf(-lam));
                const float la = -8.0f * r * sp;
                aa[e] = __expf(la);
                uu[e] = sqrtf(-expm1f(2.0f * la)) * (ig * xc[e]);
            }
            __syncthreads();
            if (tid < 48) { float hh = hs[tid]; for (int t = 0; t < 64; ++t) { hh = aa[t * 48 + tid] * hh + uu[t * 48 + tid]; uu[t * 48 + tid] = hh; } hs[tid] = hh; }
            __syncthreads();
            for (int e = tid; e < 64 * 48; e += NT) {
                const int t = e / 48, d = e % 48;
                bf16_t* y = p.proj + ((size_t)b * TSEQ + t0 + t) * NP + C_DY + ch0 + d;
                *y = f2bf(gelu_tanh(bf2f(*y)) * uu[e]);
            }
            __syncthreads();
        }
    }
}

constexpr int DIL_LDS = 8 * (64 + 320) * 4;
__device__ void phase_dil(const Params& p, int bid, int nb, unsigned char* lds) {
    const int tid = threadIdx.x, wave = tid >> 6, lane = tid & 63;
    float* sq = (float*)lds + wave * 384;
    float* sp = sq + 64;
    for (int row = bid * 8 + wave; row < NTOK; row += nb * 8) {
        const int b = row / TSEQ, t = row % TSEQ;
        for (int h = 0; h < 6; ++h) {
            sq[lane] = bf2f(p.proj[(size_t)row * NP + C_CQ + h * 64 + lane]) * 0.125f;
            __builtin_amdgcn_s_waitcnt(0);
            __builtin_amdgcn_wave_barrier();
            float lg[5]; float mx = -1e30f;
#pragma unroll
            for (int r = 0; r < 5; ++r) {
                const int j = lane + 64 * r;
                const int d = j < 129 ? j : (j < 225 ? 132 + 4 * (j - 129) : 528 + 16 * (j - 225));
                float v = -1e30f;
                if (d <= t) {
                    const bf16_t* kp = p.proj + ((size_t)b * TSEQ + (t - d)) * NP + C_CK + h * 64;
                    float a = 0.f;
#pragma unroll
                    for (int q8 = 0; q8 < 8; ++q8) {
                        const u32x4 kv = *(const u32x4*)(kp + q8 * 8);
#pragma unroll
                        for (int w = 0; w < 4; ++w) {
                            a += sq[q8 * 8 + 2 * w] * __uint_as_float(kv[w] << 16);
                            a += sq[q8 * 8 + 2 * w + 1] * __uint_as_float(kv[w] & 0xFFFF0000u);
                        }
                    }
                    v = a + p.biasC[h * 2048 + d];
                }
                lg[r] = v; mx = fmaxf(mx, v);
            }
            mx = wave_max(mx);
            float sum = 0.f;
#pragma unroll
            for (int r = 0; r < 5; ++r) { const float e = lg[r] > -1e29f ? __expf(lg[r] - mx) : 0.f; sp[lane + 64 * r] = e; sum += e; }
            sum = wave_sum(sum);
            __builtin_amdgcn_s_waitcnt(0);
            __builtin_amdgcn_wave_barrier();
            float o = 0.f;
            for (int j = 0; j < 320; ++j) {
                const int d = j < 129 ? j : (j < 225 ? 132 + 4 * (j - 129) : 528 + 16 * (j - 225));
                if (d > t) continue;
                o += sp[j] * bf2f(p.proj[((size_t)b * TSEQ + (t - d)) * NP + C_CV + h * 64 + lane]);
            }
            __builtin_amdgcn_wave_barrier();
            p.proj[(size_t)row * NP + C_CQ + h * 64 + lane] = f2bf(o / sum);
        }
    }
}

constexpr int DSA_W_FLOATS = 128 + 4 + 384 + 256 + 6 * 256 + 60;
constexpr int DSA_LDS = 8 * DSA_W_FLOATS * 4;
__device__ void phase_dsa(const Params& p, int bid, int nb, unsigned char* lds) {
    const int tid = threadIdx.x, wave = tid >> 6, lane = tid & 63;
    float* siq = (float*)lds + wave * DSA_W_FLOATS;
    float* siw = siq + 128;
    float* sq = siw + 4;
    int* sel = (int*)(sq + 384);
    float* sp = (float*)(sel + 256);
    for (int row = bid * 8 + wave; row < NTOK; row += nb * 8) {
        const int b = row / TSEQ, t = row % TSEQ;
        const bf16_t* pr = p.proj + (size_t)row * NP;
        siq[lane] = bf2f(pr[C_IQ + lane]) * 0.17677669529663687f;
        siq[64 + lane] = bf2f(pr[C_IQ + 64 + lane]) * 0.17677669529663687f;
        if (lane < 4) siw[lane] = bf2f(pr[C_IW + lane]) * 0.5f;
#pragma unroll
        for (int i = 0; i < 6; ++i) sq[i * 64 + lane] = bf2f(pr[C_BQ + i * 64 + lane]) * 0.125f;
        __builtin_amdgcn_s_waitcnt(0);
        __builtin_amdgcn_wave_barrier();
        unsigned key[32];
#pragma unroll
        for (int r = 0; r < 32; ++r) {
            const int kidx = lane + 64 * r;
            unsigned kk = 0u;
            if (r * 64 <= t) {
                if (kidx <= t) {
                    const bf16_t* kp = p.proj + ((size_t)b * TSEQ + kidx) * NP + C_IK;
                    float kf[32];
#pragma unroll
                    for (int q8 = 0; q8 < 4; ++q8) {
                        const u32x4 kv = *(const u32x4*)(kp + q8 * 8);
#pragma unroll
                        for (int w = 0; w < 4; ++w) { kf[q8 * 8 + 2 * w] = __uint_as_float(kv[w] << 16); kf[q8 * 8 + 2 * w + 1] = __uint_as_float(kv[w] & 0xFFFF0000u); }
                    }
                    float sc = 0.f;
#pragma unroll
                    for (int hh = 0; hh < 4; ++hh) {
                        float a = 0.f;
#pragma unroll
                        for (int d = 0; d < 32; ++d) a += siq[hh * 32 + d] * kf[d];
                        sc += siw[hh] * fmaxf(a, 0.f);
                    }
                    const unsigned u = __float_as_uint(sc);
                    kk = (u & 0x80000000u) ? ~u : (u | 0x80000000u);
                    if (kk == 0u) kk = 1u;
                }
            }
            key[r] = kk;
        }
        const int nvalid = t + 1;
        unsigned T = 0u; int need_eq = 0;
        if (nvalid > 256) {
            for (int bit = 31; bit >= 0; --bit) {
                const unsigned Tc = T | (1u << bit);
                int c = 0;
#pragma unroll
                for (int r = 0; r < 32; ++r) c += (key[r] >= Tc) ? 1 : 0;
                c = wave_sum_i(c);
                if (c >= 256) T = Tc;
            }
            int cgt = 0;
#pragma unroll
            for (int r = 0; r < 32; ++r) cgt += (key[r] > T) ? 1 : 0;
            cgt = wave_sum_i(cgt);
            need_eq = 256 - cgt;
        } else { T = 1u; need_eq = 0x7fffffff; }
        int base = 0, eqseen = 0;
        const unsigned long long lt = (1ull << lane) - 1ull;
#pragma unroll
        for (int r = 0; r < 32; ++r) {
            if (r * 64 <= t) {
                const bool gt = key[r] > T, eq = key[r] == T;
                const unsigned long long em = __ballot(eq);
                const int erank = eqseen + __popcll(em & lt);
                const bool take = gt || (eq && erank < need_eq);
                const unsigned long long tm = __ballot(take);
                if (take) sel[base + __popcll(tm & lt)] = lane + 64 * r;
                base += __popcll(tm); eqseen += __popcll(em);
            }
        }
        const int nsel = base;
        __builtin_amdgcn_s_waitcnt(0);
        __builtin_amdgcn_wave_barrier();
        float lg[4][6]; float mx[6];
#pragma unroll
        for (int hh = 0; hh < 6; ++hh) mx[hh] = -1e30f;
#pragma unroll
        for (int rr = 0; rr < 4; ++rr) {
            const int j = lane + 64 * rr;
#pragma unroll
            for (int hh = 0; hh < 6; ++hh) lg[rr][hh] = -1e30f;
            if (j < nsel) {
                const int kidx = sel[j];
                const bf16_t* kp = p.proj + ((size_t)b * TSEQ + kidx) * NP + C_BK;
#pragma unroll
                for (int hh = 0; hh < 6; ++hh) {
                    float a = 0.f;
#pragma unroll
                    for (int q8 = 0; q8 < 8; ++q8) {
                        const u32x4 kv = *(const u32x4*)(kp + hh * 64 + q8 * 8);
#pragma unroll
                        for (int w = 0; w < 4; ++w) {
                            a += sq[hh * 64 + q8 * 8 + 2 * w] * __uint_as_float(kv[w] << 16);
                            a += sq[hh * 64 + q8 * 8 + 2 * w + 1] * __uint_as_float(kv[w] & 0xFFFF0000u);
                        }
                    }
                    a += p.biasB[hh * 2048 + (t - kidx)];
                    lg[rr][hh] = a; mx[hh] = fmaxf(mx[hh], a);
                }
            }
        }
        float sm[6];
#pragma unroll
        for (int hh = 0; hh < 6; ++hh) {
            mx[hh] = wave_max(mx[hh]);
            float s = 0.f;
#pragma unroll
            for (int rr = 0; rr < 4; ++rr) { const float e = lg[rr][hh] > -1e29f ? __expf(lg[rr][hh] - mx[hh]) : 0.f; sp[hh * 256 + lane + 64 * rr] = e; s += e; }
            sm[hh] = wave_sum(s);
        }
        __builtin_amdgcn_s_waitcnt(0);
        __builtin_amdgcn_wave_barrier();
        float o[6];
#pragma unroll
        for (int hh = 0; hh < 6; ++hh) o[hh] = 0.f;
        for (int j = 0; j < nsel; ++j) {
            const bf16_t* vp = p.proj + ((size_t)b * TSEQ + sel[j]) * NP + C_BV + lane;
#pragma unroll
            for (int hh = 0; hh < 6; ++hh) o[hh] += sp[hh * 256 + j] * bf2f(vp[hh * 64]);
        }
        __builtin_amdgcn_wave_barrier();
        bf16_t* op = p.proj + (size_t)row * NP + C_BQ + lane;
#pragma unroll
        for (int hh = 0; hh < 6; ++hh) op[hh * 64] = f2bf(o[hh] / sm[hh]);
    }
}

constexpr int MG_LDS = G_LDS + 1024 + 32 * NT * 4;
__device__ void phase_merge(const Params& p, int l, int bid, int nb, unsigned char* lds) {
    const GemmCtx c = gemm_ctx();
    float* srstd = (float*)(lds + G_LDS);
    unsigned* sgate = (unsigned*)(lds + G_LDS + 1024);
    constexpr int NCT = DM / 128, NU = (NTOK / 256) * NCT;
    const float* bg = p.in[I_BGATE] + (size_t)l * 4 * DM;
    for (int u = bid; u < NU; u += nb) {
        const int rt = u / NCT, ct = u % NCT, brow = rt * 256, bcol = ct * 128;
        if (c.tid < 256) srstd[c.tid] = rstd_of(p.part, brow + c.tid);
        __syncthreads();
        f32x4 mg[4][4]; acc_zero(mg);
        const int r = c.tid >> 2;
        for (int i = 0; i < 4; ++i) {
            f32x4 acc[4][4]; acc_zero(acc);
            gemm_kloop(acc, p.hb + (size_t)(brow + r) * DM, p.hb + (size_t)(brow + r + 128) * DM, p.Bt_gate + ((size_t)i * DM + bcol + r) * DM, DM / 32, lds, c);
#pragma unroll
            for (int m = 0; m < 4; ++m)
#pragma unroll
                for (int n = 0; n < 4; ++n) {
                    const float bv = bg[i * DM + bcol + c.wc * 64 + n * 16 + c.fr];
                    float g[4];
#pragma unroll
                    for (int j = 0; j < 4; ++j) g[j] = sigmoidf_(acc[m][n][j] * srstd[c.wr * 64 + m * 16 + c.fq * 4 + j] + bv);
                    sgate[((m * 4 + n) * 2 + 0) * NT + c.tid] = (unsigned)f2bf(g[0]) | ((unsigned)f2bf(g[1]) << 16);
                    sgate[((m * 4 + n) * 2 + 1) * NT + c.tid] = (unsigned)f2bf(g[2]) | ((unsigned)f2bf(g[3]) << 16);
                }
            acc_zero(acc);
            gemm_kloop(acc, p.proj + (size_t)(brow + r) * NP + C_OB + i * 384, p.proj + (size_t)(brow + r + 128) * NP + C_OB + i * 384,
                       p.Bt_br + ((size_t)i * DM + bcol + r) * 384, 384 / 32, lds, c);
#pragma unroll
            for (int m = 0; m < 4; ++m)
#pragma unroll
                for (int n = 0; n < 4; ++n) {
                    const unsigned g0 = sgate[((m * 4 + n) * 2 + 0) * NT + c.tid], g1 = sgate[((m * 4 + n) * 2 + 1) * NT + c.tid];
                    mg[m][n][0] += __uint_as_float(g0 << 16) * acc[m][n][0];
                    mg[m][n][1] += __uint_as_float(g0 & 0xFFFF0000u) * acc[m][n][1];
                    mg[m][n][2] += __uint_as_float(g1 << 16) * acc[m][n][2];
                    mg[m][n][3] += __uint_as_float(g1 & 0xFFFF0000u) * acc[m][n][3];
                }
        }
#pragma unroll
        for (int m = 0; m < 4; ++m)
#pragma unroll
            for (int j = 0; j < 4; ++j) {
                const int rl = c.wr * 64 + m * 16 + c.fq * 4 + j;
                bf16_t* o = p.proj + (size_t)(brow + rl) * NP + C_MG + bcol + c.wc * 64 + c.fr;
#pragma unroll
                for (int n = 0; n < 4; ++n) o[n * 16] = f2bf(mg[m][n][j]);
            }
        __syncthreads();
    }
}

__device__ void phase_out(const Params& p, int l, int bid, int nb, unsigned char* lds) {
    const GemmCtx c = gemm_ctx();
    constexpr int NCT = DM / 128, NU = (NTOK / 256) * NCT;
    const float* hin = (l == 0) ? p.in[I_X] : p.h;
    for (int u = bid; u < NU; u += nb) {
        const int rt = u / NCT, ct = u % NCT, brow = rt * 256, bcol = ct * 128;
        f32x4 acc[4][4]; acc_zero(acc);
        const int r = c.tid >> 2;
        gemm_kloop(acc, p.proj + (size_t)(brow + r) * NP + C_MG, p.proj + (size_t)(brow + r + 128) * NP + C_MG, p.Bt_out + (size_t)(bcol + r) * DM, DM / 32, lds, c);
#pragma unroll
        for (int m = 0; m < 4; ++m)
#pragma unroll
            for (int j = 0; j < 4; ++j) {
                const int row = brow + c.wr * 64 + m * 16 + c.fq * 4 + j;
                const size_t off = (size_t)row * DM + bcol + c.wc * 64 + c.fr;
                float ss = 0.f;
#pragma unroll
                for (int n = 0; n < 4; ++n) { const float v = hin[off + n * 16] + acc[m][n][j]; p.h[off + n * 16] = v; p.hb[off + n * 16] = f2bf(v); ss += v * v; }
                ss += __shfl_xor(ss, 1); ss += __shfl_xor(ss, 2); ss += __shfl_xor(ss, 4); ss += __shfl_xor(ss, 8);
                if (c.fr == 0) p.part[(size_t)row * 16 + ct * 2 + c.wc] = ss;
            }
    }
}

constexpr int RT_LDS = 1024 * 20 * 4;
__device__ void phase_router(const Params& p, int l, int bid, int nb, unsigned char* lds) {
    float* W = (float*)lds;
    const int tid = threadIdx.x, wave = tid >> 6, lane = tid & 63;
    const float* n2 = p.in[I_N2] + l * DM;
    const float* wrg = p.in[I_WRG] + (size_t)l * DM * 4;
    const float* wre = p.in[I_WRE] + (size_t)l * DM * 16;
    for (int i = tid; i < 1024 * 20; i += NT) { const int k = i / 20, j = i % 20; W[i] = n2[k] * (j < 4 ? wrg[k * 4 + j] : wre[k * 16 + (j - 4)]); }
    __syncthreads();
    int* cnt = p.cnt + l * 32;
    for (int row = bid * 8 + wave; row < NTOK; row += nb * 8) {
        float pr = p.part[(size_t)row * 16 + (lane & 15)];
        pr += __shfl_xor(pr, 1); pr += __shfl_xor(pr, 2); pr += __shfl_xor(pr, 4); pr += __shfl_xor(pr, 8);
        const float rs = rsqrtf(pr * (1.0f / 1024.0f) + EPS);
        float a[20];
#pragma unroll
        for (int j = 0; j < 20; ++j) a[j] = 0.f;
#pragma unroll 1
        for (int i = 0; i < 16; ++i) {
            const float hv = p.h[(size_t)row * DM + i * 64 + lane];
            const float* w = W + (i * 64 + lane) * 20;
#pragma unroll
            for (int j = 0; j < 20; ++j) a[j] += hv * w[j];
        }
#pragma unroll
        for (int j = 0; j < 20; ++j) a[j] = wave_sum(a[j]);
        if (lane == 0) {
            float gl[4];
#pragma unroll
            for (int j = 0; j < 4; ++j) gl[j] = a[j] * rs + p.in[I_BRG][l * 4 + j];
            int g = 0; float gm = gl[0];
#pragma unroll
            for (int j = 1; j < 4; ++j) if (gl[j] > gm) { gm = gl[j]; g = j; }
            float den = 0.f;
#pragma unroll
            for (int j = 0; j < 4; ++j) den += __expf(gl[j] - gm);
            const float gw = 1.0f / den;
            float el[4];
#pragma unroll
            for (int j = 0; j < 4; ++j) {
                float v = 0.f;
#pragma unroll
                for (int gg = 0; gg < 4; ++gg) v = (gg == g) ? (a[4 + gg * 4 + j] * rs + p.in[I_BRE][l * 16 + gg * 4 + j]) : v;
                el[j] = v;
            }
            int i1 = 0; float v1 = el[0];
#pragma unroll
            for (int j = 1; j < 4; ++j) if (el[j] > v1) { v1 = el[j]; i1 = j; }
            int i2 = -1; float v2 = -3.0e38f;
#pragma unroll
            for (int j = 0; j < 4; ++j) if (j != i1 && el[j] > v2) { v2 = el[j]; i2 = j; }
            const float e2 = __expf(v2 - v1);
            const float w1 = gw / (1.0f + e2), w2 = gw * e2 / (1.0f + e2);
            const int lo = i1 < i2 ? i1 : i2, hi = i1 < i2 ? i2 : i1;
            const float wlo = i1 < i2 ? w1 : w2, whi = i1 < i2 ? w2 : w1;
            const int pidx = lo == 0 ? (hi - 1) : (lo == 1 ? (hi + 1) : 5);
            const int cls = g * 6 + pidx;
            const int pos = __hip_atomic_fetch_add(&cnt[cls], 1, __ATOMIC_RELAXED, __HIP_MEMORY_SCOPE_AGENT);
            p.perm[(size_t)cls * NTOK + pos] = row;
            p.tokw[(size_t)row * 2] = wlo; p.tokw[(size_t)row * 2 + 1] = whi;
        }
    }
}

__device__ __forceinline__ void cls_experts(int cls, int& elo, int& ehi) {
    const int g = cls / 6, pi = cls % 6;
    const int lo = pi < 3 ? 0 : (pi < 5 ? 1 : 2), hi = pi < 3 ? pi + 1 : (pi < 5 ? pi - 1 : 3);
    elo = g * 4 + lo; ehi = g * 4 + hi;
}
__device__ __forceinline__ void moe_prefix(const int* cnt, int* spre, int* scnt) {
    if (threadIdx.x == 0) { int s = 0; for (int c = 0; c < NCLS; ++c) { const int n = cnt[c]; scnt[c] = n; spre[c] = s; s += (n + 255) >> 8; } spre[NCLS] = s; }
    __syncthreads();
}

__device__ void phase_moe1(const Params& p, int l, int bid, int nb, unsigned char* lds) {
    const GemmCtx c = gemm_ctx();
    int* spre = (int*)(lds + G_LDS); int* scnt = spre + 32;
    int* stok = scnt + 32; float* srs = (float*)(stok + 256); float* swl = srs + 256; float* swh = swl + 256;
    moe_prefix(p.cnt + l * 32, spre, scnt);
    const int nrt = spre[NCLS], NU = nrt * 16;
    for (int u = bid; u < NU; u += nb) {
        const int rt = u >> 4, ct = u & 15;
        int cls = 0;
        for (int q = 1; q < NCLS; ++q) if (spre[q] <= rt) cls = q;
        int elo, ehi; cls_experts(cls, elo, ehi);
        const int lrow0 = (rt - spre[cls]) * 256, n = scnt[cls];
        if (c.tid < 256) {
            const int lr = lrow0 + c.tid; const bool ok = lr < n;
            const int tok = ok ? p.perm[(size_t)cls * NTOK + lr] : 0;
            stok[c.tid] = ok ? tok : -1; srs[c.tid] = rstd_of(p.part, tok);
            swl[c.tid] = p.tokw[(size_t)tok * 2]; swh[c.tid] = p.tokw[(size_t)tok * 2 + 1];
        }
        __syncthreads();
        const int r = c.tid >> 2;
        const int t0 = stok[r] < 0 ? 0 : stok[r], t1 = stok[r + 128] < 0 ? 0 : stok[r + 128];
        const int ex = ct < 8 ? elo : ehi;
        f32x4 acc[4][4]; acc_zero(acc);
        gemm_kloop(acc, p.hb + (size_t)t0 * DM, p.hb + (size_t)t1 * DM, p.Wgu + ((size_t)ex * DM + (ct & 7) * 128 + r) * DM, DM / 32, lds, c);
#pragma unroll
        for (int m = 0; m < 4; ++m)
#pragma unroll
            for (int j = 0; j < 4; ++j) {
                const int rl = c.wr * 64 + m * 16 + c.fq * 4 + j; const float rs = srs[rl], w = ct < 8 ? swl[rl] : swh[rl];
                bf16_t* o = p.Hbuf + ((size_t)rt * 256 + rl) * DM + (ct < 8 ? 0 : 512) + (ct & 7) * 64 + c.wc * 32 + c.fr;
#pragma unroll
                for (int n2 = 0; n2 < 2; ++n2) { const float g = acc[m][n2][j] * rs, uu = acc[m][n2 + 2][j] * rs; o[n2 * 16] = f2bf(siluf_(g) * uu * w); }
            }
        __syncthreads();
    }
}

__device__ void phase_moe2(const Params& p, int l, int bid, int nb, unsigned char* lds) {
    const GemmCtx c = gemm_ctx();
    int* spre = (int*)(lds + G_LDS); int* scnt = spre + 32; int* stok = scnt + 32;
    moe_prefix(p.cnt + l * 32, spre, scnt);
    const int nrt = spre[NCLS], NU = nrt * 8;
    for (int u = bid; u < NU; u += nb) {
        const int rt = u >> 3, ct = u & 7;
        int cls = 0;
        for (int q = 1; q < NCLS; ++q) if (spre[q] <= rt) cls = q;
        int elo, ehi; cls_experts(cls, elo, ehi);
        const int lrow0 = (rt - spre[cls]) * 256, n = scnt[cls];
        if (c.tid < 256) { const int lr = lrow0 + c.tid; stok[c.tid] = lr < n ? p.perm[(size_t)cls * NTOK + lr] : -1; }
        __syncthreads();
        const int r = c.tid >> 2;
        f32x4 acc[4][4]; acc_zero(acc);
        const bf16_t* a0 = p.Hbuf + ((size_t)rt * 256 + r) * DM; const bf16_t* a1 = a0 + (size_t)128 * DM;
        gemm_kloop(acc, a0, a1, p.WdT + ((size_t)elo * DM + ct * 128 + r) * 512, 16, lds, c);
        gemm_kloop(acc, a0 + 512, a1 + 512, p.WdT + ((size_t)ehi * DM + ct * 128 + r) * 512, 16, lds, c);
#pragma unroll
        for (int m = 0; m < 4; ++m)
#pragma unroll
            for (int j = 0; j < 4; ++j) {
                const int rl = c.wr * 64 + m * 16 + c.fq * 4 + j; const int tok = stok[rl];
                const size_t off = (size_t)(tok < 0 ? 0 : tok) * DM + ct * 128 + c.wc * 64 + c.fr;
                float ss = 0.f;
                if (tok >= 0) {
#pragma unroll
                    for (int n2 = 0; n2 < 4; ++n2) { const float v = p.h[off + n2 * 16] + acc[m][n2][j]; p.h[off + n2 * 16] = v; p.hb[off + n2 * 16] = f2bf(v); ss += v * v; }
                }
                ss += __shfl_xor(ss, 1); ss += __shfl_xor(ss, 2); ss += __shfl_xor(ss, 4); ss += __shfl_xor(ss, 8);
                if (c.fr == 0 && tok >= 0) p.part[(size_t)tok * 16 + ct * 2 + c.wc] = ss;
            }
        __syncthreads();
    }
}

__device__ void phase_final(const Params& p, int bid, int nb) {
    const int tid = threadIdx.x, wave = tid >> 6, lane = tid & 63;
    const float* nf = p.in[I_NF];
    for (int row = bid * 8 + wave; row < NTOK; row += nb * 8) {
        const float rs = rstd_of(p.part, row);
        float* hr = p.h + (size_t)row * DM;
#pragma unroll
        for (int i = 0; i < 4; ++i) {
            f32x4 v = *(const f32x4*)(hr + i * 256 + lane * 4);
            const f32x4 g = *(const f32x4*)(nf + i * 256 + lane * 4);
            v[0] *= rs * g[0]; v[1] *= rs * g[1]; v[2] *= rs * g[2]; v[3] *= rs * g[3];
            *(f32x4*)(hr + i * 256 + lane * 4) = v;
        }
    }
}

extern __shared__ __attribute__((aligned(16))) unsigned char dyn_lds[];
__global__ void __launch_bounds__(NT, 2) k_weights(Params p, int l) { phase_weights(p, l, blockIdx.x, gridDim.x, dyn_lds); }
__global__ void __launch_bounds__(NT, 2) k_prep(Params p) { phase_prep(p, blockIdx.x, gridDim.x); }
__global__ void __launch_bounds__(NT, 2) k_inproj(Params p) { phase_inproj(p, blockIdx.x, gridDim.x, dyn_lds); }
__global__ void __launch_bounds__(NT, 2) k_gla(Params p, int l) { phase_gla(p, l, blockIdx.x, gridDim.x, dyn_lds); }
__global__ void __launch_bounds__(NT, 2) k_lru(Params p, int l) { phase_lru(p, l, blockIdx.x, gridDim.x, dyn_lds); }
__global__ void __launch_bounds__(NT, 2) k_dil(Params p) { phase_dil(p, blockIdx.x, gridDim.x, dyn_lds); }
__global__ void __launch_bounds__(NT, 2) k_dsa(Params p) { phase_dsa(p, blockIdx.x, gridDim.x, dyn_lds); }
__global__ void __launch_bounds__(NT, 2) k_merge(Params p, int l) { phase_merge(p, l, blockIdx.x, gridDim.x, dyn_lds); }
__global__ void __launch_bounds__(NT, 2) k_out(Params p, int l) { phase_out(p, l, blockIdx.x, gridDim.x, dyn_lds); }
__global__ void __launch_bounds__(NT, 2) k_router(Params p, int l) { phase_router(p, l, blockIdx.x, gridDim.x, dyn_lds); }
__global__ void __launch_bounds__(NT, 2) k_moe1(Params p, int l) { phase_moe1(p, l, blockIdx.x, gridDim.x, dyn_lds); }
__global__ void __launch_bounds__(NT, 2) k_moe2(Params p, int l) { phase_moe2(p, l, blockIdx.x, gridDim.x, dyn_lds); }
__global__ void __launch_bounds__(NT, 2) k_final(Params p) { phase_final(p, blockIdx.x, gridDim.x); }

static size_t align_up(size_t v, size_t a) { return (v + a - 1) / a * a; }

extern "C" void kernel_launch(void* const* d_in, const int* in_sizes, int n_in, void* d_out, int out_size, void* d_ws, size_t ws_size, hipStream_t stream) {
    (void)in_sizes; (void)n_in; (void)out_size; (void)ws_size;
    Params p{};
    for (int i = 0; i < N_IN; ++i) p.in[i] = (const float*)d_in[i];
    p.h = (float*)d_out;
    unsigned char* w = (unsigned char*)d_ws; size_t off = 0;
    auto take = [&](size_t bytes) { unsigned char* r = w + off; off = align_up(off + bytes, 256); return r; };
    p.bar = (unsigned*)take(16384);
    p.cnt = (int*)take(DEPTH * 32 * 4);
    p.Bt_in = (bf16_t*)take((size_t)NP * DM * 2);
    p.Bt_gate = (bf16_t*)take((size_t)4 * DM * DM * 2);
    p.Bt_br = (bf16_t*)take((size_t)4 * DM * 384 * 2);
    p.Bt_out = (bf16_t*)take((size_t)DM * DM * 2);
    p.Wgu = (bf16_t*)take((size_t)16 * DM * DM * 2);
    p.WdT = (bf16_t*)take((size_t)16 * DM * 512 * 2);
    p.hb = (bf16_t*)take((size_t)NTOK * DM * 2);
    p.part = (float*)take((size_t)NTOK * 16 * 4);
    p.biasB = (float*)take(6 * 2048 * 4);
    p.biasC = (float*)take(6 * 2048 * 4);
    p.tokw = (float*)take((size_t)NTOK * 2 * 4);
    p.perm = (int*)take((size_t)NCLS * NTOK * 4);
    p.proj = (bf16_t*)take((size_t)NTOK * NP * 2);
    p.Hbuf = p.proj;

    static bool attr_done = false;
    if (!attr_done) {
        (void)hipFuncSetAttribute((const void*)k_gla, hipFuncAttributeMaxDynamicSharedMemorySize, GLA_LDS);
        (void)hipFuncSetAttribute((const void*)k_lru, hipFuncAttributeMaxDynamicSharedMemorySize, LRU_LDS);
        (void)hipFuncSetAttribute((const void*)k_router, hipFuncAttributeMaxDynamicSharedMemorySize, RT_LDS);
        (void)hipFuncSetAttribute((const void*)k_dsa, hipFuncAttributeMaxDynamicSharedMemorySize, DSA_LDS);
        (void)hipFuncSetAttribute((const void*)k_merge, hipFuncAttributeMaxDynamicSharedMemorySize, MG_LDS);
        attr_done = true;
    }
    const int G = 256;
    k_prep<<<G * 2, NT, 0, stream>>>(p);
    for (int l = 0; l < DEPTH; ++l) {
        k_weights<<<G * 2, NT, 64 * 65 * 4, stream>>>(p, l);
        k_inproj<<<G * 2, NT, G_LDS + 1024, stream>>>(p);
        k_gla<<<64, NT, GLA_LDS, stream>>>(p, l);
        k_lru<<<128, NT, LRU_LDS, stream>>>(p, l);
        k_dil<<<G * 2, NT, DIL_LDS, stream>>>(p);
        k_dsa<<<G * 2, NT, DSA_LDS, stream>>>(p);
        k_merge<<<G * 2, NT, MG_LDS, stream>>>(p, l);
        k_out<<<G * 2, NT, G_LDS, stream>>>(p, l);
        k_router<<<G, NT, RT_LDS, stream>>>(p, l);
        k_moe1<<<G * 2, NT, G_LDS + 4096 + 256, stream>>>(p, l);
        k_moe2<<<G * 2, NT, G_LDS + 2048, stream>>>(p, l);
    }
    k_final<<<G * 2, NT, 0, stream>>>(p);
}
```

```cpp
#include <hip/hip_runtime.h>
#include <stdint.h>

typedef unsigned short bf16_t;
typedef short bf16x8 __attribute__((ext_vector_type(8)));
typedef float f32x4 __attribute__((ext_vector_type(4)));
typedef unsigned u32x4 __attribute__((ext_vector_type(4)));

constexpr int NTOK = 32768, TSEQ = 2048, NBATCH = 16, DM = 1024, DEPTH = 2;
constexpr int NP = 4608;
constexpr int NT = 512;
constexpr int C_AQ = 0, C_AK = 192, C_AV = 384, C_AG = 768, C_BQ = 1152, C_CQ = 1536, C_DY = 1920, C_BK = 2304, C_BV = 2688,
              C_CK = 3072, C_CV = 3456, C_DX = 3840, C_IQ = 4224, C_IK = 4352, C_ALR = 4384, C_IW = 4400;
constexpr int C_OB = 768;
constexpr int C_MG = 2304;
constexpr float EPS = 1e-6f;
constexpr int NCLS = 24, MAXRT = 152;

enum { I_X = 0, I_WIN, I_AW2, I_AB2, I_AGAIN, I_CONVW, I_CONVB, I_WR, I_BR, I_WI, I_BI, I_LAM, I_WGATE, I_BGATE, I_WBR, I_WOUT, I_RELB,
       I_N1, I_N2, I_NF, I_WRG, I_BRG, I_WRE, I_BRE, I_MWG, I_MWU, I_MWD, N_IN };

struct Params {
    const float* in[N_IN];
    float* h;
    bf16_t* Bt_in;
    bf16_t* Bt_gate;
    bf16_t* Bt_br;
    bf16_t* Bt_out;
    bf16_t* Wgu;
    bf16_t* WdT;
    bf16_t* hb;
    bf16_t* proj;
    bf16_t* Hbuf;
    float* part;
    float* biasB;
    float* biasC;
    float* tokw;
    int* perm;
    int* cnt;
    unsigned* bar;
};

__device__ __forceinline__ bf16_t f2bf(float f) { unsigned u = __float_as_uint(f); u += 0x7FFFu + ((u >> 16) & 1u); return (bf16_t)(u >> 16); }
__device__ __forceinline__ float bf2f(bf16_t b) { return __uint_as_float(((unsigned)b) << 16); }
__device__ __forceinline__ float wave_sum(float v) {
#pragma unroll
    for (int o = 32; o > 0; o >>= 1) v += __shfl_xor(v, o);
    return v;
}
__device__ __forceinline__ float wave_max(float v) {
#pragma unroll
    for (int o = 32; o > 0; o >>= 1) v = fmaxf(v, __shfl_xor(v, o));
    return v;
}
__device__ __forceinline__ int wave_sum_i(int v) {
#pragma unroll
    for (int o = 32; o > 0; o >>= 1) v += __shfl_xor(v, o);
    return v;
}
__device__ __forceinline__ int opaque_tid() { int t = threadIdx.x; asm volatile("" : "+v"(t)); return t; }
__device__ __forceinline__ float sigmoidf_(float x) { return 1.0f / (1.0f + __expf(-x)); }
__device__ __forceinline__ float siluf_(float x) { return x / (1.0f + __expf(-x)); }
__device__ __forceinline__ float rstd_of(const float* part, int row) {
    const f32x4* p = (const f32x4*)(part + (size_t)row * 16);
    f32x4 a = p[0], b = p[1], c = p[2], d = p[3];
    float s = ((a[0] + a[1]) + (a[2] + a[3])) + ((b[0] + b[1]) + (b[2] + b[3])) + ((c[0] + c[1]) + (c[2] + c[3])) + ((d[0] + d[1]) + (d[2] + d[3]));
    return rsqrtf(s * (1.0f / 1024.0f) + EPS);
}
__device__ __forceinline__ int map_in_col(int c) {
    if (c < 1152) return c;
    if (c < 1536) return 1168 + (c - 1152);
    if (c < 1920) return 2484 + (c - 1536);
    if (c < 2304) return 3636 + (c - 1920);
    if (c < 2688) return 1552 + (c - 2304);
    if (c < 3072) return 1936 + (c - 2688);
    if (c < 3456) return 2868 + (c - 3072);
    if (c < 3840) return 3252 + (c - 3456);
    if (c < 4224) return 4020 + (c - 3840);
    if (c < 4352) return 2320 + (c - 4224);
    if (c < 4384) return 2448 + (c - 4352);
    if (c < 4400) return 1152 + (c - 4384);
    if (c < 4404) return 2480 + (c - 4400);
    return -1;
}
__device__ __forceinline__ int rel_bucket(int n) {
    if (n < 16) return n;
    float v = logf((float)n / 16.0f) / 4.852030263919617f * 16.0f;
    int b = 16 + (int)v;
    return b < 31 ? b : 31;
}

#define XB_TMO      128
#define XB_XCNT(j)  (256  + 64 * (j))
#define XB_XSUB(j)  (1280 + 64 * (j))
#define XB_XGEN(j)  (2304 + 64 * (j))
#define XB_TOP      3328
#define XB_TOPGEN   3392
#define XCD_BAR_WORDS 3456
#define XB_SPIN_CAP (1u << 18)
#define LAS __attribute__((address_space(3)))

__device__ __forceinline__ unsigned xb_ld(unsigned* p)              { return __hip_atomic_load(p, __ATOMIC_RELAXED, __HIP_MEMORY_SCOPE_AGENT); }
__device__ __forceinline__ unsigned xb_add(unsigned* p, unsigned v) { return __hip_atomic_fetch_add(p, v, __ATOMIC_RELAXED, __HIP_MEMORY_SCOPE_AGENT); }
__device__ __forceinline__ unsigned xb_xcc_id() { return (unsigned)__builtin_amdgcn_s_getreg((3 << 11) | 20) & 0xFu; }
#define XB_SPIN(cond, bar) do { unsigned _sp = 0; while (cond) { __builtin_amdgcn_s_sleep(1); \
    if ((++_sp & 255u) == 0u) { if (xb_ld(&(bar)[XB_TMO])) break; if (_sp > XB_SPIN_CAP) { atomicAdd(&(bar)[XB_TMO], 1u); break; } } } } while (0)

struct XcdBarrier {
    unsigned* bar; unsigned x;
    volatile LAS unsigned* st;
};

__device__ __forceinline__ XcdBarrier xcd_barrier_post(unsigned* bar, volatile LAS unsigned* st) {
    XcdBarrier b; b.bar = bar; b.x = xb_xcc_id(); b.st = st;
    if (threadIdx.x == 0) (void)xb_add(&bar[XB_XCNT(b.x)], 1u);
    return b;
}
__device__ __forceinline__ void xcd_barrier_complete(unsigned* bar, unsigned x, unsigned& nloc, unsigned& nx) {
    const unsigned G = gridDim.x * gridDim.y * gridDim.z;
    unsigned sum, cnt, mine, sp = 0u;
    for (;;) {
        sum = 0u; cnt = 0u; mine = 0u;
#pragma unroll
        for (unsigned j = 0; j < 16; ++j) { const unsigned c = xb_ld(&bar[XB_XCNT(j)]); sum += c; cnt += (c > 0u) ? 1u : 0u; mine = (j == x) ? c : mine; }
        if (sum == G) break;
        __builtin_amdgcn_s_sleep(1);
        if ((++sp & 255u) == 0u) { if (xb_ld(&bar[XB_TMO])) break; if (sp > XB_SPIN_CAP) { atomicAdd(&bar[XB_TMO], 1u); break; } }
    }
    nloc = mine > 0u ? mine : 1u; nx = cnt > 0u ? cnt : 1u;
}

__device__ __forceinline__ void xcd_barrier(const XcdBarrier& b) {
    asm volatile("s_waitcnt vmcnt(0)" ::: "memory");
    __syncthreads();
    if (threadIdx.x == 0) {
        unsigned* bar = b.bar;
        __builtin_amdgcn_s_waitcnt(0);
        unsigned nloc = b.st[0], nx = b.st[1];
        if (nloc == 0u) { xcd_barrier_complete(bar, b.x, nloc, nx); b.st[0] = nloc; b.st[1] = nx; }
        const unsigned old = xb_add(&bar[XB_XSUB(b.x)], 1u);
        const unsigned gen = old / nloc;
        if (old + 1u == (gen + 1u) * nloc) {
            __builtin_amdgcn_fence(__ATOMIC_RELEASE, "agent");
            asm volatile("s_waitcnt vmcnt(0)" ::: "memory");
            const unsigned og = xb_add(&bar[XB_TOP], 1u);
            const unsigned tg = og / nx;
            if (og + 1u == (tg + 1u) * nx) xb_add(&bar[XB_TOPGEN], 1u);
            else XB_SPIN(xb_ld(&bar[XB_TOPGEN]) == tg, bar);
            __builtin_amdgcn_fence(__ATOMIC_ACQUIRE, "agent");
            xb_add(&bar[XB_XGEN(b.x)], 1u);
            asm volatile("s_waitcnt vmcnt(0)" ::: "memory");
        } else {
            XB_SPIN(xb_ld(&bar[XB_XGEN(b.x)]) == gen, bar);
            __builtin_amdgcn_fence(__ATOMIC_ACQUIRE, "agent");
            asm volatile("s_waitcnt vmcnt(0)" ::: "memory");
        }
    }
    __syncthreads();
}


template <class MapF>
__device__ __forceinline__ void conv_wT(const float* __restrict__ src, int ldsrc, int K, bf16_t* __restrict__ dst, int nrows, MapF colmap,
                                        const float* __restrict__ scale, int bid, int nb, float* tile) {
    const int tid = opaque_tid(), nkt = K / 64, ntile = (nrows / 64) * nkt;
    for (int t = bid; t < ntile; t += nb) {
        const int r0 = (t / nkt) * 64, k0 = (t % nkt) * 64;
#pragma unroll
        for (int i = 0; i < 8; ++i) {
            const int e = tid + NT * i, kk = e >> 6, rr = e & 63;
            const int c = colmap(r0 + rr);
            float v = 0.f;
            if (c >= 0) { v = src[(size_t)(k0 + kk) * ldsrc + c]; if (scale) v *= scale[k0 + kk]; }
            tile[kk * 65 + rr] = v;
        }
        __syncthreads();
#pragma unroll
        for (int i = 0; i < 8; ++i) {
            const int e = tid + NT * i, rr = e >> 6, kk = e & 63;
            dst[(size_t)(r0 + rr) * K + k0 + kk] = f2bf(tile[kk * 65 + rr]);
        }
        __syncthreads();
    }
}

__device__ void phase_weights(const Params& p, int l, int bid, int nb, unsigned char* lds) {
    float* tile = (float*)lds;
    const float* n1 = p.in[I_N1] + l * DM;
    const float* n2 = p.in[I_N2] + l * DM;
    conv_wT(p.in[I_WIN] + (size_t)l * DM * 4404, 4404, DM, p.Bt_in, NP, [](int r) { return map_in_col(r); }, n1, bid, nb, tile);
    for (int i = 0; i < 4; ++i) {
        conv_wT(p.in[I_WGATE] + ((size_t)l * 4 + i) * DM * DM, DM, DM, p.Bt_gate + (size_t)i * DM * DM, DM, [](int r) { return r; }, n1, bid, nb, tile);
        conv_wT(p.in[I_WBR] + ((size_t)l * 4 + i) * 384 * DM, DM, 384, p.Bt_br + (size_t)i * DM * 384, DM, [](int r) { return r; }, nullptr, bid, nb, tile);
    }
    conv_wT(p.in[I_WOUT] + (size_t)l * DM * DM, DM, DM, p.Bt_out, DM, [](int r) { return r; }, nullptr, bid, nb, tile);
    for (int e = 0; e < 16; ++e) {
        const float* wg = p.in[I_MWG] + ((size_t)l * 16 + e) * DM * 512;
        const float* wu = p.in[I_MWU] + ((size_t)l * 16 + e) * DM * 512;
        bf16_t* dst = p.Wgu + (size_t)e * DM * DM;
        {
            const int tid = opaque_tid();
            for (int t = bid; t < 16 * 16; t += nb) {
                const int r0 = (t / 16) * 64, k0 = (t % 16) * 64;
#pragma unroll
                for (int i = 0; i < 8; ++i) {
                    const int ee = tid + NT * i, kk = ee >> 6, rr = ee & 63, rho = r0 + rr;
                    const int T = rho >> 7, wc = (rho >> 6) & 1, q = (rho >> 5) & 1, ii = rho & 31, hcol = 64 * T + 32 * wc + ii;
                    const float* s = q ? wu : wg;
                    tile[kk * 65 + rr] = s[(size_t)(k0 + kk) * 512 + hcol] * n2[k0 + kk];
                }
                __syncthreads();
#pragma unroll
                for (int i = 0; i < 8; ++i) {
                    const int ee = tid + NT * i, rr = ee >> 6, kk = ee & 63;
                    dst[(size_t)(r0 + rr) * DM + k0 + kk] = f2bf(tile[kk * 65 + rr]);
                }
                __syncthreads();
            }
        }
        conv_wT(p.in[I_MWD] + ((size_t)l * 16 + e) * 512 * DM, DM, 512, p.WdT + (size_t)e * DM * 512, DM, [](int r) { return r; }, nullptr, bid, nb, tile);
    }
}

__device__ void phase_prep(const Params& p, int bid, int nb) {
    const int tid = opaque_tid(), wave = tid >> 6, lane = tid & 63;
    const float* x = p.in[I_X];
    for (int row = bid * 8 + wave; row < NTOK; row += nb * 8) {
        const float* xr = x + (size_t)row * DM;
        float s = 0.f;
#pragma unroll
        for (int i = 0; i < 4; ++i) {
            const f32x4 v = *(const f32x4*)(xr + i * 256 + lane * 4);
            s += v[0] * v[0] + v[1] * v[1] + v[2] * v[2] + v[3] * v[3];
            const unsigned lo = (unsigned)f2bf(v[0]) | ((unsigned)f2bf(v[1]) << 16), hi = (unsigned)f2bf(v[2]) | ((unsigned)f2bf(v[3]) << 16);
            *(uint2*)(p.hb + (size_t)row * DM + i * 256 + lane * 4) = make_uint2(lo, hi);
        }
        s = wave_sum(s);
        if (lane < 16) p.part[(size_t)row * 16 + lane] = (lane == 0) ? s : 0.f;
    }
    const float* rb = p.in[I_RELB];
    for (int i = bid * NT + tid; i < 6 * 2048; i += nb * NT) {
        const int h = i / 2048, d = i % 2048, bk = rel_bucket(d);
        p.biasB[i] = rb[bk * 12 + h];
        const int m = (d <= 128 ? 1 : 0) + ((d % 4 == 0 && d <= 512) ? 1 : 0) + ((d % 16 == 0) ? 1 : 0);
        p.biasC[i] = rb[bk * 12 + 6 + h] + (m > 0 ? logf((float)m) : -1e30f);
    }
    for (int i = bid * NT + tid; i < DEPTH * 32; i += nb * NT) p.cnt[i] = 0;
}

constexpr int G_LDS = 256 * 32 * 2 + 128 * 32 * 2;
struct GemmCtx { int tid, wid, lane, wr, wc, fr, fq; };
__device__ __forceinline__ GemmCtx gemm_ctx() { GemmCtx c; c.tid = opaque_tid(); c.wid = c.tid >> 6; c.lane = c.tid & 63; c.wr = c.wid >> 1; c.wc = c.wid & 1; c.fr = c.lane & 15; c.fq = c.lane >> 4; return c; }
__device__ __forceinline__ void acc_zero(f32x4 (&acc)[4][4]) {
#pragma unroll
    for (int m = 0; m < 4; ++m)
#pragma unroll
        for (int n = 0; n < 4; ++n) acc[m][n] = (f32x4){0.f, 0.f, 0.f, 0.f};
}
__device__ __forceinline__ void gemm_kloop(f32x4 (&acc)[4][4], const bf16_t* a0, const bf16_t* a1, const bf16_t* b0, int nkt, unsigned char* lds, const GemmCtx& c) {
    bf16_t* SA = (bf16_t*)lds; bf16_t* SB = (bf16_t*)(lds + 256 * 32 * 2);
    const int cc = (c.tid & 3) * 8;
    for (int t = 0; t < nkt; ++t) {
        __builtin_amdgcn_global_load_lds((const unsigned*)(a0 + t * 32 + cc), (unsigned*)((char*)SA + c.tid * 16), 16, 0, 0);
        __builtin_amdgcn_global_load_lds((const unsigned*)(a1 + t * 32 + cc), (unsigned*)((char*)SA + c.tid * 16 + 8192), 16, 0, 0);
        __builtin_amdgcn_global_load_lds((const unsigned*)(b0 + t * 32 + cc), (unsigned*)((char*)SB + c.tid * 16), 16, 0, 0);
        asm volatile("s_waitcnt vmcnt(0)" ::: "memory");
        __syncthreads();
        bf16x8 At[4], Bt[4];
#pragma unroll
        for (int m = 0; m < 4; ++m) At[m] = *reinterpret_cast<const bf16x8*>((char*)SA + (c.wr * 64 + m * 16 + c.fr) * 64 + c.fq * 16);
#pragma unroll
        for (int n = 0; n < 4; ++n) Bt[n] = *reinterpret_cast<const bf16x8*>((char*)SB + (c.wc * 64 + n * 16 + c.fr) * 64 + c.fq * 16);
        asm volatile("s_waitcnt lgkmcnt(0)" ::: "memory");
        __builtin_amdgcn_sched_barrier(0);
#pragma unroll
        for (int m = 0; m < 4; ++m)
#pragma unroll
            for (int n = 0; n < 4; ++n) acc[m][n] = __builtin_amdgcn_mfma_f32_16x16x32_bf16(At[m], Bt[n], acc[m][n], 0, 0, 0);
        __syncthreads();
    }
}

__device__ void phase_inproj(const Params& p, int bid, int nb, unsigned char* lds) {
    const GemmCtx c = gemm_ctx();
    float* srstd = (float*)(lds + G_LDS);
    constexpr int NCT = NP / 128, NU = (NTOK / 256) * NCT;
    for (int u = bid; u < NU; u += nb) {
        const int rt = u / NCT, ct = u % NCT, brow = rt * 256, bcol = ct * 128;
        if (c.tid < 256) srstd[c.tid] = rstd_of(p.part, brow + c.tid);
        f32x4 acc[4][4]; acc_zero(acc);
        const int r = c.tid >> 2;
        gemm_kloop(acc, p.hb + (size_t)(brow + r) * DM, p.hb + (size_t)(brow + r + 128) * DM, p.Bt_in + (size_t)(bcol + r) * DM, DM / 32, lds, c);
#pragma unroll
        for (int m = 0; m < 4; ++m)
#pragma unroll
            for (int j = 0; j < 4; ++j) {
                const int rl = c.wr * 64 + m * 16 + c.fq * 4 + j; const float rs = srstd[rl];
                bf16_t* o = p.proj + (size_t)(brow + rl) * NP + bcol + c.wc * 64 + c.fr;
#pragma unroll
                for (int n = 0; n < 4; ++n) o[n * 16] = f2bf(acc[m][n][j] * rs);
            }
        __syncthreads();
    }
}

constexpr int GLA_LDS = (48 * 96 + 3 * 64 * 48 + 64 * 96 + 64 * 64 + 64 * 48 + 64 * 96) * 4;
__device__ void phase_gla(const Params& p, int l, int bid, int nb, unsigned char* lds) {
    float* S = (float*)lds;
    float* qd = S + 48 * 96;
    float* kd = qd + 64 * 48;
    float* ke = kd + 64 * 48;
    float* vv = ke + 64 * 48;
    float* att = vv + 64 * 96;
    float* bc = att + 64 * 64;
    float* oo = bc + 64 * 48;
    const int tid = opaque_tid(), wave = tid >> 6, lane = tid & 63;
    const float* w2 = p.in[I_AW2] + (size_t)l * 16 * 192;
    const float* b2 = p.in[I_AB2] + l * 192;
    const float* gain = p.in[I_AGAIN] + l * 384;
    for (int u = bid; u < NBATCH * 4; u += nb) {
        const int b = u >> 2, h = u & 3;
        for (int i = tid; i < 48 * 96; i += NT) S[i] = 0.f;
        __syncthreads();
        for (int n = 0; n < 32; ++n) {
            const size_t row0 = (size_t)b * TSEQ + n * 64;
            for (int e = tid; e < 64 * 48; e += NT) {
                const int t = e / 48, k = e % 48;
                const bf16_t* al = p.proj + (row0 + t) * NP + C_ALR;
                float z = b2[h * 48 + k];
#pragma unroll
                for (int r = 0; r < 16; ++r) z += bf2f(al[r]) * w2[r * 192 + h * 48 + k];
                const float ls = fminf(z, 0.f) - log1pf(__expf(-fabsf(z)));
                bc[e] = ls * (1.0f / 16.0f);
            }
            __syncthreads();
            if (tid < 48) { float s = 0.f; for (int t = 0; t < 64; ++t) { s += bc[t * 48 + tid]; bc[t * 48 + tid] = s; } }
            __syncthreads();
            for (int e = tid; e < 64 * 48; e += NT) {
                const int t = e / 48, k = e % 48;
                const float bb = bc[e], bl = bc[63 * 48 + k];
                const float q = bf2f(p.proj[(row0 + t) * NP + C_AQ + h * 48 + k]) * 0.14433756729740643f;
                const float kk = bf2f(p.proj[(row0 + t) * NP + C_AK + h * 48 + k]);
                qd[e] = q * __expf(bb); kd[e] = kk * __expf(-bb); ke[e] = kk * __expf(bl - bb);
            }
            for (int e = tid; e < 64 * 96; e += NT) { const int t = e / 96, v = e % 96; vv[e] = bf2f(p.proj[(row0 + t) * NP + C_AV + h * 96 + v]); }
            __syncthreads();
            for (int e = tid; e < 64 * 64; e += NT) {
                const int cq = e >> 6, s = e & 63; float a = 0.f;
                if (cq >= s) { for (int k = 0; k < 48; ++k) a += qd[cq * 48 + k] * kd[s * 48 + k]; }
                att[e] = a;
            }
            __syncthreads();
            for (int e = tid; e < 64 * 96; e += NT) {
                const int cq = e / 96, v = e % 96; float a = 0.f;
                for (int s = 0; s <= cq; ++s) a += att[cq * 64 + s] * vv[s * 96 + v];
                for (int k = 0; k < 48; ++k) a += qd[cq * 48 + k] * S[k * 96 + v];
                oo[e] = a;
            }
            __syncthreads();
            for (int e = tid; e < 48 * 96; e += NT) {
                const int k = e / 96, v = e % 96; float a = __expf(bc[63 * 48 + k]) * S[e];
                for (int s = 0; s < 64; ++s) a += ke[s * 48 + k] * vv[s * 96 + v];
                S[e] = a;
            }
            for (int t = wave; t < 64; t += 8) {
                const float o0 = oo[t * 96 + lane], o1 = lane < 32 ? oo[t * 96 + 64 + lane] : 0.f;
                const float ms = wave_sum(o0 * o0 + o1 * o1) * (1.0f / 96.0f);
                const float rs = rsqrtf(ms + EPS);
                bf16_t* g = p.proj + (row0 + t) * NP + C_AG + h * 96;
                { const float gv = bf2f(g[lane]); g[lane] = f2bf(o0 * rs * gain[h * 96 + lane] * siluf_(gv)); }
                if (lane < 32) { const float gv = bf2f(g[64 + lane]); g[64 + lane] = f2bf(o1 * rs * gain[h * 96 + 64 + lane] * siluf_(gv)); }
            }
            __syncthreads();
        }
    }
}

constexpr int LRU_LDS = (67 * 48 + 3 * 64 * 48 + 2 * 48 * 48 + 48) * 4;
__device__ __forceinline__ float gelu_tanh(float x) { const float u = 0.7978845608028654f * (x + 0.044715f * x * x * x); return 0.5f * x * (1.0f + tanhf(u)); }
__device__ void phase_lru(const Params& p, int l, int bid, int nb, unsigned char* lds) {
    float* xin = (float*)lds;
    float* xc = xin + 67 * 48;
    float* aa = xc + 64 * 48;
    float* uu = aa + 64 * 48;
    float* wr = uu + 64 * 48;
    float* wi = wr + 48 * 48;
    float* hs = wi + 48 * 48;
    const int tid = opaque_tid();
    for (int u = bid; u < NBATCH * 8; u += nb) {
        const int b = u >> 3, nblk = u & 7, ch0 = nblk * 48;
        for (int i = tid; i < 48 * 48; i += NT) { wr[i] = p.in[I_WR][((size_t)l * 8 + nblk) * 2304 + i]; wi[i] = p.in[I_WI][((size_t)l * 8 + nblk) * 2304 + i]; }
        if (tid < 48) hs[tid] = 0.f;
        __syncthreads();
        for (int tt = 0; tt < TSEQ / 64; ++tt) {
            const int t0 = tt * 64;
            for (int e = tid; e < 67 * 48; e += NT) {
                const int r = e / 48, cidx = e % 48, t = t0 - 3 + r;
                xin[e] = t >= 0 ? bf2f(p.proj[((size_t)b * TSEQ + t) * NP + C_DX + ch0 + cidx]) : 0.f;
            }
            __syncthreads();
            for (int e = tid; e < 64 * 48; e += NT) {
                const int t = e / 48, cidx = e % 48; float a = p.in[I_CONVB][l * 384 + ch0 + cidx];
#pragma unroll
                for (int j = 0; j < 4; ++j) a += p.in[I_CONVW][((size_t)l * 4 + j) * 384 + ch0 + cidx] * xin[(t + j) * 48 + cidx];
                xc[e] = a;
            }
            __syncthreads();
            for (int e = tid; e < 64 * 48; e += NT) {
                const int t = e / 48, d = e % 48;
                float rr = p.in[I_BR][l * 384 + ch0 + d], ii = p.in[I_BI][l * 384 + ch0 + d];
                for (int cidx = 0; cidx < 48; ++cidx) { const float xv = xc[t * 48 + cidx]; rr += xv * wr[cidx * 48 + d]; ii += xv * wi[cidx * 48 + d]; }
                const float r = sigmoidf_(rr), ig = sigmoidf_(ii);
                const float lam = p.in[I_LAM][l * 384 + ch0 + d];
                const float sp = log1pf(__expf(-lam));
                const float la = -8.0f * r * sp;
                aa[e] = __expf(la);
                uu[e] = sqrtf(-expm1f(2.0f * la)) * (ig * xc[e]);
            }
            __syncthreads();
            if (tid < 48) { float hh = hs[tid]; for (int t = 0; t < 64; ++t) { hh = aa[t * 48 + tid] * hh + uu[t * 48 + tid]; uu[t * 48 + tid] = hh; } hs[tid] = hh; }
            __syncthreads();
            for (int e = tid; e < 64 * 48; e += NT) {
                const int t = e / 48, d = e % 48;
                bf16_t* y = p.proj + ((size_t)b * TSEQ + t0 + t) * NP + C_DY + ch0 + d;
                *y = f2bf(gelu_tanh(bf2f(*y)) * uu[e]);
            }
            __syncthreads();
        }
    }
}

constexpr int DIL_LDS = 8 * (64 + 320) * 4;
__device__ void phase_dil(const Params& p, int bid, int nb, unsigned char* lds) {
    const int tid = opaque_tid(), wave = tid >> 6, lane = tid & 63;
    float* sq = (float*)lds + wave * 384;
    float* sp = sq + 64;
    for (int row = bid * 8 + wave; row < NTOK; row += nb * 8) {
        const int b = row / TSEQ, t = row % TSEQ;
        for (int h = 0; h < 6; ++h) {
            sq[lane] = bf2f(p.proj[(size_t)row * NP + C_CQ + h * 64 + lane]) * 0.125f;
            __builtin_amdgcn_s_waitcnt(0);
            __builtin_amdgcn_wave_barrier();
            float lg[5]; float mx = -1e30f;
#pragma unroll
            for (int r = 0; r < 5; ++r) {
                const int j = lane + 64 * r;
                const int d = j < 129 ? j : (j < 225 ? 132 + 4 * (j - 129) : 528 + 16 * (j - 225));
                float v = -1e30f;
                if (d <= t) {
                    const bf16_t* kp = p.proj + ((size_t)b * TSEQ + (t - d)) * NP + C_CK + h * 64;
                    float a = 0.f;
#pragma unroll
                    for (int q8 = 0; q8 < 8; ++q8) {
                        const u32x4 kv = *(const u32x4*)(kp + q8 * 8);
#pragma unroll
                        for (int w = 0; w < 4; ++w) {
                            a += sq[q8 * 8 + 2 * w] * __uint_as_float(kv[w] << 16);
                            a += sq[q8 * 8 + 2 * w + 1] * __uint_as_float(kv[w] & 0xFFFF0000u);
                        }
                    }
                    v = a + p.biasC[h * 2048 + d];
                }
                lg[r] = v; mx = fmaxf(mx, v);
            }
            mx = wave_max(mx);
            float sum = 0.f;
#pragma unroll
            for (int r = 0; r < 5; ++r) { const float e = lg[r] > -1e29f ? __expf(lg[r] - mx) : 0.f; sp[lane + 64 * r] = e; sum += e; }
            sum = wave_sum(sum);
            __builtin_amdgcn_s_waitcnt(0);
            __builtin_amdgcn_wave_barrier();
            float o = 0.f;
            for (int j = 0; j < 320; ++j) {
                const int d = j < 129 ? j : (j < 225 ? 132 + 4 * (j - 129) : 528 + 16 * (j - 225));
                if (d > t) continue;
                o += sp[j] * bf2f(p.proj[((size_t)b * TSEQ + (t - d)) * NP + C_CV + h * 64 + lane]);
            }
            __builtin_amdgcn_wave_barrier();
            p.proj[(size_t)row * NP + C_CQ + h * 64 + lane] = f2bf(o / sum);
        }
    }
}

constexpr int DSA_W_FLOATS = 128 + 4 + 384 + 256 + 6 * 256 + 60;
constexpr int DSA_LDS = 8 * DSA_W_FLOATS * 4;
__device__ void phase_dsa(const Params& p, int bid, int nb, unsigned char* lds) {
    const int tid = opaque_tid(), wave = tid >> 6, lane = tid & 63;
    float* siq = (float*)lds + wave * DSA_W_FLOATS;
    float* siw = siq + 128;
    float* sq = siw + 4;
    int* sel = (int*)(sq + 384);
    float* sp = (float*)(sel + 256);
    for (int row = bid * 8 + wave; row < NTOK; row += nb * 8) {
        const int b = row / TSEQ, t = row % TSEQ;
        const bf16_t* pr = p.proj + (size_t)row * NP;
        siq[lane] = bf2f(pr[C_IQ + lane]) * 0.17677669529663687f;
        siq[64 + lane] = bf2f(pr[C_IQ + 64 + lane]) * 0.17677669529663687f;
        if (lane < 4) siw[lane] = bf2f(pr[C_IW + lane]) * 0.5f;
#pragma unroll
        for (int i = 0; i < 6; ++i) sq[i * 64 + lane] = bf2f(pr[C_BQ + i * 64 + lane]) * 0.125f;
        __builtin_amdgcn_s_waitcnt(0);
        __builtin_amdgcn_wave_barrier();
        unsigned key[32];
#pragma unroll
        for (int r = 0; r < 32; ++r) {
            const int kidx = lane + 64 * r;
            unsigned kk = 0u;
            if (r * 64 <= t) {
                if (kidx <= t) {
                    const bf16_t* kp = p.proj + ((size_t)b * TSEQ + kidx) * NP + C_IK;
                    float kf[32];
#pragma unroll
                    for (int q8 = 0; q8 < 4; ++q8) {
                        const u32x4 kv = *(const u32x4*)(kp + q8 * 8);
#pragma unroll
                        for (int w = 0; w < 4; ++w) { kf[q8 * 8 + 2 * w] = __uint_as_float(kv[w] << 16); kf[q8 * 8 + 2 * w + 1] = __uint_as_float(kv[w] & 0xFFFF0000u); }
                    }
                    float sc = 0.f;
#pragma unroll
                    for (int hh = 0; hh < 4; ++hh) {
                        float a = 0.f;
#pragma unroll
                        for (int d = 0; d < 32; ++d) a += siq[hh * 32 + d] * kf[d];
                        sc += siw[hh] * fmaxf(a, 0.f);
                    }
                    const unsigned u = __float_as_uint(sc);
                    kk = (u & 0x80000000u) ? ~u : (u | 0x80000000u);
                    if (kk == 0u) kk = 1u;
                }
            }
            key[r] = kk;
        }
        const int nvalid = t + 1;
        unsigned T = 0u; int need_eq = 0;
        if (nvalid > 256) {
            for (int bit = 31; bit >= 0; --bit) {
                const unsigned Tc = T | (1u << bit);
                int c = 0;
#pragma unroll
                for (int r = 0; r < 32; ++r) c += (key[r] >= Tc) ? 1 : 0;
                c = wave_sum_i(c);
                if (c >= 256) T = Tc;
            }
            int cgt = 0;
#pragma unroll
            for (int r = 0; r < 32; ++r) cgt += (key[r] > T) ? 1 : 0;
            cgt = wave_sum_i(cgt);
            need_eq = 256 - cgt;
        } else { T = 1u; need_eq = 0x7fffffff; }
        int base = 0, eqseen = 0;
        const unsigned long long lt = (1ull << lane) - 1ull;
#pragma unroll
        for (int r = 0; r < 32; ++r) {
            if (r * 64 <= t) {
                const bool gt = key[r] > T, eq = key[r] == T;
                const unsigned long long em = __ballot(eq);
                const int erank = eqseen + __popcll(em & lt);
                const bool take = gt || (eq && erank < need_eq);
                const unsigned long long tm = __ballot(take);
                if (take) sel[base + __popcll(tm & lt)] = lane + 64 * r;
                base += __popcll(tm); eqseen += __popcll(em);
            }
        }
        const int nsel = base;
        __builtin_amdgcn_s_waitcnt(0);
        __builtin_amdgcn_wave_barrier();
        float lg[4][6]; float mx[6];
#pragma unroll
        for (int hh = 0; hh < 6; ++hh) mx[hh] = -1e30f;
#pragma unroll
        for (int rr = 0; rr < 4; ++rr) {
            const int j = lane + 64 * rr;
#pragma unroll
            for (int hh = 0; hh < 6; ++hh) lg[rr][hh] = -1e30f;
            if (j < nsel) {
                const int kidx = sel[j];
                const bf16_t* kp = p.proj + ((size_t)b * TSEQ + kidx) * NP + C_BK;
#pragma unroll
                for (int hh = 0; hh < 6; ++hh) {
                    float a = 0.f;
#pragma unroll
                    for (int q8 = 0; q8 < 8; ++q8) {
                        const u32x4 kv = *(const u32x4*)(kp + hh * 64 + q8 * 8);
#pragma unroll
                        for (int w = 0; w < 4; ++w) {
                            a += sq[hh * 64 + q8 * 8 + 2 * w] * __uint_as_float(kv[w] << 16);
                            a += sq[hh * 64 + q8 * 8 + 2 * w + 1] * __uint_as_float(kv[w] & 0xFFFF0000u);
                        }
                    }
                    a += p.biasB[hh * 2048 + (t - kidx)];
                    lg[rr][hh] = a; mx[hh] = fmaxf(mx[hh], a);
                }
            }
        }
        float sm[6];
#pragma unroll
        for (int hh = 0; hh < 6; ++hh) {
            mx[hh] = wave_max(mx[hh]);
            float s = 0.f;
#pragma unroll
            for (int rr = 0; rr < 4; ++rr) { const float e = lg[rr][hh] > -1e29f ? __expf(lg[rr][hh] - mx[hh]) : 0.f; sp[hh * 256 + lane + 64 * rr] = e; s += e; }
            sm[hh] = wave_sum(s);
        }
        __builtin_amdgcn_s_waitcnt(0);
        __builtin_amdgcn_wave_barrier();
        float o[6];
#pragma unroll
        for (int hh = 0; hh < 6; ++hh) o[hh] = 0.f;
        for (int j = 0; j < nsel; ++j) {
            const bf16_t* vp = p.proj + ((size_t)b * TSEQ + sel[j]) * NP + C_BV + lane;
#pragma unroll
            for (int hh = 0; hh < 6; ++hh) o[hh] += sp[hh * 256 + j] * bf2f(vp[hh * 64]);
        }
        __builtin_amdgcn_wave_barrier();
        bf16_t* op = p.proj + (size_t)row * NP + C_BQ + lane;
#pragma unroll
        for (int hh = 0; hh < 6; ++hh) op[hh * 64] = f2bf(o[hh] / sm[hh]);
    }
}

constexpr int MG_LDS = G_LDS + 1024 + 32 * NT * 4;
__device__ void phase_merge(const Params& p, int l, int bid, int nb, unsigned char* lds) {
    const GemmCtx c = gemm_ctx();
    float* srstd = (float*)(lds + G_LDS);
    unsigned* sgate = (unsigned*)(lds + G_LDS + 1024);
    constexpr int NCT = DM / 128, NU = (NTOK / 256) * NCT;
    const float* bg = p.in[I_BGATE] + (size_t)l * 4 * DM;
    for (int u = bid; u < NU; u += nb) {
        const int rt = u / NCT, ct = u % NCT, brow = rt * 256, bcol = ct * 128;
        if (c.tid < 256) srstd[c.tid] = rstd_of(p.part, brow + c.tid);
        __syncthreads();
        f32x4 mg[4][4]; acc_zero(mg);
        const int r = c.tid >> 2;
        for (int i = 0; i < 4; ++i) {
            f32x4 acc[4][4]; acc_zero(acc);
            gemm_kloop(acc, p.hb + (size_t)(brow + r) * DM, p.hb + (size_t)(brow + r + 128) * DM, p.Bt_gate + ((size_t)i * DM + bcol + r) * DM, DM / 32, lds, c);
#pragma unroll
            for (int m = 0; m < 4; ++m)
#pragma unroll
                for (int n = 0; n < 4; ++n) {
                    const float bv = bg[i * DM + bcol + c.wc * 64 + n * 16 + c.fr];
                    float g[4];
#pragma unroll
                    for (int j = 0; j < 4; ++j) g[j] = sigmoidf_(acc[m][n][j] * srstd[c.wr * 64 + m * 16 + c.fq * 4 + j] + bv);
                    sgate[((m * 4 + n) * 2 + 0) * NT + c.tid] = (unsigned)f2bf(g[0]) | ((unsigned)f2bf(g[1]) << 16);
                    sgate[((m * 4 + n) * 2 + 1) * NT + c.tid] = (unsigned)f2bf(g[2]) | ((unsigned)f2bf(g[3]) << 16);
                }
            acc_zero(acc);
            gemm_kloop(acc, p.proj + (size_t)(brow + r) * NP + C_OB + i * 384, p.proj + (size_t)(brow + r + 128) * NP + C_OB + i * 384,
                       p.Bt_br + ((size_t)i * DM + bcol + r) * 384, 384 / 32, lds, c);
#pragma unroll
            for (int m = 0; m < 4; ++m)
#pragma unroll
                for (int n = 0; n < 4; ++n) {
                    const unsigned g0 = sgate[((m * 4 + n) * 2 + 0) * NT + c.tid], g1 = sgate[((m * 4 + n) * 2 + 1) * NT + c.tid];
                    mg[m][n][0] += __uint_as_float(g0 << 16) * acc[m][n][0];
                    mg[m][n][1] += __uint_as_float(g0 & 0xFFFF0000u) * acc[m][n][1];
                    mg[m][n][2] += __uint_as_float(g1 << 16) * acc[m][n][2];
                    mg[m][n][3] += __uint_as_float(g1 & 0xFFFF0000u) * acc[m][n][3];
                }
        }
#pragma unroll
        for (int m = 0; m < 4; ++m)
#pragma unroll
            for (int j = 0; j < 4; ++j) {
                const int rl = c.wr * 64 + m * 16 + c.fq * 4 + j;
                bf16_t* o = p.proj + (size_t)(brow + rl) * NP + C_MG + bcol + c.wc * 64 + c.fr;
#pragma unroll
                for (int n = 0; n < 4; ++n) o[n * 16] = f2bf(mg[m][n][j]);
            }
        __syncthreads();
    }
}

__device__ void phase_out(const Params& p, int l, int bid, int nb, unsigned char* lds) {
    const GemmCtx c = gemm_ctx();
    constexpr int NCT = DM / 128, NU = (NTOK / 256) * NCT;
    const float* hin = (l == 0) ? p.in[I_X] : p.h;
    for (int u = bid; u < NU; u += nb) {
        const int rt = u / NCT, ct = u % NCT, brow = rt * 256, bcol = ct * 128;
        f32x4 acc[4][4]; acc_zero(acc);
        const int r = c.tid >> 2;
        gemm_kloop(acc, p.proj + (size_t)(brow + r) * NP + C_MG, p.proj + (size_t)(brow + r + 128) * NP + C_MG, p.Bt_out + (size_t)(bcol + r) * DM, DM / 32, lds, c);
#pragma unroll
        for (int m = 0; m < 4; ++m)
#pragma unroll
            for (int j = 0; j < 4; ++j) {
                const int row = brow + c.wr * 64 + m * 16 + c.fq * 4 + j;
                const size_t off = (size_t)row * DM + bcol + c.wc * 64 + c.fr;
                float ss = 0.f;
#pragma unroll
                for (int n = 0; n < 4; ++n) { const float v = hin[off + n * 16] + acc[m][n][j]; p.h[off + n * 16] = v; p.hb[off + n * 16] = f2bf(v); ss += v * v; }
                ss += __shfl_xor(ss, 1); ss += __shfl_xor(ss, 2); ss += __shfl_xor(ss, 4); ss += __shfl_xor(ss, 8);
                if (c.fr == 0) p.part[(size_t)row * 16 + ct * 2 + c.wc] = ss;
            }
    }
}

constexpr int RT_LDS = 1024 * 20 * 4;
__device__ void phase_router(const Params& p, int l, int bid, int nb, unsigned char* lds) {
    float* W = (float*)lds;
    const int tid = opaque_tid(), wave = tid >> 6, lane = tid & 63;
    const float* n2 = p.in[I_N2] + l * DM;
    const float* wrg = p.in[I_WRG] + (size_t)l * DM * 4;
    const float* wre = p.in[I_WRE] + (size_t)l * DM * 16;
    for (int i = tid; i < 1024 * 20; i += NT) { const int k = i / 20, j = i % 20; W[i] = n2[k] * (j < 4 ? wrg[k * 4 + j] : wre[k * 16 + (j - 4)]); }
    __syncthreads();
    int* cnt = p.cnt + l * 32;
    for (int row = bid * 8 + wave; row < NTOK; row += nb * 8) {
        float pr = p.part[(size_t)row * 16 + (lane & 15)];
        pr += __shfl_xor(pr, 1); pr += __shfl_xor(pr, 2); pr += __shfl_xor(pr, 4); pr += __shfl_xor(pr, 8);
        const float rs = rsqrtf(pr * (1.0f / 1024.0f) + EPS);
        float a[20];
#pragma unroll
        for (int j = 0; j < 20; ++j) a[j] = 0.f;
#pragma unroll 1
        for (int i = 0; i < 16; ++i) {
            const float hv = p.h[(size_t)row * DM + i * 64 + lane];
            const float* w = W + (i * 64 + lane) * 20;
#pragma unroll
            for (int j = 0; j < 20; ++j) a[j] += hv * w[j];
        }
#pragma unroll
        for (int j = 0; j < 20; ++j) a[j] = wave_sum(a[j]);
        if (lane == 0) {
            float gl[4];
#pragma unroll
            for (int j = 0; j < 4; ++j) gl[j] = a[j] * rs + p.in[I_BRG][l * 4 + j];
            int g = 0; float gm = gl[0];
#pragma unroll
            for (int j = 1; j < 4; ++j) if (gl[j] > gm) { gm = gl[j]; g = j; }
            float den = 0.f;
#pragma unroll
            for (int j = 0; j < 4; ++j) den += __expf(gl[j] - gm);
            const float gw = 1.0f / den;
            float el[4];
#pragma unroll
            for (int j = 0; j < 4; ++j) {
                float v = 0.f;
#pragma unroll
                for (int gg = 0; gg < 4; ++gg) v = (gg == g) ? (a[4 + gg * 4 + j] * rs + p.in[I_BRE][l * 16 + gg * 4 + j]) : v;
                el[j] = v;
            }
            int i1 = 0; float v1 = el[0];
#pragma unroll
            for (int j = 1; j < 4; ++j) if (el[j] > v1) { v1 = el[j]; i1 = j; }
            int i2 = -1; float v2 = -3.0e38f;
#pragma unroll
            for (int j = 0; j < 4; ++j) if (j != i1 && el[j] > v2) { v2 = el[j]; i2 = j; }
            const float e2 = __expf(v2 - v1);
            const float w1 = gw / (1.0f + e2), w2 = gw * e2 / (1.0f + e2);
            const int lo = i1 < i2 ? i1 : i2, hi = i1 < i2 ? i2 : i1;
            const float wlo = i1 < i2 ? w1 : w2, whi = i1 < i2 ? w2 : w1;
            const int pidx = lo == 0 ? (hi - 1) : (lo == 1 ? (hi + 1) : 5);
            const int cls = g * 6 + pidx;
            const int pos = __hip_atomic_fetch_add(&cnt[cls], 1, __ATOMIC_RELAXED, __HIP_MEMORY_SCOPE_AGENT);
            p.perm[(size_t)cls * NTOK + pos] = row;
            p.tokw[(size_t)row * 2] = wlo; p.tokw[(size_t)row * 2 + 1] = whi;
        }
    }
}

__device__ __forceinline__ void cls_experts(int cls, int& elo, int& ehi) {
    const int g = cls / 6, pi = cls % 6;
    const int lo = pi < 3 ? 0 : (pi < 5 ? 1 : 2), hi = pi < 3 ? pi + 1 : (pi < 5 ? pi - 1 : 3);
    elo = g * 4 + lo; ehi = g * 4 + hi;
}
__device__ __forceinline__ void moe_prefix(const int* cnt, int* spre, int* scnt) {
    if (opaque_tid() == 0) { int s = 0; for (int c = 0; c < NCLS; ++c) { const int n = cnt[c]; scnt[c] = n; spre[c] = s; s += (n + 255) >> 8; } spre[NCLS] = s; }
    __syncthreads();
}

__device__ void phase_moe1(const Params& p, int l, int bid, int nb, unsigned char* lds) {
    const GemmCtx c = gemm_ctx();
    int* spre = (int*)(lds + G_LDS); int* scnt = spre + 32;
    int* stok = scnt + 32; float* srs = (float*)(stok + 256); float* swl = srs + 256; float* swh = swl + 256;
    moe_prefix(p.cnt + l * 32, spre, scnt);
    const int nrt = spre[NCLS], NU = nrt * 16;
    for (int u = bid; u < NU; u += nb) {
        const int rt = u >> 4, ct = u & 15;
        int cls = 0;
        for (int q = 1; q < NCLS; ++q) if (spre[q] <= rt) cls = q;
        int elo, ehi; cls_experts(cls, elo, ehi);
        const int lrow0 = (rt - spre[cls]) * 256, n = scnt[cls];
        if (c.tid < 256) {
            const int lr = lrow0 + c.tid; const bool ok = lr < n;
            const int tok = ok ? p.perm[(size_t)cls * NTOK + lr] : 0;
            stok[c.tid] = ok ? tok : -1; srs[c.tid] = rstd_of(p.part, tok);
            swl[c.tid] = p.tokw[(size_t)tok * 2]; swh[c.tid] = p.tokw[(size_t)tok * 2 + 1];
        }
        __syncthreads();
        const int r = c.tid >> 2;
        const int t0 = stok[r] < 0 ? 0 : stok[r], t1 = stok[r + 128] < 0 ? 0 : stok[r + 128];
        const int ex = ct < 8 ? elo : ehi;
        f32x4 acc[4][4]; acc_zero(acc);
        gemm_kloop(acc, p.hb + (size_t)t0 * DM, p.hb + (size_t)t1 * DM, p.Wgu + ((size_t)ex * DM + (ct & 7) * 128 + r) * DM, DM / 32, lds, c);
#pragma unroll
        for (int m = 0; m < 4; ++m)
#pragma unroll
            for (int j = 0; j < 4; ++j) {
                const int rl = c.wr * 64 + m * 16 + c.fq * 4 + j; const float rs = srs[rl], w = ct < 8 ? swl[rl] : swh[rl];
                bf16_t* o = p.Hbuf + ((size_t)rt * 256 + rl) * DM + (ct < 8 ? 0 : 512) + (ct & 7) * 64 + c.wc * 32 + c.fr;
#pragma unroll
                for (int n2 = 0; n2 < 2; ++n2) { const float g = acc[m][n2][j] * rs, uu = acc[m][n2 + 2][j] * rs; o[n2 * 16] = f2bf(siluf_(g) * uu * w); }
            }
        __syncthreads();
    }
}

__device__ void phase_moe2(const Params& p, int l, int bid, int nb, unsigned char* lds) {
    const GemmCtx c = gemm_ctx();
    int* spre = (int*)(lds + G_LDS); int* scnt = spre + 32; int* stok = scnt + 32;
    moe_prefix(p.cnt + l * 32, spre, scnt);
    const int nrt = spre[NCLS], NU = nrt * 8;
    for (int u = bid; u < NU; u += nb) {
        const int rt = u >> 3, ct = u & 7;
        int cls = 0;
        for (int q = 1; q < NCLS; ++q) if (spre[q] <= rt) cls = q;
        int elo, ehi; cls_experts(cls, elo, ehi);
        const int lrow0 = (rt - spre[cls]) * 256, n = scnt[cls];
        if (c.tid < 256) { const int lr = lrow0 + c.tid; stok[c.tid] = lr < n ? p.perm[(size_t)cls * NTOK + lr] : -1; }
        __syncthreads();
        const int r = c.tid >> 2;
        f32x4 acc[4][4]; acc_zero(acc);
        const bf16_t* a0 = p.Hbuf + ((size_t)rt * 256 + r) * DM; const bf16_t* a1 = a0 + (size_t)128 * DM;
        gemm_kloop(acc, a0, a1, p.WdT + ((size_t)elo * DM + ct * 128 + r) * 512, 16, lds, c);
        gemm_kloop(acc, a0 + 512, a1 + 512, p.WdT + ((size_t)ehi * DM + ct * 128 + r) * 512, 16, lds, c);
#pragma unroll
        for (int m = 0; m < 4; ++m)
#pragma unroll
            for (int j = 0; j < 4; ++j) {
                const int rl = c.wr * 64 + m * 16 + c.fq * 4 + j; const int tok = stok[rl];
                const size_t off = (size_t)(tok < 0 ? 0 : tok) * DM + ct * 128 + c.wc * 64 + c.fr;
                float ss = 0.f;
                if (tok >= 0) {
#pragma unroll
                    for (int n2 = 0; n2 < 4; ++n2) { const float v = p.h[off + n2 * 16] + acc[m][n2][j]; p.h[off + n2 * 16] = v; p.hb[off + n2 * 16] = f2bf(v); ss += v * v; }
                }
                ss += __shfl_xor(ss, 1); ss += __shfl_xor(ss, 2); ss += __shfl_xor(ss, 4); ss += __shfl_xor(ss, 8);
                if (c.fr == 0 && tok >= 0) p.part[(size_t)tok * 16 + ct * 2 + c.wc] = ss;
            }
        __syncthreads();
    }
}

__device__ void phase_final(const Params& p, int bid, int nb) {
    const int tid = opaque_tid(), wave = tid >> 6, lane = tid & 63;
    const float* nf = p.in[I_NF];
    for (int row = bid * 8 + wave; row < NTOK; row += nb * 8) {
        const float rs = rstd_of(p.part, row);
        float* hr = p.h + (size_t)row * DM;
#pragma unroll
        for (int i = 0; i < 4; ++i) {
            f32x4 v = *(const f32x4*)(hr + i * 256 + lane * 4);
            const f32x4 g = *(const f32x4*)(nf + i * 256 + lane * 4);
            v[0] *= rs * g[0]; v[1] *= rs * g[1]; v[2] *= rs * g[2]; v[3] *= rs * g[3];
            *(f32x4*)(hr + i * 256 + lane * 4) = v;
        }
    }
}

extern __shared__ __attribute__((aligned(16))) unsigned char dyn_lds[];
constexpr int cmax(int a, int b) { return a > b ? a : b; }
constexpr int MEGA_LDS_BODY = cmax(cmax(cmax(GLA_LDS, LRU_LDS), cmax(DSA_LDS, DIL_LDS)), cmax(cmax(MG_LDS, RT_LDS), G_LDS + 8192));
constexpr int MEGA_LDS = MEGA_LDS_BODY + 16;

__global__ void __launch_bounds__(NT, 2) mega(Params p) {
    unsigned char* lds = dyn_lds;
    volatile LAS unsigned* xbw = (volatile LAS unsigned*)(dyn_lds + MEGA_LDS_BODY);
    if (threadIdx.x == 0) { xbw[0] = 0u; xbw[1] = 0u; xbw[2] = 0u; xbw[3] = 0u; }
    __syncthreads();
    XcdBarrier bar = xcd_barrier_post(p.bar, xbw);
    const int bid = blockIdx.x, nb = gridDim.x;
    phase_prep(p, bid, nb);
    xcd_barrier(bar);
#pragma unroll 1
    for (int l = 0; l < DEPTH; ++l) {
        phase_weights(p, l, bid, nb, lds);
        xcd_barrier(bar);
        phase_inproj(p, bid, nb, lds);
        xcd_barrier(bar);
        phase_gla(p, l, bid, nb, lds);
        phase_lru(p, l, (bid + nb - 64) % nb, nb, lds);
        phase_dil(p, bid, nb, lds);
        __syncthreads();
        phase_dsa(p, bid, nb, lds);
        xcd_barrier(bar);
        phase_merge(p, l, bid, nb, lds);
        xcd_barrier(bar);
        phase_out(p, l, bid, nb, lds);
        xcd_barrier(bar);
        phase_router(p, l, bid, nb, lds);
        xcd_barrier(bar);
        phase_moe1(p, l, bid, nb, lds);
        xcd_barrier(bar);
        phase_moe2(p, l, bid, nb, lds);
        xcd_barrier(bar);
    }
    phase_final(p, bid, nb);
}

static size_t align_up(size_t v, size_t a) { return (v + a - 1) / a * a; }

extern "C" void kernel_launch(void* const* d_in, const int* in_sizes, int n_in, void* d_out, int out_size, void* d_ws, size_t ws_size, hipStream_t stream) {
    (void)in_sizes; (void)n_in; (void)out_size; (void)ws_size;
    Params p{};
    for (int i = 0; i < N_IN; ++i) p.in[i] = (const float*)d_in[i];
    p.h = (float*)d_out;
    unsigned char* w = (unsigned char*)d_ws; size_t off = 0;
    auto take = [&](size_t bytes) { unsigned char* r = w + off; off = align_up(off + bytes, 256); return r; };
    p.bar = (unsigned*)take(XCD_BAR_WORDS * 4);
    p.cnt = (int*)take(DEPTH * 32 * 4);
    p.Bt_in = (bf16_t*)take((size_t)NP * DM * 2);
    p.Bt_gate = (bf16_t*)take((size_t)4 * DM * DM * 2);
    p.Bt_br = (bf16_t*)take((size_t)4 * DM * 384 * 2);
    p.Bt_out = (bf16_t*)take((size_t)DM * DM * 2);
    p.Wgu = (bf16_t*)take((size_t)16 * DM * DM * 2);
    p.WdT = (bf16_t*)take((size_t)16 * DM * 512 * 2);
    p.hb = (bf16_t*)take((size_t)NTOK * DM * 2);
    p.part = (float*)take((size_t)NTOK * 16 * 4);
    p.biasB = (float*)take(6 * 2048 * 4);
    p.biasC = (float*)take(6 * 2048 * 4);
    p.tokw = (float*)take((size_t)NTOK * 2 * 4);
    p.perm = (int*)take((size_t)NCLS * NTOK * 4);
    p.proj = (bf16_t*)take((size_t)NTOK * NP * 2);
    p.Hbuf = p.proj;

    static int grid = 0;
    if (grid == 0) {
        int dev = 0, cus = 0;
        (void)hipGetDevice(&dev);
        (void)hipDeviceGetAttribute(&cus, hipDeviceAttributeMultiprocessorCount, dev);
        if (hipFuncSetAttribute((const void*)mega, hipFuncAttributeMaxDynamicSharedMemorySize, MEGA_LDS) != hipSuccess) { grid = -1; return; }
        int per_cu = 0;
        (void)hipOccupancyMaxActiveBlocksPerMultiprocessor(&per_cu, (const void*)mega, NT, MEGA_LDS);
        (void)hipGetLastError();
        grid = cus > 0 ? cus : 256;
    }
    if (grid < 0) return;
    (void)hipMemsetAsync(p.bar, 0, XCD_BAR_WORDS * sizeof(unsigned), stream);
    mega<<<grid, NT, MEGA_LDS, stream>>>(p);
}
```

```cpp
#include <hip/hip_runtime.h>
#include <stdint.h>

typedef unsigned short bf16_t;
typedef short bf16x8 __attribute__((ext_vector_type(8)));
typedef float f32x4 __attribute__((ext_vector_type(4)));
typedef unsigned u32x4 __attribute__((ext_vector_type(4)));
typedef float f32x16 __attribute__((ext_vector_type(16)));

constexpr int NTOK = 32768, TSEQ = 2048, NBATCH = 16, DM = 1024, DEPTH = 2;
constexpr int NP = 4608;
constexpr int NT = 512;
constexpr int C_AQ = 0, C_AK = 192, C_AV = 384, C_AG = 768, C_BQ = 1152, C_CQ = 1536, C_DY = 1920, C_BK = 2304, C_BV = 2688,
              C_CK = 3072, C_CV = 3456, C_DX = 3840, C_IQ = 4224, C_IK = 4352, C_ALR = 4384, C_IW = 4400;
constexpr int C_OB = 768;
constexpr int C_MG = 2304;
constexpr float EPS = 1e-6f;
constexpr int NCLS = 24, MAXRT = 152;
constexpr int TABW = 2080;
constexpr float LOG2E = 1.4426950408889634f, NEG_BIG = -3.0e38f;

#ifndef PROBE_MASK
#define PROBE_MASK 0
#endif
extern __shared__ __attribute__((aligned(16))) unsigned char dyn_lds[];
constexpr int PROBE_OFF = 160 * 1024 - 64;
#define PROBE_UNIT_BEGIN(bit, cond) do { if (((PROBE_MASK >> (bit)) & 1) && (cond) && threadIdx.x == 0) { volatile __attribute__((address_space(3))) unsigned long long* pw = (volatile __attribute__((address_space(3))) unsigned long long*)(dyn_lds + PROBE_OFF); pw[2] = __builtin_amdgcn_s_memrealtime(); } } while (0)
#define PROBE_UNIT_END(bit, cond) do { if (((PROBE_MASK >> (bit)) & 1) && (cond) && threadIdx.x == 0) { volatile __attribute__((address_space(3))) unsigned long long* pw = (volatile __attribute__((address_space(3))) unsigned long long*)(dyn_lds + PROBE_OFF); pw[1] += 4ull * (__builtin_amdgcn_s_memrealtime() - pw[2]); } } while (0)

enum { I_X = 0, I_WIN, I_AW2, I_AB2, I_AGAIN, I_CONVW, I_CONVB, I_WR, I_BR, I_WI, I_BI, I_LAM, I_WGATE, I_BGATE, I_WBR, I_WOUT, I_RELB,
       I_N1, I_N2, I_NF, I_WRG, I_BRG, I_WRE, I_BRE, I_MWG, I_MWU, I_MWD, N_IN };

struct Params {
    const float* in[N_IN];
    float* h;
    bf16_t* Bt_in;
    bf16_t* Bt_gate;
    bf16_t* Bt_br;
    bf16_t* Bt_out;
    bf16_t* Wgu;
    bf16_t* WdT;
    bf16_t* hb;
    bf16_t* proj;
    bf16_t* Hbuf;
    float* part;
    float* biasB;
    float* biasC;
    bf16_t* VtB;
    bf16_t* VtC;
    float* tokw;
    int* perm;
    int* cnt;
    unsigned* bar;
};

__device__ __forceinline__ bf16_t f2bf(float f) { unsigned u = __float_as_uint(f); u += 0x7FFFu + ((u >> 16) & 1u); return (bf16_t)(u >> 16); }
__device__ __forceinline__ float bf2f(bf16_t b) { return __uint_as_float(((unsigned)b) << 16); }
__device__ __forceinline__ float wave_sum(float v) {
#pragma unroll
    for (int o = 32; o > 0; o >>= 1) v += __shfl_xor(v, o);
    return v;
}
__device__ __forceinline__ float wave_max(float v) {
#pragma unroll
    for (int o = 32; o > 0; o >>= 1) v = fmaxf(v, __shfl_xor(v, o));
    return v;
}
__device__ __forceinline__ int wave_sum_i(int v) {
#pragma unroll
    for (int o = 32; o > 0; o >>= 1) v += __shfl_xor(v, o);
    return v;
}
__device__ __forceinline__ int opaque_tid() { int t = threadIdx.x; asm volatile("" : "+v"(t)); return t; }
__device__ __forceinline__ unsigned cvt_pk_bf16(float lo, float hi) { unsigned r; asm volatile("v_cvt_pk_bf16_f32 %0, %1, %2" : "=v"(r) : "v"(lo), "v"(hi)); return r; }
__device__ __forceinline__ float sigmoidf_(float x) { return 1.0f / (1.0f + __expf(-x)); }
__device__ __forceinline__ float siluf_(float x) { return x / (1.0f + __expf(-x)); }
__device__ __forceinline__ float rstd_of(const float* part, int row) {
    const f32x4* p = (const f32x4*)(part + (size_t)row * 16);
    f32x4 a = p[0], b = p[1], c = p[2], d = p[3];
    float s = ((a[0] + a[1]) + (a[2] + a[3])) + ((b[0] + b[1]) + (b[2] + b[3])) + ((c[0] + c[1]) + (c[2] + c[3])) + ((d[0] + d[1]) + (d[2] + d[3]));
    return rsqrtf(s * (1.0f / 1024.0f) + EPS);
}
__device__ __forceinline__ int map_in_col(int c) {
    if (c < 1152) return c;
    if (c < 1536) return 1168 + (c - 1152);
    if (c < 1920) return 2484 + (c - 1536);
    if (c < 2304) return 3636 + (c - 1920);
    if (c < 2688) return 1552 + (c - 2304);
    if (c < 3072) return 1936 + (c - 2688);
    if (c < 3456) return 2868 + (c - 3072);
    if (c < 3840) return 3252 + (c - 3456);
    if (c < 4224) return 4020 + (c - 3840);
    if (c < 4352) return 2320 + (c - 4224);
    if (c < 4384) return 2448 + (c - 4352);
    if (c < 4400) return 1152 + (c - 4384);
    if (c < 4404) return 2480 + (c - 4400);
    return -1;
}
__device__ __forceinline__ int rel_bucket(int n) {
    if (n < 16) return n;
    float v = logf((float)n / 16.0f) / 4.852030263919617f * 16.0f;
    int b = 16 + (int)v;
    return b < 31 ? b : 31;
}

#define XB_TMO      128
#define XB_XCNT(j)  (256  + 64 * (j))
#define XB_XSUB(j)  (1280 + 64 * (j))
#define XB_XGEN(j)  (2304 + 64 * (j))
#define XB_TOP      3328
#define XB_TOPGEN   3392
#define XCD_BAR_WORDS 3456
#define XB_SPIN_CAP (1u << 18)
#define LAS __attribute__((address_space(3)))

__device__ __forceinline__ unsigned xb_ld(unsigned* p)              { return __hip_atomic_load(p, __ATOMIC_RELAXED, __HIP_MEMORY_SCOPE_AGENT); }
__device__ __forceinline__ unsigned xb_add(unsigned* p, unsigned v) { return __hip_atomic_fetch_add(p, v, __ATOMIC_RELAXED, __HIP_MEMORY_SCOPE_AGENT); }
__device__ __forceinline__ unsigned xb_xcc_id() { return (unsigned)__builtin_amdgcn_s_getreg((3 << 11) | 20) & 0xFu; }
#define XB_SPIN(cond, bar) do { unsigned _sp = 0; while (cond) { __builtin_amdgcn_s_sleep(1); \
    if ((++_sp & 255u) == 0u) { if (xb_ld(&(bar)[XB_TMO])) break; if (_sp > XB_SPIN_CAP) { atomicAdd(&(bar)[XB_TMO], 1u); break; } } } } while (0)

struct XcdBarrier {
    unsigned* bar; unsigned x;
    volatile LAS unsigned* st;
};

__device__ __forceinline__ XcdBarrier xcd_barrier_post(unsigned* bar, volatile LAS unsigned* st) {
    XcdBarrier b; b.bar = bar; b.x = xb_xcc_id(); b.st = st;
    if (threadIdx.x == 0) (void)xb_add(&bar[XB_XCNT(b.x)], 1u);
    return b;
}
__device__ __forceinline__ void xcd_barrier_complete(unsigned* bar, unsigned x, unsigned& nloc, unsigned& nx) {
    const unsigned G = gridDim.x * gridDim.y * gridDim.z;
    unsigned sum, cnt, mine, sp = 0u;
    for (;;) {
        sum = 0u; cnt = 0u; mine = 0u;
#pragma unroll
        for (unsigned j = 0; j < 16; ++j) { const unsigned c = xb_ld(&bar[XB_XCNT(j)]); sum += c; cnt += (c > 0u) ? 1u : 0u; mine = (j == x) ? c : mine; }
        if (sum == G) break;
        __builtin_amdgcn_s_sleep(1);
        if ((++sp & 255u) == 0u) { if (xb_ld(&bar[XB_TMO])) break; if (sp > XB_SPIN_CAP) { atomicAdd(&bar[XB_TMO], 1u); break; } }
    }
    nloc = mine > 0u ? mine : 1u; nx = cnt > 0u ? cnt : 1u;
}

__device__ __forceinline__ void xcd_barrier(const XcdBarrier& b) {
    asm volatile("s_waitcnt vmcnt(0)" ::: "memory");
    __syncthreads();
    if (threadIdx.x == 0) {
        unsigned* bar = b.bar;
        __builtin_amdgcn_s_waitcnt(0);
        unsigned nloc = b.st[0], nx = b.st[1];
        if (nloc == 0u) { xcd_barrier_complete(bar, b.x, nloc, nx); b.st[0] = nloc; b.st[1] = nx; }
        const unsigned old = xb_add(&bar[XB_XSUB(b.x)], 1u);
        const unsigned gen = old / nloc;
        if (old + 1u == (gen + 1u) * nloc) {
            __builtin_amdgcn_fence(__ATOMIC_RELEASE, "agent");
            asm volatile("s_waitcnt vmcnt(0)" ::: "memory");
            const unsigned og = xb_add(&bar[XB_TOP], 1u);
            const unsigned tg = og / nx;
            if (og + 1u == (tg + 1u) * nx) xb_add(&bar[XB_TOPGEN], 1u);
            else XB_SPIN(xb_ld(&bar[XB_TOPGEN]) == tg, bar);
            __builtin_amdgcn_fence(__ATOMIC_ACQUIRE, "agent");
            xb_add(&bar[XB_XGEN(b.x)], 1u);
            asm volatile("s_waitcnt vmcnt(0)" ::: "memory");
        } else {
            XB_SPIN(xb_ld(&bar[XB_XGEN(b.x)]) == gen, bar);
            __builtin_amdgcn_fence(__ATOMIC_ACQUIRE, "agent");
            asm volatile("s_waitcnt vmcnt(0)" ::: "memory");
        }
    }
    __syncthreads();
}


template <class MapF>
__device__ __forceinline__ void conv_wT(const float* __restrict__ src, int ldsrc, int K, bf16_t* __restrict__ dst, int nrows, MapF colmap,
                                        const float* __restrict__ scale, int bid, int nb, float* tile) {
    const int tid = opaque_tid(), nkt = K / 64, ntile = (nrows / 64) * nkt;
    for (int t = bid; t < ntile; t += nb) {
        const int r0 = (t / nkt) * 64, k0 = (t % nkt) * 64;
#pragma unroll
        for (int i = 0; i < 8; ++i) {
            const int e = tid + NT * i, kk = e >> 6, rr = e & 63;
            const int c = colmap(r0 + rr);
            float v = 0.f;
            if (c >= 0) { v = src[(size_t)(k0 + kk) * ldsrc + c]; if (scale) v *= scale[k0 + kk]; }
            tile[kk * 65 + rr] = v;
        }
        __syncthreads();
#pragma unroll
        for (int i = 0; i < 8; ++i) {
            const int e = tid + NT * i, rr = e >> 6, kk = e & 63;
            dst[(size_t)(r0 + rr) * K + k0 + kk] = f2bf(tile[kk * 65 + rr]);
        }
        __syncthreads();
    }
}

__device__ __forceinline__ void phase_weights(const Params& p, int l, int bid, int nb, unsigned char* lds) {
    float* tile = (float*)lds;
    const float* n1 = p.in[I_N1] + l * DM;
    const float* n2 = p.in[I_N2] + l * DM;
    conv_wT(p.in[I_WIN] + (size_t)l * DM * 4404, 4404, DM, p.Bt_in, NP, [](int r) { return map_in_col(r); }, n1, bid, nb, tile);
    for (int i = 0; i < 4; ++i) {
        conv_wT(p.in[I_WGATE] + ((size_t)l * 4 + i) * DM * DM, DM, DM, p.Bt_gate + (size_t)i * DM * DM, DM, [](int r) { return r; }, n1, bid, nb, tile);
        conv_wT(p.in[I_WBR] + ((size_t)l * 4 + i) * 384 * DM, DM, 384, p.Bt_br + (size_t)i * DM * 384, DM, [](int r) { return r; }, nullptr, bid, nb, tile);
    }
    conv_wT(p.in[I_WOUT] + (size_t)l * DM * DM, DM, DM, p.Bt_out, DM, [](int r) { return r; }, nullptr, bid, nb, tile);
    for (int e = 0; e < 16; ++e) {
        const float* wg = p.in[I_MWG] + ((size_t)l * 16 + e) * DM * 512;
        const float* wu = p.in[I_MWU] + ((size_t)l * 16 + e) * DM * 512;
        bf16_t* dst = p.Wgu + (size_t)e * DM * DM;
        {
            const int tid = opaque_tid();
            for (int t = bid; t < 16 * 16; t += nb) {
                const int r0 = (t / 16) * 64, k0 = (t % 16) * 64;
#pragma unroll
                for (int i = 0; i < 8; ++i) {
                    const int ee = tid + NT * i, kk = ee >> 6, rr = ee & 63, rho = r0 + rr;
                    const int T = rho >> 7, wc = (rho >> 6) & 1, q = (rho >> 5) & 1, ii = rho & 31, hcol = 64 * T + 32 * wc + ii;
                    const float* s = q ? wu : wg;
                    tile[kk * 65 + rr] = s[(size_t)(k0 + kk) * 512 + hcol] * n2[k0 + kk];
                }
                __syncthreads();
#pragma unroll
                for (int i = 0; i < 8; ++i) {
                    const int ee = tid + NT * i, rr = ee >> 6, kk = ee & 63;
                    dst[(size_t)(r0 + rr) * DM + k0 + kk] = f2bf(tile[kk * 65 + rr]);
                }
                __syncthreads();
            }
        }
        conv_wT(p.in[I_MWD] + ((size_t)l * 16 + e) * 512 * DM, DM, 512, p.WdT + (size_t)e * DM * 512, DM, [](int r) { return r; }, nullptr, bid, nb, tile);
    }
}

__device__ __forceinline__ void phase_prep(const Params& p, int bid, int nb) {
    const int tid = opaque_tid(), wave = tid >> 6, lane = tid & 63;
    const float* x = p.in[I_X];
    for (int row = bid * 8 + wave; row < NTOK; row += nb * 8) {
        const float* xr = x + (size_t)row * DM;
        float s = 0.f;
#pragma unroll
        for (int i = 0; i < 4; ++i) {
            const f32x4 v = *(const f32x4*)(xr + i * 256 + lane * 4);
            s += v[0] * v[0] + v[1] * v[1] + v[2] * v[2] + v[3] * v[3];
            const unsigned lo = (unsigned)f2bf(v[0]) | ((unsigned)f2bf(v[1]) << 16), hi = (unsigned)f2bf(v[2]) | ((unsigned)f2bf(v[3]) << 16);
            *(uint2*)(p.hb + (size_t)row * DM + i * 256 + lane * 4) = make_uint2(lo, hi);
        }
        s = wave_sum(s);
        if (lane < 16) p.part[(size_t)row * 16 + lane] = (lane == 0) ? s : 0.f;
    }
    const float* rb = p.in[I_RELB];
    for (int i = bid * NT + tid; i < 6 * TABW; i += nb * NT) {
        const int h = i / TABW, d = i % TABW - 32;
        float vb = NEG_BIG, vc = NEG_BIG;
        if (d >= 0) {
            const int bk = rel_bucket(d);
            vb = rb[bk * 12 + h] * LOG2E;
            const int m = (d <= 128 ? 1 : 0) + ((d % 4 == 0 && d <= 512) ? 1 : 0) + ((d % 16 == 0) ? 1 : 0);
            if (m > 0) vc = (rb[bk * 12 + 6 + h] + logf((float)m)) * LOG2E;
        }
        p.biasB[i] = vb; p.biasC[i] = vc;
    }
    for (int i = bid * NT + tid; i < DEPTH * 32; i += nb * NT) p.cnt[i] = 0;
}

constexpr int G_BUF = 256 * 32 * 2 + 128 * 32 * 2;
constexpr int G_LDS = 3 * G_BUF;
struct GemmCtx { int tid, wid, lane, wr, wc, fr, fq, sc, rdo; };
__device__ __forceinline__ GemmCtx gemm_ctx() {
    GemmCtx c; c.tid = opaque_tid(); c.wid = c.tid >> 6; c.lane = c.tid & 63; c.wr = c.wid >> 1; c.wc = c.wid & 1; c.fr = c.lane & 15; c.fq = c.lane >> 4;
    c.sc = (((c.tid & 3) ^ ((0 - (c.tid >> 4)) & 3))) * 8;
    c.rdo = c.fr * 64 + ((c.fq ^ ((0 - (c.fr >> 2)) & 3)) * 16);
    return c;
}
__device__ __forceinline__ void acc_zero(f32x4 (&acc)[4][4]) {
#pragma unroll
    for (int m = 0; m < 4; ++m)
#pragma unroll
        for (int n = 0; n < 4; ++n) acc[m][n] = (f32x4){0.f, 0.f, 0.f, 0.f};
}
__device__ __forceinline__ void gemm_stage(const bf16_t* A, unsigned oa0, unsigned oa1, const bf16_t* B, unsigned ob, int t, unsigned char* buf, const GemmCtx& c) {
    const bf16_t* At = A + t * 32; const bf16_t* Bt = B + t * 32;
    __builtin_amdgcn_global_load_lds((const unsigned*)(At + oa0), (unsigned*)(buf + c.tid * 16), 16, 0, 0);
    __builtin_amdgcn_global_load_lds((const unsigned*)(At + oa1), (unsigned*)(buf + 8192 + c.tid * 16), 16, 0, 0);
    __builtin_amdgcn_global_load_lds((const unsigned*)(Bt + ob), (unsigned*)(buf + 16384 + c.tid * 16), 16, 0, 0);
}
template <bool LEAN = false>
__device__ __forceinline__ void gemm_kloop(f32x4 (&acc)[4][4], const bf16_t* A, unsigned oa0, unsigned oa1, const bf16_t* B, unsigned ob, int nkt, unsigned char* lds, const GemmCtx& c) {
    gemm_stage(A, oa0, oa1, B, ob, 0, lds, c);
    gemm_stage(A, oa0, oa1, B, ob, 1, lds + G_BUF, c);
    int cur = 0;
#pragma unroll 1
    for (int t = 0; t < nkt; ++t) {
        if (t + 1 < nkt) asm volatile("s_waitcnt vmcnt(3)" ::: "memory"); else asm volatile("s_waitcnt vmcnt(0)" ::: "memory");
        __builtin_amdgcn_s_barrier();
        asm volatile("" ::: "memory");
        const int nxt = cur == 0 ? 2 : cur - 1;
        if (t + 2 < nkt) gemm_stage(A, oa0, oa1, B, ob, t + 2, lds + nxt * G_BUF, c);
        const unsigned char* SA = lds + cur * G_BUF; const unsigned char* SB = SA + 16384;
        bf16x8 At[4], Bt[4];
#pragma unroll
        for (int m = 0; m < 4; ++m) At[m] = *reinterpret_cast<const bf16x8*>(SA + (c.wr * 64 + m * 16) * 64 + c.rdo);
#pragma unroll
        for (int n = 0; n < 4; ++n) Bt[n] = *reinterpret_cast<const bf16x8*>(SB + (c.wc * 64 + n * 16) * 64 + c.rdo);
        asm volatile("s_waitcnt lgkmcnt(0)" ::: "memory");
        __builtin_amdgcn_sched_barrier(0);
#pragma unroll
        for (int m = 0; m < 4; ++m)
#pragma unroll
            for (int n = 0; n < 4; ++n) acc[m][n] = __builtin_amdgcn_mfma_f32_16x16x32_bf16(At[m], Bt[n], acc[m][n], 0, 0, 0);
        cur = cur == 2 ? 0 : cur + 1;
    }
    __builtin_amdgcn_s_barrier();
    asm volatile("" ::: "memory");
}

__device__ __forceinline__ void phase_inproj(const Params& p, int bid, int nb, unsigned char* lds) {
    const GemmCtx c = gemm_ctx();
    float* srstd = (float*)(lds + G_LDS);
    constexpr int NCT = NP / 128, NU = (NTOK / 256) * NCT;
    for (int u = bid; u < NU; u += nb) {
        const int rt = u / NCT, ct = u % NCT, brow = rt * 256, bcol = ct * 128;
        if (c.tid < 256) srstd[c.tid] = rstd_of(p.part, brow + c.tid);
        f32x4 acc[4][4]; acc_zero(acc);
        const int r = c.tid >> 2;
        gemm_kloop(acc, p.hb + (size_t)brow * DM, (unsigned)(r * DM + c.sc), (unsigned)((r + 128) * DM + c.sc), p.Bt_in + (size_t)bcol * DM, (unsigned)(r * DM + c.sc), DM / 32, lds, c);
        const bool isVB = (ct >= C_BV / 128 && ct < C_BV / 128 + 3), isVC = (ct >= C_CV / 128 && ct < C_CV / 128 + 3);
        if (isVB || isVC) {
            bf16_t* vt = (isVB ? p.VtB : p.VtC) + ((size_t)(brow / TSEQ) * 384 + (bcol - (isVB ? C_BV : C_CV)) + c.wc * 64 + c.fr) * TSEQ + (brow % TSEQ) + c.wr * 64 + c.fq * 4;
#pragma unroll
            for (int m = 0; m < 4; ++m) {
                const int rl = c.wr * 64 + m * 16 + c.fq * 4;
                const float r0 = srstd[rl], r1 = srstd[rl + 1], r2 = srstd[rl + 2], r3 = srstd[rl + 3];
#pragma unroll
                for (int n = 0; n < 4; ++n) {
                    const unsigned lo = (unsigned)f2bf(acc[m][n][0] * r0) | ((unsigned)f2bf(acc[m][n][1] * r1) << 16);
                    const unsigned hi = (unsigned)f2bf(acc[m][n][2] * r2) | ((unsigned)f2bf(acc[m][n][3] * r3) << 16);
                    *(uint2*)(vt + (size_t)(n * 16) * TSEQ + m * 16) = make_uint2(lo, hi);
                }
            }
        } else {
#pragma unroll
        for (int m = 0; m < 4; ++m)
#pragma unroll
            for (int j = 0; j < 4; ++j) {
                const int rl = c.wr * 64 + m * 16 + c.fq * 4 + j; const float rs = srstd[rl];
                bf16_t* o = p.proj + (size_t)(brow + rl) * NP + bcol + c.wc * 64 + c.fr;
#pragma unroll
                for (int n = 0; n < 4; ++n) o[n * 16] = f2bf(acc[m][n][j] * rs);
            }
        }
        __syncthreads();
    }
}

__device__ __forceinline__ int grab_unit(int* ctr, volatile LAS int* slot) {
    __syncthreads();
    if (opaque_tid() == 0) *slot = __hip_atomic_fetch_add(ctr, 1, __ATOMIC_RELAXED, __HIP_MEMORY_SCOPE_AGENT);
    __syncthreads();
    return *slot;
}
constexpr int GQ = 56, GS = 72, GO = 97;
constexpr int GL_QD = 0, GL_KD = GL_QD + 64 * GQ * 2, GL_KET = GL_KD + 64 * GQ * 2, GL_VT = GL_KET + 64 * GS * 2, GL_ATT = GL_VT + 96 * GS * 2, GL_ST = GL_ATT + 64 * GS * 2,
              GL_OO = GL_ST + 96 * GQ * 2, GL_BC = GL_OO + 64 * GO * 4, GL_SEG = GL_BC + 64 * 48 * 4, GL_EBL = GL_SEG + 8 * 48 * 4, GL_W2 = GL_EBL + 64 * 4, GL_B2 = GL_W2 + 16 * 48 * 4,
              GL_GAIN = GL_B2 + 48 * 4, GL_RQ = GL_GAIN + 96 * 4, GL_RK = GL_RQ + 64 * 48 * 2, GL_RV = GL_RK + 64 * 48 * 2, GL_RA = GL_RV + 64 * 96 * 2, GL_RG = GL_RA + 64 * 16 * 2,
              GLA_LDS = GL_RG + 2 * 64 * 96 * 2;
static_assert(GL_OO % 16 == 0 && GL_RQ % 16 == 0 && GL_RG % 16 == 0 && GL_ST % 16 == 0, "GLA LDS map alignment");
__device__ __forceinline__ void phase_gla(const Params& p, int l, int* ctr, volatile LAS int* slot, unsigned char* lds) {
    bf16_t* qd = (bf16_t*)(lds + GL_QD); bf16_t* kd = (bf16_t*)(lds + GL_KD); bf16_t* keT = (bf16_t*)(lds + GL_KET); bf16_t* vT = (bf16_t*)(lds + GL_VT);
    bf16_t* att = (bf16_t*)(lds + GL_ATT); bf16_t* ST = (bf16_t*)(lds + GL_ST);
    float* oo = (float*)(lds + GL_OO); float* bc = (float*)(lds + GL_BC); float* seg = (float*)(lds + GL_SEG); float* ebl = (float*)(lds + GL_EBL);
    float* w2s = (float*)(lds + GL_W2); float* b2s = (float*)(lds + GL_B2); float* gains = (float*)(lds + GL_GAIN);
    bf16_t* rq = (bf16_t*)(lds + GL_RQ); bf16_t* rk = (bf16_t*)(lds + GL_RK); bf16_t* rv = (bf16_t*)(lds + GL_RV); bf16_t* ra = (bf16_t*)(lds + GL_RA); bf16_t* rg = (bf16_t*)(lds + GL_RG);
    const int tid = opaque_tid(), wave = tid >> 6, lane = tid & 63, r = lane & 31, hf = lane >> 5;
    for (int u = grab_unit(ctr, slot); u < NBATCH * 4; u = grab_unit(ctr, slot)) {
        const int b = u >> 2, h = u & 3;
        PROBE_UNIT_BEGIN(9, u == 0);
        for (int i = tid; i < 16 * 48; i += NT) w2s[i] = p.in[I_AW2][(size_t)l * 16 * 192 + (i / 48) * 192 + h * 48 + (i % 48)];
        if (tid < 48) b2s[tid] = p.in[I_AB2][l * 192 + h * 48 + tid];
        if (tid < 96) gains[tid] = p.in[I_AGAIN][l * 384 + h * 96 + tid];
        if (tid < 64) ebl[tid] = 1.0f;
        for (int i = tid; i < 96 * GQ; i += NT) ST[i] = 0;
        for (int i = tid; i < 64 * GS; i += NT) { keT[i] = 0; att[i] = 0; }
        const bf16_t* src[5]; int dsto[5];
#pragma unroll
        for (int j = 0; j < 5; ++j) {
            const int pid = tid + NT * j; int row = 0, col = 0, dst = -1;
            if (pid < 384) { row = pid / 6; col = C_AQ + h * 48 + (pid % 6) * 8; dst = GL_RQ + pid * 16; }
            else if (pid < 768) { const int q = pid - 384; row = q / 6; col = C_AK + h * 48 + (q % 6) * 8; dst = GL_RK + q * 16; }
            else if (pid < 1536) { const int q = pid - 768; row = q / 12; col = C_AV + h * 96 + (q % 12) * 8; dst = GL_RV + q * 16; }
            else if (pid < 2304) { const int q = pid - 1536; row = q / 12; col = C_AG + h * 96 + (q % 12) * 8; dst = GL_RG + q * 16; }
            else if (pid < 2432) { const int q = pid - 2304; row = q / 2; col = C_ALR + (q % 2) * 8; dst = GL_RA + q * 16; }
            src[j] = p.proj + ((size_t)b * TSEQ + row) * NP + col; dsto[j] = dst;
        }
        u32x4 pre[5];
#pragma unroll
        for (int j = 0; j < 5; ++j) pre[j] = dsto[j] >= 0 ? *(const u32x4*)src[j] : (u32x4){0u, 0u, 0u, 0u};
        f32x16 Sacc;
#pragma unroll
        for (int i = 0; i < 16; ++i) Sacc[i] = 0.f;
        const int kt = wave / 3, vt = wave % 3;
        __syncthreads();
        for (int n = 0; n < 32; ++n) {
            const size_t row0 = (size_t)b * TSEQ + n * 64;
            const int gsel = (n & 1) * (64 * 96 * 2);
#pragma unroll
            for (int j = 0; j < 5; ++j) if (dsto[j] >= 0) *(u32x4*)(lds + dsto[j] + (dsto[j] >= GL_RG ? gsel : 0)) = pre[j];
            if (n + 1 < 32) {
#pragma unroll
                for (int j = 0; j < 5; ++j) if (dsto[j] >= 0) pre[j] = *(const u32x4*)(src[j] + (size_t)(n + 1) * 64 * NP);
            }
            __syncthreads();
            for (int e = tid; e < 64 * 48; e += NT) {
                const int t = e / 48, k = e % 48;
                float z = b2s[k];
#pragma unroll
                for (int rr = 0; rr < 16; ++rr) z += bf2f(ra[t * 16 + rr]) * w2s[rr * 48 + k];
                bc[e] = (fminf(z, 0.f) - log1pf(__expf(-fabsf(z)))) * (1.0f / 16.0f);
            }
            __syncthreads();
            if (tid < 384) {
                const int k = tid % 48, sg = tid / 48; float run = 0.f;
#pragma unroll
                for (int i = 0; i < 8; ++i) { run += bc[(sg * 8 + i) * 48 + k]; bc[(sg * 8 + i) * 48 + k] = run; }
                seg[sg * 48 + k] = run;
            }
            __syncthreads();
            if (tid < 384) {
                const int k = tid % 48, sg = tid / 48; float pre_s = 0.f;
                for (int s2 = 0; s2 < sg; ++s2) pre_s += seg[s2 * 48 + k];
#pragma unroll
                for (int i = 0; i < 8; ++i) bc[(sg * 8 + i) * 48 + k] += pre_s;
            }
            __syncthreads();
            for (int e = tid; e < 64 * 48; e += NT) {
                const int t = e / 48, k = e % 48;
                const float bb = bc[e], bl = bc[63 * 48 + k];
                const float q = bf2f(rq[e]) * 0.14433756729740643f, kk = bf2f(rk[e]);
                qd[t * GQ + k] = f2bf(q * __expf(bb)); kd[t * GQ + k] = f2bf(kk * __expf(-bb)); keT[k * GS + t] = f2bf(kk * __expf(bl - bb));
                if (t == 63) ebl[k] = __expf(bl);
            }
            for (int e = tid; e < 64 * 96; e += NT) { const int t = e / 96, v = e % 96; vT[v * GS + t] = rv[e]; }
            __syncthreads();
            if (wave < 3) {
                const int si = wave == 2 ? 1 : 0, ci = wave >= 1 ? 1 : 0;
                f32x16 x;
#pragma unroll
                for (int i = 0; i < 16; ++i) x[i] = 0.f;
#pragma unroll
                for (int st = 0; st < 3; ++st)
                    x = __builtin_amdgcn_mfma_f32_32x32x16_bf16(*(const bf16x8*)(kd + (si * 32 + r) * GQ + 16 * st + 8 * hf), *(const bf16x8*)(qd + (ci * 32 + r) * GQ + 16 * st + 8 * hf), x, 0, 0, 0);
                const int cq = ci * 32 + r;
#pragma unroll
                for (int g = 0; g < 4; ++g) {
                    const int s0 = si * 32 + 8 * g + 4 * hf;
                    const float v0 = s0 <= cq ? x[4 * g] : 0.f, v1 = s0 + 1 <= cq ? x[4 * g + 1] : 0.f, v2 = s0 + 2 <= cq ? x[4 * g + 2] : 0.f, v3 = s0 + 3 <= cq ? x[4 * g + 3] : 0.f;
                    *(uint2*)(att + cq * GS + s0) = make_uint2(cvt_pk_bf16(v0, v1), cvt_pk_bf16(v2, v3));
                }
            }
            if (wave < 6) {
#pragma unroll
                for (int i = 0; i < 16; ++i) Sacc[i] *= ebl[kt * 32 + (i & 3) + 8 * (i >> 2) + 4 * hf];
#pragma unroll
                for (int st = 0; st < 4; ++st)
                    Sacc = __builtin_amdgcn_mfma_f32_32x32x16_bf16(*(const bf16x8*)(keT + (kt * 32 + r) * GS + 16 * st + 8 * hf), *(const bf16x8*)(vT + (vt * 32 + r) * GS + 16 * st + 8 * hf), Sacc, 0, 0, 0);
            }
            __syncthreads();
            if (wave < 6) {
                f32x16 o;
#pragma unroll
                for (int i = 0; i < 16; ++i) o[i] = 0.f;
#pragma unroll
                for (int st = 0; st < 4; ++st)
                    if (st < 2 || kt == 1)
                        o = __builtin_amdgcn_mfma_f32_32x32x16_bf16(*(const bf16x8*)(att + (kt * 32 + r) * GS + 16 * st + 8 * hf), *(const bf16x8*)(vT + (vt * 32 + r) * GS + 16 * st + 8 * hf), o, 0, 0, 0);
#pragma unroll
                for (int st = 0; st < 3; ++st)
                    o = __builtin_amdgcn_mfma_f32_32x32x16_bf16(*(const bf16x8*)(qd + (kt * 32 + r) * GQ + 16 * st + 8 * hf), *(const bf16x8*)(ST + (vt * 32 + r) * GQ + 16 * st + 8 * hf), o, 0, 0, 0);
#pragma unroll
                for (int i = 0; i < 16; ++i) oo[(kt * 32 + (i & 3) + 8 * (i >> 2) + 4 * hf) * GO + vt * 32 + r] = o[i];
            }
            __syncthreads();
            for (int t = wave; t < 64; t += 8) {
                const float o0 = oo[t * GO + lane], o1 = lane < 32 ? oo[t * GO + 64 + lane] : 0.f;
                const float ms = wave_sum(o0 * o0 + o1 * o1) * (1.0f / 96.0f);
                const float rs = rsqrtf(ms + EPS);
                const bf16_t* gr = (const bf16_t*)((const unsigned char*)rg + gsel) + t * 96;
                bf16_t* g = p.proj + (row0 + t) * NP + C_AG + h * 96;
                g[lane] = f2bf(o0 * rs * gains[lane] * siluf_(bf2f(gr[lane])));
                if (lane < 32) g[64 + lane] = f2bf(o1 * rs * gains[64 + lane] * siluf_(bf2f(gr[64 + lane])));
            }
            if (wave < 6) {
#pragma unroll
                for (int g = 0; g < 4; ++g) {
                    const int k0 = kt * 32 + 8 * g + 4 * hf;
                    if (k0 < 48) *(uint2*)(ST + (vt * 32 + r) * GQ + k0) = make_uint2(cvt_pk_bf16(Sacc[4 * g], Sacc[4 * g + 1]), cvt_pk_bf16(Sacc[4 * g + 2], Sacc[4 * g + 3]));
                }
            }
            __syncthreads();
        }
        PROBE_UNIT_END(9, u == 0);
    }
}

constexpr int LRU_LDS = (67 * 48 + 3 * 64 * 48 + 2 * 48 * 48 + 48) * 4;
__device__ __forceinline__ float gelu_tanh(float x) { const float u = 0.7978845608028654f * (x + 0.044715f * x * x * x); return 0.5f * x * (1.0f + tanhf(u)); }
__device__ __forceinline__ void phase_lru(const Params& p, int l, int* ctr, volatile LAS int* slot, unsigned char* lds) {
    float* xin = (float*)lds;
    float* xc = xin + 67 * 48;
    float* aa = xc + 64 * 48;
    float* uu = aa + 64 * 48;
    float* wr = uu + 64 * 48;
    float* wi = wr + 48 * 48;
    float* hs = wi + 48 * 48;
    const int tid = opaque_tid();
    for (int u = grab_unit(ctr, slot); u < NBATCH * 8; u = grab_unit(ctr, slot)) {
        const int b = u >> 3, nblk = u & 7, ch0 = nblk * 48;
        PROBE_UNIT_BEGIN(10, u == 0);
        for (int i = tid; i < 48 * 48; i += NT) { wr[i] = p.in[I_WR][((size_t)l * 8 + nblk) * 2304 + i]; wi[i] = p.in[I_WI][((size_t)l * 8 + nblk) * 2304 + i]; }
        if (tid < 48) hs[tid] = 0.f;
        __syncthreads();
        for (int tt = 0; tt < TSEQ / 64; ++tt) {
            const int t0 = tt * 64;
            for (int e = tid; e < 67 * 48; e += NT) {
                const int r = e / 48, cidx = e % 48, t = t0 - 3 + r;
                xin[e] = t >= 0 ? bf2f(p.proj[((size_t)b * TSEQ + t) * NP + C_DX + ch0 + cidx]) : 0.f;
            }
            __syncthreads();
            for (int e = tid; e < 64 * 48; e += NT) {
                const int t = e / 48, cidx = e % 48; float a = p.in[I_CONVB][l * 384 + ch0 + cidx];
#pragma unroll
                for (int j = 0; j < 4; ++j) a += p.in[I_CONVW][((size_t)l * 4 + j) * 384 + ch0 + cidx] * xin[(t + j) * 48 + cidx];
                xc[e] = a;
            }
            __syncthreads();
            for (int e = tid; e < 64 * 48; e += NT) {
                const int t = e / 48, d = e % 48;
                float rr = p.in[I_BR][l * 384 + ch0 + d], ii = p.in[I_BI][l * 384 + ch0 + d];
                for (int cidx = 0; cidx < 48; ++cidx) { const float xv = xc[t * 48 + cidx]; rr += xv * wr[cidx * 48 + d]; ii += xv * wi[cidx * 48 + d]; }
                const float r = sigmoidf_(rr), ig = sigmoidf_(ii);
                const float lam = p.in[I_LAM][l * 384 + ch0 + d];
                const float sp = log1pf(__expf(-lam));
                const float la = -8.0f * r * sp;
                aa[e] = __expf(la);
                uu[e] = sqrtf(-expm1f(2.0f * la)) * (ig * xc[e]);
            }
            __syncthreads();
            if (tid < 48) { float hh = hs[tid]; for (int t = 0; t < 64; ++t) { hh = aa[t * 48 + tid] * hh + uu[t * 48 + tid]; uu[t * 48 + tid] = hh; } hs[tid] = hh; }
            __syncthreads();
            for (int e = tid; e < 64 * 48; e += NT) {
                const int t = e / 48, d = e % 48;
                bf16_t* y = p.proj + ((size_t)b * TSEQ + t0 + t) * NP + C_DY + ch0 + d;
                *y = f2bf(gelu_tanh(bf2f(*y)) * uu[e]);
            }
            __syncthreads();
        }
        PROBE_UNIT_END(10, u == 0);
    }
}

template <bool MASKED>
__device__ __forceinline__ void attn_wave(const bf16_t* __restrict__ proj, const bf16_t* __restrict__ Vt, int b, int h, int q0, int cq, int ck, const float* tab,
                                          const unsigned* maskq, bf16_t* __restrict__ outp, int lane) {
    const int r = lane & 31, hf = lane >> 5, q = q0 + r;
    const bf16_t* qrow = proj + ((size_t)b * TSEQ + q) * NP + cq + h * 64 + 8 * hf;
    bf16x8 qf[4];
#pragma unroll
    for (int s = 0; s < 4; ++s) qf[s] = *(const bf16x8*)(qrow + 16 * s);
    f32x16 o0, o1;
#pragma unroll
    for (int i = 0; i < 16; ++i) { o0[i] = 0.f; o1[i] = 0.f; }
    float m = -1e30f, l = 0.f;
    const bf16_t* kbase = proj + ((size_t)b * TSEQ + r) * NP + ck + h * 64 + 8 * hf;
    const bf16_t* vbase = Vt + ((size_t)(b * 384 + h * 64 + r)) * TSEQ + 4 * hf;
    const int nkt = q0 / 32 + 1;
    constexpr float C1 = 0.125f * LOG2E;
    bf16x8 kfn[4]; uint2 vrn[2][2][2];
#pragma unroll
    for (int s = 0; s < 4; ++s) kfn[s] = *(const bf16x8*)(kbase + 16 * s);
#pragma unroll
    for (int db = 0; db < 2; ++db)
#pragma unroll
        for (int s = 0; s < 2; ++s) { const bf16_t* vp = vbase + (size_t)db * 32 * TSEQ + 16 * s; vrn[db][s][0] = *(const uint2*)vp; vrn[db][s][1] = *(const uint2*)(vp + 8); }
    for (int kt = 0; kt < nkt; ++kt) {
        bf16x8 kf[4]; uint2 vr[2][2][2];
#pragma unroll
        for (int s = 0; s < 4; ++s) kf[s] = kfn[s];
#pragma unroll
        for (int db = 0; db < 2; ++db)
#pragma unroll
            for (int s = 0; s < 2; ++s) { vr[db][s][0] = vrn[db][s][0]; vr[db][s][1] = vrn[db][s][1]; }
        if (kt + 1 < nkt) {
#pragma unroll
            for (int s = 0; s < 4; ++s) kfn[s] = *(const bf16x8*)(kbase + (size_t)(kt + 1) * 32 * NP + 16 * s);
#pragma unroll
            for (int db = 0; db < 2; ++db)
#pragma unroll
                for (int s = 0; s < 2; ++s) {
                    const bf16_t* vp = vbase + (size_t)db * 32 * TSEQ + (kt + 1) * 32 + 16 * s;
                    vrn[db][s][0] = *(const uint2*)vp; vrn[db][s][1] = *(const uint2*)(vp + 8);
                }
        }
        f32x16 sa;
#pragma unroll
        for (int i = 0; i < 16; ++i) sa[i] = 0.f;
#pragma unroll
        for (int s = 0; s < 4; ++s) sa = __builtin_amdgcn_mfma_f32_32x32x16_bf16(kf[s], qf[s], sa, 0, 0, 0);
        const float* tb = tab + (q - kt * 32 - 4 * hf + 32);
        unsigned w = 0u;
        if (MASKED) w = maskq[r * 64 + kt] >> (4 * hf);
        float sv[16]; float tmax = NEG_BIG;
#pragma unroll
        for (int i = 0; i < 16; ++i) {
            const int ko = (i & 3) + 8 * (i >> 2);
            float v = sa[i] * C1 + tb[-ko];
            if (MASKED) v = ((w >> ko) & 1u) ? v : NEG_BIG;
            sv[i] = v; tmax = fmaxf(tmax, v);
        }
        tmax = fmaxf(tmax, __shfl_xor(tmax, 32));
        const float mn = fmaxf(m, tmax);
        if (!__all(mn == m)) {
            const float alpha = exp2f(m - mn);
            l *= alpha;
#pragma unroll
            for (int i = 0; i < 16; ++i) { o0[i] *= alpha; o1[i] *= alpha; }
            m = mn;
        }
        float ps = 0.f;
#pragma unroll
        for (int i = 0; i < 16; ++i) { sv[i] = exp2f(sv[i] - m); ps += sv[i]; }
        l += ps;
        bf16x8 pf[2];
#pragma unroll
        for (int s = 0; s < 2; ++s) {
            u32x4 t;
            t[0] = cvt_pk_bf16(sv[8 * s + 0], sv[8 * s + 1]); t[1] = cvt_pk_bf16(sv[8 * s + 2], sv[8 * s + 3]);
            t[2] = cvt_pk_bf16(sv[8 * s + 4], sv[8 * s + 5]); t[3] = cvt_pk_bf16(sv[8 * s + 6], sv[8 * s + 7]);
            pf[s] = __builtin_bit_cast(bf16x8, t);
        }
#pragma unroll
        for (int s = 0; s < 2; ++s) {
            u32x4 a0; a0[0] = vr[0][s][0].x; a0[1] = vr[0][s][0].y; a0[2] = vr[0][s][1].x; a0[3] = vr[0][s][1].y;
            u32x4 a1; a1[0] = vr[1][s][0].x; a1[1] = vr[1][s][0].y; a1[2] = vr[1][s][1].x; a1[3] = vr[1][s][1].y;
            o0 = __builtin_amdgcn_mfma_f32_32x32x16_bf16(__builtin_bit_cast(bf16x8, a0), pf[s], o0, 0, 0, 0);
            o1 = __builtin_amdgcn_mfma_f32_32x32x16_bf16(__builtin_bit_cast(bf16x8, a1), pf[s], o1, 0, 0, 0);
        }
    }
    l += __shfl_xor(l, 32);
    const float inv = 1.0f / l;
    bf16_t* orow = outp + ((size_t)b * TSEQ + q) * NP + cq + h * 64 + 4 * hf;
#pragma unroll
    for (int g = 0; g < 4; ++g) {
        *(uint2*)(orow + 8 * g) = make_uint2(cvt_pk_bf16(o0[4 * g] * inv, o0[4 * g + 1] * inv), cvt_pk_bf16(o0[4 * g + 2] * inv, o0[4 * g + 3] * inv));
        *(uint2*)(orow + 32 + 8 * g) = make_uint2(cvt_pk_bf16(o1[4 * g] * inv, o1[4 * g + 1] * inv), cvt_pk_bf16(o1[4 * g + 2] * inv, o1[4 * g + 3] * inv));
    }
}

constexpr int DIL_LDS = 6 * TABW * 4;
__device__ __forceinline__ void dil_unit(const Params& p, int b, int qb, unsigned char* lds) {
    float* tab = (float*)lds;
    const int tid = opaque_tid(), wave = tid >> 6, lane = tid & 63;
    for (int i = tid; i < 6 * TABW; i += NT) tab[i] = p.biasC[i];
    __syncthreads();
    for (int it = wave; it < 24; it += 8) {
        const int sb = 3 - it / 6, h = it % 6;
        attn_wave<false>(p.proj, p.VtC, b, h, qb * 128 + sb * 32, C_CQ, C_CK, tab + h * TABW, nullptr, p.proj, lane);
    }
    __syncthreads();
}
__device__ __forceinline__ void phase_dil(const Params& p, int* ctr, volatile LAS int* slot, unsigned char* lds) {
    for (int u = grab_unit(ctr, slot); u < NBATCH * 16; u = grab_unit(ctr, slot)) { PROBE_UNIT_BEGIN(12, u == 0); dil_unit(p, u & 15, 15 - (u >> 4), lds); PROBE_UNIT_END(12, u == 0); }
}

constexpr int DSA_LDS = 6 * TABW * 4 + 128 * 64 * 4;
__device__ __forceinline__ void cnt_ge(int& c, unsigned k, unsigned t) { asm("v_cmp_ge_u32 vcc, %1, %2\n\tv_addc_co_u32 %0, vcc, 0, %0, vcc" : "+v"(c) : "v"(k), "v"(t) : "vcc"); }
__device__ __forceinline__ void cnt_gt(int& c, unsigned k, unsigned t) { asm("v_cmp_gt_u32 vcc, %1, %2\n\tv_addc_co_u32 %0, vcc, 0, %0, vcc" : "+v"(c) : "v"(k), "v"(t) : "vcc"); }
__device__ __forceinline__ void cnt_eq(int& c, unsigned k, unsigned t) { asm("v_cmp_eq_u32 vcc, %1, %2\n\tv_addc_co_u32 %0, vcc, 0, %0, vcc" : "+v"(c) : "v"(k), "v"(t) : "vcc"); }
__device__ __forceinline__ int grp16_sum(int v) { v += __shfl_xor(v, 1); v += __shfl_xor(v, 2); v += __shfl_xor(v, 4); v += __shfl_xor(v, 8); return v; }
__device__ __forceinline__ void dsa_unit(const Params& p, int b, int qb, unsigned char* lds) {
    float* tab = (float*)lds;
    unsigned* mask32 = (unsigned*)(lds + 6 * TABW * 4);
    unsigned short* mask16 = (unsigned short*)mask32;
    const int tid = opaque_tid(), wave = tid >> 6, lane = tid & 63;
    for (int i = tid; i < 6 * TABW; i += NT) tab[i] = p.biasB[i];
    for (int i = tid; i < 128 * 64; i += NT) mask32[i] = 0u;
    __syncthreads();
    const int qi = lane >> 4, kl = lane & 15;
    PROBE_UNIT_BEGIN(13, qb == 15 && b == 0);
    for (int grp = wave; grp < 32; grp += 8) {
        const int qg = qb * 128 + grp * 4, myq = qg + qi, ntile = (qg + 3) / 16 + 1;
        const bf16x8 af = *(const bf16x8*)(p.proj + ((size_t)b * TSEQ + qg + (kl >> 2)) * NP + C_IQ + (kl & 3) * 32 + 8 * qi);
        float w[4];
        {
            const uint2 wv = *(const uint2*)(p.proj + ((size_t)b * TSEQ + myq) * NP + C_IW);
            constexpr float WS = 0.5f * 0.17677669529663687f;
            w[0] = __uint_as_float(wv.x << 16) * WS; w[1] = __uint_as_float(wv.x & 0xFFFF0000u) * WS; w[2] = __uint_as_float(wv.y << 16) * WS; w[3] = __uint_as_float(wv.y & 0xFFFF0000u) * WS;
        }
        const bf16_t* kp = p.proj + ((size_t)b * TSEQ + kl) * NP + C_IK + 8 * qi;
        unsigned key[128];
#pragma unroll
        for (int c4 = 0; c4 < 32; ++c4) {
            if (c4 * 4 < ntile) {
                bf16x8 bfr[4];
                const bf16_t* kc = kp + (size_t)(c4 * 4) * 16 * NP; asm volatile("" : "+v"(kc));
#pragma unroll
                for (int i = 0; i < 4; ++i) bfr[i] = *(const bf16x8*)(kc + (size_t)i * 16 * NP);
#pragma unroll
                for (int i = 0; i < 4; ++i) {
                    const int t = c4 * 4 + i;
                    f32x4 a4 = {0.f, 0.f, 0.f, 0.f};
                    a4 = __builtin_amdgcn_mfma_f32_16x16x32_bf16(af, bfr[i], a4, 0, 0, 0);
                    float sc = w[0] * fmaxf(a4[0], 0.f) + w[1] * fmaxf(a4[1], 0.f) + w[2] * fmaxf(a4[2], 0.f) + w[3] * fmaxf(a4[3], 0.f);
                    sc += 0.0f;
                    const unsigned u = __float_as_uint(sc);
                    unsigned kk = (u & 0x80000000u) ? ~u : (u | 0x80000000u);
                    kk = kk == 0u ? 1u : kk;
                    key[t] = (t * 16 + kl <= myq) ? kk : 0u;
                }
            } else {
#pragma unroll
                for (int i = 0; i < 4; ++i) key[c4 * 4 + i] = 0u;
            }
            asm volatile("" ::: "memory");
        }
        unsigned T = 1u; int need = 0x7fffffff;
        if (qg + 3 >= 256) {
            unsigned Tb = 0u;
#pragma unroll 1
            for (int bit = 31; bit >= 0; --bit) {
                const unsigned Tc = Tb | (1u << bit);
                int c = 0;
#pragma unroll
                for (int t = 0; t < 128; ++t) cnt_ge(c, key[t], Tc);
                c = grp16_sum(c);
                Tb = (c >= 256) ? Tc : Tb;
            }
            int cgt = 0;
#pragma unroll
            for (int t = 0; t < 128; ++t) cnt_gt(cgt, key[t], Tb);
            cgt = grp16_sum(cgt);
            if (myq >= 256) { T = Tb; need = 256 - cgt; }
        }
        int ceq = 0;
#pragma unroll
        for (int t = 0; t < 128; ++t) cnt_eq(ceq, key[t], T);
        ceq = grp16_sum(ceq);
        const bool slow = __any(need != 0x7fffffff && ceq != need);
        int run = 0;
        unsigned short* mrow = mask16 + (grp * 4 + qi) * 128;
#pragma unroll
        for (int t = 0; t < 128; ++t) {
            if (t < ntile) {
                const bool gt = key[t] > T, eq = key[t] == T;
                bool take = gt || eq;
                if (slow) {
                    const unsigned long long em = __ballot(eq);
                    const unsigned bits = (unsigned)(em >> (16 * qi)) & 0xFFFFu;
                    const int rank = run + __popc(bits & ((1u << kl) - 1u));
                    take = gt || (eq && rank < need);
                    run += __popc(bits);
                }
                const unsigned long long tm = __ballot(take);
                if (kl == 0) mrow[t] = (unsigned short)((tm >> (16 * qi)) & 0xFFFFull);
            }
        }
    }
    __syncthreads();
    PROBE_UNIT_END(13, qb == 15 && b == 0);
    for (int it = wave; it < 24; it += 8) {
        const int sb = 3 - it / 6, h = it % 6;
        attn_wave<true>(p.proj, p.VtB, b, h, qb * 128 + sb * 32, C_BQ, C_BK, tab + h * TABW, mask32 + sb * 32 * 64, p.proj, lane);
    }
    __syncthreads();
}
__device__ __forceinline__ void phase_dsa(const Params& p, int* ctr, volatile LAS int* slot, unsigned char* lds) {
    for (int u = grab_unit(ctr, slot); u < NBATCH * 16; u = grab_unit(ctr, slot)) { PROBE_UNIT_BEGIN(11, u == 0); dsa_unit(p, u & 15, 15 - (u >> 4), lds); PROBE_UNIT_END(11, u == 0); }
}

constexpr int MG_LDS = G_LDS + 1024 + 32 * NT * 4;
__device__ __forceinline__ void phase_merge(const Params& p, int l, int bid, int nb, unsigned char* lds) {
    const GemmCtx c = gemm_ctx();
    float* srstd = (float*)(lds + G_LDS);
    unsigned* sgate = (unsigned*)(lds + G_LDS + 1024);
    constexpr int NCT = DM / 128, NU = (NTOK / 256) * NCT;
    const float* bg = p.in[I_BGATE] + (size_t)l * 4 * DM;
    for (int u = bid; u < NU; u += nb) {
        const int rt = u / NCT, ct = u % NCT, brow = rt * 256, bcol = ct * 128;
        if (c.tid < 256) srstd[c.tid] = rstd_of(p.part, brow + c.tid);
        __syncthreads();
        f32x4 mg[4][4]; acc_zero(mg);
        const int r = c.tid >> 2;
        for (int i = 0; i < 4; ++i) {
            f32x4 acc[4][4]; acc_zero(acc);
            gemm_kloop<true>(acc, p.hb + (size_t)brow * DM, (unsigned)(r * DM + c.sc), (unsigned)((r + 128) * DM + c.sc), p.Bt_gate + ((size_t)i * DM + bcol) * DM, (unsigned)(r * DM + c.sc), DM / 32, lds, c);
            int i2 = i; asm volatile("" : "+s"(i2));
#pragma unroll
            for (int m = 0; m < 4; ++m)
#pragma unroll
                for (int n = 0; n < 4; ++n) {
                    const float bv = bg[i2 * DM + bcol + c.wc * 64 + n * 16 + c.fr];
                    float g[4];
#pragma unroll
                    for (int j = 0; j < 4; ++j) g[j] = sigmoidf_(acc[m][n][j] * srstd[c.wr * 64 + m * 16 + c.fq * 4 + j] + bv);
                    sgate[((m * 4 + n) * 2 + 0) * NT + c.tid] = (unsigned)f2bf(g[0]) | ((unsigned)f2bf(g[1]) << 16);
                    sgate[((m * 4 + n) * 2 + 1) * NT + c.tid] = (unsigned)f2bf(g[2]) | ((unsigned)f2bf(g[3]) << 16);
                }
            acc_zero(acc);
            gemm_kloop<true>(acc, p.proj + (size_t)brow * NP + C_OB + i2 * 384, (unsigned)(r * NP + c.sc), (unsigned)((r + 128) * NP + c.sc),
                             p.Bt_br + ((size_t)i2 * DM + bcol) * 384, (unsigned)(r * 384 + c.sc), 384 / 32, lds, c);
#pragma unroll
            for (int m = 0; m < 4; ++m)
#pragma unroll
                for (int n = 0; n < 4; ++n) {
                    const unsigned g0 = sgate[((m * 4 + n) * 2 + 0) * NT + c.tid], g1 = sgate[((m * 4 + n) * 2 + 1) * NT + c.tid];
                    mg[m][n][0] += __uint_as_float(g0 << 16) * acc[m][n][0];
                    mg[m][n][1] += __uint_as_float(g0 & 0xFFFF0000u) * acc[m][n][1];
                    mg[m][n][2] += __uint_as_float(g1 << 16) * acc[m][n][2];
                    mg[m][n][3] += __uint_as_float(g1 & 0xFFFF0000u) * acc[m][n][3];
                }
        }
#pragma unroll
        for (int m = 0; m < 4; ++m)
#pragma unroll
            for (int j = 0; j < 4; ++j) {
                const int rl = c.wr * 64 + m * 16 + c.fq * 4 + j;
                bf16_t* o = p.proj + (size_t)(brow + rl) * NP + C_MG + bcol + c.wc * 64 + c.fr;
#pragma unroll
                for (int n = 0; n < 4; ++n) o[n * 16] = f2bf(mg[m][n][j]);
            }
        __syncthreads();
    }
}

__device__ __forceinline__ void phase_out(const Params& p, int l, int bid, int nb, unsigned char* lds) {
    const GemmCtx c = gemm_ctx();
    constexpr int NCT = DM / 128, NU = (NTOK / 256) * NCT;
    const float* hin = (l == 0) ? p.in[I_X] : p.h;
    for (int u = bid; u < NU; u += nb) {
        const int rt = u / NCT, ct = u % NCT, brow = rt * 256, bcol = ct * 128;
        f32x4 acc[4][4]; acc_zero(acc);
        const int r = c.tid >> 2;
        gemm_kloop(acc, p.proj + (size_t)brow * NP + C_MG, (unsigned)(r * NP + c.sc), (unsigned)((r + 128) * NP + c.sc), p.Bt_out + (size_t)bcol * DM, (unsigned)(r * DM + c.sc), DM / 32, lds, c);
#pragma unroll
        for (int m = 0; m < 4; ++m)
#pragma unroll
            for (int j = 0; j < 4; ++j) {
                const int row = brow + c.wr * 64 + m * 16 + c.fq * 4 + j;
                const size_t off = (size_t)row * DM + bcol + c.wc * 64 + c.fr;
                float ss = 0.f;
#pragma unroll
                for (int n = 0; n < 4; ++n) { const float v = hin[off + n * 16] + acc[m][n][j]; p.h[off + n * 16] = v; p.hb[off + n * 16] = f2bf(v); ss += v * v; }
                ss += __shfl_xor(ss, 1); ss += __shfl_xor(ss, 2); ss += __shfl_xor(ss, 4); ss += __shfl_xor(ss, 8);
                if (c.fr == 0) p.part[(size_t)row * 16 + ct * 2 + c.wc] = ss;
            }
    }
}

constexpr int RT_LDS = 1024 * 20 * 4;
__device__ __forceinline__ void phase_router(const Params& p, int l, int bid, int nb, unsigned char* lds) {
    float* W = (float*)lds;
    const int tid = opaque_tid(), wave = tid >> 6, lane = tid & 63;
    const float* n2 = p.in[I_N2] + l * DM;
    const float* wrg = p.in[I_WRG] + (size_t)l * DM * 4;
    const float* wre = p.in[I_WRE] + (size_t)l * DM * 16;
    for (int i = tid; i < 1024 * 20; i += NT) { const int k = i / 20, j = i % 20; W[i] = n2[k] * (j < 4 ? wrg[k * 4 + j] : wre[k * 16 + (j - 4)]); }
    __syncthreads();
    int* cnt = p.cnt + l * 32;
    for (int row = bid * 8 + wave; row < NTOK; row += nb * 8) {
        float pr = p.part[(size_t)row * 16 + (lane & 15)];
        pr += __shfl_xor(pr, 1); pr += __shfl_xor(pr, 2); pr += __shfl_xor(pr, 4); pr += __shfl_xor(pr, 8);
        const float rs = rsqrtf(pr * (1.0f / 1024.0f) + EPS);
        float a[20];
#pragma unroll
        for (int j = 0; j < 20; ++j) a[j] = 0.f;
#pragma unroll 1
        for (int i = 0; i < 16; ++i) {
            const float hv = p.h[(size_t)row * DM + i * 64 + lane];
            const float* w = W + (i * 64 + lane) * 20;
#pragma unroll
            for (int j = 0; j < 20; ++j) a[j] += hv * w[j];
        }
#pragma unroll
        for (int j = 0; j < 20; ++j) a[j] = wave_sum(a[j]);
        if (lane == 0) {
            float gl[4];
#pragma unroll
            for (int j = 0; j < 4; ++j) gl[j] = a[j] * rs + p.in[I_BRG][l * 4 + j];
            int g = 0; float gm = gl[0];
#pragma unroll
            for (int j = 1; j < 4; ++j) if (gl[j] > gm) { gm = gl[j]; g = j; }
            float den = 0.f;
#pragma unroll
            for (int j = 0; j < 4; ++j) den += __expf(gl[j] - gm);
            const float gw = 1.0f / den;
            float el[4];
#pragma unroll
            for (int j = 0; j < 4; ++j) {
                float v = 0.f;
#pragma unroll
                for (int gg = 0; gg < 4; ++gg) v = (gg == g) ? (a[4 + gg * 4 + j] * rs + p.in[I_BRE][l * 16 + gg * 4 + j]) : v;
                el[j] = v;
            }
            int i1 = 0; float v1 = el[0];
#pragma unroll
            for (int j = 1; j < 4; ++j) if (el[j] > v1) { v1 = el[j]; i1 = j; }
            int i2 = -1; float v2 = -3.0e38f;
#pragma unroll
            for (int j = 0; j < 4; ++j) if (j != i1 && el[j] > v2) { v2 = el[j]; i2 = j; }
            const float e2 = __expf(v2 - v1);
            const float w1 = gw / (1.0f + e2), w2 = gw * e2 / (1.0f + e2);
            const int lo = i1 < i2 ? i1 : i2, hi = i1 < i2 ? i2 : i1;
            const float wlo = i1 < i2 ? w1 : w2, whi = i1 < i2 ? w2 : w1;
            const int pidx = lo == 0 ? (hi - 1) : (lo == 1 ? (hi + 1) : 5);
            const int cls = g * 6 + pidx;
            const int pos = __hip_atomic_fetch_add(&cnt[cls], 1, __ATOMIC_RELAXED, __HIP_MEMORY_SCOPE_AGENT);
            p.perm[(size_t)cls * NTOK + pos] = row;
            p.tokw[(size_t)row * 2] = wlo; p.tokw[(size_t)row * 2 + 1] = whi;
        }
    }
}

__device__ __forceinline__ void cls_experts(int cls, int& elo, int& ehi) {
    const int g = cls / 6, pi = cls % 6;
    const int lo = pi < 3 ? 0 : (pi < 5 ? 1 : 2), hi = pi < 3 ? pi + 1 : (pi < 5 ? pi - 1 : 3);
    elo = g * 4 + lo; ehi = g * 4 + hi;
}
__device__ __forceinline__ void moe_prefix(const int* cnt, int* spre, int* scnt) {
    if (opaque_tid() == 0) { int s = 0; for (int c = 0; c < NCLS; ++c) { const int n = cnt[c]; scnt[c] = n; spre[c] = s; s += (n + 255) >> 8; } spre[NCLS] = s; }
    __syncthreads();
}

__device__ __forceinline__ void phase_moe1(const Params& p, int l, int bid, int nb, unsigned char* lds) {
    const GemmCtx c = gemm_ctx();
    int* spre = (int*)(lds + G_LDS); int* scnt = spre + 32;
    int* stok = scnt + 32; float* srs = (float*)(stok + 256); float* swl = srs + 256; float* swh = swl + 256;
    moe_prefix(p.cnt + l * 32, spre, scnt);
    const int nrt = spre[NCLS], NU = nrt * 16;
    for (int u = bid; u < NU; u += nb) {
        const int rt = u >> 4, ct = u & 15;
        int cls = 0;
        for (int q = 1; q < NCLS; ++q) if (spre[q] <= rt) cls = q;
        int elo, ehi; cls_experts(cls, elo, ehi);
        const int lrow0 = (rt - spre[cls]) * 256, n = scnt[cls];
        if (c.tid < 256) {
            const int lr = lrow0 + c.tid; const bool ok = lr < n;
            const int tok = ok ? p.perm[(size_t)cls * NTOK + lr] : 0;
            stok[c.tid] = ok ? tok : -1; srs[c.tid] = rstd_of(p.part, tok);
            swl[c.tid] = p.tokw[(size_t)tok * 2]; swh[c.tid] = p.tokw[(size_t)tok * 2 + 1];
        }
        __syncthreads();
        const int r = c.tid >> 2;
        const int t0 = stok[r] < 0 ? 0 : stok[r], t1 = stok[r + 128] < 0 ? 0 : stok[r + 128];
        const int ex = ct < 8 ? elo : ehi;
        f32x4 acc[4][4]; acc_zero(acc);
        gemm_kloop(acc, p.hb, (unsigned)(t0 * DM + c.sc), (unsigned)(t1 * DM + c.sc), p.Wgu + ((size_t)ex * DM + (ct & 7) * 128) * DM, (unsigned)(r * DM + c.sc), DM / 32, lds, c);
#pragma unroll
        for (int m = 0; m < 4; ++m)
#pragma unroll
            for (int j = 0; j < 4; ++j) {
                const int rl = c.wr * 64 + m * 16 + c.fq * 4 + j; const float rs = srs[rl], w = ct < 8 ? swl[rl] : swh[rl];
                bf16_t* o = p.Hbuf + ((size_t)rt * 256 + rl) * DM + (ct < 8 ? 0 : 512) + (ct & 7) * 64 + c.wc * 32 + c.fr;
#pragma unroll
                for (int n2 = 0; n2 < 2; ++n2) { const float g = acc[m][n2][j] * rs, uu = acc[m][n2 + 2][j] * rs; o[n2 * 16] = f2bf(siluf_(g) * uu * w); }
            }
        __syncthreads();
    }
}

__device__ __forceinline__ void phase_moe2(const Params& p, int l, int bid, int nb, unsigned char* lds) {
    const GemmCtx c = gemm_ctx();
    int* spre = (int*)(lds + G_LDS); int* scnt = spre + 32; int* stok = scnt + 32;
    moe_prefix(p.cnt + l * 32, spre, scnt);
    const int nrt = spre[NCLS], NU = nrt * 8;
    for (int u = bid; u < NU; u += nb) {
        const int rt = u >> 3, ct = u & 7;
        int cls = 0;
        for (int q = 1; q < NCLS; ++q) if (spre[q] <= rt) cls = q;
        int elo, ehi; cls_experts(cls, elo, ehi);
        const int lrow0 = (rt - spre[cls]) * 256, n = scnt[cls];
        if (c.tid < 256) { const int lr = lrow0 + c.tid; stok[c.tid] = lr < n ? p.perm[(size_t)cls * NTOK + lr] : -1; }
        __syncthreads();
        const int r = c.tid >> 2;
        f32x4 acc[4][4]; acc_zero(acc);
        const bf16_t* a0 = p.Hbuf + (size_t)rt * 256 * DM;
        gemm_kloop(acc, a0, (unsigned)(r * DM + c.sc), (unsigned)((r + 128) * DM + c.sc), p.WdT + ((size_t)elo * DM + ct * 128) * 512, (unsigned)(r * 512 + c.sc), 16, lds, c);
        gemm_kloop(acc, a0 + 512, (unsigned)(r * DM + c.sc), (unsigned)((r + 128) * DM + c.sc), p.WdT + ((size_t)ehi * DM + ct * 128) * 512, (unsigned)(r * 512 + c.sc), 16, lds, c);
#pragma unroll
        for (int m = 0; m < 4; ++m)
#pragma unroll
            for (int j = 0; j < 4; ++j) {
                const int rl = c.wr * 64 + m * 16 + c.fq * 4 + j; const int tok = stok[rl];
                const size_t off = (size_t)(tok < 0 ? 0 : tok) * DM + ct * 128 + c.wc * 64 + c.fr;
                float ss = 0.f;
                if (tok >= 0) {
#pragma unroll
                    for (int n2 = 0; n2 < 4; ++n2) { const float v = p.h[off + n2 * 16] + acc[m][n2][j]; p.h[off + n2 * 16] = v; p.hb[off + n2 * 16] = f2bf(v); ss += v * v; }
                }
                ss += __shfl_xor(ss, 1); ss += __shfl_xor(ss, 2); ss += __shfl_xor(ss, 4); ss += __shfl_xor(ss, 8);
                if (c.fr == 0 && tok >= 0) p.part[(size_t)tok * 16 + ct * 2 + c.wc] = ss;
            }
        __syncthreads();
    }
}

__device__ __forceinline__ void phase_final(const Params& p, int bid, int nb) {
    const int tid = opaque_tid(), wave = tid >> 6, lane = tid & 63;
    const float* nf = p.in[I_NF];
    for (int row = bid * 8 + wave; row < NTOK; row += nb * 8) {
        const float rs = rstd_of(p.part, row);
        float* hr = p.h + (size_t)row * DM;
#pragma unroll
        for (int i = 0; i < 4; ++i) {
            f32x4 v = *(const f32x4*)(hr + i * 256 + lane * 4);
            const f32x4 g = *(const f32x4*)(nf + i * 256 + lane * 4);
            v[0] *= rs * g[0]; v[1] *= rs * g[1]; v[2] *= rs * g[2]; v[3] *= rs * g[3];
            *(f32x4*)(hr + i * 256 + lane * 4) = v;
        }
    }
}

constexpr int cmax(int a, int b) { return a > b ? a : b; }
constexpr int MEGA_LDS_BODY = cmax(cmax(cmax(GLA_LDS, LRU_LDS), cmax(DSA_LDS, DIL_LDS)), cmax(cmax(MG_LDS, RT_LDS), G_LDS + 8192));
constexpr int MEGA_LDS = PROBE_MASK ? 160 * 1024 : MEGA_LDS_BODY + 16;


__device__ __forceinline__ const Params& kparams() {
    const __attribute__((address_space(4))) Params* q = (const __attribute__((address_space(4))) Params*)__builtin_amdgcn_kernarg_segment_ptr();
    asm volatile("" : "+s"(q));
    return *(const Params*)q;
}
__global__ void __launch_bounds__(NT, 2) mega(Params p_kernarg) {
    (void)p_kernarg;
#define p kparams()
    unsigned char* lds = dyn_lds;
    volatile LAS unsigned* xbw = (volatile LAS unsigned*)(dyn_lds + MEGA_LDS_BODY);
    if (threadIdx.x == 0) { xbw[0] = 0u; xbw[1] = 0u; xbw[2] = 0u; xbw[3] = 0u; }
    __syncthreads();
    (void)xcd_barrier_post(p.bar, xbw);
#define PROBE_TICK(type) do { if (PROBE_MASK != 0 && blockIdx.x == 0 && threadIdx.x == 0) { volatile LAS unsigned long long* pw = (volatile LAS unsigned long long*)(dyn_lds + PROBE_OFF); \
        const unsigned long long now = __builtin_amdgcn_s_memrealtime(); if ((PROBE_MASK >> (type)) & 1) pw[1] += now - pw[0]; pw[0] = now; } } while (0)
#define GRID_SYNC() do { XcdBarrier _b; _b.bar = p.bar; _b.x = xb_xcc_id(); _b.st = (volatile LAS unsigned*)(dyn_lds + MEGA_LDS_BODY); xcd_barrier(_b); } while (0)
    const int bid = blockIdx.x, nb = gridDim.x;
    if (PROBE_MASK != 0 && threadIdx.x == 0) { volatile LAS unsigned long long* pw = (volatile LAS unsigned long long*)(dyn_lds + PROBE_OFF); pw[0] = __builtin_amdgcn_s_memrealtime(); pw[1] = 0ull; }
    phase_prep(p, bid, nb);
    GRID_SYNC(); PROBE_TICK(0);
#pragma unroll 1
    for (int l = 0; l < DEPTH; ++l) {
        phase_weights(p, l, bid, nb, lds);
        GRID_SYNC(); PROBE_TICK(1);
        phase_inproj(p, bid, nb, lds);
        GRID_SYNC(); PROBE_TICK(2);
        {
            volatile LAS int* slot = (volatile LAS int*)(dyn_lds + MEGA_LDS_BODY + 12);
            int* qc = p.cnt + l * 32 + 24;
            phase_gla(p, l, qc + 0, slot, lds);
            phase_lru(p, l, qc + 1, slot, lds);
            phase_dsa(p, qc + 2, slot, lds);
            phase_dil(p, qc + 3, slot, lds);
        }
        GRID_SYNC(); PROBE_TICK(3);
        phase_merge(p, l, bid, nb, lds);
        GRID_SYNC(); PROBE_TICK(4);
        phase_out(p, l, bid, nb, lds);
        GRID_SYNC(); PROBE_TICK(5);
        phase_router(p, l, bid, nb, lds);
        GRID_SYNC(); PROBE_TICK(6);
        phase_moe1(p, l, bid, nb, lds);
        GRID_SYNC(); PROBE_TICK(7);
        phase_moe2(p, l, bid, nb, lds);
        GRID_SYNC(); PROBE_TICK(8);
    }
    phase_final(p, bid, nb);
    if (PROBE_MASK != 0 && threadIdx.x == 0) { volatile LAS unsigned long long* pw = (volatile LAS unsigned long long*)(dyn_lds + PROBE_OFF);
        const unsigned long long t0 = __builtin_amdgcn_s_memrealtime(), w = pw[1]; while (__builtin_amdgcn_s_memrealtime() - t0 < w) __builtin_amdgcn_s_sleep(8); }
#undef p
}

static size_t align_up(size_t v, size_t a) { return (v + a - 1) / a * a; }

extern "C" void kernel_launch(void* const* d_in, const int* in_sizes, int n_in, void* d_out, int out_size, void* d_ws, size_t ws_size, hipStream_t stream) {
    (void)in_sizes; (void)n_in; (void)out_size;
    Params p{};
    for (int i = 0; i < N_IN; ++i) p.in[i] = (const float*)d_in[i];
    p.h = (float*)d_out;
    unsigned char* w = (unsigned char*)d_ws; size_t off = 0;
    auto take = [&](size_t bytes) { unsigned char* r = w + off; off = align_up(off + bytes, 256); return r; };
    p.bar = (unsigned*)take(XCD_BAR_WORDS * 4);
    p.cnt = (int*)take(DEPTH * 32 * 4);
    p.Bt_in = (bf16_t*)take((size_t)NP * DM * 2);
    p.Bt_gate = (bf16_t*)take((size_t)4 * DM * DM * 2);
    p.Bt_br = (bf16_t*)take((size_t)4 * DM * 384 * 2);
    p.Bt_out = (bf16_t*)take((size_t)DM * DM * 2);
    p.Wgu = (bf16_t*)take((size_t)16 * DM * DM * 2);
    p.WdT = (bf16_t*)take((size_t)16 * DM * 512 * 2);
    p.hb = (bf16_t*)take((size_t)NTOK * DM * 2);
    p.part = (float*)take((size_t)NTOK * 16 * 4);
    p.biasB = (float*)take(6 * TABW * 4);
    p.biasC = (float*)take(6 * TABW * 4);
    p.VtB = (bf16_t*)take((size_t)NTOK * 384 * 2);
    p.VtC = (bf16_t*)take((size_t)NTOK * 384 * 2);
    p.tokw = (float*)take((size_t)NTOK * 2 * 4);
    p.perm = (int*)take((size_t)NCLS * NTOK * 4);
    p.proj = (bf16_t*)take((size_t)NTOK * NP * 2);
    p.Hbuf = p.proj;
    if (off > ws_size) return;

    static int grid = 0;
    if (grid == 0) {
        int dev = 0, cus = 0;
        (void)hipGetDevice(&dev);
        (void)hipDeviceGetAttribute(&cus, hipDeviceAttributeMultiprocessorCount, dev);
        if (hipFuncSetAttribute((const void*)mega, hipFuncAttributeMaxDynamicSharedMemorySize, MEGA_LDS) != hipSuccess) { grid = -1; return; }
        int per_cu = 0;
        (void)hipOccupancyMaxActiveBlocksPerMultiprocessor(&per_cu, (const void*)mega, NT, MEGA_LDS);
        (void)hipGetLastError();
        grid = cus > 0 ? cus : 256;
    }
    if (grid < 0) return;
    (void)hipMemsetAsync(p.bar, 0, XCD_BAR_WORDS * sizeof(unsigned), stream);
    mega<<<grid, NT, MEGA_LDS, stream>>>(p);
}
```

```cpp
#include <hip/hip_runtime.h>
#include <stdint.h>

typedef unsigned short bf16_t;
typedef short bf16x8 __attribute__((ext_vector_type(8)));
typedef float f32x4 __attribute__((ext_vector_type(4)));
typedef unsigned u32x4 __attribute__((ext_vector_type(4)));
typedef float f32x16 __attribute__((ext_vector_type(16)));

constexpr int NTOK = 32768, TSEQ = 2048, NBATCH = 16, DM = 1024, DEPTH = 2;
constexpr int NP = 4608;
constexpr int NT = 512;
constexpr int C_AQ = 0, C_AK = 192, C_AV = 384, C_AG = 768, C_BQ = 1152, C_CQ = 1536, C_DY = 1920, C_BK = 2304, C_CK = 2688,
              C_BV = 3072, C_CV = 3456, C_DX = 3840, C_IQ = 4224, C_IK = 4352, C_ALR = 4384, C_IW = 4400;
constexpr int C_OB = 768;
constexpr int C_MG = 2304;
constexpr float EPS = 1e-6f;
constexpr int NCLS = 24, MAXRT = 152;
constexpr int TABW = 2080;
constexpr float LOG2E = 1.4426950408889634f, NEG_BIG = -3.0e38f;

#ifndef PROBE_MASK
#define PROBE_MASK 0
#endif
extern __shared__ __attribute__((aligned(16))) unsigned char dyn_lds[];
constexpr int PROBE_OFF = 160 * 1024 - 64;
#define PROBE_UNIT_BEGIN(bit, cond) do { if (((PROBE_MASK >> (bit)) & 1) && (cond) && threadIdx.x == 0) { volatile __attribute__((address_space(3))) unsigned long long* pw = (volatile __attribute__((address_space(3))) unsigned long long*)(dyn_lds + PROBE_OFF); pw[2] = __builtin_amdgcn_s_memrealtime(); } } while (0)
#define PROBE_UNIT_END(bit, cond) do { if (((PROBE_MASK >> (bit)) & 1) && (cond) && threadIdx.x == 0) { volatile __attribute__((address_space(3))) unsigned long long* pw = (volatile __attribute__((address_space(3))) unsigned long long*)(dyn_lds + PROBE_OFF); pw[1] += 4ull * (__builtin_amdgcn_s_memrealtime() - pw[2]); } } while (0)

enum { I_X = 0, I_WIN, I_AW2, I_AB2, I_AGAIN, I_CONVW, I_CONVB, I_WR, I_BR, I_WI, I_BI, I_LAM, I_WGATE, I_BGATE, I_WBR, I_WOUT, I_RELB,
       I_N1, I_N2, I_NF, I_WRG, I_BRG, I_WRE, I_BRE, I_MWG, I_MWU, I_MWD, N_IN };

struct Params {
    const float* in[N_IN];
    float* h;
    bf16_t* Bt_in;
    bf16_t* Bt_gate;
    bf16_t* Bt_br;
    bf16_t* Bt_out;
    bf16_t* Wgu;
    bf16_t* WdT;
    bf16_t* hb;
    bf16_t* proj;
    bf16_t* Hbuf;
    float* part;
    float* biasB;
    float* biasC;
    bf16_t* VtB;
    bf16_t* VtC;
    float* tokw;
    int* perm;
    int* cnt;
    unsigned* bar;
};

__device__ __forceinline__ bf16_t f2bf(float f) { unsigned u = __float_as_uint(f); u += 0x7FFFu + ((u >> 16) & 1u); return (bf16_t)(u >> 16); }
__device__ __forceinline__ float bf2f(bf16_t b) { return __uint_as_float(((unsigned)b) << 16); }
__device__ __forceinline__ float wave_sum(float v) {
#pragma unroll
    for (int o = 32; o > 0; o >>= 1) v += __shfl_xor(v, o);
    return v;
}
__device__ __forceinline__ float wave_max(float v) {
#pragma unroll
    for (int o = 32; o > 0; o >>= 1) v = fmaxf(v, __shfl_xor(v, o));
    return v;
}
__device__ __forceinline__ int wave_sum_i(int v) {
#pragma unroll
    for (int o = 32; o > 0; o >>= 1) v += __shfl_xor(v, o);
    return v;
}
__device__ __forceinline__ int opaque_tid() { int t = threadIdx.x; asm volatile("" : "+v"(t)); return t; }
__device__ __forceinline__ unsigned cvt_pk_bf16(float lo, float hi) { unsigned r; asm volatile("v_cvt_pk_bf16_f32 %0, %1, %2" : "=v"(r) : "v"(lo), "v"(hi)); return r; }
__device__ __forceinline__ float sigmoidf_(float x) { return 1.0f / (1.0f + __expf(-x)); }
__device__ __forceinline__ float siluf_(float x) { return x / (1.0f + __expf(-x)); }
__device__ __forceinline__ float rstd_of(const float* part, int row) {
    const f32x4* p = (const f32x4*)(part + (size_t)row * 16);
    f32x4 a = p[0], b = p[1], c = p[2], d = p[3];
    float s = ((a[0] + a[1]) + (a[2] + a[3])) + ((b[0] + b[1]) + (b[2] + b[3])) + ((c[0] + c[1]) + (c[2] + c[3])) + ((d[0] + d[1]) + (d[2] + d[3]));
    return rsqrtf(s * (1.0f / 1024.0f) + EPS);
}
__device__ __forceinline__ int map_in_col(int c) {
    if (c < 1152) return c;
    if (c < 1536) return 1168 + (c - 1152);
    if (c < 1920) return 2484 + (c - 1536);
    if (c < 2304) return 3636 + (c - 1920);
    if (c < 2688) return 1552 + (c - 2304);
    if (c < 3072) return 2868 + (c - 2688);
    if (c < 3456) return 1936 + (c - 3072);
    if (c < 3840) return 3252 + (c - 3456);
    if (c < 4224) return 4020 + (c - 3840);
    if (c < 4352) return 2320 + (c - 4224);
    if (c < 4384) return 2448 + (c - 4352);
    if (c < 4400) return 1152 + (c - 4384);
    if (c < 4404) return 2480 + (c - 4400);
    return -1;
}
__device__ __forceinline__ int rel_bucket(int n) {
    if (n < 16) return n;
    float v = logf((float)n / 16.0f) / 4.852030263919617f * 16.0f;
    int b = 16 + (int)v;
    return b < 31 ? b : 31;
}

#define XB_TMO      128
#define XB_XCNT(j)  (256  + 64 * (j))
#define XB_XSUB(j)  (1280 + 64 * (j))
#define XB_XGEN(j)  (2304 + 64 * (j))
#define XB_TOP      3328
#define XB_TOPGEN   3392
#define XCD_BAR_WORDS 3456
#define XB_SPIN_CAP (1u << 18)
#define LAS __attribute__((address_space(3)))

__device__ __forceinline__ unsigned xb_ld(unsigned* p)              { return __hip_atomic_load(p, __ATOMIC_RELAXED, __HIP_MEMORY_SCOPE_AGENT); }
__device__ __forceinline__ unsigned xb_add(unsigned* p, unsigned v) { return __hip_atomic_fetch_add(p, v, __ATOMIC_RELAXED, __HIP_MEMORY_SCOPE_AGENT); }
__device__ __forceinline__ unsigned xb_xcc_id() { return (unsigned)__builtin_amdgcn_s_getreg((3 << 11) | 20) & 0xFu; }
#define XB_SPIN(cond, bar) do { unsigned _sp = 0; while (cond) { __builtin_amdgcn_s_sleep(1); \
    if ((++_sp & 255u) == 0u) { if (xb_ld(&(bar)[XB_TMO])) break; if (_sp > XB_SPIN_CAP) { atomicAdd(&(bar)[XB_TMO], 1u); break; } } } } while (0)

struct XcdBarrier {
    unsigned* bar; unsigned x;
    volatile LAS unsigned* st;
};

__device__ __forceinline__ XcdBarrier xcd_barrier_post(unsigned* bar, volatile LAS unsigned* st) {
    XcdBarrier b; b.bar = bar; b.x = xb_xcc_id(); b.st = st;
    if (threadIdx.x == 0) (void)xb_add(&bar[XB_XCNT(b.x)], 1u);
    return b;
}
__device__ __forceinline__ void xcd_barrier_complete(unsigned* bar, unsigned x, unsigned& nloc, unsigned& nx) {
    const unsigned G = gridDim.x * gridDim.y * gridDim.z;
    unsigned sum, cnt, mine, sp = 0u;
    for (;;) {
        sum = 0u; cnt = 0u; mine = 0u;
#pragma unroll
        for (unsigned j = 0; j < 16; ++j) { const unsigned c = xb_ld(&bar[XB_XCNT(j)]); sum += c; cnt += (c > 0u) ? 1u : 0u; mine = (j == x) ? c : mine; }
        if (sum == G) break;
        __builtin_amdgcn_s_sleep(1);
        if ((++sp & 255u) == 0u) { if (xb_ld(&bar[XB_TMO])) break; if (sp > XB_SPIN_CAP) { atomicAdd(&bar[XB_TMO], 1u); break; } }
    }
    nloc = mine > 0u ? mine : 1u; nx = cnt > 0u ? cnt : 1u;
}

__device__ __forceinline__ void xcd_barrier(const XcdBarrier& b) {
    asm volatile("s_waitcnt vmcnt(0)" ::: "memory");
    __syncthreads();
    if (threadIdx.x == 0) {
        unsigned* bar = b.bar;
        __builtin_amdgcn_s_waitcnt(0);
        unsigned nloc = b.st[0], nx = b.st[1];
        if (nloc == 0u) { xcd_barrier_complete(bar, b.x, nloc, nx); b.st[0] = nloc; b.st[1] = nx; }
        const unsigned old = xb_add(&bar[XB_XSUB(b.x)], 1u);
        const unsigned gen = old / nloc;
        if (old + 1u == (gen + 1u) * nloc) {
            __builtin_amdgcn_fence(__ATOMIC_RELEASE, "agent");
            asm volatile("s_waitcnt vmcnt(0)" ::: "memory");
            const unsigned og = xb_add(&bar[XB_TOP], 1u);
            const unsigned tg = og / nx;
            if (og + 1u == (tg + 1u) * nx) xb_add(&bar[XB_TOPGEN], 1u);
            else XB_SPIN(xb_ld(&bar[XB_TOPGEN]) == tg, bar);
            __builtin_amdgcn_fence(__ATOMIC_ACQUIRE, "agent");
            xb_add(&bar[XB_XGEN(b.x)], 1u);
            asm volatile("s_waitcnt vmcnt(0)" ::: "memory");
        } else {
            XB_SPIN(xb_ld(&bar[XB_XGEN(b.x)]) == gen, bar);
            __builtin_amdgcn_fence(__ATOMIC_ACQUIRE, "agent");
            asm volatile("s_waitcnt vmcnt(0)" ::: "memory");
        }
    }
    __syncthreads();
}


template <class MapF>
__device__ __forceinline__ void conv_wT(const float* __restrict__ src, int ldsrc, int K, bf16_t* __restrict__ dst, int nrows, MapF colmap,
                                        const float* __restrict__ scale, int bid, int nb, float* tile) {
    const int tid = opaque_tid(), nkt = K / 64, ntile = (nrows / 64) * nkt;
    for (int t = bid; t < ntile; t += nb) {
        const int r0 = (t / nkt) * 64, k0 = (t % nkt) * 64;
#pragma unroll
        for (int i = 0; i < 8; ++i) {
            const int e = tid + NT * i, kk = e >> 6, rr = e & 63;
            const int c = colmap(r0 + rr);
            float v = 0.f;
            if (c >= 0) { v = src[(size_t)(k0 + kk) * ldsrc + c]; if (scale) v *= scale[k0 + kk]; }
            tile[kk * 65 + rr] = v;
        }
        __syncthreads();
#pragma unroll
        for (int i = 0; i < 8; ++i) {
            const int e = tid + NT * i, rr = e >> 6, kk = e & 63;
            dst[(size_t)(r0 + rr) * K + k0 + kk] = f2bf(tile[kk * 65 + rr]);
        }
        __syncthreads();
    }
}

__device__ __forceinline__ void phase_weights(const Params& p, int l, int bid, int nb, unsigned char* lds) {
    float* tile = (float*)lds;
    const float* n1 = p.in[I_N1] + l * DM;
    const float* n2 = p.in[I_N2] + l * DM;
    conv_wT(p.in[I_WIN] + (size_t)l * DM * 4404, 4404, DM, p.Bt_in, NP, [](int r) { return map_in_col(r); }, n1, bid, nb, tile);
    for (int i = 0; i < 4; ++i) {
        conv_wT(p.in[I_WGATE] + ((size_t)l * 4 + i) * DM * DM, DM, DM, p.Bt_gate + (size_t)i * DM * DM, DM, [](int r) { return r; }, n1, bid, nb, tile);
        conv_wT(p.in[I_WBR] + ((size_t)l * 4 + i) * 384 * DM, DM, 384, p.Bt_br + (size_t)i * DM * 384, DM, [](int r) { return r; }, nullptr, bid, nb, tile);
    }
    conv_wT(p.in[I_WOUT] + (size_t)l * DM * DM, DM, DM, p.Bt_out, DM, [](int r) { return r; }, nullptr, bid, nb, tile);
    for (int e = 0; e < 16; ++e) {
        const float* wg = p.in[I_MWG] + ((size_t)l * 16 + e) * DM * 512;
        const float* wu = p.in[I_MWU] + ((size_t)l * 16 + e) * DM * 512;
        bf16_t* dst = p.Wgu + (size_t)e * DM * DM;
        {
            const int tid = opaque_tid();
            for (int t = bid; t < 16 * 16; t += nb) {
                const int r0 = (t / 16) * 64, k0 = (t % 16) * 64;
#pragma unroll
                for (int i = 0; i < 8; ++i) {
                    const int ee = tid + NT * i, kk = ee >> 6, rr = ee & 63, rho = r0 + rr;
                    const int T = rho >> 8, wc = (rho >> 6) & 3, q = (rho >> 5) & 1, ii = rho & 31, hcol = 128 * T + 32 * wc + ii;
                    const float* s = q ? wu : wg;
                    tile[kk * 65 + rr] = s[(size_t)(k0 + kk) * 512 + hcol] * n2[k0 + kk];
                }
                __syncthreads();
#pragma unroll
                for (int i = 0; i < 8; ++i) {
                    const int ee = tid + NT * i, rr = ee >> 6, kk = ee & 63;
                    dst[(size_t)(r0 + rr) * DM + k0 + kk] = f2bf(tile[kk * 65 + rr]);
                }
                __syncthreads();
            }
        }
        conv_wT(p.in[I_MWD] + ((size_t)l * 16 + e) * 512 * DM, DM, 512, p.WdT + (size_t)e * DM * 512, DM, [](int r) { return r; }, nullptr, bid, nb, tile);
    }
}

__device__ __forceinline__ void phase_prep(const Params& p, int bid, int nb) {
    const int tid = opaque_tid(), wave = tid >> 6, lane = tid & 63;
    const float* x = p.in[I_X];
    for (int row = bid * 8 + wave; row < NTOK; row += nb * 8) {
        const float* xr = x + (size_t)row * DM;
        float s = 0.f;
#pragma unroll
        for (int i = 0; i < 4; ++i) {
            const f32x4 v = *(const f32x4*)(xr + i * 256 + lane * 4);
            s += v[0] * v[0] + v[1] * v[1] + v[2] * v[2] + v[3] * v[3];
            const unsigned lo = (unsigned)f2bf(v[0]) | ((unsigned)f2bf(v[1]) << 16), hi = (unsigned)f2bf(v[2]) | ((unsigned)f2bf(v[3]) << 16);
            *(uint2*)(p.hb + (size_t)row * DM + i * 256 + lane * 4) = make_uint2(lo, hi);
        }
        s = wave_sum(s);
        if (lane < 16) p.part[(size_t)row * 16 + lane] = (lane == 0) ? s : 0.f;
    }
    const float* rb = p.in[I_RELB];
    for (int i = bid * NT + tid; i < 6 * TABW; i += nb * NT) {
        const int h = i / TABW, d = i % TABW - 32;
        float vb = NEG_BIG, vc = NEG_BIG;
        if (d >= 0) {
            const int bk = rel_bucket(d);
            vb = rb[bk * 12 + h] * LOG2E;
            const int m = (d <= 128 ? 1 : 0) + ((d % 4 == 0 && d <= 512) ? 1 : 0) + ((d % 16 == 0) ? 1 : 0);
            if (m > 0) vc = (rb[bk * 12 + 6 + h] + logf((float)m)) * LOG2E;
        }
        p.biasB[i] = vb; p.biasC[i] = vc;
    }
    for (int i = bid * NT + tid; i < DEPTH * 32; i += nb * NT) p.cnt[i] = 0;
}

constexpr int G_BUF = 256 * 32 * 2 + 128 * 32 * 2;
constexpr int G_NS = 6, G_LDS = G_NS * G_BUF;
constexpr int MG_NS = 5, MG_GLDS = MG_NS * G_BUF;
struct GemmCtx { int tid, wid, lane, wr, wc, fr, fq, sc, rdo; };
__device__ __forceinline__ GemmCtx gemm_ctx() {
    GemmCtx c; c.tid = opaque_tid(); c.wid = c.tid >> 6; c.lane = c.tid & 63; c.wr = c.wid >> 1; c.wc = c.wid & 1; c.fr = c.lane & 15; c.fq = c.lane >> 4;
    c.sc = (((c.tid & 3) ^ ((0 - (c.tid >> 4)) & 3))) * 8;
    c.rdo = c.fr * 64 + ((c.fq ^ ((0 - (c.fr >> 2)) & 3)) * 16);
    return c;
}
__device__ __forceinline__ void acc_zero(f32x4 (&acc)[4][4]) {
#pragma unroll
    for (int m = 0; m < 4; ++m)
#pragma unroll
        for (int n = 0; n < 4; ++n) acc[m][n] = (f32x4){0.f, 0.f, 0.f, 0.f};
}
__device__ __forceinline__ void gemm_stage(const bf16_t* A, unsigned oa0, unsigned oa1, const bf16_t* B, unsigned ob, int t, unsigned char* buf, const GemmCtx& c) {
    const bf16_t* At = A + t * 32; const bf16_t* Bt = B + t * 32;
    __builtin_amdgcn_global_load_lds((const unsigned*)(At + oa0), (unsigned*)(buf + c.tid * 16), 16, 0, 0);
    __builtin_amdgcn_global_load_lds((const unsigned*)(At + oa1), (unsigned*)(buf + 8192 + c.tid * 16), 16, 0, 0);
    __builtin_amdgcn_global_load_lds((const unsigned*)(Bt + ob), (unsigned*)(buf + 16384 + c.tid * 16), 16, 0, 0);
}
template <int NS>
__device__ __forceinline__ void gemm_kloop(f32x4 (&acc)[4][4], const bf16_t* A, unsigned oa0, unsigned oa1, const bf16_t* B, unsigned ob, int nkt, unsigned char* lds, const GemmCtx& c) {
#pragma unroll
    for (int i = 0; i < NS - 1; ++i) gemm_stage(A, oa0, oa1, B, ob, i, lds + i * G_BUF, c);
    int cur = 0;
#pragma unroll 1
    for (int t = 0; t < nkt; ++t) {
        const int young = nkt - 1 - t;
        if (NS >= 6 && young >= 4) asm volatile("s_waitcnt vmcnt(12)" ::: "memory");
        else if (NS >= 5 && young >= 3) asm volatile("s_waitcnt vmcnt(9)" ::: "memory");
        else if (NS >= 4 && young >= 2) asm volatile("s_waitcnt vmcnt(6)" ::: "memory");
        else if (young >= 1) asm volatile("s_waitcnt vmcnt(3)" ::: "memory");
        else asm volatile("s_waitcnt vmcnt(0)" ::: "memory");
        __builtin_amdgcn_s_barrier();
        asm volatile("" ::: "memory");
        const int nxt = cur == 0 ? NS - 1 : cur - 1;
        if (t + NS - 1 < nkt) gemm_stage(A, oa0, oa1, B, ob, t + NS - 1, lds + nxt * G_BUF, c);
        const unsigned char* SA = lds + cur * G_BUF; const unsigned char* SB = SA + 16384;
        bf16x8 At[4], Bt[4];
#pragma unroll
        for (int m = 0; m < 4; ++m) At[m] = *reinterpret_cast<const bf16x8*>(SA + (c.wr * 64 + m * 16) * 64 + c.rdo);
#pragma unroll
        for (int n = 0; n < 4; ++n) Bt[n] = *reinterpret_cast<const bf16x8*>(SB + (c.wc * 64 + n * 16) * 64 + c.rdo);
        asm volatile("s_waitcnt lgkmcnt(0)" ::: "memory");
        __builtin_amdgcn_sched_barrier(0);
#pragma unroll
        for (int m = 0; m < 4; ++m)
#pragma unroll
            for (int n = 0; n < 4; ++n) acc[m][n] = __builtin_amdgcn_mfma_f32_16x16x32_bf16(At[m], Bt[n], acc[m][n], 0, 0, 0);
        cur = cur == NS - 1 ? 0 : cur + 1;
    }
    __builtin_amdgcn_s_barrier();
    asm volatile("" ::: "memory");
}

template <int NS>
__device__ __forceinline__ void gemm_kloop_p(f32x4 (&acc)[4][4], const bf16_t* A, unsigned oa0, unsigned oa1, const bf16_t* B, unsigned ob, int nkt, unsigned char* lds, const GemmCtx& c) {
#pragma unroll
    for (int i = 0; i < NS; ++i) gemm_stage(A, oa0, oa1, B, ob, i, lds + i * G_BUF, c);
    const int aoff = (c.wr * 64) * 64 + c.rdo, boff = 16384 + (c.wc * 64) * 64 + c.rdo;
    bf16x8 A0[4], B0[4], A1[4], B1[4];
#define GK_WAIT(young_) do { const int _y = (young_); \
        if (NS >= 6 && _y >= 4) asm volatile("s_waitcnt vmcnt(12)" ::: "memory"); \
        else if (NS >= 5 && _y >= 3) asm volatile("s_waitcnt vmcnt(9)" ::: "memory"); \
        else if (NS >= 4 && _y >= 2) asm volatile("s_waitcnt vmcnt(6)" ::: "memory"); \
        else if (_y >= 1) asm volatile("s_waitcnt vmcnt(3)" ::: "memory"); \
        else asm volatile("s_waitcnt vmcnt(0)" ::: "memory"); } while (0)
#define GK_READ(FA, FB, buf_) do { const unsigned char* _s = lds + (buf_) * G_BUF; \
        _Pragma("unroll") for (int m = 0; m < 4; ++m) FA[m] = *reinterpret_cast<const bf16x8*>(_s + aoff + m * 1024); \
        _Pragma("unroll") for (int n = 0; n < 4; ++n) FB[n] = *reinterpret_cast<const bf16x8*>(_s + boff + n * 1024); } while (0)
#define GK_MMA(FA, FB) do { _Pragma("unroll") for (int m = 0; m < 4; ++m) _Pragma("unroll") for (int n = 0; n < 4; ++n) \
        acc[m][n] = __builtin_amdgcn_mfma_f32_16x16x32_bf16(FA[m], FB[n], acc[m][n], 0, 0, 0); } while (0)
    GK_WAIT(NS - 1);
    __builtin_amdgcn_s_barrier(); asm volatile("" ::: "memory");
    GK_READ(A0, B0, 0);
    int cur = 0;
#pragma unroll 1
    for (int t = 0; t < nkt; t += 2) {
        {
            GK_WAIT(nkt - 2 - t < NS - 2 ? nkt - 2 - t : NS - 2);
            asm volatile("s_waitcnt lgkmcnt(0)" ::: "memory");
            __builtin_amdgcn_s_barrier(); asm volatile("" ::: "memory");
            if (t + NS < nkt) gemm_stage(A, oa0, oa1, B, ob, t + NS, lds + cur * G_BUF, c);
            const int n1 = cur == NS - 1 ? 0 : cur + 1;
            GK_READ(A1, B1, n1);
            GK_MMA(A0, B0);
            cur = n1;
        }
        {
            const bool more = t + 2 < nkt;
            if (more) GK_WAIT(nkt - 3 - t < NS - 2 ? nkt - 3 - t : NS - 2);
            asm volatile("s_waitcnt lgkmcnt(0)" ::: "memory");
            __builtin_amdgcn_s_barrier(); asm volatile("" ::: "memory");
            if (t + 1 + NS < nkt) gemm_stage(A, oa0, oa1, B, ob, t + 1 + NS, lds + cur * G_BUF, c);
            const int n1 = cur == NS - 1 ? 0 : cur + 1;
            if (more) GK_READ(A0, B0, n1);
            GK_MMA(A1, B1);
            cur = n1;
        }
    }
#undef GK_WAIT
#undef GK_READ
#undef GK_MMA
    __builtin_amdgcn_s_barrier(); asm volatile("" ::: "memory");
}

template <int NS, bool SWAP>
__device__ __forceinline__ void gemm_kloop_s(f32x4 (&acc)[4][4], const bf16_t* A, unsigned oa0, unsigned oa1, const bf16_t* B, unsigned ob, int nkt, unsigned char* lds, const GemmCtx& c) {
    constexpr int D = NS - 2;
#pragma unroll
    for (int i = 0; i < D; ++i) gemm_stage(A, oa0, oa1, B, ob, i, lds + i * G_BUF, c);
    const int aoff = (c.wr * 64) * 64 + c.rdo, boff = 16384 + (c.wc * 64) * 64 + c.rdo;
    const bool trailing = __builtin_amdgcn_readfirstlane(c.wid) >= 4;
#define GS_WAIT(young_) do { const int _y = (young_); \
        if (D >= 5 && _y >= 3) asm volatile("s_waitcnt vmcnt(9)" ::: "memory"); \
        else if (D >= 4 && _y >= 2) asm volatile("s_waitcnt vmcnt(6)" ::: "memory"); \
        else if (_y >= 1) asm volatile("s_waitcnt vmcnt(3)" ::: "memory"); \
        else asm volatile("s_waitcnt vmcnt(0)" ::: "memory"); } while (0)
    GS_WAIT(D - 1);
    __builtin_amdgcn_s_barrier(); asm volatile("" ::: "memory");
    if (trailing) { __builtin_amdgcn_s_barrier(); asm volatile("" ::: "memory"); }
    int cur = 0, nxt = D % NS;
#pragma unroll 1
    for (int t = 0; t < nkt; ++t) {
        if (t + 1 < nkt) GS_WAIT(nkt - 2 - t < D - 2 ? nkt - 2 - t : D - 2);
        if (t + D < nkt) gemm_stage(A, oa0, oa1, B, ob, t + D, lds + nxt * G_BUF, c);
        const unsigned char* sb = lds + cur * G_BUF;
        bf16x8 At[4], Bt[4];
#pragma unroll
        for (int m = 0; m < 4; ++m) At[m] = *reinterpret_cast<const bf16x8*>(sb + aoff + m * 1024);
#pragma unroll
        for (int n = 0; n < 4; ++n) Bt[n] = *reinterpret_cast<const bf16x8*>(sb + boff + n * 1024);
        __builtin_amdgcn_s_barrier(); asm volatile("" ::: "memory");
        asm volatile("s_waitcnt lgkmcnt(0)" ::: "memory");
        __builtin_amdgcn_sched_barrier(0);
        __builtin_amdgcn_s_setprio(1);
#pragma unroll
        for (int m = 0; m < 4; ++m)
#pragma unroll
            for (int n = 0; n < 4; ++n) acc[m][n] = SWAP ? __builtin_amdgcn_mfma_f32_16x16x32_bf16(Bt[n], At[m], acc[m][n], 0, 0, 0) : __builtin_amdgcn_mfma_f32_16x16x32_bf16(At[m], Bt[n], acc[m][n], 0, 0, 0);
        __builtin_amdgcn_s_setprio(0);
        __builtin_amdgcn_s_barrier(); asm volatile("" ::: "memory");
        cur = cur == NS - 1 ? 0 : cur + 1; nxt = nxt == NS - 1 ? 0 : nxt + 1;
    }
#undef GS_WAIT
    if (!trailing) { __builtin_amdgcn_s_barrier(); asm volatile("" ::: "memory"); }
}

constexpr int G2_BUF = 2 * 256 * 32 * 2, G2_NS = 4, G2_LDS = G2_NS * G2_BUF;
struct Gemm2Ctx { int tid, wid, lane, wr, wc, fr, fq, sc, aoff, boff; };
__device__ __forceinline__ Gemm2Ctx gemm2_ctx() {
    Gemm2Ctx c; c.tid = opaque_tid(); c.wid = c.tid >> 6; c.lane = c.tid & 63; c.wr = c.wid >> 2; c.wc = c.wid & 3; c.fr = c.lane & 15; c.fq = c.lane >> 4;
    c.sc = (((c.tid & 3) ^ ((0 - (c.tid >> 4)) & 3))) * 8;
    const int rdo = c.fr * 64 + ((c.fq ^ ((0 - (c.fr >> 2)) & 3)) * 16);
    c.aoff = (c.wr * 128) * 64 + rdo; c.boff = 16384 + (c.wc * 64) * 64 + rdo;
    return c;
}
__device__ __forceinline__ void acc2_zero(f32x4 (&acc)[8][4]) {
#pragma unroll
    for (int m = 0; m < 8; ++m)
#pragma unroll
        for (int n = 0; n < 4; ++n) acc[m][n] = (f32x4){0.f, 0.f, 0.f, 0.f};
}
__device__ __forceinline__ void gemm2_stage(const bf16_t* A, unsigned oa0, unsigned oa1, const bf16_t* B, unsigned ob0, unsigned ob1, int t, unsigned char* buf, int tid) {
    const bf16_t* At = A + t * 32; const bf16_t* Bt = B + t * 32;
    __builtin_amdgcn_global_load_lds((const unsigned*)(At + oa0), (unsigned*)(buf + tid * 16), 16, 0, 0);
    __builtin_amdgcn_global_load_lds((const unsigned*)(At + oa1), (unsigned*)(buf + 8192 + tid * 16), 16, 0, 0);
    __builtin_amdgcn_global_load_lds((const unsigned*)(Bt + ob0), (unsigned*)(buf + 16384 + tid * 16), 16, 0, 0);
    __builtin_amdgcn_global_load_lds((const unsigned*)(Bt + ob1), (unsigned*)(buf + 24576 + tid * 16), 16, 0, 0);
}
template <bool SWAP>
__device__ __forceinline__ void gemm2_kloop(f32x4 (&acc)[8][4], const bf16_t* A, unsigned oa0, unsigned oa1, const bf16_t* B, unsigned ob0, unsigned ob1, int nkt, unsigned char* lds, const Gemm2Ctx& c) {
#pragma unroll
    for (int i = 0; i < 3; ++i) gemm2_stage(A, oa0, oa1, B, ob0, ob1, i, lds + i * G2_BUF, c.tid);
    const bool trailing = __builtin_amdgcn_readfirstlane(c.wid) >= 4;
    asm volatile("s_waitcnt vmcnt(8)" ::: "memory");
    __builtin_amdgcn_s_barrier(); asm volatile("" ::: "memory");
    if (trailing) { __builtin_amdgcn_s_barrier(); asm volatile("" ::: "memory"); }
    int cur = 0;
#pragma unroll 1
    for (int t = 0; t < nkt; ++t) {
        if (t + 2 < nkt) asm volatile("s_waitcnt vmcnt(4)" ::: "memory"); else asm volatile("s_waitcnt vmcnt(0)" ::: "memory");
        const unsigned char* sb = lds + cur * G2_BUF;
        bf16x8 At[8], Bt[4];
#pragma unroll
        for (int n = 0; n < 4; ++n) Bt[n] = *reinterpret_cast<const bf16x8*>(sb + c.boff + n * 1024);
#pragma unroll
        for (int m = 0; m < 8; ++m) At[m] = *reinterpret_cast<const bf16x8*>(sb + c.aoff + m * 1024);
        __builtin_amdgcn_s_barrier(); asm volatile("" ::: "memory");
        asm volatile("s_waitcnt lgkmcnt(0)" ::: "memory");
        __builtin_amdgcn_sched_barrier(0);
#pragma unroll
        for (int m = 0; m < 4; ++m)
#pragma unroll
            for (int n = 0; n < 4; ++n) acc[m][n] = SWAP ? __builtin_amdgcn_mfma_f32_16x16x32_bf16(Bt[n], At[m], acc[m][n], 0, 0, 0) : __builtin_amdgcn_mfma_f32_16x16x32_bf16(At[m], Bt[n], acc[m][n], 0, 0, 0);
        __builtin_amdgcn_sched_barrier(0);
        if (t + 3 < nkt) gemm2_stage(A, oa0, oa1, B, ob0, ob1, t + 3, lds + (cur == 0 ? 3 : cur - 1) * G2_BUF, c.tid);
        __builtin_amdgcn_sched_barrier(0);
#pragma unroll
        for (int m = 4; m < 8; ++m)
#pragma unroll
            for (int n = 0; n < 4; ++n) acc[m][n] = SWAP ? __builtin_amdgcn_mfma_f32_16x16x32_bf16(Bt[n], At[m], acc[m][n], 0, 0, 0) : __builtin_amdgcn_mfma_f32_16x16x32_bf16(At[m], Bt[n], acc[m][n], 0, 0, 0);
        __builtin_amdgcn_s_barrier(); asm volatile("" ::: "memory");
        cur = cur == 3 ? 0 : cur + 1;
    }
    if (!trailing) { __builtin_amdgcn_s_barrier(); asm volatile("" ::: "memory"); }
}

__device__ __forceinline__ void phase_inproj(const Params& p, int bid, int nb, unsigned char* lds) {
    const Gemm2Ctx c = gemm2_ctx();
    float* srstd = (float*)(lds + G2_LDS);
    constexpr int NCT = NP / 256, NU = (NTOK / 256) * NCT;
    for (int u = bid; u < NU; u += nb) {
        const int rt = u / NCT, ct = u % NCT, brow = rt * 256, bcol = ct * 256;
        if (c.tid < 256) srstd[c.tid] = rstd_of(p.part, brow + c.tid);
        f32x4 acc[8][4]; acc2_zero(acc);
        const int r = c.tid >> 2;
        const unsigned o0 = (unsigned)(r * DM + c.sc), o1 = (unsigned)((r + 128) * DM + c.sc);
        if (ct >= C_BV / 256 && ct < C_BV / 256 + 3) {
            gemm2_kloop<false>(acc, p.hb + (size_t)brow * DM, o0, o1, p.Bt_in + (size_t)bcol * DM, o0, o1, DM / 32, lds, c);
            const int vcol = bcol - C_BV + c.wc * 64;
            bf16_t* vt = (vcol < 384 ? p.VtB + ((size_t)(brow / TSEQ) * 384 + vcol + c.fr) * TSEQ : p.VtC + ((size_t)(brow / TSEQ) * 384 + (vcol - 384) + c.fr) * TSEQ)
                         + (brow % TSEQ) + c.wr * 128 + ((((c.fq & 1) << 1) | (c.fq >> 1)) * 4);
#pragma unroll
            for (int m = 0; m < 8; ++m) {
                const int rl = c.wr * 128 + m * 16 + c.fq * 4;
                const float r0 = srstd[rl], r1 = srstd[rl + 1], r2 = srstd[rl + 2], r3 = srstd[rl + 3];
#pragma unroll
                for (int n = 0; n < 4; ++n)
                    *(uint2*)(vt + (size_t)(n * 16) * TSEQ + m * 16) = make_uint2(cvt_pk_bf16(acc[m][n][0] * r0, acc[m][n][1] * r1), cvt_pk_bf16(acc[m][n][2] * r2, acc[m][n][3] * r3));
            }
        } else {
            gemm2_kloop<true>(acc, p.hb + (size_t)brow * DM, o0, o1, p.Bt_in + (size_t)bcol * DM, o0, o1, DM / 32, lds, c);
#pragma unroll
            for (int m = 0; m < 8; ++m) {
                const int rl = c.wr * 128 + m * 16 + c.fr; const float rs = srstd[rl];
                bf16_t* o = p.proj + (size_t)(brow + rl) * NP + bcol + c.wc * 64 + c.fq * 4;
#pragma unroll
                for (int n = 0; n < 4; ++n) *(uint2*)(o + n * 16) = make_uint2(cvt_pk_bf16(acc[m][n][0] * rs, acc[m][n][1] * rs), cvt_pk_bf16(acc[m][n][2] * rs, acc[m][n][3] * rs));
            }
        }
        __syncthreads();
    }
}

__device__ __forceinline__ int grab_unit(int* ctr, volatile LAS int* slot) {
    __syncthreads();
    if (opaque_tid() == 0) *slot = __hip_atomic_fetch_add(ctr, 1, __ATOMIC_RELAXED, __HIP_MEMORY_SCOPE_AGENT);
    __syncthreads();
    return *slot;
}

#ifndef PROBE_GEMM_VAR
#define PROBE_GEMM_VAR -1
#endif
template <int VAR>
__device__ __forceinline__ void phase_gemm_probe(const Params& p, int bid, int nb, unsigned char* lds) {
    const GemmCtx c = gemm_ctx();
    constexpr int NS = G_NS, NCT = NP / 128, NU = (NTOK / 256) * NCT;
    for (int u = bid; u < NU; u += nb) {
        const int rt = u / NCT, ct = u % NCT, brow = rt * 256, bcol = ct * 128;
        f32x4 acc[4][4]; acc_zero(acc);
        const int r = c.tid >> 2;
        const bf16_t* A = p.hb + (size_t)brow * DM; const bf16_t* B = p.Bt_in + (size_t)bcol * DM;
        const unsigned oa0 = (unsigned)(r * DM + c.sc), oa1 = (unsigned)((r + 128) * DM + c.sc), ob = (unsigned)(r * DM + c.sc);
        const int nkt = DM / 32;
#pragma unroll
        for (int i = 0; i < NS - 1; ++i) gemm_stage(A, oa0, oa1, B, ob, i, lds + i * G_BUF, c);
        int cur = 0;
        bf16x8 At[4], Bt[4];
        if (VAR == 2) {
            asm volatile("s_waitcnt vmcnt(0)" ::: "memory"); __builtin_amdgcn_s_barrier();
#pragma unroll
            for (int m = 0; m < 4; ++m) At[m] = *reinterpret_cast<const bf16x8*>(lds + (c.wr * 64 + m * 16) * 64 + c.rdo);
#pragma unroll
            for (int n = 0; n < 4; ++n) Bt[n] = *reinterpret_cast<const bf16x8*>(lds + 16384 + (c.wc * 64 + n * 16) * 64 + c.rdo);
        }
#pragma unroll 1
        for (int t = 0; t < nkt; ++t) {
            const int young = nkt - 1 - t;
            if (VAR == 1) { if (t == 0) asm volatile("s_waitcnt vmcnt(0)" ::: "memory"); }
            else if (young >= 4) asm volatile("s_waitcnt vmcnt(12)" ::: "memory");
            else if (young >= 3) asm volatile("s_waitcnt vmcnt(9)" ::: "memory");
            else if (young >= 2) asm volatile("s_waitcnt vmcnt(6)" ::: "memory");
            else if (young >= 1) asm volatile("s_waitcnt vmcnt(3)" ::: "memory");
            else asm volatile("s_waitcnt vmcnt(0)" ::: "memory");
            if (VAR != 3) __builtin_amdgcn_s_barrier();
            asm volatile("" ::: "memory");
            const int nxt = cur == 0 ? NS - 1 : cur - 1;
            if (VAR != 1 && t + NS - 1 < nkt) gemm_stage(A, oa0, oa1, B, ob, t + NS - 1, lds + nxt * G_BUF, c);
            const unsigned char* SA = lds + cur * G_BUF; const unsigned char* SB = SA + 16384;
            if (VAR != 2) {
#pragma unroll
                for (int m = 0; m < 4; ++m) At[m] = *reinterpret_cast<const bf16x8*>(SA + (c.wr * 64 + m * 16) * 64 + c.rdo);
#pragma unroll
                for (int n = 0; n < 4; ++n) Bt[n] = *reinterpret_cast<const bf16x8*>(SB + (c.wc * 64 + n * 16) * 64 + c.rdo);
                asm volatile("s_waitcnt lgkmcnt(0)" ::: "memory");
            }
            __builtin_amdgcn_sched_barrier(0);
            if (VAR != 4) {
#pragma unroll
                for (int m = 0; m < 4; ++m)
#pragma unroll
                    for (int n = 0; n < 4; ++n) acc[m][n] = __builtin_amdgcn_mfma_f32_16x16x32_bf16(At[m], Bt[n], acc[m][n], 0, 0, 0);
            } else {
#pragma unroll
                for (int m = 0; m < 4; ++m) asm volatile("" :: "v"(At[m]), "v"(Bt[m]));
            }
            cur = cur == NS - 1 ? 0 : cur + 1;
        }
        __builtin_amdgcn_s_barrier();
        asm volatile("" ::: "memory");
        float sacc = 0.f;
#pragma unroll
        for (int m = 0; m < 4; ++m)
#pragma unroll
            for (int n = 0; n < 4; ++n) sacc += acc[m][n][0] + acc[m][n][1] + acc[m][n][2] + acc[m][n][3];
        if (sacc == 1.2345e33f) p.part[0] = sacc;
    }
}

constexpr int GQ = 56, GS = 72, GO = 97;
constexpr int GL_QD = 0, GL_KD = GL_QD + 64 * GQ * 2, GL_KET = GL_KD + 64 * GQ * 2, GL_VT = GL_KET + 64 * GS * 2, GL_ATT = GL_VT + 96 * GS * 2, GL_ST = GL_ATT + 64 * GS * 2,
              GL_OO = GL_ST + 96 * GQ * 2, GL_BC = GL_OO + 64 * GO * 4, GL_SEG = GL_BC + 64 * 48 * 4, GL_EBL = GL_SEG + 8 * 48 * 4, GL_W2 = GL_EBL + 64 * 4, GL_B2 = GL_W2 + 16 * 48 * 4,
              GL_GAIN = GL_B2 + 48 * 4, GL_RQ = GL_GAIN + 96 * 4, GL_RK = GL_RQ + 64 * 48 * 2, GL_RV = GL_RK + 64 * 48 * 2, GL_RA = GL_RV + 64 * 96 * 2, GL_RG = GL_RA + 64 * 16 * 2,
              GLA_LDS = GL_RG + 2 * 64 * 96 * 2;
static_assert(GL_OO % 16 == 0 && GL_RQ % 16 == 0 && GL_RG % 16 == 0 && GL_ST % 16 == 0, "GLA LDS map alignment");
__device__ __forceinline__ void phase_gla(const Params& p, int l, int* ctr, volatile LAS int* slot, unsigned char* lds) {
    bf16_t* qd = (bf16_t*)(lds + GL_QD); bf16_t* kd = (bf16_t*)(lds + GL_KD); bf16_t* keT = (bf16_t*)(lds + GL_KET); bf16_t* vT = (bf16_t*)(lds + GL_VT);
    bf16_t* att = (bf16_t*)(lds + GL_ATT); bf16_t* ST = (bf16_t*)(lds + GL_ST);
    float* oo = (float*)(lds + GL_OO); float* bc = (float*)(lds + GL_BC); float* seg = (float*)(lds + GL_SEG); float* ebl = (float*)(lds + GL_EBL);
    float* w2s = (float*)(lds + GL_W2); float* b2s = (float*)(lds + GL_B2); float* gains = (float*)(lds + GL_GAIN);
    bf16_t* rq = (bf16_t*)(lds + GL_RQ); bf16_t* rk = (bf16_t*)(lds + GL_RK); bf16_t* rv = (bf16_t*)(lds + GL_RV); bf16_t* ra = (bf16_t*)(lds + GL_RA); bf16_t* rg = (bf16_t*)(lds + GL_RG);
    const int tid = opaque_tid(), wave = tid >> 6, lane = tid & 63, r = lane & 31, hf = lane >> 5;
    for (int u = grab_unit(ctr, slot); u < NBATCH * 4; u = grab_unit(ctr, slot)) {
        const int b = u >> 2, h = u & 3;
        PROBE_UNIT_BEGIN(9, u == 0);
        for (int i = tid; i < 16 * 48; i += NT) w2s[i] = p.in[I_AW2][(size_t)l * 16 * 192 + (i / 48) * 192 + h * 48 + (i % 48)];
        if (tid < 48) b2s[tid] = p.in[I_AB2][l * 192 + h * 48 + tid];
        if (tid < 96) gains[tid] = p.in[I_AGAIN][l * 384 + h * 96 + tid];
        if (tid < 64) ebl[tid] = 1.0f;
        for (int i = tid; i < 96 * GQ; i += NT) ST[i] = 0;
        for (int i = tid; i < 64 * GS; i += NT) { keT[i] = 0; att[i] = 0; }
        const bf16_t* src[5]; int dsto[5];
#pragma unroll
        for (int j = 0; j < 5; ++j) {
            const int pid = tid + NT * j; int row = 0, col = 0, dst = -1;
            if (pid < 384) { row = pid / 6; col = C_AQ + h * 48 + (pid % 6) * 8; dst = GL_RQ + pid * 16; }
            else if (pid < 768) { const int q = pid - 384; row = q / 6; col = C_AK + h * 48 + (q % 6) * 8; dst = GL_RK + q * 16; }
            else if (pid < 1536) { const int q = pid - 768; row = q / 12; col = C_AV + h * 96 + (q % 12) * 8; dst = GL_RV + q * 16; }
            else if (pid < 2304) { const int q = pid - 1536; row = q / 12; col = C_AG + h * 96 + (q % 12) * 8; dst = GL_RG + q * 16; }
            else if (pid < 2432) { const int q = pid - 2304; row = q / 2; col = C_ALR + (q % 2) * 8; dst = GL_RA + q * 16; }
            src[j] = p.proj + ((size_t)b * TSEQ + row) * NP + col; dsto[j] = dst;
        }
        u32x4 pre[5];
#pragma unroll
        for (int j = 0; j < 5; ++j) pre[j] = dsto[j] >= 0 ? *(const u32x4*)src[j] : (u32x4){0u, 0u, 0u, 0u};
        f32x16 Sacc;
#pragma unroll
        for (int i = 0; i < 16; ++i) Sacc[i] = 0.f;
        const int kt = wave / 3, vt = wave % 3;
        __syncthreads();
        for (int n = 0; n < 32; ++n) {
            const size_t row0 = (size_t)b * TSEQ + n * 64;
            const int gsel = (n & 1) * (64 * 96 * 2);
#pragma unroll
            for (int j = 0; j < 5; ++j) if (dsto[j] >= 0) *(u32x4*)(lds + dsto[j] + (dsto[j] >= GL_RG ? gsel : 0)) = pre[j];
            if (n + 1 < 32) {
#pragma unroll
                for (int j = 0; j < 5; ++j) if (dsto[j] >= 0) pre[j] = *(const u32x4*)(src[j] + (size_t)(n + 1) * 64 * NP);
            }
            __syncthreads();
            for (int e = tid; e < 64 * 48; e += NT) {
                const int t = e / 48, k = e % 48;
                float z = b2s[k];
#pragma unroll
                for (int rr = 0; rr < 16; ++rr) z += bf2f(ra[t * 16 + rr]) * w2s[rr * 48 + k];
                bc[e] = (fminf(z, 0.f) - log1pf(__expf(-fabsf(z)))) * (1.0f / 16.0f);
            }
            __syncthreads();
            if (tid < 384) {
                const int k = tid % 48, sg = tid / 48; float run = 0.f;
#pragma unroll
                for (int i = 0; i < 8; ++i) { run += bc[(sg * 8 + i) * 48 + k]; bc[(sg * 8 + i) * 48 + k] = run; }
                seg[sg * 48 + k] = run;
            }
            __syncthreads();
            if (tid < 384) {
                const int k = tid % 48, sg = tid / 48; float pre_s = 0.f;
                for (int s2 = 0; s2 < sg; ++s2) pre_s += seg[s2 * 48 + k];
#pragma unroll
                for (int i = 0; i < 8; ++i) bc[(sg * 8 + i) * 48 + k] += pre_s;
            }
            __syncthreads();
            for (int e = tid; e < 64 * 48; e += NT) {
                const int t = e / 48, k = e % 48;
                const float bb = bc[e], bl = bc[63 * 48 + k];
                const float q = bf2f(rq[e]) * 0.14433756729740643f, kk = bf2f(rk[e]);
                qd[t * GQ + k] = f2bf(q * __expf(bb)); kd[t * GQ + k] = f2bf(kk * __expf(-bb)); keT[k * GS + t] = f2bf(kk * __expf(bl - bb));
                if (t == 63) ebl[k] = __expf(bl);
            }
            for (int e = tid; e < 64 * 96; e += NT) { const int t = e / 96, v = e % 96; vT[v * GS + t] = rv[e]; }
            __syncthreads();
            if (wave < 3) {
                const int si = wave == 2 ? 1 : 0, ci = wave >= 1 ? 1 : 0;
                f32x16 x;
#pragma unroll
                for (int i = 0; i < 16; ++i) x[i] = 0.f;
#pragma unroll
                for (int st = 0; st < 3; ++st)
                    x = __builtin_amdgcn_mfma_f32_32x32x16_bf16(*(const bf16x8*)(kd + (si * 32 + r) * GQ + 16 * st + 8 * hf), *(const bf16x8*)(qd + (ci * 32 + r) * GQ + 16 * st + 8 * hf), x, 0, 0, 0);
                const int cq = ci * 32 + r;
#pragma unroll
                for (int g = 0; g < 4; ++g) {
                    const int s0 = si * 32 + 8 * g + 4 * hf;
                    const float v0 = s0 <= cq ? x[4 * g] : 0.f, v1 = s0 + 1 <= cq ? x[4 * g + 1] : 0.f, v2 = s0 + 2 <= cq ? x[4 * g + 2] : 0.f, v3 = s0 + 3 <= cq ? x[4 * g + 3] : 0.f;
                    *(uint2*)(att + cq * GS + s0) = make_uint2(cvt_pk_bf16(v0, v1), cvt_pk_bf16(v2, v3));
                }
            }
            if (wave < 6) {
#pragma unroll
                for (int i = 0; i < 16; ++i) Sacc[i] *= ebl[kt * 32 + (i & 3) + 8 * (i >> 2) + 4 * hf];
#pragma unroll
                for (int st = 0; st < 4; ++st)
                    Sacc = __builtin_amdgcn_mfma_f32_32x32x16_bf16(*(const bf16x8*)(keT + (kt * 32 + r) * GS + 16 * st + 8 * hf), *(const bf16x8*)(vT + (vt * 32 + r) * GS + 16 * st + 8 * hf), Sacc, 0, 0, 0);
            }
            __syncthreads();
            if (wave < 6) {
                f32x16 o;
#pragma unroll
                for (int i = 0; i < 16; ++i) o[i] = 0.f;
#pragma unroll
                for (int st = 0; st < 4; ++st)
                    if (st < 2 || kt == 1)
                        o = __builtin_amdgcn_mfma_f32_32x32x16_bf16(*(const bf16x8*)(att + (kt * 32 + r) * GS + 16 * st + 8 * hf), *(const bf16x8*)(vT + (vt * 32 + r) * GS + 16 * st + 8 * hf), o, 0, 0, 0);
#pragma unroll
                for (int st = 0; st < 3; ++st)
                    o = __builtin_amdgcn_mfma_f32_32x32x16_bf16(*(const bf16x8*)(qd + (kt * 32 + r) * GQ + 16 * st + 8 * hf), *(const bf16x8*)(ST + (vt * 32 + r) * GQ + 16 * st + 8 * hf), o, 0, 0, 0);
#pragma unroll
                for (int i = 0; i < 16; ++i) oo[(kt * 32 + (i & 3) + 8 * (i >> 2) + 4 * hf) * GO + vt * 32 + r] = o[i];
            }
            __syncthreads();
            for (int t = wave; t < 64; t += 8) {
                const float o0 = oo[t * GO + lane], o1 = lane < 32 ? oo[t * GO + 64 + lane] : 0.f;
                const float ms = wave_sum(o0 * o0 + o1 * o1) * (1.0f / 96.0f);
                const float rs = rsqrtf(ms + EPS);
                const bf16_t* gr = (const bf16_t*)((const unsigned char*)rg + gsel) + t * 96;
                bf16_t* g = p.proj + (row0 + t) * NP + C_AG + h * 96;
                g[lane] = f2bf(o0 * rs * gains[lane] * siluf_(bf2f(gr[lane])));
                if (lane < 32) g[64 + lane] = f2bf(o1 * rs * gains[64 + lane] * siluf_(bf2f(gr[64 + lane])));
            }
            if (wave < 6) {
#pragma unroll
                for (int g = 0; g < 4; ++g) {
                    const int k0 = kt * 32 + 8 * g + 4 * hf;
                    if (k0 < 48) *(uint2*)(ST + (vt * 32 + r) * GQ + k0) = make_uint2(cvt_pk_bf16(Sacc[4 * g], Sacc[4 * g + 1]), cvt_pk_bf16(Sacc[4 * g + 2], Sacc[4 * g + 3]));
                }
            }
            __syncthreads();
        }
        PROBE_UNIT_END(9, u == 0);
    }
}

constexpr int LRU_LDS = (67 * 48 + 3 * 64 * 48 + 2 * 48 * 48 + 48) * 4;
__device__ __forceinline__ float gelu_tanh(float x) { const float u = 0.7978845608028654f * (x + 0.044715f * x * x * x); return 0.5f * x * (1.0f + tanhf(u)); }
__device__ __forceinline__ void phase_lru(const Params& p, int l, int* ctr, volatile LAS int* slot, unsigned char* lds) {
    float* xin = (float*)lds;
    float* xc = xin + 67 * 48;
    float* aa = xc + 64 * 48;
    float* uu = aa + 64 * 48;
    float* wr = uu + 64 * 48;
    float* wi = wr + 48 * 48;
    float* hs = wi + 48 * 48;
    const int tid = opaque_tid();
    for (int u = grab_unit(ctr, slot); u < NBATCH * 8; u = grab_unit(ctr, slot)) {
        const int b = u >> 3, nblk = u & 7, ch0 = nblk * 48;
        PROBE_UNIT_BEGIN(10, u == 0);
        for (int i = tid; i < 48 * 48; i += NT) { wr[i] = p.in[I_WR][((size_t)l * 8 + nblk) * 2304 + i]; wi[i] = p.in[I_WI][((size_t)l * 8 + nblk) * 2304 + i]; }
        if (tid < 48) hs[tid] = 0.f;
        __syncthreads();
        for (int tt = 0; tt < TSEQ / 64; ++tt) {
            const int t0 = tt * 64;
            for (int e = tid; e < 67 * 48; e += NT) {
                const int r = e / 48, cidx = e % 48, t = t0 - 3 + r;
                xin[e] = t >= 0 ? bf2f(p.proj[((size_t)b * TSEQ + t) * NP + C_DX + ch0 + cidx]) : 0.f;
            }
            __syncthreads();
            for (int e = tid; e < 64 * 48; e += NT) {
                const int t = e / 48, cidx = e % 48; float a = p.in[I_CONVB][l * 384 + ch0 + cidx];
#pragma unroll
                for (int j = 0; j < 4; ++j) a += p.in[I_CONVW][((size_t)l * 4 + j) * 384 + ch0 + cidx] * xin[(t + j) * 48 + cidx];
                xc[e] = a;
            }
            __syncthreads();
            for (int e = tid; e < 64 * 48; e += NT) {
                const int t = e / 48, d = e % 48;
                float rr = p.in[I_BR][l * 384 + ch0 + d], ii = p.in[I_BI][l * 384 + ch0 + d];
                for (int cidx = 0; cidx < 48; ++cidx) { const float xv = xc[t * 48 + cidx]; rr += xv * wr[cidx * 48 + d]; ii += xv * wi[cidx * 48 + d]; }
                const float r = sigmoidf_(rr), ig = sigmoidf_(ii);
                const float lam = p.in[I_LAM][l * 384 + ch0 + d];
                const float sp = log1pf(__expf(-lam));
                const float la = -8.0f * r * sp;
                aa[e] = __expf(la);
                uu[e] = sqrtf(-expm1f(2.0f * la)) * (ig * xc[e]);
            }
            __syncthreads();
            if (tid < 48) { float hh = hs[tid]; for (int t = 0; t < 64; ++t) { hh = aa[t * 48 + tid] * hh + uu[t * 48 + tid]; uu[t * 48 + tid] = hh; } hs[tid] = hh; }
            __syncthreads();
            for (int e = tid; e < 64 * 48; e += NT) {
                const int t = e / 48, d = e % 48;
                bf16_t* y = p.proj + ((size_t)b * TSEQ + t0 + t) * NP + C_DY + ch0 + d;
                *y = f2bf(gelu_tanh(bf2f(*y)) * uu[e]);
            }
            __syncthreads();
        }
        PROBE_UNIT_END(10, u == 0);
    }
}

constexpr int AT_STAGE = 16384, AT_LDS = 3 * AT_STAGE;
template <bool MASKED>
__device__ __forceinline__ void attn_block(const bf16_t* __restrict__ proj, const bf16_t* __restrict__ Vt, int b, int qb, int cq, int ck, const float* tabAll,
                                           const unsigned* mask32, unsigned char* stage, bf16_t* __restrict__ outp, int tid) {
    const int wave = tid >> 6, lane = tid & 63, r = lane & 31, hf = lane >> 5, hh = wave >> 2, sb = wave & 3;
    const int q0 = qb * 128 + sb * 32, q = q0 + r, mykt = q0 >> 5, nkt = 4 * qb + 4;
    const int skey = (tid >> 3) & 31, sdim = (tid >> 2) & 63, shh = tid >> 8;
    const unsigned offK = (unsigned)(skey * NP + shh * 64 + (((tid & 7) ^ ((skey >> 1) & 7)) * 8));
    const unsigned offV = (unsigned)((shh * 64 + sdim) * TSEQ + (((tid & 3) ^ ((0 - (sdim >> 2)) & 3)) * 8));
    int kro[4], vro[2][2];
#pragma unroll
    for (int s = 0; s < 4; ++s) kro[s] = hh * 4096 + r * 128 + (((2 * s + hf) ^ ((r >> 1) & 7)) * 16);
#pragma unroll
    for (int db = 0; db < 2; ++db)
#pragma unroll
        for (int s = 0; s < 2; ++s) vro[db][s] = 8192 + hh * 4096 + (db * 32 + r) * 64 + (((2 * s + hf) ^ ((0 - (r >> 2)) & 3)) * 16);
    constexpr float C1 = 0.125f * LOG2E;
    const unsigned* maskq = MASKED ? mask32 + (sb * 32 + r) * 64 : nullptr;
#pragma unroll 1
    for (int rnd = 0; rnd < 3; ++rnd) {
        const int h = 2 * rnd + hh;
        const float* tab = tabAll + h * TABW;
        const bf16_t* qrow = proj + ((size_t)b * TSEQ + q) * NP + cq + h * 64 + 8 * hf;
        bf16x8 qf[4];
#pragma unroll
        for (int s = 0; s < 4; ++s) qf[s] = *(const bf16x8*)(qrow + 16 * s);
        f32x16 o0, o1;
#pragma unroll
        for (int i = 0; i < 16; ++i) { o0[i] = 0.f; o1[i] = 0.f; }
        float m = -1e30f, l = 0.f;
        const bf16_t* Kb = proj + (size_t)b * TSEQ * NP + ck + 2 * rnd * 64;
        const bf16_t* Vb = Vt + ((size_t)b * 384 + 2 * rnd * 64) * TSEQ;
#define AT_STAGE_TILE(kt_, buf_) do { \
        __builtin_amdgcn_global_load_lds((const unsigned*)(Kb + (size_t)(kt_) * 32 * NP + offK), (unsigned*)((buf_) + tid * 16), 16, 0, 0); \
        __builtin_amdgcn_global_load_lds((const unsigned*)(Vb + (kt_) * 32 + offV), (unsigned*)((buf_) + 8192 + tid * 16), 16, 0, 0); } while (0)
        AT_STAGE_TILE(0, stage);
        AT_STAGE_TILE(1, stage + AT_STAGE);
        int cur = 0;
#pragma unroll 1
        for (int kt = 0; kt < nkt; ++kt) {
            if (kt + 1 < nkt) asm volatile("s_waitcnt vmcnt(2)" ::: "memory"); else asm volatile("s_waitcnt vmcnt(0)" ::: "memory");
            __builtin_amdgcn_s_barrier();
            asm volatile("" ::: "memory");
            const int nxt = cur == 0 ? 2 : cur - 1;
            if (kt + 2 < nkt) AT_STAGE_TILE(kt + 2, stage + nxt * AT_STAGE);
            if (kt <= mykt) {
                const unsigned char* st = stage + cur * AT_STAGE;
                f32x16 sa;
#pragma unroll
                for (int i = 0; i < 16; ++i) sa[i] = 0.f;
#pragma unroll
                for (int s = 0; s < 4; ++s) sa = __builtin_amdgcn_mfma_f32_32x32x16_bf16(*(const bf16x8*)(st + kro[s]), qf[s], sa, 0, 0, 0);
                const float* tb = tab + (q - kt * 32 - 4 * hf + 32);
                unsigned w = 0u;
                if (MASKED) w = maskq[kt] >> (4 * hf);
                float sv[16]; float tmax = NEG_BIG;
#pragma unroll
                for (int i = 0; i < 16; ++i) {
                    const int ko = (i & 3) + 8 * (i >> 2);
                    float v = sa[i] * C1 + tb[-ko];
                    if (MASKED) v = ((w >> ko) & 1u) ? v : NEG_BIG;
                    sv[i] = v; tmax = fmaxf(tmax, v);
                }
                tmax = fmaxf(tmax, __shfl_xor(tmax, 32));
                const float mn = fmaxf(m, tmax);
                if (!__all(mn == m)) {
                    const float alpha = __builtin_amdgcn_exp2f(m - mn);
                    l *= alpha;
#pragma unroll
                    for (int i = 0; i < 16; ++i) { o0[i] *= alpha; o1[i] *= alpha; }
                    m = mn;
                }
                float ps = 0.f;
#pragma unroll
                for (int i = 0; i < 16; ++i) { sv[i] = __builtin_amdgcn_exp2f(sv[i] - m); ps += sv[i]; }
                l += ps;
                bf16x8 pf[2];
#pragma unroll
                for (int s = 0; s < 2; ++s) {
                    u32x4 t;
                    t[0] = cvt_pk_bf16(sv[8 * s + 0], sv[8 * s + 1]); t[1] = cvt_pk_bf16(sv[8 * s + 2], sv[8 * s + 3]);
                    t[2] = cvt_pk_bf16(sv[8 * s + 4], sv[8 * s + 5]); t[3] = cvt_pk_bf16(sv[8 * s + 6], sv[8 * s + 7]);
                    pf[s] = __builtin_bit_cast(bf16x8, t);
                }
#pragma unroll
                for (int s = 0; s < 2; ++s) {
                    o0 = __builtin_amdgcn_mfma_f32_32x32x16_bf16(*(const bf16x8*)(st + vro[0][s]), pf[s], o0, 0, 0, 0);
                    o1 = __builtin_amdgcn_mfma_f32_32x32x16_bf16(*(const bf16x8*)(st + vro[1][s]), pf[s], o1, 0, 0, 0);
                }
            }
            cur = cur == 2 ? 0 : cur + 1;
        }
#undef AT_STAGE_TILE
        __builtin_amdgcn_s_barrier();
        asm volatile("" ::: "memory");
        l += __shfl_xor(l, 32);
        const float inv = 1.0f / l;
        bf16_t* orow = outp + ((size_t)b * TSEQ + q) * NP + cq + h * 64 + 4 * hf;
#pragma unroll
        for (int g = 0; g < 4; ++g) {
            *(uint2*)(orow + 8 * g) = make_uint2(cvt_pk_bf16(o0[4 * g] * inv, o0[4 * g + 1] * inv), cvt_pk_bf16(o0[4 * g + 2] * inv, o0[4 * g + 3] * inv));
            *(uint2*)(orow + 32 + 8 * g) = make_uint2(cvt_pk_bf16(o1[4 * g] * inv, o1[4 * g + 1] * inv), cvt_pk_bf16(o1[4 * g + 2] * inv, o1[4 * g + 3] * inv));
        }
    }
}

constexpr int DIL_LDS = 6 * TABW * 4 + AT_LDS;
__device__ __forceinline__ void dil_unit(const Params& p, int b, int qb, unsigned char* lds) {
    float* tab = (float*)lds;
    const int tid = opaque_tid(), wave = tid >> 6, lane = tid & 63;
    for (int i = tid; i < 6 * TABW; i += NT) tab[i] = p.biasC[i];
    __syncthreads();
    attn_block<false>(p.proj, p.VtC, b, qb, C_CQ, C_CK, tab, nullptr, lds + 6 * TABW * 4, p.proj, tid);
    __syncthreads();
}
__device__ __forceinline__ void phase_dil(const Params& p, int* ctr, volatile LAS int* slot, unsigned char* lds) {
    for (int u = grab_unit(ctr, slot); u < NBATCH * 16; u = grab_unit(ctr, slot)) { PROBE_UNIT_BEGIN(12, u == 0); dil_unit(p, u & 15, 15 - (u >> 4), lds); PROBE_UNIT_END(12, u == 0); }
}

constexpr int DSA_LDS = 6 * TABW * 4 + 128 * 64 * 4 + AT_LDS;
__device__ __forceinline__ void cnt_ge(int& c, unsigned k, unsigned t) { asm("v_cmp_ge_u32 vcc, %1, %2\n\tv_addc_co_u32 %0, vcc, 0, %0, vcc" : "+v"(c) : "v"(k), "v"(t) : "vcc"); }
__device__ __forceinline__ void cnt_gt(int& c, unsigned k, unsigned t) { asm("v_cmp_gt_u32 vcc, %1, %2\n\tv_addc_co_u32 %0, vcc, 0, %0, vcc" : "+v"(c) : "v"(k), "v"(t) : "vcc"); }
__device__ __forceinline__ void cnt_eq(int& c, unsigned k, unsigned t) { asm("v_cmp_eq_u32 vcc, %1, %2\n\tv_addc_co_u32 %0, vcc, 0, %0, vcc" : "+v"(c) : "v"(k), "v"(t) : "vcc"); }
__device__ __forceinline__ int grp16_sum(int v) { v += __shfl_xor(v, 1); v += __shfl_xor(v, 2); v += __shfl_xor(v, 4); v += __shfl_xor(v, 8); return v; }
__device__ __forceinline__ void dsa_unit(const Params& p, int b, int qb, unsigned char* lds) {
    float* tab = (float*)lds;
    unsigned* mask32 = (unsigned*)(lds + 6 * TABW * 4);
    unsigned short* mask16 = (unsigned short*)mask32;
    const int tid = opaque_tid(), wave = tid >> 6, lane = tid & 63;
    for (int i = tid; i < 6 * TABW; i += NT) tab[i] = p.biasB[i];
    for (int i = tid; i < 128 * 64; i += NT) mask32[i] = 0u;
    __syncthreads();
    const int qi = lane >> 4, kl = lane & 15;
    PROBE_UNIT_BEGIN(13, qb == 15 && b == 0);
    for (int grp = wave; grp < 32; grp += 8) {
        const int qg = qb * 128 + grp * 4, myq = qg + qi, ntile = (qg + 3) / 16 + 1;
        const bf16x8 af = *(const bf16x8*)(p.proj + ((size_t)b * TSEQ + qg + (kl >> 2)) * NP + C_IQ + (kl & 3) * 32 + 8 * qi);
        float w[4];
        {
            const uint2 wv = *(const uint2*)(p.proj + ((size_t)b * TSEQ + myq) * NP + C_IW);
            constexpr float WS = 0.5f * 0.17677669529663687f;
            w[0] = __uint_as_float(wv.x << 16) * WS; w[1] = __uint_as_float(wv.x & 0xFFFF0000u) * WS; w[2] = __uint_as_float(wv.y << 16) * WS; w[3] = __uint_as_float(wv.y & 0xFFFF0000u) * WS;
        }
        const bf16_t* kp = p.proj + ((size_t)b * TSEQ + kl) * NP + C_IK + 8 * qi;
        unsigned key[128];
#pragma unroll
        for (int c4 = 0; c4 < 32; ++c4) {
            if (c4 * 4 < ntile) {
                bf16x8 bfr[4];
                const bf16_t* kc = kp + (size_t)(c4 * 4) * 16 * NP; asm volatile("" : "+v"(kc));
#pragma unroll
                for (int i = 0; i < 4; ++i) bfr[i] = *(const bf16x8*)(kc + (size_t)i * 16 * NP);
#pragma unroll
                for (int i = 0; i < 4; ++i) {
                    const int t = c4 * 4 + i;
                    f32x4 a4 = {0.f, 0.f, 0.f, 0.f};
                    a4 = __builtin_amdgcn_mfma_f32_16x16x32_bf16(af, bfr[i], a4, 0, 0, 0);
                    float sc = w[0] * fmaxf(a4[0], 0.f) + w[1] * fmaxf(a4[1], 0.f) + w[2] * fmaxf(a4[2], 0.f) + w[3] * fmaxf(a4[3], 0.f);
                    sc += 0.0f;
                    const unsigned u = __float_as_uint(sc);
                    unsigned kk = (u & 0x80000000u) ? ~u : (u | 0x80000000u);
                    kk = kk == 0u ? 1u : kk;
                    key[t] = (t * 16 + kl <= myq) ? kk : 0u;
                }
            } else {
#pragma unroll
                for (int i = 0; i < 4; ++i) key[c4 * 4 + i] = 0u;
            }
            asm volatile("" ::: "memory");
        }
        unsigned T = 1u; int need = 0x7fffffff;
        if (qg + 3 >= 256) {
            unsigned Tb = 0u;
#pragma unroll 1
            for (int bit = 31; bit >= 0; --bit) {
                const unsigned Tc = Tb | (1u << bit);
                int c = 0;
#pragma unroll
                for (int t = 0; t < 128; ++t) cnt_ge(c, key[t], Tc);
                c = grp16_sum(c);
                Tb = (c >= 256) ? Tc : Tb;
            }
            int cgt = 0;
#pragma unroll
            for (int t = 0; t < 128; ++t) cnt_gt(cgt, key[t], Tb);
            cgt = grp16_sum(cgt);
            if (myq >= 256) { T = Tb; need = 256 - cgt; }
        }
        int ceq = 0;
#pragma unroll
        for (int t = 0; t < 128; ++t) cnt_eq(ceq, key[t], T);
        ceq = grp16_sum(ceq);
        const bool slow = __any(need != 0x7fffffff && ceq != need);
        int run = 0;
        unsigned short* mrow = mask16 + (grp * 4 + qi) * 128;
#pragma unroll
        for (int t = 0; t < 128; ++t) {
            if (t < ntile) {
                const bool gt = key[t] > T, eq = key[t] == T;
                bool take = gt || eq;
                if (slow) {
                    const unsigned long long em = __ballot(eq);
                    const unsigned bits = (unsigned)(em >> (16 * qi)) & 0xFFFFu;
                    const int rank = run + __popc(bits & ((1u << kl) - 1u));
                    take = gt || (eq && rank < need);
                    run += __popc(bits);
                }
                const unsigned long long tm = __ballot(take);
                if (kl == 0) mrow[t] = (unsigned short)((tm >> (16 * qi)) & 0xFFFFull);
            }
        }
    }
    __syncthreads();
    PROBE_UNIT_END(13, qb == 15 && b == 0);
    attn_block<true>(p.proj, p.VtB, b, qb, C_BQ, C_BK, tab, mask32, lds + 6 * TABW * 4 + 128 * 64 * 4, p.proj, tid);
    __syncthreads();
}
__device__ __forceinline__ void phase_dsa(const Params& p, int* ctr, volatile LAS int* slot, unsigned char* lds) {
    for (int u = grab_unit(ctr, slot); u < NBATCH * 16; u = grab_unit(ctr, slot)) { PROBE_UNIT_BEGIN(11, u == 0); dsa_unit(p, u & 15, 15 - (u >> 4), lds); PROBE_UNIT_END(11, u == 0); }
}

constexpr int MG_LDS = MG_GLDS + 1024 + 16 * NT * 4;
__device__ __forceinline__ void phase_merge(const Params& p, int l, int bid, int nb, unsigned char* lds) {
    const GemmCtx c = gemm_ctx();
    float* srstd = (float*)(lds + MG_NS * G_BUF);
    unsigned* sgate = (unsigned*)(lds + MG_NS * G_BUF + 1024);
    constexpr int NCT = DM / 128, NU = (NTOK / 256) * NCT;
    const float* bg = p.in[I_BGATE] + (size_t)l * 4 * DM;
    for (int u = bid; u < NU; u += nb) {
        const int rt = u / NCT, ct = u % NCT, brow = rt * 256, bcol = ct * 128;
        if (c.tid < 256) srstd[c.tid] = rstd_of(p.part, brow + c.tid);
        __syncthreads();
        f32x4 mg[4][4]; acc_zero(mg);
        const int r = c.tid >> 2;
        for (int i = 0; i < 4; ++i) {
            f32x4 acc[4][4]; acc_zero(acc);
            gemm_kloop_s<MG_NS, true>(acc, p.hb + (size_t)brow * DM, (unsigned)(r * DM + c.sc), (unsigned)((r + 128) * DM + c.sc), p.Bt_gate + ((size_t)i * DM + bcol) * DM, (unsigned)(r * DM + c.sc), DM / 32, lds, c);
            int i2 = i; asm volatile("" : "+s"(i2));
            unsigned lcol = (unsigned)(c.wc * 64 + c.fq * 4); asm volatile("" : "+v"(lcol));
            unsigned gp[2][4][2];
#pragma unroll
            for (int m = 0; m < 4; ++m) {
                const float rs = srstd[c.wr * 64 + m * 16 + c.fr];
#pragma unroll
                for (int n = 0; n < 4; ++n) {
                    const f32x4 bv = *(const f32x4*)(bg + i2 * DM + bcol + n * 16 + lcol);
                    const unsigned g0 = cvt_pk_bf16(sigmoidf_(acc[m][n][0] * rs + bv[0]), sigmoidf_(acc[m][n][1] * rs + bv[1]));
                    const unsigned g1 = cvt_pk_bf16(sigmoidf_(acc[m][n][2] * rs + bv[2]), sigmoidf_(acc[m][n][3] * rs + bv[3]));
                    if (m < 2) { sgate[((m * 4 + n) * 2 + 0) * NT + c.tid] = g0; sgate[((m * 4 + n) * 2 + 1) * NT + c.tid] = g1; }
                    else { gp[m - 2][n][0] = g0; gp[m - 2][n][1] = g1; }
                }
            }
            acc_zero(acc);
            gemm_kloop_s<MG_NS, true>(acc, p.proj + (size_t)brow * NP + C_OB + i2 * 384, (unsigned)(r * NP + c.sc), (unsigned)((r + 128) * NP + c.sc),
                                     p.Bt_br + ((size_t)i2 * DM + bcol) * 384, (unsigned)(r * 384 + c.sc), 384 / 32, lds, c);
#pragma unroll
            for (int m = 0; m < 4; ++m)
#pragma unroll
                for (int n = 0; n < 4; ++n) {
                    const unsigned g0 = m < 2 ? sgate[((m * 4 + n) * 2 + 0) * NT + c.tid] : gp[m < 2 ? 0 : m - 2][n][0];
                    const unsigned g1 = m < 2 ? sgate[((m * 4 + n) * 2 + 1) * NT + c.tid] : gp[m < 2 ? 0 : m - 2][n][1];
                    mg[m][n][0] += __uint_as_float(g0 << 16) * acc[m][n][0];
                    mg[m][n][1] += __uint_as_float(g0 & 0xFFFF0000u) * acc[m][n][1];
                    mg[m][n][2] += __uint_as_float(g1 << 16) * acc[m][n][2];
                    mg[m][n][3] += __uint_as_float(g1 & 0xFFFF0000u) * acc[m][n][3];
                }
        }
        unsigned orow = (unsigned)(c.wr * 64 + c.fr), ocol = (unsigned)(c.wc * 64 + c.fq * 4); asm volatile("" : "+v"(orow), "+v"(ocol));
#pragma unroll
        for (int m = 0; m < 4; ++m) {
            bf16_t* o = p.proj + (size_t)brow * NP + C_MG + bcol + (orow + m * 16) * NP + ocol;
#pragma unroll
            for (int n = 0; n < 4; ++n) *(uint2*)(o + n * 16) = make_uint2(cvt_pk_bf16(mg[m][n][0], mg[m][n][1]), cvt_pk_bf16(mg[m][n][2], mg[m][n][3]));
        }
        __syncthreads();
    }
}

__device__ __forceinline__ void phase_out(const Params& p, int l, int bid, int nb, unsigned char* lds) {
    const Gemm2Ctx c = gemm2_ctx();
    constexpr int NCT = DM / 256, NU = (NTOK / 256) * NCT;
    const float* hin = (l == 0) ? p.in[I_X] : p.h;
    for (int u = bid; u < NU; u += nb) {
        const int rt = u / NCT, ct = u % NCT, brow = rt * 256, bcol = ct * 256;
        f32x4 acc[8][4]; acc2_zero(acc);
        const int r = c.tid >> 2;
        gemm2_kloop<true>(acc, p.proj + (size_t)brow * NP + C_MG, (unsigned)(r * NP + c.sc), (unsigned)((r + 128) * NP + c.sc), p.Bt_out + (size_t)bcol * DM,
                          (unsigned)(r * DM + c.sc), (unsigned)((r + 128) * DM + c.sc), DM / 32, lds, c);
#pragma unroll
        for (int m = 0; m < 8; ++m) {
            const int row = brow + c.wr * 128 + m * 16 + c.fr;
            const size_t off = (size_t)row * DM + bcol + c.wc * 64 + c.fq * 4;
            float ss = 0.f;
#pragma unroll
            for (int n = 0; n < 4; ++n) {
                const f32x4 v = *(const f32x4*)(hin + off + n * 16) + acc[m][n];
                *(f32x4*)(p.h + off + n * 16) = v;
                *(uint2*)(p.hb + off + n * 16) = make_uint2(cvt_pk_bf16(v[0], v[1]), cvt_pk_bf16(v[2], v[3]));
                ss += (v[0] * v[0] + v[1] * v[1]) + (v[2] * v[2] + v[3] * v[3]);
            }
            ss += __shfl_xor(ss, 16); ss += __shfl_xor(ss, 32);
            if (c.fq == 0) p.part[(size_t)row * 16 + ct * 4 + c.wc] = ss;
        }
    }
}

constexpr int RT_LDS = 1024 * 20 * 4;
__device__ __forceinline__ void phase_router(const Params& p, int l, int bid, int nb, unsigned char* lds) {
    float* W = (float*)lds;
    const int tid = opaque_tid(), wave = tid >> 6, lane = tid & 63;
    const float* n2 = p.in[I_N2] + l * DM;
    const float* wrg = p.in[I_WRG] + (size_t)l * DM * 4;
    const float* wre = p.in[I_WRE] + (size_t)l * DM * 16;
    for (int i = tid; i < 1024 * 20; i += NT) { const int k = i / 20, j = i % 20; W[i] = n2[k] * (j < 4 ? wrg[k * 4 + j] : wre[k * 16 + (j - 4)]); }
    __syncthreads();
    int* cnt = p.cnt + l * 32;
    for (int row = bid * 8 + wave; row < NTOK; row += nb * 8) {
        float pr = p.part[(size_t)row * 16 + (lane & 15)];
        pr += __shfl_xor(pr, 1); pr += __shfl_xor(pr, 2); pr += __shfl_xor(pr, 4); pr += __shfl_xor(pr, 8);
        const float rs = rsqrtf(pr * (1.0f / 1024.0f) + EPS);
        float a[20];
#pragma unroll
        for (int j = 0; j < 20; ++j) a[j] = 0.f;
#pragma unroll 1
        for (int i = 0; i < 16; ++i) {
            const float hv = p.h[(size_t)row * DM + i * 64 + lane];
            const float* w = W + (i * 64 + lane) * 20;
#pragma unroll
            for (int j = 0; j < 20; ++j) a[j] += hv * w[j];
        }
#pragma unroll
        for (int j = 0; j < 20; ++j) a[j] = wave_sum(a[j]);
        if (lane == 0) {
            float gl[4];
#pragma unroll
            for (int j = 0; j < 4; ++j) gl[j] = a[j] * rs + p.in[I_BRG][l * 4 + j];
            int g = 0; float gm = gl[0];
#pragma unroll
            for (int j = 1; j < 4; ++j) if (gl[j] > gm) { gm = gl[j]; g = j; }
            float den = 0.f;
#pragma unroll
            for (int j = 0; j < 4; ++j) den += __expf(gl[j] - gm);
            const float gw = 1.0f / den;
            float el[4];
#pragma unroll
            for (int j = 0; j < 4; ++j) {
                float v = 0.f;
#pragma unroll
                for (int gg = 0; gg < 4; ++gg) v = (gg == g) ? (a[4 + gg * 4 + j] * rs + p.in[I_BRE][l * 16 + gg * 4 + j]) : v;
                el[j] = v;
            }
            int i1 = 0; float v1 = el[0];
#pragma unroll
            for (int j = 1; j < 4; ++j) if (el[j] > v1) { v1 = el[j]; i1 = j; }
            int i2 = -1; float v2 = -3.0e38f;
#pragma unroll
            for (int j = 0; j < 4; ++j) if (j != i1 && el[j] > v2) { v2 = el[j]; i2 = j; }
            const float e2 = __expf(v2 - v1);
            const float w1 = gw / (1.0f + e2), w2 = gw * e2 / (1.0f + e2);
            const int lo = i1 < i2 ? i1 : i2, hi = i1 < i2 ? i2 : i1;
            const float wlo = i1 < i2 ? w1 : w2, whi = i1 < i2 ? w2 : w1;
            const int pidx = lo == 0 ? (hi - 1) : (lo == 1 ? (hi + 1) : 5);
            const int cls = g * 6 + pidx;
            const int pos = __hip_atomic_fetch_add(&cnt[cls], 1, __ATOMIC_RELAXED, __HIP_MEMORY_SCOPE_AGENT);
            p.perm[(size_t)cls * NTOK + pos] = row;
            p.tokw[(size_t)row * 2] = wlo; p.tokw[(size_t)row * 2 + 1] = whi;
        }
    }
}

__device__ __forceinline__ void cls_experts(int cls, int& elo, int& ehi) {
    const int g = cls / 6, pi = cls % 6;
    const int lo = pi < 3 ? 0 : (pi < 5 ? 1 : 2), hi = pi < 3 ? pi + 1 : (pi < 5 ? pi - 1 : 3);
    elo = g * 4 + lo; ehi = g * 4 + hi;
}
__device__ __forceinline__ void moe_prefix(const int* cnt, int* spre, int* scnt) {
    if (opaque_tid() == 0) { int s = 0; for (int c = 0; c < NCLS; ++c) { const int n = cnt[c]; scnt[c] = n; spre[c] = s; s += (n + 255) >> 8; } spre[NCLS] = s; }
    __syncthreads();
}

__device__ __forceinline__ void phase_moe1(const Params& p, int l, int bid, int nb, unsigned char* lds) {
    const Gemm2Ctx c = gemm2_ctx();
    int* spre = (int*)(lds + G2_LDS); int* scnt = spre + 32;
    int* stok = scnt + 32; float* srs = (float*)(stok + 256); float* swl = srs + 256; float* swh = swl + 256;
    moe_prefix(p.cnt + l * 32, spre, scnt);
    const int nrt = spre[NCLS], NU = nrt * 8;
    for (int u = bid; u < NU; u += nb) {
        const int rt = u >> 3, ct = u & 7;
        int cls = 0;
        for (int q = 1; q < NCLS; ++q) if (spre[q] <= rt) cls = q;
        int elo, ehi; cls_experts(cls, elo, ehi);
        const int lrow0 = (rt - spre[cls]) * 256, n = scnt[cls];
        if (c.tid < 256) {
            const int lr = lrow0 + c.tid; const bool ok = lr < n;
            const int tok = ok ? p.perm[(size_t)cls * NTOK + lr] : 0;
            stok[c.tid] = ok ? tok : -1; srs[c.tid] = rstd_of(p.part, tok);
            swl[c.tid] = p.tokw[(size_t)tok * 2]; swh[c.tid] = p.tokw[(size_t)tok * 2 + 1];
        }
        __syncthreads();
        const int r = c.tid >> 2;
        const int t0 = stok[r] < 0 ? 0 : stok[r], t1 = stok[r + 128] < 0 ? 0 : stok[r + 128];
        const int ex = ct < 4 ? elo : ehi;
        f32x4 acc[8][4]; acc2_zero(acc);
        gemm2_kloop<true>(acc, p.hb, (unsigned)(t0 * DM + c.sc), (unsigned)(t1 * DM + c.sc), p.Wgu + ((size_t)ex * DM + (ct & 3) * 256) * DM,
                          (unsigned)(r * DM + c.sc), (unsigned)((r + 128) * DM + c.sc), DM / 32, lds, c);
#pragma unroll
        for (int m = 0; m < 8; ++m) {
            const int rl = c.wr * 128 + m * 16 + c.fr; const float rs = srs[rl], w = ct < 4 ? swl[rl] : swh[rl];
            bf16_t* o = p.Hbuf + ((size_t)rt * 256 + rl) * DM + (ct < 4 ? 0 : 512) + (ct & 3) * 128 + c.wc * 32 + c.fq * 4;
#pragma unroll
            for (int n2 = 0; n2 < 2; ++n2) {
                float hv[4];
#pragma unroll
                for (int j = 0; j < 4; ++j) hv[j] = siluf_(acc[m][n2][j] * rs) * (acc[m][n2 + 2][j] * rs) * w;
                *(uint2*)(o + n2 * 16) = make_uint2(cvt_pk_bf16(hv[0], hv[1]), cvt_pk_bf16(hv[2], hv[3]));
            }
        }
        __syncthreads();
    }
}

__device__ __forceinline__ void phase_moe2(const Params& p, int l, int bid, int nb, unsigned char* lds) {
    const Gemm2Ctx c = gemm2_ctx();
    int* spre = (int*)(lds + G2_LDS); int* scnt = spre + 32; int* stok = scnt + 32;
    moe_prefix(p.cnt + l * 32, spre, scnt);
    const int nrt = spre[NCLS], NU = nrt * 4;
    for (int u = bid; u < NU; u += nb) {
        const int rt = u >> 2, ct = u & 3;
        int cls = 0;
        for (int q = 1; q < NCLS; ++q) if (spre[q] <= rt) cls = q;
        int elo, ehi; cls_experts(cls, elo, ehi);
        const int lrow0 = (rt - spre[cls]) * 256, n = scnt[cls];
        if (c.tid < 256) { const int lr = lrow0 + c.tid; stok[c.tid] = lr < n ? p.perm[(size_t)cls * NTOK + lr] : -1; }
        __syncthreads();
        const int r = c.tid >> 2;
        f32x4 acc[8][4]; acc2_zero(acc);
        const bf16_t* a0 = p.Hbuf + (size_t)rt * 256 * DM;
        const unsigned oa0 = (unsigned)(r * DM + c.sc), oa1 = (unsigned)((r + 128) * DM + c.sc), ob0 = (unsigned)(r * 512 + c.sc), ob1 = (unsigned)((r + 128) * 512 + c.sc);
        gemm2_kloop<true>(acc, a0, oa0, oa1, p.WdT + ((size_t)elo * DM + ct * 256) * 512, ob0, ob1, 16, lds, c);
        gemm2_kloop<true>(acc, a0 + 512, oa0, oa1, p.WdT + ((size_t)ehi * DM + ct * 256) * 512, ob0, ob1, 16, lds, c);
#pragma unroll
        for (int m = 0; m < 8; ++m) {
            const int rl = c.wr * 128 + m * 16 + c.fr; const int tok = stok[rl];
            const size_t off = (size_t)(tok < 0 ? 0 : tok) * DM + ct * 256 + c.wc * 64 + c.fq * 4;
            float ss = 0.f;
            if (tok >= 0) {
#pragma unroll
                for (int n2 = 0; n2 < 4; ++n2) {
                    const f32x4 v = *(const f32x4*)(p.h + off + n2 * 16) + acc[m][n2];
                    *(f32x4*)(p.h + off + n2 * 16) = v;
                    *(uint2*)(p.hb + off + n2 * 16) = make_uint2(cvt_pk_bf16(v[0], v[1]), cvt_pk_bf16(v[2], v[3]));
                    ss += (v[0] * v[0] + v[1] * v[1]) + (v[2] * v[2] + v[3] * v[3]);
                }
            }
            ss += __shfl_xor(ss, 16); ss += __shfl_xor(ss, 32);
            if (c.fq == 0 && tok >= 0) p.part[(size_t)tok * 16 + ct * 4 + c.wc] = ss;
        }
        __syncthreads();
    }
}

__device__ __forceinline__ void phase_final(const Params& p, int bid, int nb) {
    const int tid = opaque_tid(), wave = tid >> 6, lane = tid & 63;
    const float* nf = p.in[I_NF];
    for (int row = bid * 8 + wave; row < NTOK; row += nb * 8) {
        const float rs = rstd_of(p.part, row);
        float* hr = p.h + (size_t)row * DM;
#pragma unroll
        for (int i = 0; i < 4; ++i) {
            f32x4 v = *(const f32x4*)(hr + i * 256 + lane * 4);
            const f32x4 g = *(const f32x4*)(nf + i * 256 + lane * 4);
            v[0] *= rs * g[0]; v[1] *= rs * g[1]; v[2] *= rs * g[2]; v[3] *= rs * g[3];
            *(f32x4*)(hr + i * 256 + lane * 4) = v;
        }
    }
}

constexpr int cmax(int a, int b) { return a > b ? a : b; }
constexpr int MEGA_LDS_BODY = cmax(cmax(cmax(GLA_LDS, LRU_LDS), cmax(DSA_LDS, DIL_LDS)), cmax(cmax(MG_LDS, RT_LDS), G2_LDS + 8192));
constexpr int MEGA_LDS = PROBE_MASK ? 160 * 1024 : MEGA_LDS_BODY + 16;


__device__ __forceinline__ const Params& kparams() {
    const __attribute__((address_space(4))) Params* q = (const __attribute__((address_space(4))) Params*)__builtin_amdgcn_kernarg_segment_ptr();
    asm volatile("" : "+s"(q));
    return *(const Params*)q;
}
__global__ void __launch_bounds__(NT, 2) mega(Params p_kernarg) {
    (void)p_kernarg;
#define p kparams()
    unsigned char* lds = dyn_lds;
    volatile LAS unsigned* xbw = (volatile LAS unsigned*)(dyn_lds + MEGA_LDS_BODY);
    if (threadIdx.x == 0) { xbw[0] = 0u; xbw[1] = 0u; xbw[2] = 0u; xbw[3] = 0u; }
    __syncthreads();
    (void)xcd_barrier_post(p.bar, xbw);
#define PROBE_TICK(type) do { if (PROBE_MASK != 0 && blockIdx.x == 0 && threadIdx.x == 0) { volatile LAS unsigned long long* pw = (volatile LAS unsigned long long*)(dyn_lds + PROBE_OFF); \
        const unsigned long long now = __builtin_amdgcn_s_memrealtime(); if ((PROBE_MASK >> (type)) & 1) pw[1] += now - pw[0]; pw[0] = now; } } while (0)
#define PROBE_SINCE(bit) do { if (((PROBE_MASK >> (bit)) & 1) && blockIdx.x == 0 && threadIdx.x == 0) { volatile LAS unsigned long long* pw = (volatile LAS unsigned long long*)(dyn_lds + PROBE_OFF); \
        pw[1] += __builtin_amdgcn_s_memrealtime() - pw[0]; } } while (0)
#define GRID_SYNC() do { XcdBarrier _b; _b.bar = p.bar; _b.x = xb_xcc_id(); _b.st = (volatile LAS unsigned*)(dyn_lds + MEGA_LDS_BODY); xcd_barrier(_b); } while (0)
    const int bid = blockIdx.x, nb = gridDim.x;
    if (PROBE_MASK != 0 && threadIdx.x == 0) { volatile LAS unsigned long long* pw = (volatile LAS unsigned long long*)(dyn_lds + PROBE_OFF); pw[0] = __builtin_amdgcn_s_memrealtime(); pw[1] = 0ull; }
    phase_prep(p, bid, nb);
    GRID_SYNC(); PROBE_TICK(0);
#pragma unroll 1
    for (int l = 0; l < DEPTH; ++l) {
        phase_weights(p, l, bid, nb, lds);
        GRID_SYNC(); PROBE_TICK(1);
        phase_inproj(p, bid, nb, lds);
        GRID_SYNC(); PROBE_TICK(2);
        if (PROBE_GEMM_VAR >= 0 && l == 0) { phase_gemm_probe<PROBE_GEMM_VAR>(p, bid, nb, lds); GRID_SYNC(); }
        {
            volatile LAS int* slot = (volatile LAS int*)(dyn_lds + MEGA_LDS_BODY + 12);
            int* qc = p.cnt + l * 32 + 24;
            phase_gla(p, l, qc + 0, slot, lds); PROBE_SINCE(14);
            phase_lru(p, l, qc + 1, slot, lds); PROBE_SINCE(15);
            phase_dsa(p, qc + 2, slot, lds); PROBE_SINCE(16);
            phase_dil(p, qc + 3, slot, lds); PROBE_SINCE(17);
        }
        GRID_SYNC(); PROBE_TICK(3);
        phase_merge(p, l, bid, nb, lds);
        GRID_SYNC(); PROBE_TICK(4);
        phase_out(p, l, bid, nb, lds);
        GRID_SYNC(); PROBE_TICK(5);
        phase_router(p, l, bid, nb, lds);
        GRID_SYNC(); PROBE_TICK(6);
        phase_moe1(p, l, bid, nb, lds);
        GRID_SYNC(); PROBE_TICK(7);
        phase_moe2(p, l, bid, nb, lds);
        GRID_SYNC(); PROBE_TICK(8);
    }
    phase_final(p, bid, nb);
    if (PROBE_MASK != 0 && threadIdx.x == 0) { volatile LAS unsigned long long* pw = (volatile LAS unsigned long long*)(dyn_lds + PROBE_OFF);
        const unsigned long long t0 = __builtin_amdgcn_s_memrealtime(), w = pw[1]; while (__builtin_amdgcn_s_memrealtime() - t0 < w) __builtin_amdgcn_s_sleep(8); }
#undef p
}

static size_t align_up(size_t v, size_t a) { return (v + a - 1) / a * a; }

extern "C" void kernel_launch(void* const* d_in, const int* in_sizes, int n_in, void* d_out, int out_size, void* d_ws, size_t ws_size, hipStream_t stream) {
    (void)in_sizes; (void)n_in; (void)out_size;
    Params p{};
    for (int i = 0; i < N_IN; ++i) p.in[i] = (const float*)d_in[i];
    p.h = (float*)d_out;
    unsigned char* w = (unsigned char*)d_ws; size_t off = 0;
    auto take = [&](size_t bytes) { unsigned char* r = w + off; off = align_up(off + bytes, 256); return r; };
    p.bar = (unsigned*)take(XCD_BAR_WORDS * 4);
    p.cnt = (int*)take(DEPTH * 32 * 4);
    p.Bt_in = (bf16_t*)take((size_t)NP * DM * 2);
    p.Bt_gate = (bf16_t*)take((size_t)4 * DM * DM * 2);
    p.Bt_br = (bf16_t*)take((size_t)4 * DM * 384 * 2);
    p.Bt_out = (bf16_t*)take((size_t)DM * DM * 2);
    p.Wgu = (bf16_t*)take((size_t)16 * DM * DM * 2);
    p.WdT = (bf16_t*)take((size_t)16 * DM * 512 * 2);
    p.hb = (bf16_t*)take((size_t)NTOK * DM * 2);
    p.part = (float*)take((size_t)NTOK * 16 * 4);
    p.biasB = (float*)take(6 * TABW * 4);
    p.biasC = (float*)take(6 * TABW * 4);
    p.VtB = (bf16_t*)take((size_t)NTOK * 384 * 2);
    p.VtC = (bf16_t*)take((size_t)NTOK * 384 * 2);
    p.tokw = (float*)take((size_t)NTOK * 2 * 4);
    p.perm = (int*)take((size_t)NCLS * NTOK * 4);
    p.proj = (bf16_t*)take((size_t)NTOK * NP * 2);
    p.Hbuf = p.proj;
    if (off > ws_size) return;

    static int grid = 0;
    if (grid == 0) {
        int dev = 0, cus = 0;
        (void)hipGetDevice(&dev);
        (void)hipDeviceGetAttribute(&cus, hipDeviceAttributeMultiprocessorCount, dev);
        if (hipFuncSetAttribute((const void*)mega, hipFuncAttributeMaxDynamicSharedMemorySize, MEGA_LDS) != hipSuccess) { grid = -1; return; }
        int per_cu = 0;
        (void)hipOccupancyMaxActiveBlocksPerMultiprocessor(&per_cu, (const void*)mega, NT, MEGA_LDS);
        (void)hipGetLastError();
        grid = cus > 0 ? cus : 256;
    }
    if (grid < 0) return;
    (void)hipMemsetAsync(p.bar, 0, XCD_BAR_WORDS * sizeof(unsigned), stream);
    mega<<<grid, NT, MEGA_LDS, stream>>>(p);
}
```

```cpp
#include <hip/hip_runtime.h>
#include <stdint.h>

typedef unsigned short bf16_t;
typedef short bf16x8 __attribute__((ext_vector_type(8)));
typedef float f32x4 __attribute__((ext_vector_type(4)));
typedef unsigned u32x4 __attribute__((ext_vector_type(4)));
typedef float f32x16 __attribute__((ext_vector_type(16)));

constexpr int NTOK = 32768, TSEQ = 2048, NBATCH = 16, DM = 1024, DEPTH = 2;
constexpr int NP = 4608;
constexpr int NT = 512;
constexpr int C_AQ = 0, C_AK = 192, C_AV = 384, C_AG = 768, C_BQ = 1152, C_CQ = 1536, C_DY = 1920, C_BK = 2304, C_CK = 2688,
              C_BV = 3072, C_CV = 3456, C_DX = 3840, C_IQ = 4224, C_IK = 4352, C_ALR = 4384, C_IW = 4400;
constexpr int C_OB = 768;
constexpr int C_MG = 2304;
constexpr float EPS = 1e-6f;
constexpr int NCLS = 24, MAXRT = 152;
constexpr int TABW = 2080;
constexpr float LOG2E = 1.4426950408889634f, NEG_BIG = -3.0e38f;

#ifndef PROBE_MASK
#define PROBE_MASK 0
#endif
extern __shared__ __attribute__((aligned(16))) unsigned char dyn_lds[];
constexpr int PROBE_OFF = 160 * 1024 - 64;
#define PROBE_UNIT_BEGIN(bit, cond) do { if (((PROBE_MASK >> (bit)) & 1) && (cond) && threadIdx.x == 0) { volatile __attribute__((address_space(3))) unsigned long long* pw = (volatile __attribute__((address_space(3))) unsigned long long*)(dyn_lds + PROBE_OFF); pw[2] = __builtin_amdgcn_s_memrealtime(); } } while (0)
#define PROBE_UNIT_END(bit, cond) do { if (((PROBE_MASK >> (bit)) & 1) && (cond) && threadIdx.x == 0) { volatile __attribute__((address_space(3))) unsigned long long* pw = (volatile __attribute__((address_space(3))) unsigned long long*)(dyn_lds + PROBE_OFF); pw[1] += 4ull * (__builtin_amdgcn_s_memrealtime() - pw[2]); } } while (0)

enum { I_X = 0, I_WIN, I_AW2, I_AB2, I_AGAIN, I_CONVW, I_CONVB, I_WR, I_BR, I_WI, I_BI, I_LAM, I_WGATE, I_BGATE, I_WBR, I_WOUT, I_RELB,
       I_N1, I_N2, I_NF, I_WRG, I_BRG, I_WRE, I_BRE, I_MWG, I_MWU, I_MWD, N_IN };

struct Params {
    const float* in[N_IN];
    float* h;
    bf16_t* Bt_in;
    bf16_t* Bt_gate;
    bf16_t* Bt_br;
    bf16_t* Bt_out;
    bf16_t* Wgu;
    bf16_t* WdT;
    bf16_t* hb;
    bf16_t* proj;
    bf16_t* Hbuf;
    float* part;
    float* biasB;
    float* biasC;
    bf16_t* VtB;
    bf16_t* VtC;
    float* tokw;
    int* perm;
    int* cnt;
    unsigned* bar;
};

__device__ __forceinline__ bf16_t f2bf(float f) { unsigned u = __float_as_uint(f); u += 0x7FFFu + ((u >> 16) & 1u); return (bf16_t)(u >> 16); }
__device__ __forceinline__ float bf2f(bf16_t b) { return __uint_as_float(((unsigned)b) << 16); }
__device__ __forceinline__ float wave_sum(float v) {
#pragma unroll
    for (int o = 32; o > 0; o >>= 1) v += __shfl_xor(v, o);
    return v;
}
__device__ __forceinline__ float wave_max(float v) {
#pragma unroll
    for (int o = 32; o > 0; o >>= 1) v = fmaxf(v, __shfl_xor(v, o));
    return v;
}
__device__ __forceinline__ int wave_sum_i(int v) {
#pragma unroll
    for (int o = 32; o > 0; o >>= 1) v += __shfl_xor(v, o);
    return v;
}
__device__ __forceinline__ int opaque_tid() { int t = threadIdx.x; asm volatile("" : "+v"(t)); return t; }
__device__ __forceinline__ unsigned cvt_pk_bf16(float lo, float hi) { unsigned r; asm volatile("v_cvt_pk_bf16_f32 %0, %1, %2" : "=v"(r) : "v"(lo), "v"(hi)); return r; }
__device__ __forceinline__ float sigmoidf_(float x) { return 1.0f / (1.0f + __expf(-x)); }
__device__ __forceinline__ float siluf_(float x) { return x / (1.0f + __expf(-x)); }
__device__ __forceinline__ float rstd_of(const float* part, int row) {
    const f32x4* p = (const f32x4*)(part + (size_t)row * 16);
    f32x4 a = p[0], b = p[1], c = p[2], d = p[3];
    float s = ((a[0] + a[1]) + (a[2] + a[3])) + ((b[0] + b[1]) + (b[2] + b[3])) + ((c[0] + c[1]) + (c[2] + c[3])) + ((d[0] + d[1]) + (d[2] + d[3]));
    return rsqrtf(s * (1.0f / 1024.0f) + EPS);
}
__device__ __forceinline__ int map_in_col(int c) {
    if (c < 1152) return c;
    if (c < 1536) return 1168 + (c - 1152);
    if (c < 1920) return 2484 + (c - 1536);
    if (c < 2304) return 3636 + (c - 1920);
    if (c < 2688) return 1552 + (c - 2304);
    if (c < 3072) return 2868 + (c - 2688);
    if (c < 3456) return 1936 + (c - 3072);
    if (c < 3840) return 3252 + (c - 3456);
    if (c < 4224) return 4020 + (c - 3840);
    if (c < 4352) return 2320 + (c - 4224);
    if (c < 4384) return 2448 + (c - 4352);
    if (c < 4400) return 1152 + (c - 4384);
    if (c < 4404) return 2480 + (c - 4400);
    return -1;
}
__device__ __forceinline__ int rel_bucket(int n) {
    if (n < 16) return n;
    float v = logf((float)n / 16.0f) / 4.852030263919617f * 16.0f;
    int b = 16 + (int)v;
    return b < 31 ? b : 31;
}

#define XB_TMO      128
#define XB_XCNT(j)  (256  + 64 * (j))
#define XB_XSUB(j)  (1280 + 64 * (j))
#define XB_XGEN(j)  (2304 + 64 * (j))
#define XB_TOP      3328
#define XB_TOPGEN   3392
#define XCD_BAR_WORDS 3456
#define XB_SPIN_CAP (1u << 18)
#define LAS __attribute__((address_space(3)))

__device__ __forceinline__ unsigned xb_ld(unsigned* p)              { return __hip_atomic_load(p, __ATOMIC_RELAXED, __HIP_MEMORY_SCOPE_AGENT); }
__device__ __forceinline__ unsigned xb_add(unsigned* p, unsigned v) { return __hip_atomic_fetch_add(p, v, __ATOMIC_RELAXED, __HIP_MEMORY_SCOPE_AGENT); }
__device__ __forceinline__ unsigned xb_xcc_id() { return (unsigned)__builtin_amdgcn_s_getreg((3 << 11) | 20) & 0xFu; }
#define XB_SPIN(cond, bar) do { unsigned _sp = 0; while (cond) { __builtin_amdgcn_s_sleep(1); \
    if ((++_sp & 255u) == 0u) { if (xb_ld(&(bar)[XB_TMO])) break; if (_sp > XB_SPIN_CAP) { atomicAdd(&(bar)[XB_TMO], 1u); break; } } } } while (0)

struct XcdBarrier {
    unsigned* bar; unsigned x;
    volatile LAS unsigned* st;
};

__device__ __forceinline__ XcdBarrier xcd_barrier_post(unsigned* bar, volatile LAS unsigned* st) {
    XcdBarrier b; b.bar = bar; b.x = xb_xcc_id(); b.st = st;
    if (threadIdx.x == 0) (void)xb_add(&bar[XB_XCNT(b.x)], 1u);
    return b;
}
__device__ __forceinline__ void xcd_barrier_complete(unsigned* bar, unsigned x, unsigned& nloc, unsigned& nx) {
    const unsigned G = gridDim.x * gridDim.y * gridDim.z;
    unsigned sum, cnt, mine, sp = 0u;
    for (;;) {
        sum = 0u; cnt = 0u; mine = 0u;
#pragma unroll
        for (unsigned j = 0; j < 16; ++j) { const unsigned c = xb_ld(&bar[XB_XCNT(j)]); sum += c; cnt += (c > 0u) ? 1u : 0u; mine = (j == x) ? c : mine; }
        if (sum == G) break;
        __builtin_amdgcn_s_sleep(1);
        if ((++sp & 255u) == 0u) { if (xb_ld(&bar[XB_TMO])) break; if (sp > XB_SPIN_CAP) { atomicAdd(&bar[XB_TMO], 1u); break; } }
    }
    nloc = mine > 0u ? mine : 1u; nx = cnt > 0u ? cnt : 1u;
}

__device__ __forceinline__ void xcd_barrier(const XcdBarrier& b) {
    asm volatile("s_waitcnt vmcnt(0)" ::: "memory");
    __syncthreads();
    if (threadIdx.x == 0) {
        unsigned* bar = b.bar;
        __builtin_amdgcn_s_waitcnt(0);
        unsigned nloc = b.st[0], nx = b.st[1];
        if (nloc == 0u) { xcd_barrier_complete(bar, b.x, nloc, nx); b.st[0] = nloc; b.st[1] = nx; }
        const unsigned old = xb_add(&bar[XB_XSUB(b.x)], 1u);
        const unsigned gen = old / nloc;
        if (old + 1u == (gen + 1u) * nloc) {
            __builtin_amdgcn_fence(__ATOMIC_RELEASE, "agent");
            asm volatile("s_waitcnt vmcnt(0)" ::: "memory");
            const unsigned og = xb_add(&bar[XB_TOP], 1u);
            const unsigned tg = og / nx;
            if (og + 1u == (tg + 1u) * nx) xb_add(&bar[XB_TOPGEN], 1u);
            else XB_SPIN(xb_ld(&bar[XB_TOPGEN]) == tg, bar);
            __builtin_amdgcn_fence(__ATOMIC_ACQUIRE, "agent");
            xb_add(&bar[XB_XGEN(b.x)], 1u);
            asm volatile("s_waitcnt vmcnt(0)" ::: "memory");
        } else {
            XB_SPIN(xb_ld(&bar[XB_XGEN(b.x)]) == gen, bar);
            __builtin_amdgcn_fence(__ATOMIC_ACQUIRE, "agent");
            asm volatile("s_waitcnt vmcnt(0)" ::: "memory");
        }
    }
    __syncthreads();
}


template <class MapF>
__device__ __forceinline__ void conv_wT(const float* __restrict__ src, int ldsrc, int K, bf16_t* __restrict__ dst, int nrows, MapF colmap,
                                        const float* __restrict__ scale, int bid, int nb, float* tile) {
    const int tid = opaque_tid(), nkt = K / 64, ntile = (nrows / 64) * nkt;
    for (int t = bid; t < ntile; t += nb) {
        const int r0 = (t / nkt) * 64, k0 = (t % nkt) * 64;
#pragma unroll
        for (int i = 0; i < 8; ++i) {
            const int e = tid + NT * i, kk = e >> 6, rr = e & 63;
            const int c = colmap(r0 + rr);
            float v = 0.f;
            if (c >= 0) { v = src[(size_t)(k0 + kk) * ldsrc + c]; if (scale) v *= scale[k0 + kk]; }
            tile[kk * 65 + rr] = v;
        }
        __syncthreads();
#pragma unroll
        for (int i = 0; i < 8; ++i) {
            const int e = tid + NT * i, rr = e >> 6, kk = e & 63;
            dst[(size_t)(r0 + rr) * K + k0 + kk] = f2bf(tile[kk * 65 + rr]);
        }
        __syncthreads();
    }
}

__device__ __forceinline__ void phase_weights(const Params& p, int l, int bid, int nb, unsigned char* lds) {
    float* tile = (float*)lds;
    const float* n1 = p.in[I_N1] + l * DM;
    const float* n2 = p.in[I_N2] + l * DM;
    conv_wT(p.in[I_WIN] + (size_t)l * DM * 4404, 4404, DM, p.Bt_in, NP, [](int r) { return map_in_col(r); }, n1, bid, nb, tile);
    for (int i = 0; i < 4; ++i) {
        conv_wT(p.in[I_WGATE] + ((size_t)l * 4 + i) * DM * DM, DM, DM, p.Bt_gate + (size_t)i * DM * DM, DM, [](int r) { return r; }, n1, bid, nb, tile);
        conv_wT(p.in[I_WBR] + ((size_t)l * 4 + i) * 384 * DM, DM, 384, p.Bt_br + (size_t)i * DM * 384, DM, [](int r) { return r; }, nullptr, bid, nb, tile);
    }
    conv_wT(p.in[I_WOUT] + (size_t)l * DM * DM, DM, DM, p.Bt_out, DM, [](int r) { return r; }, nullptr, bid, nb, tile);
    for (int e = 0; e < 16; ++e) {
        const float* wg = p.in[I_MWG] + ((size_t)l * 16 + e) * DM * 512;
        const float* wu = p.in[I_MWU] + ((size_t)l * 16 + e) * DM * 512;
        bf16_t* dst = p.Wgu + (size_t)e * DM * DM;
        {
            const int tid = opaque_tid();
            for (int t = bid; t < 16 * 16; t += nb) {
                const int r0 = (t / 16) * 64, k0 = (t % 16) * 64;
#pragma unroll
                for (int i = 0; i < 8; ++i) {
                    const int ee = tid + NT * i, kk = ee >> 6, rr = ee & 63, rho = r0 + rr;
                    const int T = rho >> 8, wc = (rho >> 6) & 3, q = (rho >> 5) & 1, ii = rho & 31, hcol = 128 * T + 32 * wc + ii;
                    const float* s = q ? wu : wg;
                    tile[kk * 65 + rr] = s[(size_t)(k0 + kk) * 512 + hcol] * n2[k0 + kk];
                }
                __syncthreads();
#pragma unroll
                for (int i = 0; i < 8; ++i) {
                    const int ee = tid + NT * i, rr = ee >> 6, kk = ee & 63;
                    dst[(size_t)(r0 + rr) * DM + k0 + kk] = f2bf(tile[kk * 65 + rr]);
                }
                __syncthreads();
            }
        }
        conv_wT(p.in[I_MWD] + ((size_t)l * 16 + e) * 512 * DM, DM, 512, p.WdT + (size_t)e * DM * 512, DM, [](int r) { return r; }, nullptr, bid, nb, tile);
    }
}

__device__ __forceinline__ void phase_prep(const Params& p, int bid, int nb) {
    const int tid = opaque_tid(), wave = tid >> 6, lane = tid & 63;
    const float* x = p.in[I_X];
    for (int row = bid * 8 + wave; row < NTOK; row += nb * 8) {
        const float* xr = x + (size_t)row * DM;
        float s = 0.f;
#pragma unroll
        for (int i = 0; i < 4; ++i) {
            const f32x4 v = *(const f32x4*)(xr + i * 256 + lane * 4);
            s += v[0] * v[0] + v[1] * v[1] + v[2] * v[2] + v[3] * v[3];
            const unsigned lo = (unsigned)f2bf(v[0]) | ((unsigned)f2bf(v[1]) << 16), hi = (unsigned)f2bf(v[2]) | ((unsigned)f2bf(v[3]) << 16);
            *(uint2*)(p.hb + (size_t)row * DM + i * 256 + lane * 4) = make_uint2(lo, hi);
        }
        s = wave_sum(s);
        if (lane < 16) p.part[(size_t)row * 16 + lane] = (lane == 0) ? s : 0.f;
    }
    const float* rb = p.in[I_RELB];
    for (int i = bid * NT + tid; i < 6 * TABW; i += nb * NT) {
        const int h = i / TABW, d = i % TABW - 32;
        float vb = NEG_BIG, vc = NEG_BIG;
        if (d >= 0) {
            const int bk = rel_bucket(d);
            vb = rb[bk * 12 + h] * LOG2E;
            const int m = (d <= 128 ? 1 : 0) + ((d % 4 == 0 && d <= 512) ? 1 : 0) + ((d % 16 == 0) ? 1 : 0);
            if (m > 0) vc = (rb[bk * 12 + 6 + h] + logf((float)m)) * LOG2E;
        }
        p.biasB[i] = vb; p.biasC[i] = vc;
    }
    for (int i = bid * NT + tid; i < DEPTH * 32; i += nb * NT) p.cnt[i] = 0;
}

constexpr int G_BUF = 256 * 32 * 2 + 128 * 32 * 2;
constexpr int G_NS = 6, G_LDS = G_NS * G_BUF;
constexpr int MG_NS = 5, MG_GLDS = MG_NS * G_BUF;
struct GemmCtx { int tid, wid, lane, wr, wc, fr, fq, sc, rdo; };
__device__ __forceinline__ GemmCtx gemm_ctx() {
    GemmCtx c; c.tid = opaque_tid(); c.wid = __builtin_amdgcn_readfirstlane(c.tid >> 6); c.lane = c.tid & 63; c.wr = c.wid >> 1; c.wc = c.wid & 1; c.fr = c.lane & 15; c.fq = c.lane >> 4;
    c.sc = (((c.tid & 3) ^ ((0 - (c.tid >> 4)) & 3))) * 8;
    c.rdo = c.fr * 64 + ((c.fq ^ ((0 - (c.fr >> 2)) & 3)) * 16);
    return c;
}
__device__ __forceinline__ void gemm_relane(GemmCtx& c) { int t = c.tid; asm volatile("" : "+v"(t)); c.lane = t & 63; c.fr = t & 15; c.fq = (t >> 4) & 3; }
__device__ __forceinline__ void acc_zero(f32x4 (&acc)[4][4]) {
#pragma unroll
    for (int m = 0; m < 4; ++m)
#pragma unroll
        for (int n = 0; n < 4; ++n) acc[m][n] = (f32x4){0.f, 0.f, 0.f, 0.f};
}
__device__ __forceinline__ void gemm_stage(const bf16_t* A, unsigned oa0, unsigned oa1, const bf16_t* B, unsigned ob, int t, unsigned char* buf, const GemmCtx& c) {
    const bf16_t* At = A + t * 32; const bf16_t* Bt = B + t * 32;
    __builtin_amdgcn_global_load_lds((const unsigned*)(At + oa0), (unsigned*)(buf + c.tid * 16), 16, 0, 0);
    __builtin_amdgcn_global_load_lds((const unsigned*)(At + oa1), (unsigned*)(buf + 8192 + c.tid * 16), 16, 0, 0);
    __builtin_amdgcn_global_load_lds((const unsigned*)(Bt + ob), (unsigned*)(buf + 16384 + c.tid * 16), 16, 0, 0);
}
template <int NS>
__device__ __forceinline__ void gemm_kloop(f32x4 (&acc)[4][4], const bf16_t* A, unsigned oa0, unsigned oa1, const bf16_t* B, unsigned ob, int nkt, unsigned char* lds, const GemmCtx& c) {
#pragma unroll
    for (int i = 0; i < NS - 1; ++i) gemm_stage(A, oa0, oa1, B, ob, i, lds + i * G_BUF, c);
    int cur = 0;
#pragma unroll 1
    for (int t = 0; t < nkt; ++t) {
        const int young = nkt - 1 - t;
        if (NS >= 6 && young >= 4) asm volatile("s_waitcnt vmcnt(12)" ::: "memory");
        else if (NS >= 5 && young >= 3) asm volatile("s_waitcnt vmcnt(9)" ::: "memory");
        else if (NS >= 4 && young >= 2) asm volatile("s_waitcnt vmcnt(6)" ::: "memory");
        else if (young >= 1) asm volatile("s_waitcnt vmcnt(3)" ::: "memory");
        else asm volatile("s_waitcnt vmcnt(0)" ::: "memory");
        __builtin_amdgcn_s_barrier();
        asm volatile("" ::: "memory");
        const int nxt = cur == 0 ? NS - 1 : cur - 1;
        if (t + NS - 1 < nkt) gemm_stage(A, oa0, oa1, B, ob, t + NS - 1, lds + nxt * G_BUF, c);
        const unsigned char* SA = lds + cur * G_BUF; const unsigned char* SB = SA + 16384;
        bf16x8 At[4], Bt[4];
#pragma unroll
        for (int m = 0; m < 4; ++m) At[m] = *reinterpret_cast<const bf16x8*>(SA + (c.wr * 64 + m * 16) * 64 + c.rdo);
#pragma unroll
        for (int n = 0; n < 4; ++n) Bt[n] = *reinterpret_cast<const bf16x8*>(SB + (c.wc * 64 + n * 16) * 64 + c.rdo);
        asm volatile("s_waitcnt lgkmcnt(0)" ::: "memory");
        __builtin_amdgcn_sched_barrier(0);
#pragma unroll
        for (int m = 0; m < 4; ++m)
#pragma unroll
            for (int n = 0; n < 4; ++n) acc[m][n] = __builtin_amdgcn_mfma_f32_16x16x32_bf16(At[m], Bt[n], acc[m][n], 0, 0, 0);
        cur = cur == NS - 1 ? 0 : cur + 1;
    }
    __builtin_amdgcn_s_barrier();
    asm volatile("" ::: "memory");
}

template <int NS>
__device__ __forceinline__ void gemm_kloop_p(f32x4 (&acc)[4][4], const bf16_t* A, unsigned oa0, unsigned oa1, const bf16_t* B, unsigned ob, int nkt, unsigned char* lds, const GemmCtx& c) {
#pragma unroll
    for (int i = 0; i < NS; ++i) gemm_stage(A, oa0, oa1, B, ob, i, lds + i * G_BUF, c);
    const int aoff = (c.wr * 64) * 64 + c.rdo, boff = 16384 + (c.wc * 64) * 64 + c.rdo;
    bf16x8 A0[4], B0[4], A1[4], B1[4];
#define GK_WAIT(young_) do { const int _y = (young_); \
        if (NS >= 6 && _y >= 4) asm volatile("s_waitcnt vmcnt(12)" ::: "memory"); \
        else if (NS >= 5 && _y >= 3) asm volatile("s_waitcnt vmcnt(9)" ::: "memory"); \
        else if (NS >= 4 && _y >= 2) asm volatile("s_waitcnt vmcnt(6)" ::: "memory"); \
        else if (_y >= 1) asm volatile("s_waitcnt vmcnt(3)" ::: "memory"); \
        else asm volatile("s_waitcnt vmcnt(0)" ::: "memory"); } while (0)
#define GK_READ(FA, FB, buf_) do { const unsigned char* _s = lds + (buf_) * G_BUF; \
        _Pragma("unroll") for (int m = 0; m < 4; ++m) FA[m] = *reinterpret_cast<const bf16x8*>(_s + aoff + m * 1024); \
        _Pragma("unroll") for (int n = 0; n < 4; ++n) FB[n] = *reinterpret_cast<const bf16x8*>(_s + boff + n * 1024); } while (0)
#define GK_MMA(FA, FB) do { _Pragma("unroll") for (int m = 0; m < 4; ++m) _Pragma("unroll") for (int n = 0; n < 4; ++n) \
        acc[m][n] = __builtin_amdgcn_mfma_f32_16x16x32_bf16(FA[m], FB[n], acc[m][n], 0, 0, 0); } while (0)
    GK_WAIT(NS - 1);
    __builtin_amdgcn_s_barrier(); asm volatile("" ::: "memory");
    GK_READ(A0, B0, 0);
    int cur = 0;
#pragma unroll 1
    for (int t = 0; t < nkt; t += 2) {
        {
            GK_WAIT(nkt - 2 - t < NS - 2 ? nkt - 2 - t : NS - 2);
            asm volatile("s_waitcnt lgkmcnt(0)" ::: "memory");
            __builtin_amdgcn_s_barrier(); asm volatile("" ::: "memory");
            if (t + NS < nkt) gemm_stage(A, oa0, oa1, B, ob, t + NS, lds + cur * G_BUF, c);
            const int n1 = cur == NS - 1 ? 0 : cur + 1;
            GK_READ(A1, B1, n1);
            GK_MMA(A0, B0);
            cur = n1;
        }
        {
            const bool more = t + 2 < nkt;
            if (more) GK_WAIT(nkt - 3 - t < NS - 2 ? nkt - 3 - t : NS - 2);
            asm volatile("s_waitcnt lgkmcnt(0)" ::: "memory");
            __builtin_amdgcn_s_barrier(); asm volatile("" ::: "memory");
            if (t + 1 + NS < nkt) gemm_stage(A, oa0, oa1, B, ob, t + 1 + NS, lds + cur * G_BUF, c);
            const int n1 = cur == NS - 1 ? 0 : cur + 1;
            if (more) GK_READ(A0, B0, n1);
            GK_MMA(A1, B1);
            cur = n1;
        }
    }
#undef GK_WAIT
#undef GK_READ
#undef GK_MMA
    __builtin_amdgcn_s_barrier(); asm volatile("" ::: "memory");
}

template <int NS, bool SWAP>
__device__ __forceinline__ void gemm_kloop_s(f32x4 (&acc)[4][4], const bf16_t* A, unsigned oa0, unsigned oa1, const bf16_t* B, unsigned ob, int nkt, unsigned char* lds, const GemmCtx& c) {
    constexpr int D = NS - 2;
#pragma unroll
    for (int i = 0; i < D; ++i) gemm_stage(A, oa0, oa1, B, ob, i, lds + i * G_BUF, c);
    const int aoff = (c.wr * 64) * 64 + c.rdo, boff = 16384 + (c.wc * 64) * 64 + c.rdo;
    const bool trailing = c.wid >= 4;
#define GS_WAIT(young_) do { const int _y = (young_); \
        if (D >= 5 && _y >= 3) asm volatile("s_waitcnt vmcnt(9)" ::: "memory"); \
        else if (D >= 4 && _y >= 2) asm volatile("s_waitcnt vmcnt(6)" ::: "memory"); \
        else if (_y >= 1) asm volatile("s_waitcnt vmcnt(3)" ::: "memory"); \
        else asm volatile("s_waitcnt vmcnt(0)" ::: "memory"); } while (0)
    GS_WAIT(D - 1);
    __builtin_amdgcn_s_barrier(); asm volatile("" ::: "memory");
    if (trailing) { __builtin_amdgcn_s_barrier(); asm volatile("" ::: "memory"); }
    int cur = 0, nxt = D % NS;
#pragma unroll 1
    for (int t = 0; t < nkt; ++t) {
        if (t + 1 < nkt) GS_WAIT(nkt - 2 - t < D - 2 ? nkt - 2 - t : D - 2);
        if (t + D < nkt) gemm_stage(A, oa0, oa1, B, ob, t + D, lds + nxt * G_BUF, c);
        const unsigned char* sb = lds + cur * G_BUF;
        bf16x8 At[4], Bt[4];
#pragma unroll
        for (int m = 0; m < 4; ++m) At[m] = *reinterpret_cast<const bf16x8*>(sb + aoff + m * 1024);
#pragma unroll
        for (int n = 0; n < 4; ++n) Bt[n] = *reinterpret_cast<const bf16x8*>(sb + boff + n * 1024);
        __builtin_amdgcn_s_barrier(); asm volatile("" ::: "memory");
        asm volatile("s_waitcnt lgkmcnt(0)" ::: "memory");
        __builtin_amdgcn_sched_barrier(0);
        __builtin_amdgcn_s_setprio(1);
#pragma unroll
        for (int m = 0; m < 4; ++m)
#pragma unroll
            for (int n = 0; n < 4; ++n) acc[m][n] = SWAP ? __builtin_amdgcn_mfma_f32_16x16x32_bf16(Bt[n], At[m], acc[m][n], 0, 0, 0) : __builtin_amdgcn_mfma_f32_16x16x32_bf16(At[m], Bt[n], acc[m][n], 0, 0, 0);
        __builtin_amdgcn_s_setprio(0);
        __builtin_amdgcn_s_barrier(); asm volatile("" ::: "memory");
        cur = cur == NS - 1 ? 0 : cur + 1; nxt = nxt == NS - 1 ? 0 : nxt + 1;
    }
#undef GS_WAIT
    if (!trailing) { __builtin_amdgcn_s_barrier(); asm volatile("" ::: "memory"); }
}

constexpr int G2_BUF = 2 * 256 * 32 * 2, G2_NS = 4, G2_LDS = G2_NS * G2_BUF;
struct Gemm2Ctx { int tid, wid, wr, wc, sc, aoff, boff, fr, fq; };
__device__ __forceinline__ Gemm2Ctx gemm2_ctx() {
    Gemm2Ctx c; c.tid = opaque_tid(); c.wid = __builtin_amdgcn_readfirstlane(c.tid >> 6); c.wr = c.wid >> 2; c.wc = c.wid & 3;
    const int lane = c.tid & 63; c.fr = lane & 15; c.fq = lane >> 4;
    c.sc = (((c.tid & 3) ^ ((0 - (c.tid >> 4)) & 3))) * 8;
    const int rdo = c.fr * 64 + ((c.fq ^ ((0 - (c.fr >> 2)) & 3)) * 16);
    c.aoff = (c.wr * 128) * 64 + rdo; c.boff = 16384 + (c.wc * 64) * 64 + rdo;
    return c;
}
__device__ __forceinline__ void gemm2_relane(Gemm2Ctx& c) { int t = c.tid; asm volatile("" : "+v"(t)); c.fr = t & 15; c.fq = (t >> 4) & 3; }
__device__ __forceinline__ void acc2_zero(f32x4 (&acc)[8][4]) {
#pragma unroll
    for (int m = 0; m < 8; ++m)
#pragma unroll
        for (int n = 0; n < 4; ++n) acc[m][n] = (f32x4){0.f, 0.f, 0.f, 0.f};
}
__device__ __forceinline__ void gemm2_stage(const bf16_t* A, unsigned oa0, unsigned oa1, const bf16_t* B, unsigned ob0, unsigned ob1, int t, unsigned char* buf, int tid) {
    const bf16_t* At = A + t * 32; const bf16_t* Bt = B + t * 32;
    __builtin_amdgcn_global_load_lds((const unsigned*)(At + oa0), (unsigned*)(buf + tid * 16), 16, 0, 0);
    __builtin_amdgcn_global_load_lds((const unsigned*)(At + oa1), (unsigned*)(buf + 8192 + tid * 16), 16, 0, 0);
    __builtin_amdgcn_global_load_lds((const unsigned*)(Bt + ob0), (unsigned*)(buf + 16384 + tid * 16), 16, 0, 0);
    __builtin_amdgcn_global_load_lds((const unsigned*)(Bt + ob1), (unsigned*)(buf + 24576 + tid * 16), 16, 0, 0);
}
template <bool SWAP>
__device__ __forceinline__ void gemm2_kloop(f32x4 (&acc)[8][4], const bf16_t* A, unsigned oa0, unsigned oa1, const bf16_t* B, unsigned ob0, unsigned ob1, int nkt, unsigned char* lds, const Gemm2Ctx& c) {
#pragma unroll
    for (int i = 0; i < 3; ++i) gemm2_stage(A, oa0, oa1, B, ob0, ob1, i, lds + i * G2_BUF, c.tid);
    const bool trailing = c.wid >= 4;
    asm volatile("s_waitcnt vmcnt(8)" ::: "memory");
    __builtin_amdgcn_s_barrier(); asm volatile("" ::: "memory");
    if (trailing) { __builtin_amdgcn_s_barrier(); asm volatile("" ::: "memory"); }
    int cur = 0;
#pragma unroll 1
    for (int t = 0; t < nkt; ++t) {
        if (t + 2 < nkt) asm volatile("s_waitcnt vmcnt(4)" ::: "memory"); else asm volatile("s_waitcnt vmcnt(0)" ::: "memory");
        const unsigned char* sb = lds + cur * G2_BUF;
        bf16x8 At[8], Bt[4];
#pragma unroll
        for (int n = 0; n < 4; ++n) Bt[n] = *reinterpret_cast<const bf16x8*>(sb + c.boff + n * 1024);
#pragma unroll
        for (int m = 0; m < 8; ++m) At[m] = *reinterpret_cast<const bf16x8*>(sb + c.aoff + m * 1024);
        __builtin_amdgcn_s_barrier(); asm volatile("" ::: "memory");
        asm volatile("s_waitcnt lgkmcnt(0)" ::: "memory");
        __builtin_amdgcn_sched_barrier(0);
#pragma unroll
        for (int m = 0; m < 4; ++m)
#pragma unroll
            for (int n = 0; n < 4; ++n) acc[m][n] = SWAP ? __builtin_amdgcn_mfma_f32_16x16x32_bf16(Bt[n], At[m], acc[m][n], 0, 0, 0) : __builtin_amdgcn_mfma_f32_16x16x32_bf16(At[m], Bt[n], acc[m][n], 0, 0, 0);
        __builtin_amdgcn_sched_barrier(0);
        if (t + 3 < nkt) gemm2_stage(A, oa0, oa1, B, ob0, ob1, t + 3, lds + (cur == 0 ? 3 : cur - 1) * G2_BUF, c.tid);
        __builtin_amdgcn_sched_barrier(0);
#pragma unroll
        for (int m = 4; m < 8; ++m)
#pragma unroll
            for (int n = 0; n < 4; ++n) acc[m][n] = SWAP ? __builtin_amdgcn_mfma_f32_16x16x32_bf16(Bt[n], At[m], acc[m][n], 0, 0, 0) : __builtin_amdgcn_mfma_f32_16x16x32_bf16(At[m], Bt[n], acc[m][n], 0, 0, 0);
        __builtin_amdgcn_s_barrier(); asm volatile("" ::: "memory");
        cur = cur == 3 ? 0 : cur + 1;
    }
    if (!trailing) { __builtin_amdgcn_s_barrier(); asm volatile("" ::: "memory"); }
}

__device__ __forceinline__ void phase_inproj(const Params& p, int bid, int nb, unsigned char* lds) {
    Gemm2Ctx c = gemm2_ctx();
    float* srstd = (float*)(lds + G2_LDS);
    constexpr int NCT = NP / 256, NUX = (NTOK / 256 / 8) * NCT;
    const int xcd = bid & 7, nloc = nb >> 3;
    for (int k = bid >> 3; k < NUX; k += nloc) {
        const int rt = xcd * (NTOK / 256 / 8) + k / NCT, ct = k % NCT, brow = rt * 256, bcol = ct * 256;
        if (c.tid < 256) srstd[c.tid] = rstd_of(p.part, brow + c.tid);
        f32x4 acc[8][4]; acc2_zero(acc);
        const int r = c.tid >> 2;
        const unsigned o0 = (unsigned)(r * DM + c.sc), o1 = (unsigned)((r + 128) * DM + c.sc);
        if (ct >= C_BV / 256 && ct < C_BV / 256 + 3) {
            gemm2_kloop<false>(acc, p.hb + (size_t)brow * DM, o0, o1, p.Bt_in + (size_t)bcol * DM, o0, o1, DM / 32, lds, c);
            gemm2_relane(c);
            const int vcol = bcol - C_BV + c.wc * 64;
            bf16_t* vt = (vcol < 384 ? p.VtB + ((size_t)(brow / TSEQ) * 384 + vcol + c.fr) * TSEQ : p.VtC + ((size_t)(brow / TSEQ) * 384 + (vcol - 384) + c.fr) * TSEQ)
                         + (brow % TSEQ) + c.wr * 128 + ((((c.fq & 1) << 1) | (c.fq >> 1)) * 4);
#pragma unroll
            for (int m = 0; m < 8; ++m) {
                const int rl = c.wr * 128 + m * 16 + c.fq * 4;
                const float r0 = srstd[rl], r1 = srstd[rl + 1], r2 = srstd[rl + 2], r3 = srstd[rl + 3];
#pragma unroll
                for (int n = 0; n < 4; ++n)
                    *(uint2*)(vt + (size_t)(n * 16) * TSEQ + m * 16) = make_uint2(cvt_pk_bf16(acc[m][n][0] * r0, acc[m][n][1] * r1), cvt_pk_bf16(acc[m][n][2] * r2, acc[m][n][3] * r3));
            }
        } else {
            gemm2_kloop<true>(acc, p.hb + (size_t)brow * DM, o0, o1, p.Bt_in + (size_t)bcol * DM, o0, o1, DM / 32, lds, c);
            gemm2_relane(c);
#pragma unroll
            for (int m = 0; m < 8; ++m) {
                const int rl = c.wr * 128 + m * 16 + c.fr; const float rs = srstd[rl];
                bf16_t* o = p.proj + (size_t)(brow + rl) * NP + bcol + c.wc * 64 + c.fq * 4;
#pragma unroll
                for (int n = 0; n < 4; ++n) *(uint2*)(o + n * 16) = make_uint2(cvt_pk_bf16(acc[m][n][0] * rs, acc[m][n][1] * rs), cvt_pk_bf16(acc[m][n][2] * rs, acc[m][n][3] * rs));
            }
        }
        __syncthreads();
    }
}

__device__ __forceinline__ int grab_unit(int* ctr, volatile LAS int* slot) {
    __syncthreads();
    if (opaque_tid() == 0) *slot = __hip_atomic_fetch_add(ctr, 1, __ATOMIC_RELAXED, __HIP_MEMORY_SCOPE_AGENT);
    __syncthreads();
    return *slot;
}

#ifndef PROBE_GEMM_VAR
#define PROBE_GEMM_VAR -1
#endif
template <int VAR>
__device__ __forceinline__ void phase_gemm_probe(const Params& p, int bid, int nb, unsigned char* lds) {
    const GemmCtx c = gemm_ctx();
    constexpr int NS = G_NS, NCT = NP / 128, NU = (NTOK / 256) * NCT;
    for (int u = bid; u < NU; u += nb) {
        const int rt = u / NCT, ct = u % NCT, brow = rt * 256, bcol = ct * 128;
        f32x4 acc[4][4]; acc_zero(acc);
        const int r = c.tid >> 2;
        const bf16_t* A = p.hb + (size_t)brow * DM; const bf16_t* B = p.Bt_in + (size_t)bcol * DM;
        const unsigned oa0 = (unsigned)(r * DM + c.sc), oa1 = (unsigned)((r + 128) * DM + c.sc), ob = (unsigned)(r * DM + c.sc);
        const int nkt = DM / 32;
#pragma unroll
        for (int i = 0; i < NS - 1; ++i) gemm_stage(A, oa0, oa1, B, ob, i, lds + i * G_BUF, c);
        int cur = 0;
        bf16x8 At[4], Bt[4];
        if (VAR == 2) {
            asm volatile("s_waitcnt vmcnt(0)" ::: "memory"); __builtin_amdgcn_s_barrier();
#pragma unroll
            for (int m = 0; m < 4; ++m) At[m] = *reinterpret_cast<const bf16x8*>(lds + (c.wr * 64 + m * 16) * 64 + c.rdo);
#pragma unroll
            for (int n = 0; n < 4; ++n) Bt[n] = *reinterpret_cast<const bf16x8*>(lds + 16384 + (c.wc * 64 + n * 16) * 64 + c.rdo);
        }
#pragma unroll 1
        for (int t = 0; t < nkt; ++t) {
            const int young = nkt - 1 - t;
            if (VAR == 1) { if (t == 0) asm volatile("s_waitcnt vmcnt(0)" ::: "memory"); }
            else if (young >= 4) asm volatile("s_waitcnt vmcnt(12)" ::: "memory");
            else if (young >= 3) asm volatile("s_waitcnt vmcnt(9)" ::: "memory");
            else if (young >= 2) asm volatile("s_waitcnt vmcnt(6)" ::: "memory");
            else if (young >= 1) asm volatile("s_waitcnt vmcnt(3)" ::: "memory");
            else asm volatile("s_waitcnt vmcnt(0)" ::: "memory");
            if (VAR != 3) __builtin_amdgcn_s_barrier();
            asm volatile("" ::: "memory");
            const int nxt = cur == 0 ? NS - 1 : cur - 1;
            if (VAR != 1 && t + NS - 1 < nkt) gemm_stage(A, oa0, oa1, B, ob, t + NS - 1, lds + nxt * G_BUF, c);
            const unsigned char* SA = lds + cur * G_BUF; const unsigned char* SB = SA + 16384;
            if (VAR != 2) {
#pragma unroll
                for (int m = 0; m < 4; ++m) At[m] = *reinterpret_cast<const bf16x8*>(SA + (c.wr * 64 + m * 16) * 64 + c.rdo);
#pragma unroll
                for (int n = 0; n < 4; ++n) Bt[n] = *reinterpret_cast<const bf16x8*>(SB + (c.wc * 64 + n * 16) * 64 + c.rdo);
                asm volatile("s_waitcnt lgkmcnt(0)" ::: "memory");
            }
            __builtin_amdgcn_sched_barrier(0);
            if (VAR != 4) {
#pragma unroll
                for (int m = 0; m < 4; ++m)
#pragma unroll
                    for (int n = 0; n < 4; ++n) acc[m][n] = __builtin_amdgcn_mfma_f32_16x16x32_bf16(At[m], Bt[n], acc[m][n], 0, 0, 0);
            } else {
#pragma unroll
                for (int m = 0; m < 4; ++m) asm volatile("" :: "v"(At[m]), "v"(Bt[m]));
            }
            cur = cur == NS - 1 ? 0 : cur + 1;
        }
        __builtin_amdgcn_s_barrier();
        asm volatile("" ::: "memory");
        float sacc = 0.f;
#pragma unroll
        for (int m = 0; m < 4; ++m)
#pragma unroll
            for (int n = 0; n < 4; ++n) sacc += acc[m][n][0] + acc[m][n][1] + acc[m][n][2] + acc[m][n][3];
        if (sacc == 1.2345e33f) p.part[0] = sacc;
    }
}

constexpr int GQ = 56, GS = 72, GO = 97;
constexpr int GL_QD = 0, GL_KD = GL_QD + 64 * GQ * 2, GL_KET = GL_KD + 64 * GQ * 2, GL_VT = GL_KET + 64 * GS * 2, GL_ATT = GL_VT + 96 * GS * 2, GL_ST = GL_ATT + 64 * GS * 2,
              GL_OO = GL_ST + 96 * GQ * 2, GL_BC = GL_OO + 64 * GO * 4, GL_SEG = GL_BC + 64 * 48 * 4, GL_EBL = GL_SEG + 8 * 48 * 4, GL_W2 = GL_EBL + 64 * 4, GL_B2 = GL_W2 + 16 * 48 * 4,
              GL_GAIN = GL_B2 + 48 * 4, GL_RQ = GL_GAIN + 96 * 4, GL_RK = GL_RQ + 64 * 48 * 2, GL_RV = GL_RK + 64 * 48 * 2, GL_RA = GL_RV + 64 * 96 * 2, GL_RG = GL_RA + 64 * 16 * 2,
              GLA_LDS = GL_RG + 2 * 64 * 96 * 2;
static_assert(GL_OO % 16 == 0 && GL_RQ % 16 == 0 && GL_RG % 16 == 0 && GL_ST % 16 == 0, "GLA LDS map alignment");
__device__ __forceinline__ void phase_gla(const Params& p, int l, int* ctr, volatile LAS int* slot, unsigned char* lds) {
    bf16_t* qd = (bf16_t*)(lds + GL_QD); bf16_t* kd = (bf16_t*)(lds + GL_KD); bf16_t* keT = (bf16_t*)(lds + GL_KET); bf16_t* vT = (bf16_t*)(lds + GL_VT);
    bf16_t* att = (bf16_t*)(lds + GL_ATT); bf16_t* ST = (bf16_t*)(lds + GL_ST);
    float* oo = (float*)(lds + GL_OO); float* bc = (float*)(lds + GL_BC); float* seg = (float*)(lds + GL_SEG); float* ebl = (float*)(lds + GL_EBL);
    float* w2s = (float*)(lds + GL_W2); float* b2s = (float*)(lds + GL_B2); float* gains = (float*)(lds + GL_GAIN);
    bf16_t* rq = (bf16_t*)(lds + GL_RQ); bf16_t* rk = (bf16_t*)(lds + GL_RK); bf16_t* rv = (bf16_t*)(lds + GL_RV); bf16_t* ra = (bf16_t*)(lds + GL_RA); bf16_t* rg = (bf16_t*)(lds + GL_RG);
    const int tid = opaque_tid(), wave = tid >> 6, lane = tid & 63, r = lane & 31, hf = lane >> 5;
    for (int u = grab_unit(ctr, slot); u < NBATCH * 4; u = grab_unit(ctr, slot)) {
        const int b = u >> 2, h = u & 3;
        PROBE_UNIT_BEGIN(9, u == 0);
        for (int i = tid; i < 16 * 48; i += NT) w2s[i] = p.in[I_AW2][(size_t)l * 16 * 192 + (i / 48) * 192 + h * 48 + (i % 48)];
        if (tid < 48) b2s[tid] = p.in[I_AB2][l * 192 + h * 48 + tid];
        if (tid < 96) gains[tid] = p.in[I_AGAIN][l * 384 + h * 96 + tid];
        if (tid < 64) ebl[tid] = 1.0f;
        for (int i = tid; i < 96 * GQ; i += NT) ST[i] = 0;
        for (int i = tid; i < 64 * GS; i += NT) { keT[i] = 0; att[i] = 0; }
        const bf16_t* src[5]; int dsto[5];
#pragma unroll
        for (int j = 0; j < 5; ++j) {
            const int pid = tid + NT * j; int row = 0, col = 0, dst = -1;
            if (pid < 384) { row = pid / 6; col = C_AQ + h * 48 + (pid % 6) * 8; dst = GL_RQ + pid * 16; }
            else if (pid < 768) { const int q = pid - 384; row = q / 6; col = C_AK + h * 48 + (q % 6) * 8; dst = GL_RK + q * 16; }
            else if (pid < 1536) { const int q = pid - 768; row = q / 12; col = C_AV + h * 96 + (q % 12) * 8; dst = GL_RV + q * 16; }
            else if (pid < 2304) { const int q = pid - 1536; row = q / 12; col = C_AG + h * 96 + (q % 12) * 8; dst = GL_RG + q * 16; }
            else if (pid < 2432) { const int q = pid - 2304; row = q / 2; col = C_ALR + (q % 2) * 8; dst = GL_RA + q * 16; }
            src[j] = p.proj + ((size_t)b * TSEQ + row) * NP + col; dsto[j] = dst;
        }
        u32x4 pre[5];
#pragma unroll
        for (int j = 0; j < 5; ++j) pre[j] = dsto[j] >= 0 ? *(const u32x4*)src[j] : (u32x4){0u, 0u, 0u, 0u};
        f32x16 Sacc;
#pragma unroll
        for (int i = 0; i < 16; ++i) Sacc[i] = 0.f;
        const int kt = wave / 3, vt = wave % 3;
        __syncthreads();
        for (int n = 0; n < 32; ++n) {
            const size_t row0 = (size_t)b * TSEQ + n * 64;
            const int gsel = (n & 1) * (64 * 96 * 2);
#pragma unroll
            for (int j = 0; j < 5; ++j) if (dsto[j] >= 0) *(u32x4*)(lds + dsto[j] + (dsto[j] >= GL_RG ? gsel : 0)) = pre[j];
            if (n + 1 < 32) {
#pragma unroll
                for (int j = 0; j < 5; ++j) if (dsto[j] >= 0) pre[j] = *(const u32x4*)(src[j] + (size_t)(n + 1) * 64 * NP);
            }
            __syncthreads();
            for (int e = tid; e < 64 * 48; e += NT) {
                const int t = e / 48, k = e % 48;
                float z = b2s[k];
#pragma unroll
                for (int rr = 0; rr < 16; ++rr) z += bf2f(ra[t * 16 + rr]) * w2s[rr * 48 + k];
                bc[e] = (fminf(z, 0.f) - log1pf(__expf(-fabsf(z)))) * (1.0f / 16.0f);
            }
            __syncthreads();
            if (tid < 384) {
                const int k = tid % 48, sg = tid / 48; float run = 0.f;
#pragma unroll
                for (int i = 0; i < 8; ++i) { run += bc[(sg * 8 + i) * 48 + k]; bc[(sg * 8 + i) * 48 + k] = run; }
                seg[sg * 48 + k] = run;
            }
            __syncthreads();
            if (tid < 384) {
                const int k = tid % 48, sg = tid / 48; float pre_s = 0.f;
                for (int s2 = 0; s2 < sg; ++s2) pre_s += seg[s2 * 48 + k];
#pragma unroll
                for (int i = 0; i < 8; ++i) bc[(sg * 8 + i) * 48 + k] += pre_s;
            }
            __syncthreads();
            for (int e = tid; e < 64 * 48; e += NT) {
                const int t = e / 48, k = e % 48;
                const float bb = bc[e], bl = bc[63 * 48 + k];
                const float q = bf2f(rq[e]) * 0.14433756729740643f, kk = bf2f(rk[e]);
                qd[t * GQ + k] = f2bf(q * __expf(bb)); kd[t * GQ + k] = f2bf(kk * __expf(-bb)); keT[k * GS + t] = f2bf(kk * __expf(bl - bb));
                if (t == 63) ebl[k] = __expf(bl);
            }
            for (int e = tid; e < 64 * 96; e += NT) { const int t = e / 96, v = e % 96; vT[v * GS + t] = rv[e]; }
            __syncthreads();
            if (wave < 3) {
                const int si = wave == 2 ? 1 : 0, ci = wave >= 1 ? 1 : 0;
                f32x16 x;
#pragma unroll
                for (int i = 0; i < 16; ++i) x[i] = 0.f;
#pragma unroll
                for (int st = 0; st < 3; ++st)
                    x = __builtin_amdgcn_mfma_f32_32x32x16_bf16(*(const bf16x8*)(kd + (si * 32 + r) * GQ + 16 * st + 8 * hf), *(const bf16x8*)(qd + (ci * 32 + r) * GQ + 16 * st + 8 * hf), x, 0, 0, 0);
                const int cq = ci * 32 + r;
#pragma unroll
                for (int g = 0; g < 4; ++g) {
                    const int s0 = si * 32 + 8 * g + 4 * hf;
                    const float v0 = s0 <= cq ? x[4 * g] : 0.f, v1 = s0 + 1 <= cq ? x[4 * g + 1] : 0.f, v2 = s0 + 2 <= cq ? x[4 * g + 2] : 0.f, v3 = s0 + 3 <= cq ? x[4 * g + 3] : 0.f;
                    *(uint2*)(att + cq * GS + s0) = make_uint2(cvt_pk_bf16(v0, v1), cvt_pk_bf16(v2, v3));
                }
            }
            if (wave < 6) {
#pragma unroll
                for (int i = 0; i < 16; ++i) Sacc[i] *= ebl[kt * 32 + (i & 3) + 8 * (i >> 2) + 4 * hf];
#pragma unroll
                for (int st = 0; st < 4; ++st)
                    Sacc = __builtin_amdgcn_mfma_f32_32x32x16_bf16(*(const bf16x8*)(keT + (kt * 32 + r) * GS + 16 * st + 8 * hf), *(const bf16x8*)(vT + (vt * 32 + r) * GS + 16 * st + 8 * hf), Sacc, 0, 0, 0);
            }
            __syncthreads();
            if (wave < 6) {
                f32x16 o;
#pragma unroll
                for (int i = 0; i < 16; ++i) o[i] = 0.f;
#pragma unroll
                for (int st = 0; st < 4; ++st)
                    if (st < 2 || kt == 1)
                        o = __builtin_amdgcn_mfma_f32_32x32x16_bf16(*(const bf16x8*)(att + (kt * 32 + r) * GS + 16 * st + 8 * hf), *(const bf16x8*)(vT + (vt * 32 + r) * GS + 16 * st + 8 * hf), o, 0, 0, 0);
#pragma unroll
                for (int st = 0; st < 3; ++st)
                    o = __builtin_amdgcn_mfma_f32_32x32x16_bf16(*(const bf16x8*)(qd + (kt * 32 + r) * GQ + 16 * st + 8 * hf), *(const bf16x8*)(ST + (vt * 32 + r) * GQ + 16 * st + 8 * hf), o, 0, 0, 0);
#pragma unroll
                for (int i = 0; i < 16; ++i) oo[(kt * 32 + (i & 3) + 8 * (i >> 2) + 4 * hf) * GO + vt * 32 + r] = o[i];
            }
            __syncthreads();
            for (int t = wave; t < 64; t += 8) {
                const float o0 = oo[t * GO + lane], o1 = lane < 32 ? oo[t * GO + 64 + lane] : 0.f;
                const float ms = wave_sum(o0 * o0 + o1 * o1) * (1.0f / 96.0f);
                const float rs = rsqrtf(ms + EPS);
                const bf16_t* gr = (const bf16_t*)((const unsigned char*)rg + gsel) + t * 96;
                bf16_t* g = p.proj + (row0 + t) * NP + C_AG + h * 96;
                g[lane] = f2bf(o0 * rs * gains[lane] * siluf_(bf2f(gr[lane])));
                if (lane < 32) g[64 + lane] = f2bf(o1 * rs * gains[64 + lane] * siluf_(bf2f(gr[64 + lane])));
            }
            if (wave < 6) {
#pragma unroll
                for (int g = 0; g < 4; ++g) {
                    const int k0 = kt * 32 + 8 * g + 4 * hf;
                    if (k0 < 48) *(uint2*)(ST + (vt * 32 + r) * GQ + k0) = make_uint2(cvt_pk_bf16(Sacc[4 * g], Sacc[4 * g + 1]), cvt_pk_bf16(Sacc[4 * g + 2], Sacc[4 * g + 3]));
                }
            }
            __syncthreads();
        }
        PROBE_UNIT_END(9, u == 0);
    }
}

constexpr int LQ = 56;
constexpr int LR_XIN = 0, LR_XC = LR_XIN + 67 * 48 * 4, LR_XCB = LR_XC + 64 * 48 * 4, LR_WT = LR_XCB + 64 * LQ * 2, LR_AA = LR_WT + 128 * LQ * 2, LR_FF = LR_AA + 64 * 48 * 4,
              LR_GG = LR_FF + 64 * 48 * 4, LR_SEGA = LR_GG + 64 * 48 * 4, LR_SEGH = LR_SEGA + 8 * 48 * 4, LR_CAR = LR_SEGH + 8 * 48 * 4, LR_HS = LR_CAR + 8 * 48 * 4,
              LR_CONST = LR_HS + 64 * 4, LR_Y = LR_CONST + 8 * 48 * 4, LRU_LDS = LR_Y + 64 * 48 * 2;
static_assert(LR_XCB % 16 == 0 && LR_WT % 16 == 0 && LR_Y % 16 == 0, "LRU LDS map alignment");
__device__ __forceinline__ float gelu_tanh(float x) { const float u = 0.7978845608028654f * (x + 0.044715f * x * x * x); return 0.5f * x * (1.0f + tanhf(u)); }
__device__ __forceinline__ void phase_lru(const Params& p, int l, int* ctr, volatile LAS int* slot, unsigned char* lds) {
    float* xin = (float*)(lds + LR_XIN); float* xc = (float*)(lds + LR_XC); bf16_t* xcb = (bf16_t*)(lds + LR_XCB); bf16_t* WT = (bf16_t*)(lds + LR_WT);
    float* aa = (float*)(lds + LR_AA); float* ff = (float*)(lds + LR_FF); float* gg = (float*)(lds + LR_GG);
    float* segA = (float*)(lds + LR_SEGA); float* segH = (float*)(lds + LR_SEGH); float* car = (float*)(lds + LR_CAR); float* hs = (float*)(lds + LR_HS);
    float* cst = (float*)(lds + LR_CONST);
    bf16_t* yraw = (bf16_t*)(lds + LR_Y);
    const int tid = opaque_tid(), wave = tid >> 6, lane = tid & 63, r = lane & 31, hf = lane >> 5;
    for (int u = grab_unit(ctr, slot); u < NBATCH * 8; u = grab_unit(ctr, slot)) {
        const int b = u >> 3, nblk = u & 7, ch0 = nblk * 48;
        PROBE_UNIT_BEGIN(10, u == 0);
        for (int i = tid; i < 128 * LQ; i += NT) {
            const int n = i / LQ, cidx = i % LQ; float v = 0.f;
            if (cidx < 48) { if (n < 48) v = p.in[I_WR][((size_t)l * 8 + nblk) * 2304 + cidx * 48 + n]; else if (n >= 64 && n < 112) v = p.in[I_WI][((size_t)l * 8 + nblk) * 2304 + cidx * 48 + (n - 64)]; }
            WT[i] = f2bf(v);
        }
        if (tid < 48) {
            cst[tid] = p.in[I_BR][l * 384 + ch0 + tid]; cst[48 + tid] = p.in[I_BI][l * 384 + ch0 + tid];
            cst[96 + tid] = log1pf(__expf(-p.in[I_LAM][l * 384 + ch0 + tid])); cst[144 + tid] = p.in[I_CONVB][l * 384 + ch0 + tid];
#pragma unroll
            for (int j = 0; j < 4; ++j) cst[192 + j * 48 + tid] = p.in[I_CONVW][((size_t)l * 4 + j) * 384 + ch0 + tid];
            hs[tid] = 0.f;
        }
        if (tid < 144) xin[tid] = 0.f;
        const int xrow = tid / 6, xcol = (tid % 6) * 8, yid = tid - 128, yrow = yid / 6, ycol = (yid % 6) * 8;
        const bf16_t* xsrc = p.proj + ((size_t)b * TSEQ + xrow) * NP + C_DX + ch0 + xcol;
        const bf16_t* ysrc = p.proj + ((size_t)b * TSEQ + (yid >= 0 ? yrow : 0)) * NP + C_DY + ch0 + ycol;
        u32x4 px = {0u, 0u, 0u, 0u}, py = {0u, 0u, 0u, 0u};
        if (tid < 384) px = *(const u32x4*)xsrc;
        if (yid >= 0) py = *(const u32x4*)ysrc;
        __syncthreads();
        for (int tt = 0; tt < TSEQ / 64; ++tt) {
            if (tid < 384) {
#pragma unroll
                for (int q = 0; q < 4; ++q) { xin[(3 + xrow) * 48 + xcol + 2 * q] = __uint_as_float(px[q] << 16); xin[(3 + xrow) * 48 + xcol + 2 * q + 1] = __uint_as_float(px[q] & 0xFFFF0000u); }
            }
            if (yid >= 0) *(u32x4*)(yraw + yrow * 48 + ycol) = py;
            if (tt + 1 < TSEQ / 64) {
                if (tid < 384) px = *(const u32x4*)(xsrc + (size_t)(tt + 1) * 64 * NP);
                if (yid >= 0) py = *(const u32x4*)(ysrc + (size_t)(tt + 1) * 64 * NP);
            }
            __syncthreads();
            for (int e = tid; e < 64 * 48; e += NT) {
                const int t = e / 48, cidx = e % 48; float a = cst[144 + cidx];
#pragma unroll
                for (int j = 0; j < 4; ++j) a += cst[192 + j * 48 + cidx] * xin[(t + j) * 48 + cidx];
                xc[e] = a; xcb[t * LQ + cidx] = f2bf(a);
            }
            __syncthreads();
            {
                const int ci = wave >> 2, ni = wave & 3;
                f32x16 g;
#pragma unroll
                for (int i = 0; i < 16; ++i) g[i] = 0.f;
#pragma unroll
                for (int st = 0; st < 3; ++st)
                    g = __builtin_amdgcn_mfma_f32_32x32x16_bf16(*(const bf16x8*)(xcb + (ci * 32 + r) * LQ + 16 * st + 8 * hf), *(const bf16x8*)(WT + (ni * 32 + r) * LQ + 16 * st + 8 * hf), g, 0, 0, 0);
                const int d = (ni & 1) * 32 + r;
                if (d < 48) {
                    if (ni < 2) {
                        const float brv = cst[d], spv = cst[96 + d];
#pragma unroll
                        for (int i = 0; i < 16; ++i) {
                            const int t = ci * 32 + (i & 3) + 8 * (i >> 2) + 4 * hf;
                            const float la = -8.0f * sigmoidf_(g[i] + brv) * spv;
                            aa[t * 48 + d] = __expf(la); ff[t * 48 + d] = sqrtf(-expm1f(2.0f * la)) * xc[t * 48 + d];
                        }
                    } else {
                        const float biv = cst[48 + d];
#pragma unroll
                        for (int i = 0; i < 16; ++i) { const int t = ci * 32 + (i & 3) + 8 * (i >> 2) + 4 * hf; gg[t * 48 + d] = sigmoidf_(g[i] + biv); }
                    }
                }
                if (tid < 144) xin[tid] = xin[64 * 48 + tid];
            }
            __syncthreads();
            if (tid < 384) {
                const int d = tid % 48, sg = tid / 48; float ap = 1.f, hl = 0.f;
#pragma unroll
                for (int i = 0; i < 8; ++i) {
                    const int e = (sg * 8 + i) * 48 + d; const float av = aa[e];
                    hl = av * hl + ff[e] * gg[e]; ap *= av; aa[e] = ap; ff[e] = hl;
                }
                segA[sg * 48 + d] = ap; segH[sg * 48 + d] = hl;
            }
            __syncthreads();
            if (tid < 48) {
                float cin = hs[tid];
#pragma unroll
                for (int sg = 0; sg < 8; ++sg) { car[sg * 48 + tid] = cin; cin = segA[sg * 48 + tid] * cin + segH[sg * 48 + tid]; }
                hs[tid] = cin;
            }
            __syncthreads();
            if (tid < 384) {
                const int t = tid / 6, d0 = (tid % 6) * 8, sg = t >> 3;
                const u32x4 yv = *(const u32x4*)(yraw + t * 48 + d0);
                float o[8];
#pragma unroll
                for (int q = 0; q < 8; ++q) {
                    const int e = t * 48 + d0 + q;
                    const float h = ff[e] + aa[e] * car[sg * 48 + d0 + q];
                    const float y = (q & 1) ? __uint_as_float(yv[q >> 1] & 0xFFFF0000u) : __uint_as_float(yv[q >> 1] << 16);
                    o[q] = gelu_tanh(y) * h;
                }
                u32x4 ov; ov[0] = cvt_pk_bf16(o[0], o[1]); ov[1] = cvt_pk_bf16(o[2], o[3]); ov[2] = cvt_pk_bf16(o[4], o[5]); ov[3] = cvt_pk_bf16(o[6], o[7]);
                *(u32x4*)(p.proj + ((size_t)b * TSEQ + tt * 64 + t) * NP + C_DY + ch0 + d0) = ov;
            }
            __syncthreads();
        }
        PROBE_UNIT_END(10, u == 0);
    }
}

constexpr int AT_STAGE = 16384, AT_LDS = 3 * AT_STAGE;
template <bool MASKED>
__device__ __forceinline__ void attn_block(const bf16_t* __restrict__ proj, const bf16_t* __restrict__ Vt, int b, int qb, int cq, int ck, const float* tabAll,
                                           const unsigned* mask32, unsigned char* stage, bf16_t* __restrict__ outp, int tid) {
    const int wave = tid >> 6, lane = tid & 63, r = lane & 31, hf = lane >> 5, hh = wave >> 2, sb = wave & 3;
    const int q0 = qb * 128 + sb * 32, q = q0 + r, mykt = q0 >> 5, nkt = 4 * qb + 4;
    const int skey = (tid >> 3) & 31, sdim = (tid >> 2) & 63, shh = tid >> 8;
    const unsigned offK = (unsigned)(skey * NP + shh * 64 + (((tid & 7) ^ ((skey >> 1) & 7)) * 8));
    const unsigned offV = (unsigned)((shh * 64 + sdim) * TSEQ + (((tid & 3) ^ ((0 - (sdim >> 2)) & 3)) * 8));
    int kro[4], vro[2][2];
#pragma unroll
    for (int s = 0; s < 4; ++s) kro[s] = hh * 4096 + r * 128 + (((2 * s + hf) ^ ((r >> 1) & 7)) * 16);
#pragma unroll
    for (int db = 0; db < 2; ++db)
#pragma unroll
        for (int s = 0; s < 2; ++s) vro[db][s] = 8192 + hh * 4096 + (db * 32 + r) * 64 + (((2 * s + hf) ^ ((0 - (r >> 2)) & 3)) * 16);
    constexpr float C1 = 0.125f * LOG2E;
    const unsigned* maskq = MASKED ? mask32 + (sb * 32 + r) * 64 : nullptr;
#pragma unroll 1
    for (int rnd = 0; rnd < 3; ++rnd) {
        const int h = 2 * rnd + hh;
        const float* tab = tabAll + h * TABW;
        const bf16_t* qrow = proj + ((size_t)b * TSEQ + q) * NP + cq + h * 64 + 8 * hf;
        bf16x8 qf[4];
#pragma unroll
        for (int s = 0; s < 4; ++s) qf[s] = *(const bf16x8*)(qrow + 16 * s);
        f32x16 o0, o1;
#pragma unroll
        for (int i = 0; i < 16; ++i) { o0[i] = 0.f; o1[i] = 0.f; }
        float m = -1e30f, l = 0.f;
        const bf16_t* Kb = proj + (size_t)b * TSEQ * NP + ck + 2 * rnd * 64;
        const bf16_t* Vb = Vt + ((size_t)b * 384 + 2 * rnd * 64) * TSEQ;
#define AT_STAGE_TILE(kt_, buf_) do { \
        __builtin_amdgcn_global_load_lds((const unsigned*)(Kb + (size_t)(kt_) * 32 * NP + offK), (unsigned*)((buf_) + tid * 16), 16, 0, 0); \
        __builtin_amdgcn_global_load_lds((const unsigned*)(Vb + (kt_) * 32 + offV), (unsigned*)((buf_) + 8192 + tid * 16), 16, 0, 0); } while (0)
        AT_STAGE_TILE(0, stage);
        AT_STAGE_TILE(1, stage + AT_STAGE);
        int cur = 0;
#pragma unroll 1
        for (int kt = 0; kt < nkt; ++kt) {
            if (kt + 1 < nkt) asm volatile("s_waitcnt vmcnt(2)" ::: "memory"); else asm volatile("s_waitcnt vmcnt(0)" ::: "memory");
            __builtin_amdgcn_s_barrier();
            asm volatile("" ::: "memory");
            const int nxt = cur == 0 ? 2 : cur - 1;
            if (kt + 2 < nkt) AT_STAGE_TILE(kt + 2, stage + nxt * AT_STAGE);
            if (kt <= mykt) {
                const unsigned char* st = stage + cur * AT_STAGE;
                f32x16 sa;
#pragma unroll
                for (int i = 0; i < 16; ++i) sa[i] = 0.f;
#pragma unroll
                for (int s = 0; s < 4; ++s) sa = __builtin_amdgcn_mfma_f32_32x32x16_bf16(*(const bf16x8*)(st + kro[s]), qf[s], sa, 0, 0, 0);
                const float* tb = tab + (q - kt * 32 - 4 * hf + 32);
                unsigned w = 0u;
                if (MASKED) w = maskq[kt] >> (4 * hf);
                float sv[16]; float tmax = NEG_BIG;
#pragma unroll
                for (int i = 0; i < 16; ++i) {
                    const int ko = (i & 3) + 8 * (i >> 2);
                    float v = sa[i] * C1 + tb[-ko];
                    if (MASKED) v = ((w >> ko) & 1u) ? v : NEG_BIG;
                    sv[i] = v; tmax = fmaxf(tmax, v);
                }
                tmax = fmaxf(tmax, __shfl_xor(tmax, 32));
                const float mn = fmaxf(m, tmax);
                if (!__all(mn == m)) {
                    const float alpha = __builtin_amdgcn_exp2f(m - mn);
                    l *= alpha;
#pragma unroll
                    for (int i = 0; i < 16; ++i) { o0[i] *= alpha; o1[i] *= alpha; }
                    m = mn;
                }
                float ps = 0.f;
#pragma unroll
                for (int i = 0; i < 16; ++i) { sv[i] = __builtin_amdgcn_exp2f(sv[i] - m); ps += sv[i]; }
                l += ps;
                bf16x8 pf[2];
#pragma unroll
                for (int s = 0; s < 2; ++s) {
                    u32x4 t;
                    t[0] = cvt_pk_bf16(sv[8 * s + 0], sv[8 * s + 1]); t[1] = cvt_pk_bf16(sv[8 * s + 2], sv[8 * s + 3]);
                    t[2] = cvt_pk_bf16(sv[8 * s + 4], sv[8 * s + 5]); t[3] = cvt_pk_bf16(sv[8 * s + 6], sv[8 * s + 7]);
                    pf[s] = __builtin_bit_cast(bf16x8, t);
                }
#pragma unroll
                for (int s = 0; s < 2; ++s) {
                    o0 = __builtin_amdgcn_mfma_f32_32x32x16_bf16(*(const bf16x8*)(st + vro[0][s]), pf[s], o0, 0, 0, 0);
                    o1 = __builtin_amdgcn_mfma_f32_32x32x16_bf16(*(const bf16x8*)(st + vro[1][s]), pf[s], o1, 0, 0, 0);
                }
            }
            cur = cur == 2 ? 0 : cur + 1;
        }
#undef AT_STAGE_TILE
        __builtin_amdgcn_s_barrier();
        asm volatile("" ::: "memory");
        l += __shfl_xor(l, 32);
        const float inv = 1.0f / l;
        bf16_t* orow = outp + ((size_t)b * TSEQ + q) * NP + cq + h * 64 + 4 * hf;
#pragma unroll
        for (int g = 0; g < 4; ++g) {
            *(uint2*)(orow + 8 * g) = make_uint2(cvt_pk_bf16(o0[4 * g] * inv, o0[4 * g + 1] * inv), cvt_pk_bf16(o0[4 * g + 2] * inv, o0[4 * g + 3] * inv));
            *(uint2*)(orow + 32 + 8 * g) = make_uint2(cvt_pk_bf16(o1[4 * g] * inv, o1[4 * g + 1] * inv), cvt_pk_bf16(o1[4 * g + 2] * inv, o1[4 * g + 3] * inv));
        }
    }
}

constexpr int DIL_LDS = 6 * TABW * 4 + AT_LDS;
__device__ __forceinline__ void dil_unit(const Params& p, int b, int qb, unsigned char* lds) {
    float* tab = (float*)lds;
    const int tid = opaque_tid(), wave = tid >> 6, lane = tid & 63;
    for (int i = tid; i < 6 * TABW; i += NT) tab[i] = p.biasC[i];
    __syncthreads();
    attn_block<false>(p.proj, p.VtC, b, qb, C_CQ, C_CK, tab, nullptr, lds + 6 * TABW * 4, p.proj, tid);
    __syncthreads();
}
__device__ __forceinline__ void phase_dil(const Params& p, int* ctr, volatile LAS int* slot, unsigned char* lds) {
    for (int u = grab_unit(ctr, slot); u < NBATCH * 16; u = grab_unit(ctr, slot)) { PROBE_UNIT_BEGIN(12, u == 0); dil_unit(p, u & 15, 15 - (u >> 4), lds); PROBE_UNIT_END(12, u == 0); }
}

constexpr int DSA_LDS = 6 * TABW * 4 + 128 * 64 * 4 + AT_LDS;
__device__ __forceinline__ void cnt_ge(int& c, unsigned k, unsigned t) { asm("v_cmp_ge_u32 vcc, %1, %2\n\tv_addc_co_u32 %0, vcc, 0, %0, vcc" : "+v"(c) : "v"(k), "v"(t) : "vcc"); }
__device__ __forceinline__ void cnt_gt(int& c, unsigned k, unsigned t) { asm("v_cmp_gt_u32 vcc, %1, %2\n\tv_addc_co_u32 %0, vcc, 0, %0, vcc" : "+v"(c) : "v"(k), "v"(t) : "vcc"); }
__device__ __forceinline__ void cnt_eq(int& c, unsigned k, unsigned t) { asm("v_cmp_eq_u32 vcc, %1, %2\n\tv_addc_co_u32 %0, vcc, 0, %0, vcc" : "+v"(c) : "v"(k), "v"(t) : "vcc"); }
__device__ __forceinline__ int grp16_sum(int v) { v += __shfl_xor(v, 1); v += __shfl_xor(v, 2); v += __shfl_xor(v, 4); v += __shfl_xor(v, 8); return v; }
__device__ __forceinline__ void dsa_unit(const Params& p, int b, int qb, unsigned char* lds) {
    float* tab = (float*)lds;
    unsigned* mask32 = (unsigned*)(lds + 6 * TABW * 4);
    unsigned short* mask16 = (unsigned short*)mask32;
    const int tid = opaque_tid(), wave = tid >> 6, lane = tid & 63;
    for (int i = tid; i < 6 * TABW; i += NT) tab[i] = p.biasB[i];
    for (int i = tid; i < 128 * 64; i += NT) mask32[i] = 0u;
    __syncthreads();
    const int qi = lane >> 4, kl = lane & 15;
    PROBE_UNIT_BEGIN(13, qb == 15 && b == 0);
    for (int grp = wave; grp < 32; grp += 8) {
        const int qg = qb * 128 + grp * 4, myq = qg + qi, ntile = (qg + 3) / 16 + 1;
        const bf16x8 af = *(const bf16x8*)(p.proj + ((size_t)b * TSEQ + qg + (kl >> 2)) * NP + C_IQ + (kl & 3) * 32 + 8 * qi);
        float w[4];
        {
            const uint2 wv = *(const uint2*)(p.proj + ((size_t)b * TSEQ + myq) * NP + C_IW);
            constexpr float WS = 0.5f * 0.17677669529663687f;
            w[0] = __uint_as_float(wv.x << 16) * WS; w[1] = __uint_as_float(wv.x & 0xFFFF0000u) * WS; w[2] = __uint_as_float(wv.y << 16) * WS; w[3] = __uint_as_float(wv.y & 0xFFFF0000u) * WS;
        }
        const bf16_t* kp = p.proj + ((size_t)b * TSEQ + kl) * NP + C_IK + 8 * qi;
        unsigned key[128];
#pragma unroll
        for (int c4 = 0; c4 < 32; ++c4) {
            if (c4 * 4 < ntile) {
                bf16x8 bfr[4];
                const bf16_t* kc = kp + (size_t)(c4 * 4) * 16 * NP; asm volatile("" : "+v"(kc));
#pragma unroll
                for (int i = 0; i < 4; ++i) bfr[i] = *(const bf16x8*)(kc + (size_t)i * 16 * NP);
#pragma unroll
                for (int i = 0; i < 4; ++i) {
                    const int t = c4 * 4 + i;
                    f32x4 a4 = {0.f, 0.f, 0.f, 0.f};
                    a4 = __builtin_amdgcn_mfma_f32_16x16x32_bf16(af, bfr[i], a4, 0, 0, 0);
                    float sc = w[0] * fmaxf(a4[0], 0.f) + w[1] * fmaxf(a4[1], 0.f) + w[2] * fmaxf(a4[2], 0.f) + w[3] * fmaxf(a4[3], 0.f);
                    sc += 0.0f;
                    const unsigned u = __float_as_uint(sc);
                    unsigned kk = (u & 0x80000000u) ? ~u : (u | 0x80000000u);
                    kk = kk == 0u ? 1u : kk;
                    key[t] = (t * 16 + kl <= myq) ? kk : 0u;
                }
            } else {
#pragma unroll
                for (int i = 0; i < 4; ++i) key[c4 * 4 + i] = 0u;
            }
            asm volatile("" ::: "memory");
        }
        unsigned T = 1u; int need = 0x7fffffff;
        if (qg + 3 >= 256) {
            unsigned Tb = 0u;
#pragma unroll 1
            for (int bit = 31; bit >= 0; --bit) {
                const unsigned Tc = Tb | (1u << bit);
                int c = 0;
#pragma unroll
                for (int t = 0; t < 128; ++t) cnt_ge(c, key[t], Tc);
                c = grp16_sum(c);
                Tb = (c >= 256) ? Tc : Tb;
            }
            int cgt = 0;
#pragma unroll
            for (int t = 0; t < 128; ++t) cnt_gt(cgt, key[t], Tb);
            cgt = grp16_sum(cgt);
            if (myq >= 256) { T = Tb; need = 256 - cgt; }
        }
        int ceq = 0;
#pragma unroll
        for (int t = 0; t < 128; ++t) cnt_eq(ceq, key[t], T);
        ceq = grp16_sum(ceq);
        const bool slow = __any(need != 0x7fffffff && ceq != need);
        int run = 0;
        unsigned short* mrow = mask16 + (grp * 4 + qi) * 128;
#pragma unroll
        for (int t = 0; t < 128; ++t) {
            if (t < ntile) {
                const bool gt = key[t] > T, eq = key[t] == T;
                bool take = gt || eq;
                if (slow) {
                    const unsigned long long em = __ballot(eq);
                    const unsigned bits = (unsigned)(em >> (16 * qi)) & 0xFFFFu;
                    const int rank = run + __popc(bits & ((1u << kl) - 1u));
                    take = gt || (eq && rank < need);
                    run += __popc(bits);
                }
                const unsigned long long tm = __ballot(take);
                if (kl == 0) mrow[t] = (unsigned short)((tm >> (16 * qi)) & 0xFFFFull);
            }
        }
    }
    __syncthreads();
    PROBE_UNIT_END(13, qb == 15 && b == 0);
    attn_block<true>(p.proj, p.VtB, b, qb, C_BQ, C_BK, tab, mask32, lds + 6 * TABW * 4 + 128 * 64 * 4, p.proj, tid);
    __syncthreads();
}
__device__ __forceinline__ void phase_dsa(const Params& p, int* ctr, volatile LAS int* slot, unsigned char* lds) {
    for (int u = grab_unit(ctr, slot); u < NBATCH * 16; u = grab_unit(ctr, slot)) { PROBE_UNIT_BEGIN(11, u == 0); dsa_unit(p, u & 15, 15 - (u >> 4), lds); PROBE_UNIT_END(11, u == 0); }
}

constexpr int MG_LDS = MG_GLDS + 1024 + 16 * NT * 4;
__device__ __forceinline__ void phase_merge(const Params& p, int l, int bid, int nb, unsigned char* lds) {
    GemmCtx c = gemm_ctx();
    float* srstd = (float*)(lds + MG_NS * G_BUF);
    unsigned* sgate = (unsigned*)(lds + MG_NS * G_BUF + 1024);
    constexpr int NCT = DM / 128, NUX = (NTOK / 256 / 8) * NCT;
    const float* bg = p.in[I_BGATE] + (size_t)l * 4 * DM;
    const int xcd = bid & 7, nloc = nb >> 3;
    for (int k = bid >> 3; k < NUX; k += nloc) {
        const int rt = xcd * (NTOK / 256 / 8) + k / NCT, ct = k % NCT, brow = rt * 256, bcol = ct * 128;
        if (c.tid < 256) srstd[c.tid] = rstd_of(p.part, brow + c.tid);
        __syncthreads();
        f32x4 mg[4][4]; acc_zero(mg);
        const int r = c.tid >> 2;
        for (int i = 0; i < 4; ++i) {
            f32x4 acc[4][4]; acc_zero(acc);
            gemm_kloop_s<MG_NS, true>(acc, p.hb + (size_t)brow * DM, (unsigned)(r * DM + c.sc), (unsigned)((r + 128) * DM + c.sc), p.Bt_gate + ((size_t)i * DM + bcol) * DM, (unsigned)(r * DM + c.sc), DM / 32, lds, c);
            gemm_relane(c);
            int i2 = i; asm volatile("" : "+s"(i2));
            unsigned lcol = (unsigned)(c.wc * 64 + c.fq * 4); asm volatile("" : "+v"(lcol));
            unsigned gp[2][4][2];
#pragma unroll
            for (int m = 0; m < 4; ++m) {
                const float rs = srstd[c.wr * 64 + m * 16 + c.fr];
#pragma unroll
                for (int n = 0; n < 4; ++n) {
                    const f32x4 bv = *(const f32x4*)(bg + i2 * DM + bcol + n * 16 + lcol);
                    const unsigned g0 = cvt_pk_bf16(sigmoidf_(acc[m][n][0] * rs + bv[0]), sigmoidf_(acc[m][n][1] * rs + bv[1]));
                    const unsigned g1 = cvt_pk_bf16(sigmoidf_(acc[m][n][2] * rs + bv[2]), sigmoidf_(acc[m][n][3] * rs + bv[3]));
                    if (m < 2) { sgate[((m * 4 + n) * 2 + 0) * NT + c.tid] = g0; sgate[((m * 4 + n) * 2 + 1) * NT + c.tid] = g1; }
                    else { gp[m - 2][n][0] = g0; gp[m - 2][n][1] = g1; }
                }
            }
            acc_zero(acc);
            gemm_kloop_s<MG_NS, true>(acc, p.proj + (size_t)brow * NP + C_OB + i2 * 384, (unsigned)(r * NP + c.sc), (unsigned)((r + 128) * NP + c.sc),
                                     p.Bt_br + ((size_t)i2 * DM + bcol) * 384, (unsigned)(r * 384 + c.sc), 384 / 32, lds, c);
            gemm_relane(c);
#pragma unroll
            for (int m = 0; m < 4; ++m)
#pragma unroll
                for (int n = 0; n < 4; ++n) {
                    const unsigned g0 = m < 2 ? sgate[((m * 4 + n) * 2 + 0) * NT + c.tid] : gp[m < 2 ? 0 : m - 2][n][0];
                    const unsigned g1 = m < 2 ? sgate[((m * 4 + n) * 2 + 1) * NT + c.tid] : gp[m < 2 ? 0 : m - 2][n][1];
                    mg[m][n][0] += __uint_as_float(g0 << 16) * acc[m][n][0];
                    mg[m][n][1] += __uint_as_float(g0 & 0xFFFF0000u) * acc[m][n][1];
                    mg[m][n][2] += __uint_as_float(g1 << 16) * acc[m][n][2];
                    mg[m][n][3] += __uint_as_float(g1 & 0xFFFF0000u) * acc[m][n][3];
                }
        }
        unsigned orow = (unsigned)(c.wr * 64 + c.fr), ocol = (unsigned)(c.wc * 64 + c.fq * 4); asm volatile("" : "+v"(orow), "+v"(ocol));
#pragma unroll
        for (int m = 0; m < 4; ++m) {
            bf16_t* o = p.proj + (size_t)brow * NP + C_MG + bcol + (orow + m * 16) * NP + ocol;
#pragma unroll
            for (int n = 0; n < 4; ++n) *(uint2*)(o + n * 16) = make_uint2(cvt_pk_bf16(mg[m][n][0], mg[m][n][1]), cvt_pk_bf16(mg[m][n][2], mg[m][n][3]));
        }
        __syncthreads();
    }
}

__device__ __forceinline__ void phase_out(const Params& p, int l, int bid, int nb, unsigned char* lds) {
    Gemm2Ctx c = gemm2_ctx();
    constexpr int NCT = DM / 256, NUX = (NTOK / 256 / 8) * NCT;
    const float* hin = (l == 0) ? p.in[I_X] : p.h;
    const int xcd = bid & 7, nloc = nb >> 3;
    for (int k = bid >> 3; k < NUX; k += nloc) {
        const int rt = xcd * (NTOK / 256 / 8) + k / NCT, ct = k % NCT, brow = rt * 256, bcol = ct * 256;
        f32x4 acc[8][4]; acc2_zero(acc);
        const int r = c.tid >> 2;
        gemm2_kloop<true>(acc, p.proj + (size_t)brow * NP + C_MG, (unsigned)(r * NP + c.sc), (unsigned)((r + 128) * NP + c.sc), p.Bt_out + (size_t)bcol * DM,
                          (unsigned)(r * DM + c.sc), (unsigned)((r + 128) * DM + c.sc), DM / 32, lds, c);
        gemm2_relane(c);
#pragma unroll
        for (int m = 0; m < 8; ++m) {
            const int row = brow + c.wr * 128 + m * 16 + c.fr;
            const size_t off = (size_t)row * DM + bcol + c.wc * 64 + c.fq * 4;
            float ss = 0.f;
#pragma unroll
            for (int n = 0; n < 4; ++n) {
                const f32x4 v = *(const f32x4*)(hin + off + n * 16) + acc[m][n];
                *(f32x4*)(p.h + off + n * 16) = v;
                *(uint2*)(p.hb + off + n * 16) = make_uint2(cvt_pk_bf16(v[0], v[1]), cvt_pk_bf16(v[2], v[3]));
                ss += (v[0] * v[0] + v[1] * v[1]) + (v[2] * v[2] + v[3] * v[3]);
            }
            ss += __shfl_xor(ss, 16); ss += __shfl_xor(ss, 32);
            if (c.fq == 0) p.part[(size_t)row * 16 + ct * 4 + c.wc] = ss;
        }
    }
}

constexpr int RT_LDS = 1024 * 20 * 4;
__device__ __forceinline__ void phase_router(const Params& p, int l, int bid, int nb, unsigned char* lds) {
    float* W = (float*)lds;
    const int tid = opaque_tid(), wave = tid >> 6, lane = tid & 63;
    const float* n2 = p.in[I_N2] + l * DM;
    const float* wrg = p.in[I_WRG] + (size_t)l * DM * 4;
    const float* wre = p.in[I_WRE] + (size_t)l * DM * 16;
    for (int i = tid; i < 1024 * 20; i += NT) { const int k = i / 20, j = i % 20; W[i] = n2[k] * (j < 4 ? wrg[k * 4 + j] : wre[k * 16 + (j - 4)]); }
    __syncthreads();
    int* cnt = p.cnt + l * 32;
    float hn[16]; float prn = 0.f;
    {
        const int row = bid * 8 + wave;
        if (row < NTOK) {
#pragma unroll
            for (int i = 0; i < 16; ++i) hn[i] = p.h[(size_t)row * DM + i * 64 + lane];
            prn = p.part[(size_t)row * 16 + (lane & 15)];
        }
    }
    for (int row = bid * 8 + wave; row < NTOK; row += nb * 8) {
        float hv[16]; float pr = prn;
#pragma unroll
        for (int i = 0; i < 16; ++i) hv[i] = hn[i];
        {
            const int rown = row + nb * 8;
            if (rown < NTOK) {
#pragma unroll
                for (int i = 0; i < 16; ++i) hn[i] = p.h[(size_t)rown * DM + i * 64 + lane];
                prn = p.part[(size_t)rown * 16 + (lane & 15)];
            }
        }
        pr += __shfl_xor(pr, 1); pr += __shfl_xor(pr, 2); pr += __shfl_xor(pr, 4); pr += __shfl_xor(pr, 8);
        const float rs = rsqrtf(pr * (1.0f / 1024.0f) + EPS);
        float a[20];
#pragma unroll
        for (int j = 0; j < 20; ++j) a[j] = 0.f;
#pragma unroll 1
        for (int i4 = 0; i4 < 4; ++i4) {
#pragma unroll
            for (int ii = 0; ii < 4; ++ii) {
                const float* w = W + ((i4 * 4 + ii) * 64 + lane) * 20;
                const float h1 = ii == 0 ? hv[0] : (ii == 1 ? hv[1] : (ii == 2 ? hv[2] : hv[3]));
#pragma unroll
                for (int j = 0; j < 20; ++j) a[j] += h1 * w[j];
            }
#pragma unroll
            for (int q = 0; q < 12; ++q) hv[q] = hv[q + 4];
        }
#pragma unroll
        for (int j = 0; j < 20; ++j) a[j] = wave_sum(a[j]);
        if (lane == 0) {
            float gl[4];
#pragma unroll
            for (int j = 0; j < 4; ++j) gl[j] = a[j] * rs + p.in[I_BRG][l * 4 + j];
            int g = 0; float gm = gl[0];
#pragma unroll
            for (int j = 1; j < 4; ++j) if (gl[j] > gm) { gm = gl[j]; g = j; }
            float den = 0.f;
#pragma unroll
            for (int j = 0; j < 4; ++j) den += __expf(gl[j] - gm);
            const float gw = 1.0f / den;
            float el[4];
#pragma unroll
            for (int j = 0; j < 4; ++j) {
                float v = 0.f;
#pragma unroll
                for (int gg = 0; gg < 4; ++gg) v = (gg == g) ? (a[4 + gg * 4 + j] * rs + p.in[I_BRE][l * 16 + gg * 4 + j]) : v;
                el[j] = v;
            }
            int i1 = 0; float v1 = el[0];
#pragma unroll
            for (int j = 1; j < 4; ++j) if (el[j] > v1) { v1 = el[j]; i1 = j; }
            int i2 = -1; float v2 = -3.0e38f;
#pragma unroll
            for (int j = 0; j < 4; ++j) if (j != i1 && el[j] > v2) { v2 = el[j]; i2 = j; }
            const float e2 = __expf(v2 - v1);
            const float w1 = gw / (1.0f + e2), w2 = gw * e2 / (1.0f + e2);
            const int lo = i1 < i2 ? i1 : i2, hi = i1 < i2 ? i2 : i1;
            const float wlo = i1 < i2 ? w1 : w2, whi = i1 < i2 ? w2 : w1;
            const int pidx = lo == 0 ? (hi - 1) : (lo == 1 ? (hi + 1) : 5);
            const int cls = g * 6 + pidx;
            const int pos = __hip_atomic_fetch_add(&cnt[cls], 1, __ATOMIC_RELAXED, __HIP_MEMORY_SCOPE_AGENT);
            p.perm[(size_t)cls * NTOK + pos] = row;
            p.tokw[(size_t)row * 2] = wlo; p.tokw[(size_t)row * 2 + 1] = whi;
        }
    }
}

__device__ __forceinline__ void cls_experts(int cls, int& elo, int& ehi) {
    const int g = cls / 6, pi = cls % 6;
    const int lo = pi < 3 ? 0 : (pi < 5 ? 1 : 2), hi = pi < 3 ? pi + 1 : (pi < 5 ? pi - 1 : 3);
    elo = g * 4 + lo; ehi = g * 4 + hi;
}
__device__ __forceinline__ void moe_prefix(const int* cnt, int* spre, int* scnt) {
    if (opaque_tid() == 0) { int s = 0; for (int c = 0; c < NCLS; ++c) { const int n = cnt[c]; scnt[c] = n; spre[c] = s; s += (n + 255) >> 8; } spre[NCLS] = s; }
    __syncthreads();
}

__device__ __forceinline__ void phase_moe1(const Params& p, int l, int bid, int nb, unsigned char* lds) {
    Gemm2Ctx c = gemm2_ctx();
    int* spre = (int*)(lds + G2_LDS); int* scnt = spre + 32;
    int* stok = scnt + 32; float* srs = (float*)(stok + 256); float* swl = srs + 256; float* swh = swl + 256;
    moe_prefix(p.cnt + l * 32, spre, scnt);
    const int nrt = spre[NCLS], nrtx = (nrt + 7) >> 3, xcd = bid & 7, nloc = nb >> 3;
    const int rt_lo = xcd * nrtx, rt_hi = rt_lo + nrtx < nrt ? rt_lo + nrtx : nrt;
    for (int k = bid >> 3; k < (rt_hi - rt_lo) * 8; k += nloc) {
        const int rt = rt_lo + (k >> 3), ct = k & 7;
        int cls = 0;
        for (int q = 1; q < NCLS; ++q) if (spre[q] <= rt) cls = q;
        int elo, ehi; cls_experts(cls, elo, ehi);
        const int lrow0 = (rt - spre[cls]) * 256, n = scnt[cls];
        if (c.tid < 256) {
            const int lr = lrow0 + c.tid; const bool ok = lr < n;
            const int tok = ok ? p.perm[(size_t)cls * NTOK + lr] : 0;
            stok[c.tid] = ok ? tok : -1; srs[c.tid] = rstd_of(p.part, tok);
            swl[c.tid] = p.tokw[(size_t)tok * 2]; swh[c.tid] = p.tokw[(size_t)tok * 2 + 1];
        }
        __syncthreads();
        const int r = c.tid >> 2;
        const int t0 = stok[r] < 0 ? 0 : stok[r], t1 = stok[r + 128] < 0 ? 0 : stok[r + 128];
        const int ex = ct < 4 ? elo : ehi;
        f32x4 acc[8][4]; acc2_zero(acc);
        gemm2_kloop<true>(acc, p.hb, (unsigned)(t0 * DM + c.sc), (unsigned)(t1 * DM + c.sc), p.Wgu + ((size_t)ex * DM + (ct & 3) * 256) * DM,
                          (unsigned)(r * DM + c.sc), (unsigned)((r + 128) * DM + c.sc), DM / 32, lds, c);
        gemm2_relane(c);
#pragma unroll
        for (int m = 0; m < 8; ++m) {
            const int rl = c.wr * 128 + m * 16 + c.fr; const float rs = srs[rl], w = ct < 4 ? swl[rl] : swh[rl];
            bf16_t* o = p.Hbuf + ((size_t)rt * 256 + rl) * DM + (ct < 4 ? 0 : 512) + (ct & 3) * 128 + c.wc * 32 + c.fq * 4;
#pragma unroll
            for (int n2 = 0; n2 < 2; ++n2) {
                float hv[4];
#pragma unroll
                for (int j = 0; j < 4; ++j) hv[j] = siluf_(acc[m][n2][j] * rs) * (acc[m][n2 + 2][j] * rs) * w;
                *(uint2*)(o + n2 * 16) = make_uint2(cvt_pk_bf16(hv[0], hv[1]), cvt_pk_bf16(hv[2], hv[3]));
            }
        }
        __syncthreads();
    }
}

__device__ __forceinline__ void phase_moe2(const Params& p, int l, int bid, int nb, unsigned char* lds) {
    Gemm2Ctx c = gemm2_ctx();
    int* spre = (int*)(lds + G2_LDS); int* scnt = spre + 32; int* stok = scnt + 32;
    moe_prefix(p.cnt + l * 32, spre, scnt);
    const int nrt = spre[NCLS], nrtx = (nrt + 7) >> 3, xcd = bid & 7, nloc = nb >> 3;
    const int rt_lo = xcd * nrtx, rt_hi = rt_lo + nrtx < nrt ? rt_lo + nrtx : nrt;
    for (int k = bid >> 3; k < (rt_hi - rt_lo) * 4; k += nloc) {
        const int rt = rt_lo + (k >> 2), ct = k & 3;
        int cls = 0;
        for (int q = 1; q < NCLS; ++q) if (spre[q] <= rt) cls = q;
        int elo, ehi; cls_experts(cls, elo, ehi);
        const int lrow0 = (rt - spre[cls]) * 256, n = scnt[cls];
        if (c.tid < 256) { const int lr = lrow0 + c.tid; stok[c.tid] = lr < n ? p.perm[(size_t)cls * NTOK + lr] : -1; }
        __syncthreads();
        const int r = c.tid >> 2;
        f32x4 acc[8][4]; acc2_zero(acc);
        const bf16_t* a0 = p.Hbuf + (size_t)rt * 256 * DM;
        const unsigned oa0 = (unsigned)(r * DM + c.sc), oa1 = (unsigned)((r + 128) * DM + c.sc), ob0 = (unsigned)(r * 512 + c.sc), ob1 = (unsigned)((r + 128) * 512 + c.sc);
        gemm2_kloop<true>(acc, a0, oa0, oa1, p.WdT + ((size_t)elo * DM + ct * 256) * 512, ob0, ob1, 16, lds, c);
        gemm2_relane(c);
        gemm2_kloop<true>(acc, a0 + 512, oa0, oa1, p.WdT + ((size_t)ehi * DM + ct * 256) * 512, ob0, ob1, 16, lds, c);
        gemm2_relane(c);
#pragma unroll
        for (int m = 0; m < 8; ++m) {
            const int rl = c.wr * 128 + m * 16 + c.fr; const int tok = stok[rl];
            const size_t off = (size_t)(tok < 0 ? 0 : tok) * DM + ct * 256 + c.wc * 64 + c.fq * 4;
            float ss = 0.f;
            if (tok >= 0) {
#pragma unroll
                for (int n2 = 0; n2 < 4; ++n2) {
                    const f32x4 v = *(const f32x4*)(p.h + off + n2 * 16) + acc[m][n2];
                    *(f32x4*)(p.h + off + n2 * 16) = v;
                    *(uint2*)(p.hb + off + n2 * 16) = make_uint2(cvt_pk_bf16(v[0], v[1]), cvt_pk_bf16(v[2], v[3]));
                    ss += (v[0] * v[0] + v[1] * v[1]) + (v[2] * v[2] + v[3] * v[3]);
                }
            }
            ss += __shfl_xor(ss, 16); ss += __shfl_xor(ss, 32);
            if (c.fq == 0 && tok >= 0) p.part[(size_t)tok * 16 + ct * 4 + c.wc] = ss;
        }
        __syncthreads();
    }
}

__device__ __forceinline__ void phase_final(const Params& p, int bid, int nb) {
    const int tid = opaque_tid(), wave = tid >> 6, lane = tid & 63;
    const float* nf = p.in[I_NF];
    for (int row = bid * 8 + wave; row < NTOK; row += nb * 8) {
        const float rs = rstd_of(p.part, row);
        float* hr = p.h + (size_t)row * DM;
#pragma unroll
        for (int i = 0; i < 4; ++i) {
            f32x4 v = *(const f32x4*)(hr + i * 256 + lane * 4);
            const f32x4 g = *(const f32x4*)(nf + i * 256 + lane * 4);
            v[0] *= rs * g[0]; v[1] *= rs * g[1]; v[2] *= rs * g[2]; v[3] *= rs * g[3];
            *(f32x4*)(hr + i * 256 + lane * 4) = v;
        }
    }
}

constexpr int cmax(int a, int b) { return a > b ? a : b; }
constexpr int MEGA_LDS_BODY = cmax(cmax(cmax(GLA_LDS, LRU_LDS), cmax(DSA_LDS, DIL_LDS)), cmax(cmax(MG_LDS, RT_LDS), G2_LDS + 8192));
constexpr int MEGA_LDS = PROBE_MASK ? 160 * 1024 : MEGA_LDS_BODY + 16;


__device__ __forceinline__ const Params& kparams() {
    const __attribute__((address_space(4))) Params* q = (const __attribute__((address_space(4))) Params*)__builtin_amdgcn_kernarg_segment_ptr();
    asm volatile("" : "+s"(q));
    return *(const Params*)q;
}
__global__ void __launch_bounds__(NT, 2) mega(Params p_kernarg) {
    (void)p_kernarg;
#define p kparams()
    unsigned char* lds = dyn_lds;
    volatile LAS unsigned* xbw = (volatile LAS unsigned*)(dyn_lds + MEGA_LDS_BODY);
    if (threadIdx.x == 0) { xbw[0] = 0u; xbw[1] = 0u; xbw[2] = 0u; xbw[3] = 0u; }
    __syncthreads();
    (void)xcd_barrier_post(p.bar, xbw);
#define PROBE_TICK(type) do { if (PROBE_MASK != 0 && blockIdx.x == 0 && threadIdx.x == 0) { volatile LAS unsigned long long* pw = (volatile LAS unsigned long long*)(dyn_lds + PROBE_OFF); \
        const unsigned long long now = __builtin_amdgcn_s_memrealtime(); if ((PROBE_MASK >> (type)) & 1) pw[1] += now - pw[0]; pw[0] = now; } } while (0)
#define PROBE_SINCE(bit) do { if (((PROBE_MASK >> (bit)) & 1) && blockIdx.x == 0 && threadIdx.x == 0) { volatile LAS unsigned long long* pw = (volatile LAS unsigned long long*)(dyn_lds + PROBE_OFF); \
        pw[1] += __builtin_amdgcn_s_memrealtime() - pw[0]; } } while (0)
#define GRID_SYNC() do { XcdBarrier _b; _b.bar = p.bar; _b.x = xb_xcc_id(); _b.st = (volatile LAS unsigned*)(dyn_lds + MEGA_LDS_BODY); xcd_barrier(_b); } while (0)
    const int bid = blockIdx.x, nb = gridDim.x;
    if (PROBE_MASK != 0 && threadIdx.x == 0) { volatile LAS unsigned long long* pw = (volatile LAS unsigned long long*)(dyn_lds + PROBE_OFF); pw[0] = __builtin_amdgcn_s_memrealtime(); pw[1] = 0ull; }
    phase_prep(p, bid, nb);
    GRID_SYNC(); PROBE_TICK(0);
#pragma unroll 1
    for (int l = 0; l < DEPTH; ++l) {
        phase_weights(p, l, bid, nb, lds);
        GRID_SYNC(); PROBE_TICK(1);
        phase_inproj(p, bid, nb, lds);
        GRID_SYNC(); PROBE_TICK(2);
        if (PROBE_GEMM_VAR >= 0 && l == 0) { phase_gemm_probe<PROBE_GEMM_VAR>(p, bid, nb, lds); GRID_SYNC(); }
        {
            volatile LAS int* slot = (volatile LAS int*)(dyn_lds + MEGA_LDS_BODY + 12);
            int* qc = p.cnt + l * 32 + 24;
            phase_gla(p, l, qc + 0, slot, lds); PROBE_SINCE(14);
            phase_lru(p, l, qc + 1, slot, lds); PROBE_SINCE(15);
            phase_dsa(p, qc + 2, slot, lds); PROBE_SINCE(16);
            phase_dil(p, qc + 3, slot, lds); PROBE_SINCE(17);
        }
        GRID_SYNC(); PROBE_TICK(3);
        phase_merge(p, l, bid, nb, lds);
        GRID_SYNC(); PROBE_TICK(4);
        phase_out(p, l, bid, nb, lds);
        GRID_SYNC(); PROBE_TICK(5);
        phase_router(p, l, bid, nb, lds);
        GRID_SYNC(); PROBE_TICK(6);
        phase_moe1(p, l, bid, nb, lds);
        GRID_SYNC(); PROBE_TICK(7);
        phase_moe2(p, l, bid, nb, lds);
        GRID_SYNC(); PROBE_TICK(8);
    }
    phase_final(p, bid, nb);
    if (PROBE_MASK != 0 && threadIdx.x == 0) { volatile LAS unsigned long long* pw = (volatile LAS unsigned long long*)(dyn_lds + PROBE_OFF);
        const unsigned long long t0 = __builtin_amdgcn_s_memrealtime(), w = pw[1]; while (__builtin_amdgcn_s_memrealtime() - t0 < w) __builtin_amdgcn_s_sleep(8); }
#undef p
}

static size_t align_up(size_t v, size_t a) { return (v + a - 1) / a * a; }

extern "C" void kernel_launch(void* const* d_in, const int* in_sizes, int n_in, void* d_out, int out_size, void* d_ws, size_t ws_size, hipStream_t stream) {
    (void)in_sizes; (void)n_in; (void)out_size;
    Params p{};
    for (int i = 0; i < N_IN; ++i) p.in[i] = (const float*)d_in[i];
    p.h = (float*)d_out;
    unsigned char* w = (unsigned char*)d_ws; size_t off = 0;
    auto take = [&](size_t bytes) { unsigned char* r = w + off; off = align_up(off + bytes, 256); return r; };
    p.bar = (unsigned*)take(XCD_BAR_WORDS * 4);
    p.cnt = (int*)take(DEPTH * 32 * 4);
    p.Bt_in = (bf16_t*)take((size_t)NP * DM * 2);
    p.Bt_gate = (bf16_t*)take((size_t)4 * DM * DM * 2);
    p.Bt_br = (bf16_t*)take((size_t)4 * DM * 384 * 2);
    p.Bt_out = (bf16_t*)take((size_t)DM * DM * 2);
    p.Wgu = (bf16_t*)take((size_t)16 * DM * DM * 2);
    p.WdT = (bf16_t*)take((size_t)16 * DM * 512 * 2);
    p.hb = (bf16_t*)take((size_t)NTOK * DM * 2);
    p.part = (float*)take((size_t)NTOK * 16 * 4);
    p.biasB = (float*)take(6 * TABW * 4);
    p.biasC = (float*)take(6 * TABW * 4);
    p.VtB = (bf16_t*)take((size_t)NTOK * 384 * 2);
    p.VtC = (bf16_t*)take((size_t)NTOK * 384 * 2);
    p.tokw = (float*)take((size_t)NTOK * 2 * 4);
    p.perm = (int*)take((size_t)NCLS * NTOK * 4);
    p.proj = (bf16_t*)take((size_t)NTOK * NP * 2);
    p.Hbuf = p.proj;
    if (off > ws_size) return;

    static int grid = 0;
    if (grid == 0) {
        int dev = 0, cus = 0;
        (void)hipGetDevice(&dev);
        (void)hipDeviceGetAttribute(&cus, hipDeviceAttributeMultiprocessorCount, dev);
        if (hipFuncSetAttribute((const void*)mega, hipFuncAttributeMaxDynamicSharedMemorySize, MEGA_LDS) != hipSuccess) { grid = -1; return; }
        int per_cu = 0;
        (void)hipOccupancyMaxActiveBlocksPerMultiprocessor(&per_cu, (const void*)mega, NT, MEGA_LDS);
        (void)hipGetLastError();
        grid = cus > 0 ? cus : 256;
    }
    if (grid < 0) return;
    (void)hipMemsetAsync(p.bar, 0, XCD_BAR_WORDS * sizeof(unsigned), stream);
    mega<<<grid, NT, MEGA_LDS, stream>>>(p);
}
```

```cpp
#include <hip/hip_runtime.h>
#include <stdint.h>

typedef unsigned short bf16_t;
typedef short bf16x8 __attribute__((ext_vector_type(8)));
typedef float f32x4 __attribute__((ext_vector_type(4)));
typedef unsigned u32x4 __attribute__((ext_vector_type(4)));
typedef float f32x16 __attribute__((ext_vector_type(16)));

constexpr int NTOK = 32768, TSEQ = 2048, NBATCH = 16, DM = 1024, DEPTH = 2;
constexpr int NP = 4608;
constexpr int NT = 512;
constexpr int C_AQ = 0, C_AK = 192, C_AV = 384, C_AG = 768, C_BQ = 1152, C_CQ = 1536, C_DY = 1920, C_BK = 2304, C_CK = 2688,
              C_BV = 3072, C_CV = 3456, C_DX = 3840, C_IQ = 4224, C_IK = 4352, C_ALR = 4384, C_IW = 4400;
constexpr int C_OB = 768;
constexpr int C_MG = 2304;
constexpr float EPS = 1e-6f;
constexpr int NCLS = 24, MAXRT = 152;
constexpr int TABW = 2080;
constexpr float LOG2E = 1.4426950408889634f, NEG_BIG = -3.0e38f;

#ifndef PROBE_MASK
#define PROBE_MASK 0
#endif
extern __shared__ __attribute__((aligned(16))) unsigned char dyn_lds[];
constexpr int PROBE_OFF = 160 * 1024 - 64;
#define PROBE_UNIT_BEGIN(bit, cond) do { if (((PROBE_MASK >> (bit)) & 1) && (cond) && threadIdx.x == 0) { volatile __attribute__((address_space(3))) unsigned long long* pw = (volatile __attribute__((address_space(3))) unsigned long long*)(dyn_lds + PROBE_OFF); pw[2] = __builtin_amdgcn_s_memrealtime(); } } while (0)
#define PROBE_UNIT_END(bit, cond) do { if (((PROBE_MASK >> (bit)) & 1) && (cond) && threadIdx.x == 0) { volatile __attribute__((address_space(3))) unsigned long long* pw = (volatile __attribute__((address_space(3))) unsigned long long*)(dyn_lds + PROBE_OFF); pw[1] += 4ull * (__builtin_amdgcn_s_memrealtime() - pw[2]); } } while (0)

enum { I_X = 0, I_WIN, I_AW2, I_AB2, I_AGAIN, I_CONVW, I_CONVB, I_WR, I_BR, I_WI, I_BI, I_LAM, I_WGATE, I_BGATE, I_WBR, I_WOUT, I_RELB,
       I_N1, I_N2, I_NF, I_WRG, I_BRG, I_WRE, I_BRE, I_MWG, I_MWU, I_MWD, N_IN };

struct Params {
    const float* in[N_IN];
    float* h;
    bf16_t* Bt_in;
    bf16_t* Bt_gate;
    bf16_t* Bt_br;
    bf16_t* Bt_out;
    bf16_t* Wgu;
    bf16_t* WdT;
    bf16_t* hb;
    bf16_t* proj;
    bf16_t* Hbuf;
    float* part;
    float* biasB;
    float* biasC;
    bf16_t* VtB;
    bf16_t* VtC;
    float* tokw;
    int* perm;
    int* cnt;
    unsigned* bar;
};

__device__ __forceinline__ bf16_t f2bf(float f) { unsigned u = __float_as_uint(f); u += 0x7FFFu + ((u >> 16) & 1u); return (bf16_t)(u >> 16); }
__device__ __forceinline__ float bf2f(bf16_t b) { return __uint_as_float(((unsigned)b) << 16); }
__device__ __forceinline__ float wave_sum(float v) {
#pragma unroll
    for (int o = 32; o > 0; o >>= 1) v += __shfl_xor(v, o);
    return v;
}
__device__ __forceinline__ float wave_max(float v) {
#pragma unroll
    for (int o = 32; o > 0; o >>= 1) v = fmaxf(v, __shfl_xor(v, o));
    return v;
}
__device__ __forceinline__ int wave_sum_i(int v) {
#pragma unroll
    for (int o = 32; o > 0; o >>= 1) v += __shfl_xor(v, o);
    return v;
}
__device__ __forceinline__ int opaque_tid() { int t = threadIdx.x; asm volatile("" : "+v"(t)); return t; }
__device__ __forceinline__ unsigned cvt_pk_bf16(float lo, float hi) { unsigned r; asm volatile("v_cvt_pk_bf16_f32 %0, %1, %2" : "=v"(r) : "v"(lo), "v"(hi)); return r; }
__device__ __forceinline__ float sigmoidf_(float x) { return 1.0f / (1.0f + __expf(-x)); }
__device__ __forceinline__ float siluf_(float x) { return x / (1.0f + __expf(-x)); }
__device__ __forceinline__ float rstd_of(const float* part, int row) {
    const f32x4* p = (const f32x4*)(part + (size_t)row * 16);
    f32x4 a = p[0], b = p[1], c = p[2], d = p[3];
    float s = ((a[0] + a[1]) + (a[2] + a[3])) + ((b[0] + b[1]) + (b[2] + b[3])) + ((c[0] + c[1]) + (c[2] + c[3])) + ((d[0] + d[1]) + (d[2] + d[3]));
    return rsqrtf(s * (1.0f / 1024.0f) + EPS);
}
__device__ __forceinline__ int map_in_col(int c) {
    if (c < 1152) return c;
    if (c < 1536) return 1168 + (c - 1152);
    if (c < 1920) return 2484 + (c - 1536);
    if (c < 2304) return 3636 + (c - 1920);
    if (c < 2688) return 1552 + (c - 2304);
    if (c < 3072) return 2868 + (c - 2688);
    if (c < 3456) return 1936 + (c - 3072);
    if (c < 3840) return 3252 + (c - 3456);
    if (c < 4224) return 4020 + (c - 3840);
    if (c < 4352) return 2320 + (c - 4224);
    if (c < 4384) return 2448 + (c - 4352);
    if (c < 4400) return 1152 + (c - 4384);
    if (c < 4404) return 2480 + (c - 4400);
    return -1;
}
__device__ __forceinline__ int rel_bucket(int n) {
    if (n < 16) return n;
    float v = logf((float)n / 16.0f) / 4.852030263919617f * 16.0f;
    int b = 16 + (int)v;
    return b < 31 ? b : 31;
}

#define XB_TMO      128
#define XB_XCNT(j)  (256  + 64 * (j))
#define XB_XSUB(j)  (1280 + 64 * (j))
#define XB_XGEN(j)  (2304 + 64 * (j))
#define XB_TOP      3328
#define XB_TOPGEN   3392
#define XCD_BAR_WORDS 3456
#define XB_SPIN_CAP (1u << 18)
#define LAS __attribute__((address_space(3)))

__device__ __forceinline__ unsigned xb_ld(unsigned* p)              { return __hip_atomic_load(p, __ATOMIC_RELAXED, __HIP_MEMORY_SCOPE_AGENT); }
__device__ __forceinline__ unsigned xb_add(unsigned* p, unsigned v) { return __hip_atomic_fetch_add(p, v, __ATOMIC_RELAXED, __HIP_MEMORY_SCOPE_AGENT); }
__device__ __forceinline__ unsigned xb_xcc_id() { return (unsigned)__builtin_amdgcn_s_getreg((3 << 11) | 20) & 0xFu; }
#define XB_SPIN(cond, bar) do { unsigned _sp = 0; while (cond) { __builtin_amdgcn_s_sleep(1); \
    if ((++_sp & 255u) == 0u) { if (xb_ld(&(bar)[XB_TMO])) break; if (_sp > XB_SPIN_CAP) { atomicAdd(&(bar)[XB_TMO], 1u); break; } } } } while (0)

struct XcdBarrier {
    unsigned* bar; unsigned x;
    volatile LAS unsigned* st;
};

__device__ __forceinline__ XcdBarrier xcd_barrier_post(unsigned* bar, volatile LAS unsigned* st) {
    XcdBarrier b; b.bar = bar; b.x = xb_xcc_id(); b.st = st;
    if (threadIdx.x == 0) (void)xb_add(&bar[XB_XCNT(b.x)], 1u);
    return b;
}
__device__ __forceinline__ void xcd_barrier_complete(unsigned* bar, unsigned x, unsigned& nloc, unsigned& nx) {
    const unsigned G = gridDim.x * gridDim.y * gridDim.z;
    unsigned sum, cnt, mine, sp = 0u;
    for (;;) {
        sum = 0u; cnt = 0u; mine = 0u;
#pragma unroll
        for (unsigned j = 0; j < 16; ++j) { const unsigned c = xb_ld(&bar[XB_XCNT(j)]); sum += c; cnt += (c > 0u) ? 1u : 0u; mine = (j == x) ? c : mine; }
        if (sum == G) break;
        __builtin_amdgcn_s_sleep(1);
        if ((++sp & 255u) == 0u) { if (xb_ld(&bar[XB_TMO])) break; if (sp > XB_SPIN_CAP) { atomicAdd(&bar[XB_TMO], 1u); break; } }
    }
    nloc = mine > 0u ? mine : 1u; nx = cnt > 0u ? cnt : 1u;
}

__device__ __forceinline__ void xcd_barrier(const XcdBarrier& b) {
    asm volatile("s_waitcnt vmcnt(0)" ::: "memory");
    __syncthreads();
    if (threadIdx.x == 0) {
        unsigned* bar = b.bar;
        __builtin_amdgcn_s_waitcnt(0);
        unsigned nloc = b.st[0], nx = b.st[1];
        if (nloc == 0u) { xcd_barrier_complete(bar, b.x, nloc, nx); b.st[0] = nloc; b.st[1] = nx; }
        const unsigned old = xb_add(&bar[XB_XSUB(b.x)], 1u);
        const unsigned gen = old / nloc;
        if (old + 1u == (gen + 1u) * nloc) {
            __builtin_amdgcn_fence(__ATOMIC_RELEASE, "agent");
            asm volatile("s_waitcnt vmcnt(0)" ::: "memory");
            const unsigned og = xb_add(&bar[XB_TOP], 1u);
            const unsigned tg = og / nx;
            if (og + 1u == (tg + 1u) * nx) xb_add(&bar[XB_TOPGEN], 1u);
            else XB_SPIN(xb_ld(&bar[XB_TOPGEN]) == tg, bar);
            __builtin_amdgcn_fence(__ATOMIC_ACQUIRE, "agent");
            xb_add(&bar[XB_XGEN(b.x)], 1u);
            asm volatile("s_waitcnt vmcnt(0)" ::: "memory");
        } else {
            XB_SPIN(xb_ld(&bar[XB_XGEN(b.x)]) == gen, bar);
            __builtin_amdgcn_fence(__ATOMIC_ACQUIRE, "agent");
            asm volatile("s_waitcnt vmcnt(0)" ::: "memory");
        }
    }
    __syncthreads();
}


template <class MapF>
__device__ __forceinline__ void conv_wT(const float* __restrict__ src, int ldsrc, int K, bf16_t* __restrict__ dst, int nrows, MapF colmap,
                                        const float* __restrict__ scale, int bid, int nb, float* tile) {
    const int tid = opaque_tid(), nkt = K / 64, ntile = (nrows / 64) * nkt;
    for (int t = bid; t < ntile; t += nb) {
        const int r0 = (t / nkt) * 64, k0 = (t % nkt) * 64;
#pragma unroll
        for (int i = 0; i < 8; ++i) {
            const int e = tid + NT * i, kk = e >> 6, rr = e & 63;
            const int c = colmap(r0 + rr);
            float v = 0.f;
            if (c >= 0) { v = src[(size_t)(k0 + kk) * ldsrc + c]; if (scale) v *= scale[k0 + kk]; }
            tile[kk * 65 + rr] = v;
        }
        __syncthreads();
#pragma unroll
        for (int i = 0; i < 8; ++i) {
            const int e = tid + NT * i, rr = e >> 6, kk = e & 63;
            dst[(size_t)(r0 + rr) * K + k0 + kk] = f2bf(tile[kk * 65 + rr]);
        }
        __syncthreads();
    }
}

__device__ __forceinline__ void phase_weights(const Params& p, int l, int bid, int nb, unsigned char* lds) {
    float* tile = (float*)lds;
    const float* n1 = p.in[I_N1] + l * DM;
    const float* n2 = p.in[I_N2] + l * DM;
    conv_wT(p.in[I_WIN] + (size_t)l * DM * 4404, 4404, DM, p.Bt_in, NP, [](int r) { return map_in_col(r); }, n1, bid, nb, tile);
    for (int i = 0; i < 4; ++i) {
        conv_wT(p.in[I_WGATE] + ((size_t)l * 4 + i) * DM * DM, DM, DM, p.Bt_gate + (size_t)i * DM * DM, DM, [](int r) { return r; }, n1, bid, nb, tile);
        conv_wT(p.in[I_WBR] + ((size_t)l * 4 + i) * 384 * DM, DM, 384, p.Bt_br + (size_t)i * DM * 384, DM, [](int r) { return r; }, nullptr, bid, nb, tile);
    }
    conv_wT(p.in[I_WOUT] + (size_t)l * DM * DM, DM, DM, p.Bt_out, DM, [](int r) { return r; }, nullptr, bid, nb, tile);
    for (int e = 0; e < 16; ++e) {
        const float* wg = p.in[I_MWG] + ((size_t)l * 16 + e) * DM * 512;
        const float* wu = p.in[I_MWU] + ((size_t)l * 16 + e) * DM * 512;
        bf16_t* dst = p.Wgu + (size_t)e * DM * DM;
        {
            const int tid = opaque_tid();
            for (int t = bid; t < 16 * 16; t += nb) {
                const int r0 = (t / 16) * 64, k0 = (t % 16) * 64;
#pragma unroll
                for (int i = 0; i < 8; ++i) {
                    const int ee = tid + NT * i, kk = ee >> 6, rr = ee & 63, rho = r0 + rr;
                    const int T = rho >> 8, wc = (rho >> 6) & 3, q = (rho >> 5) & 1, ii = rho & 31, hcol = 128 * T + 32 * wc + ii;
                    const float* s = q ? wu : wg;
                    tile[kk * 65 + rr] = s[(size_t)(k0 + kk) * 512 + hcol] * n2[k0 + kk];
                }
                __syncthreads();
#pragma unroll
                for (int i = 0; i < 8; ++i) {
                    const int ee = tid + NT * i, rr = ee >> 6, kk = ee & 63;
                    dst[(size_t)(r0 + rr) * DM + k0 + kk] = f2bf(tile[kk * 65 + rr]);
                }
                __syncthreads();
            }
        }
        conv_wT(p.in[I_MWD] + ((size_t)l * 16 + e) * 512 * DM, DM, 512, p.WdT + (size_t)e * DM * 512, DM, [](int r) { return r; }, nullptr, bid, nb, tile);
    }
}

__device__ __forceinline__ void phase_prep(const Params& p, int bid, int nb) {
    const int tid = opaque_tid(), wave = tid >> 6, lane = tid & 63;
    const float* x = p.in[I_X];
    for (int row = bid * 8 + wave; row < NTOK; row += nb * 8) {
        const float* xr = x + (size_t)row * DM;
        float s = 0.f;
#pragma unroll
        for (int i = 0; i < 4; ++i) {
            const f32x4 v = *(const f32x4*)(xr + i * 256 + lane * 4);
            s += v[0] * v[0] + v[1] * v[1] + v[2] * v[2] + v[3] * v[3];
            const unsigned lo = (unsigned)f2bf(v[0]) | ((unsigned)f2bf(v[1]) << 16), hi = (unsigned)f2bf(v[2]) | ((unsigned)f2bf(v[3]) << 16);
            *(uint2*)(p.hb + (size_t)row * DM + i * 256 + lane * 4) = make_uint2(lo, hi);
        }
        s = wave_sum(s);
        if (lane < 16) p.part[(size_t)row * 16 + lane] = (lane == 0) ? s : 0.f;
    }
    const float* rb = p.in[I_RELB];
    for (int i = bid * NT + tid; i < 6 * TABW; i += nb * NT) {
        const int h = i / TABW, d = i % TABW - 32;
        float vb = NEG_BIG, vc = NEG_BIG;
        if (d >= 0) {
            const int bk = rel_bucket(d);
            vb = rb[bk * 12 + h] * LOG2E;
            const int m = (d <= 128 ? 1 : 0) + ((d % 4 == 0 && d <= 512) ? 1 : 0) + ((d % 16 == 0) ? 1 : 0);
            if (m > 0) vc = (rb[bk * 12 + 6 + h] + logf((float)m)) * LOG2E;
        }
        p.biasB[i] = vb; p.biasC[i] = vc;
    }
    for (int i = bid * NT + tid; i < DEPTH * 32 * 32; i += nb * NT) p.cnt[i] = 0;
}

constexpr int G_BUF = 256 * 32 * 2 + 128 * 32 * 2;
constexpr int G_NS = 6, G_LDS = G_NS * G_BUF;
constexpr int MG_NS = 5, MG_GLDS = MG_NS * G_BUF;
struct GemmCtx { int tid, wid, lane, wr, wc, fr, fq, sc, rdo; };
__device__ __forceinline__ GemmCtx gemm_ctx() {
    GemmCtx c; c.tid = opaque_tid(); c.wid = __builtin_amdgcn_readfirstlane(c.tid >> 6); c.lane = c.tid & 63; c.wr = c.wid >> 1; c.wc = c.wid & 1; c.fr = c.lane & 15; c.fq = c.lane >> 4;
    c.sc = (((c.tid & 3) ^ ((0 - (c.tid >> 4)) & 3))) * 8;
    c.rdo = c.fr * 64 + ((c.fq ^ ((0 - (c.fr >> 2)) & 3)) * 16);
    return c;
}
__device__ __forceinline__ void gemm_relane(GemmCtx& c) { int t = c.tid; asm volatile("" : "+v"(t)); c.lane = t & 63; c.fr = t & 15; c.fq = (t >> 4) & 3; }
__device__ __forceinline__ void acc_zero(f32x4 (&acc)[4][4]) {
#pragma unroll
    for (int m = 0; m < 4; ++m)
#pragma unroll
        for (int n = 0; n < 4; ++n) acc[m][n] = (f32x4){0.f, 0.f, 0.f, 0.f};
}
__device__ __forceinline__ void gemm_stage(const bf16_t* A, unsigned oa0, unsigned oa1, const bf16_t* B, unsigned ob, int t, unsigned char* buf, const GemmCtx& c) {
    const bf16_t* At = A + t * 32; const bf16_t* Bt = B + t * 32;
    __builtin_amdgcn_global_load_lds((const unsigned*)(At + oa0), (unsigned*)(buf + c.tid * 16), 16, 0, 0);
    __builtin_amdgcn_global_load_lds((const unsigned*)(At + oa1), (unsigned*)(buf + 8192 + c.tid * 16), 16, 0, 0);
    __builtin_amdgcn_global_load_lds((const unsigned*)(Bt + ob), (unsigned*)(buf + 16384 + c.tid * 16), 16, 0, 0);
}
template <int NS>
__device__ __forceinline__ void gemm_kloop(f32x4 (&acc)[4][4], const bf16_t* A, unsigned oa0, unsigned oa1, const bf16_t* B, unsigned ob, int nkt, unsigned char* lds, const GemmCtx& c) {
#pragma unroll
    for (int i = 0; i < NS - 1; ++i) gemm_stage(A, oa0, oa1, B, ob, i, lds + i * G_BUF, c);
    int cur = 0;
#pragma unroll 1
    for (int t = 0; t < nkt; ++t) {
        const int young = nkt - 1 - t;
        if (NS >= 6 && young >= 4) asm volatile("s_waitcnt vmcnt(12)" ::: "memory");
        else if (NS >= 5 && young >= 3) asm volatile("s_waitcnt vmcnt(9)" ::: "memory");
        else if (NS >= 4 && young >= 2) asm volatile("s_waitcnt vmcnt(6)" ::: "memory");
        else if (young >= 1) asm volatile("s_waitcnt vmcnt(3)" ::: "memory");
        else asm volatile("s_waitcnt vmcnt(0)" ::: "memory");
        __builtin_amdgcn_s_barrier();
        asm volatile("" ::: "memory");
        const int nxt = cur == 0 ? NS - 1 : cur - 1;
        if (t + NS - 1 < nkt) gemm_stage(A, oa0, oa1, B, ob, t + NS - 1, lds + nxt * G_BUF, c);
        const unsigned char* SA = lds + cur * G_BUF; const unsigned char* SB = SA + 16384;
        bf16x8 At[4], Bt[4];
#pragma unroll
        for (int m = 0; m < 4; ++m) At[m] = *reinterpret_cast<const bf16x8*>(SA + (c.wr * 64 + m * 16) * 64 + c.rdo);
#pragma unroll
        for (int n = 0; n < 4; ++n) Bt[n] = *reinterpret_cast<const bf16x8*>(SB + (c.wc * 64 + n * 16) * 64 + c.rdo);
        asm volatile("s_waitcnt lgkmcnt(0)" ::: "memory");
        __builtin_amdgcn_sched_barrier(0);
#pragma unroll
        for (int m = 0; m < 4; ++m)
#pragma unroll
            for (int n = 0; n < 4; ++n) acc[m][n] = __builtin_amdgcn_mfma_f32_16x16x32_bf16(At[m], Bt[n], acc[m][n], 0, 0, 0);
        cur = cur == NS - 1 ? 0 : cur + 1;
    }
    __builtin_amdgcn_s_barrier();
    asm volatile("" ::: "memory");
}

template <int NS>
__device__ __forceinline__ void gemm_kloop_p(f32x4 (&acc)[4][4], const bf16_t* A, unsigned oa0, unsigned oa1, const bf16_t* B, unsigned ob, int nkt, unsigned char* lds, const GemmCtx& c) {
#pragma unroll
    for (int i = 0; i < NS; ++i) gemm_stage(A, oa0, oa1, B, ob, i, lds + i * G_BUF, c);
    const int aoff = (c.wr * 64) * 64 + c.rdo, boff = 16384 + (c.wc * 64) * 64 + c.rdo;
    bf16x8 A0[4], B0[4], A1[4], B1[4];
#define GK_WAIT(young_) do { const int _y = (young_); \
        if (NS >= 6 && _y >= 4) asm volatile("s_waitcnt vmcnt(12)" ::: "memory"); \
        else if (NS >= 5 && _y >= 3) asm volatile("s_waitcnt vmcnt(9)" ::: "memory"); \
        else if (NS >= 4 && _y >= 2) asm volatile("s_waitcnt vmcnt(6)" ::: "memory"); \
        else if (_y >= 1) asm volatile("s_waitcnt vmcnt(3)" ::: "memory"); \
        else asm volatile("s_waitcnt vmcnt(0)" ::: "memory"); } while (0)
#define GK_READ(FA, FB, buf_) do { const unsigned char* _s = lds + (buf_) * G_BUF; \
        _Pragma("unroll") for (int m = 0; m < 4; ++m) FA[m] = *reinterpret_cast<const bf16x8*>(_s + aoff + m * 1024); \
        _Pragma("unroll") for (int n = 0; n < 4; ++n) FB[n] = *reinterpret_cast<const bf16x8*>(_s + boff + n * 1024); } while (0)
#define GK_MMA(FA, FB) do { _Pragma("unroll") for (int m = 0; m < 4; ++m) _Pragma("unroll") for (int n = 0; n < 4; ++n) \
        acc[m][n] = __builtin_amdgcn_mfma_f32_16x16x32_bf16(FA[m], FB[n], acc[m][n], 0, 0, 0); } while (0)
    GK_WAIT(NS - 1);
    __builtin_amdgcn_s_barrier(); asm volatile("" ::: "memory");
    GK_READ(A0, B0, 0);
    int cur = 0;
#pragma unroll 1
    for (int t = 0; t < nkt; t += 2) {
        {
            GK_WAIT(nkt - 2 - t < NS - 2 ? nkt - 2 - t : NS - 2);
            asm volatile("s_waitcnt lgkmcnt(0)" ::: "memory");
            __builtin_amdgcn_s_barrier(); asm volatile("" ::: "memory");
            if (t + NS < nkt) gemm_stage(A, oa0, oa1, B, ob, t + NS, lds + cur * G_BUF, c);
            const int n1 = cur == NS - 1 ? 0 : cur + 1;
            GK_READ(A1, B1, n1);
            GK_MMA(A0, B0);
            cur = n1;
        }
        {
            const bool more = t + 2 < nkt;
            if (more) GK_WAIT(nkt - 3 - t < NS - 2 ? nkt - 3 - t : NS - 2);
            asm volatile("s_waitcnt lgkmcnt(0)" ::: "memory");
            __builtin_amdgcn_s_barrier(); asm volatile("" ::: "memory");
            if (t + 1 + NS < nkt) gemm_stage(A, oa0, oa1, B, ob, t + 1 + NS, lds + cur * G_BUF, c);
            const int n1 = cur == NS - 1 ? 0 : cur + 1;
            if (more) GK_READ(A0, B0, n1);
            GK_MMA(A1, B1);
            cur = n1;
        }
    }
#undef GK_WAIT
#undef GK_READ
#undef GK_MMA
    __builtin_amdgcn_s_barrier(); asm volatile("" ::: "memory");
}

template <int NS, bool SWAP>
__device__ __forceinline__ void gemm_kloop_s(f32x4 (&acc)[4][4], const bf16_t* A, unsigned oa0, unsigned oa1, const bf16_t* B, unsigned ob, int nkt, unsigned char* lds, const GemmCtx& c) {
    constexpr int D = NS - 2;
#pragma unroll
    for (int i = 0; i < D; ++i) gemm_stage(A, oa0, oa1, B, ob, i, lds + i * G_BUF, c);
    const int aoff = (c.wr * 64) * 64 + c.rdo, boff = 16384 + (c.wc * 64) * 64 + c.rdo;
    const bool trailing = c.wid >= 4;
#define GS_WAIT(young_) do { const int _y = (young_); \
        if (D >= 5 && _y >= 3) asm volatile("s_waitcnt vmcnt(9)" ::: "memory"); \
        else if (D >= 4 && _y >= 2) asm volatile("s_waitcnt vmcnt(6)" ::: "memory"); \
        else if (_y >= 1) asm volatile("s_waitcnt vmcnt(3)" ::: "memory"); \
        else asm volatile("s_waitcnt vmcnt(0)" ::: "memory"); } while (0)
    GS_WAIT(D - 1);
    __builtin_amdgcn_s_barrier(); asm volatile("" ::: "memory");
    if (trailing) { __builtin_amdgcn_s_barrier(); asm volatile("" ::: "memory"); }
    int cur = 0, nxt = D % NS;
#pragma unroll 1
    for (int t = 0; t < nkt; ++t) {
        if (t + 1 < nkt) GS_WAIT(nkt - 2 - t < D - 2 ? nkt - 2 - t : D - 2);
        if (t + D < nkt) gemm_stage(A, oa0, oa1, B, ob, t + D, lds + nxt * G_BUF, c);
        const unsigned char* sb = lds + cur * G_BUF;
        bf16x8 At[4], Bt[4];
#pragma unroll
        for (int m = 0; m < 4; ++m) At[m] = *reinterpret_cast<const bf16x8*>(sb + aoff + m * 1024);
#pragma unroll
        for (int n = 0; n < 4; ++n) Bt[n] = *reinterpret_cast<const bf16x8*>(sb + boff + n * 1024);
        __builtin_amdgcn_s_barrier(); asm volatile("" ::: "memory");
        asm volatile("s_waitcnt lgkmcnt(0)" ::: "memory");
        __builtin_amdgcn_sched_barrier(0);
        __builtin_amdgcn_s_setprio(1);
#pragma unroll
        for (int m = 0; m < 4; ++m)
#pragma unroll
            for (int n = 0; n < 4; ++n) acc[m][n] = SWAP ? __builtin_amdgcn_mfma_f32_16x16x32_bf16(Bt[n], At[m], acc[m][n], 0, 0, 0) : __builtin_amdgcn_mfma_f32_16x16x32_bf16(At[m], Bt[n], acc[m][n], 0, 0, 0);
        __builtin_amdgcn_s_setprio(0);
        __builtin_amdgcn_s_barrier(); asm volatile("" ::: "memory");
        cur = cur == NS - 1 ? 0 : cur + 1; nxt = nxt == NS - 1 ? 0 : nxt + 1;
    }
#undef GS_WAIT
    if (!trailing) { __builtin_amdgcn_s_barrier(); asm volatile("" ::: "memory"); }
}

constexpr int G2_BUF = 2 * 256 * 32 * 2, G2_NS = 4, G2_LDS = G2_NS * G2_BUF;
struct Gemm2Ctx { int tid, wid, wr, wc, sc, aoff, boff, fr, fq; };
__device__ __forceinline__ Gemm2Ctx gemm2_ctx() {
    Gemm2Ctx c; c.tid = opaque_tid(); c.wid = __builtin_amdgcn_readfirstlane(c.tid >> 6); c.wr = c.wid >> 2; c.wc = c.wid & 3;
    const int lane = c.tid & 63; c.fr = lane & 15; c.fq = lane >> 4;
    c.sc = (((c.tid & 3) ^ ((0 - (c.tid >> 4)) & 3))) * 8;
    const int rdo = c.fr * 64 + ((c.fq ^ ((0 - (c.fr >> 2)) & 3)) * 16);
    c.aoff = (c.wr * 128) * 64 + rdo; c.boff = 16384 + (c.wc * 64) * 64 + rdo;
    return c;
}
__device__ __forceinline__ void gemm2_relane(Gemm2Ctx& c) { int t = c.tid; asm volatile("" : "+v"(t)); c.fr = t & 15; c.fq = (t >> 4) & 3; }
__device__ __forceinline__ void acc2_zero(f32x4 (&acc)[8][4]) {
#pragma unroll
    for (int m = 0; m < 8; ++m)
#pragma unroll
        for (int n = 0; n < 4; ++n) acc[m][n] = (f32x4){0.f, 0.f, 0.f, 0.f};
}
__device__ __forceinline__ void gemm2_stage(const bf16_t* A, unsigned oa0, unsigned oa1, const bf16_t* B, unsigned ob0, unsigned ob1, int t, unsigned char* buf, int tid) {
    const bf16_t* At = A + t * 32; const bf16_t* Bt = B + t * 32;
    __builtin_amdgcn_global_load_lds((const unsigned*)(At + oa0), (unsigned*)(buf + tid * 16), 16, 0, 0);
    __builtin_amdgcn_global_load_lds((const unsigned*)(At + oa1), (unsigned*)(buf + 8192 + tid * 16), 16, 0, 0);
    __builtin_amdgcn_global_load_lds((const unsigned*)(Bt + ob0), (unsigned*)(buf + 16384 + tid * 16), 16, 0, 0);
    __builtin_amdgcn_global_load_lds((const unsigned*)(Bt + ob1), (unsigned*)(buf + 24576 + tid * 16), 16, 0, 0);
}
template <bool SWAP>
__device__ __forceinline__ void gemm2_kloop(f32x4 (&acc)[8][4], const bf16_t* A, unsigned oa0, unsigned oa1, const bf16_t* B, unsigned ob0, unsigned ob1, int nkt, unsigned char* lds, const Gemm2Ctx& c) {
#pragma unroll
    for (int i = 0; i < 3; ++i) gemm2_stage(A, oa0, oa1, B, ob0, ob1, i, lds + i * G2_BUF, c.tid);
    const bool trailing = c.wid >= 4;
    asm volatile("s_waitcnt vmcnt(8)" ::: "memory");
    __builtin_amdgcn_s_barrier(); asm volatile("" ::: "memory");
    if (trailing) { __builtin_amdgcn_s_barrier(); asm volatile("" ::: "memory"); }
    int cur = 0;
#pragma unroll 1
    for (int t = 0; t < nkt; ++t) {
        if (t + 2 < nkt) asm volatile("s_waitcnt vmcnt(4)" ::: "memory"); else asm volatile("s_waitcnt vmcnt(0)" ::: "memory");
        const unsigned char* sb = lds + cur * G2_BUF;
        bf16x8 At[8], Bt[4];
#pragma unroll
        for (int n = 0; n < 4; ++n) Bt[n] = *reinterpret_cast<const bf16x8*>(sb + c.boff + n * 1024);
#pragma unroll
        for (int m = 0; m < 8; ++m) At[m] = *reinterpret_cast<const bf16x8*>(sb + c.aoff + m * 1024);
        __builtin_amdgcn_s_barrier(); asm volatile("" ::: "memory");
        asm volatile("s_waitcnt lgkmcnt(0)" ::: "memory");
        __builtin_amdgcn_sched_barrier(0);
#pragma unroll
        for (int m = 0; m < 4; ++m)
#pragma unroll
            for (int n = 0; n < 4; ++n) acc[m][n] = SWAP ? __builtin_amdgcn_mfma_f32_16x16x32_bf16(Bt[n], At[m], acc[m][n], 0, 0, 0) : __builtin_amdgcn_mfma_f32_16x16x32_bf16(At[m], Bt[n], acc[m][n], 0, 0, 0);
        __builtin_amdgcn_sched_barrier(0);
        if (t + 3 < nkt) gemm2_stage(A, oa0, oa1, B, ob0, ob1, t + 3, lds + (cur == 0 ? 3 : cur - 1) * G2_BUF, c.tid);
        __builtin_amdgcn_sched_barrier(0);
#pragma unroll
        for (int m = 4; m < 8; ++m)
#pragma unroll
            for (int n = 0; n < 4; ++n) acc[m][n] = SWAP ? __builtin_amdgcn_mfma_f32_16x16x32_bf16(Bt[n], At[m], acc[m][n], 0, 0, 0) : __builtin_amdgcn_mfma_f32_16x16x32_bf16(At[m], Bt[n], acc[m][n], 0, 0, 0);
        __builtin_amdgcn_s_barrier(); asm volatile("" ::: "memory");
        cur = cur == 3 ? 0 : cur + 1;
    }
    if (!trailing) { __builtin_amdgcn_s_barrier(); asm volatile("" ::: "memory"); }
}

__device__ __forceinline__ void phase_inproj(const Params& p, int bid, int nb, unsigned char* lds) {
    Gemm2Ctx c = gemm2_ctx();
    float* srstd = (float*)(lds + G2_LDS);
    constexpr int NCT = NP / 256, NUX = (NTOK / 256 / 8) * NCT;
    const int xcd = bid & 7, nloc = nb >> 3;
    for (int k = bid >> 3; k < NUX; k += nloc) {
        const int rt = xcd * (NTOK / 256 / 8) + k / NCT, ct = k % NCT, brow = rt * 256, bcol = ct * 256;
        if (c.tid < 256) srstd[c.tid] = rstd_of(p.part, brow + c.tid);
        f32x4 acc[8][4]; acc2_zero(acc);
        const int r = c.tid >> 2;
        const unsigned o0 = (unsigned)(r * DM + c.sc), o1 = (unsigned)((r + 128) * DM + c.sc);
        if (ct >= C_BV / 256 && ct < C_BV / 256 + 3) {
            gemm2_kloop<false>(acc, p.hb + (size_t)brow * DM, o0, o1, p.Bt_in + (size_t)bcol * DM, o0, o1, DM / 32, lds, c);
            gemm2_relane(c);
            const int vcol = bcol - C_BV + c.wc * 64;
            bf16_t* vt = (vcol < 384 ? p.VtB + ((size_t)(brow / TSEQ) * 384 + vcol + c.fr) * TSEQ : p.VtC + ((size_t)(brow / TSEQ) * 384 + (vcol - 384) + c.fr) * TSEQ)
                         + (brow % TSEQ) + c.wr * 128 + ((((c.fq & 1) << 1) | (c.fq >> 1)) * 4);
#pragma unroll
            for (int m = 0; m < 8; ++m) {
                const int rl = c.wr * 128 + m * 16 + c.fq * 4;
                const float r0 = srstd[rl], r1 = srstd[rl + 1], r2 = srstd[rl + 2], r3 = srstd[rl + 3];
#pragma unroll
                for (int n = 0; n < 4; ++n)
                    *(uint2*)(vt + (size_t)(n * 16) * TSEQ + m * 16) = make_uint2(cvt_pk_bf16(acc[m][n][0] * r0, acc[m][n][1] * r1), cvt_pk_bf16(acc[m][n][2] * r2, acc[m][n][3] * r3));
            }
        } else {
            gemm2_kloop<true>(acc, p.hb + (size_t)brow * DM, o0, o1, p.Bt_in + (size_t)bcol * DM, o0, o1, DM / 32, lds, c);
            gemm2_relane(c);
#pragma unroll
            for (int m = 0; m < 8; ++m) {
                const int rl = c.wr * 128 + m * 16 + c.fr; const float rs = srstd[rl];
                bf16_t* o = p.proj + (size_t)(brow + rl) * NP + bcol + c.wc * 64 + c.fq * 4;
#pragma unroll
                for (int n = 0; n < 4; ++n) *(uint2*)(o + n * 16) = make_uint2(cvt_pk_bf16(acc[m][n][0] * rs, acc[m][n][1] * rs), cvt_pk_bf16(acc[m][n][2] * rs, acc[m][n][3] * rs));
            }
        }
        __syncthreads();
    }
}

__device__ __forceinline__ int grab_unit(int* ctr, volatile LAS int* slot) {
    __syncthreads();
    if (opaque_tid() == 0) *slot = __hip_atomic_fetch_add(ctr, 1, __ATOMIC_RELAXED, __HIP_MEMORY_SCOPE_AGENT);
    __syncthreads();
    return *slot;
}

#ifndef PROBE_GEMM_VAR
#define PROBE_GEMM_VAR -1
#endif
template <int VAR>
__device__ __forceinline__ void phase_gemm_probe(const Params& p, int bid, int nb, unsigned char* lds) {
    const GemmCtx c = gemm_ctx();
    constexpr int NS = G_NS, NCT = NP / 128, NU = (NTOK / 256) * NCT;
    for (int u = bid; u < NU; u += nb) {
        const int rt = u / NCT, ct = u % NCT, brow = rt * 256, bcol = ct * 128;
        f32x4 acc[4][4]; acc_zero(acc);
        const int r = c.tid >> 2;
        const bf16_t* A = p.hb + (size_t)brow * DM; const bf16_t* B = p.Bt_in + (size_t)bcol * DM;
        const unsigned oa0 = (unsigned)(r * DM + c.sc), oa1 = (unsigned)((r + 128) * DM + c.sc), ob = (unsigned)(r * DM + c.sc);
        const int nkt = DM / 32;
#pragma unroll
        for (int i = 0; i < NS - 1; ++i) gemm_stage(A, oa0, oa1, B, ob, i, lds + i * G_BUF, c);
        int cur = 0;
        bf16x8 At[4], Bt[4];
        if (VAR == 2) {
            asm volatile("s_waitcnt vmcnt(0)" ::: "memory"); __builtin_amdgcn_s_barrier();
#pragma unroll
            for (int m = 0; m < 4; ++m) At[m] = *reinterpret_cast<const bf16x8*>(lds + (c.wr * 64 + m * 16) * 64 + c.rdo);
#pragma unroll
            for (int n = 0; n < 4; ++n) Bt[n] = *reinterpret_cast<const bf16x8*>(lds + 16384 + (c.wc * 64 + n * 16) * 64 + c.rdo);
        }
#pragma unroll 1
        for (int t = 0; t < nkt; ++t) {
            const int young = nkt - 1 - t;
            if (VAR == 1) { if (t == 0) asm volatile("s_waitcnt vmcnt(0)" ::: "memory"); }
            else if (young >= 4) asm volatile("s_waitcnt vmcnt(12)" ::: "memory");
            else if (young >= 3) asm volatile("s_waitcnt vmcnt(9)" ::: "memory");
            else if (young >= 2) asm volatile("s_waitcnt vmcnt(6)" ::: "memory");
            else if (young >= 1) asm volatile("s_waitcnt vmcnt(3)" ::: "memory");
            else asm volatile("s_waitcnt vmcnt(0)" ::: "memory");
            if (VAR != 3) __builtin_amdgcn_s_barrier();
            asm volatile("" ::: "memory");
            const int nxt = cur == 0 ? NS - 1 : cur - 1;
            if (VAR != 1 && t + NS - 1 < nkt) gemm_stage(A, oa0, oa1, B, ob, t + NS - 1, lds + nxt * G_BUF, c);
            const unsigned char* SA = lds + cur * G_BUF; const unsigned char* SB = SA + 16384;
            if (VAR != 2) {
#pragma unroll
                for (int m = 0; m < 4; ++m) At[m] = *reinterpret_cast<const bf16x8*>(SA + (c.wr * 64 + m * 16) * 64 + c.rdo);
#pragma unroll
                for (int n = 0; n < 4; ++n) Bt[n] = *reinterpret_cast<const bf16x8*>(SB + (c.wc * 64 + n * 16) * 64 + c.rdo);
                asm volatile("s_waitcnt lgkmcnt(0)" ::: "memory");
            }
            __builtin_amdgcn_sched_barrier(0);
            if (VAR != 4) {
#pragma unroll
                for (int m = 0; m < 4; ++m)
#pragma unroll
                    for (int n = 0; n < 4; ++n) acc[m][n] = __builtin_amdgcn_mfma_f32_16x16x32_bf16(At[m], Bt[n], acc[m][n], 0, 0, 0);
            } else {
#pragma unroll
                for (int m = 0; m < 4; ++m) asm volatile("" :: "v"(At[m]), "v"(Bt[m]));
            }
            cur = cur == NS - 1 ? 0 : cur + 1;
        }
        __builtin_amdgcn_s_barrier();
        asm volatile("" ::: "memory");
        float sacc = 0.f;
#pragma unroll
        for (int m = 0; m < 4; ++m)
#pragma unroll
            for (int n = 0; n < 4; ++n) sacc += acc[m][n][0] + acc[m][n][1] + acc[m][n][2] + acc[m][n][3];
        if (sacc == 1.2345e33f) p.part[0] = sacc;
    }
}

constexpr int GQ = 56, GS = 72, GO = 97;
constexpr int GL_QD = 0, GL_KD = GL_QD + 64 * GQ * 2, GL_KET = GL_KD + 64 * GQ * 2, GL_VT = GL_KET + 64 * GS * 2, GL_ATT = GL_VT + 96 * GS * 2, GL_ST = GL_ATT + 64 * GS * 2,
              GL_OO = GL_ST + 96 * GQ * 2, GL_BC = GL_OO + 64 * GO * 4, GL_SEG = GL_BC + 64 * 48 * 4, GL_EBL = GL_SEG + 8 * 48 * 4, GL_W2 = GL_EBL + 64 * 4, GL_B2 = GL_W2 + 16 * 48 * 4,
              GL_GAIN = GL_B2 + 48 * 4, GL_RQ = GL_GAIN + 96 * 4, GL_RK = GL_RQ + 64 * 48 * 2, GL_RV = GL_RK + 64 * 48 * 2, GL_RA = GL_RV + 64 * 96 * 2, GL_RG = GL_RA + 64 * 16 * 2,
              GLA_LDS = GL_RG + 2 * 64 * 96 * 2;
static_assert(GL_OO % 16 == 0 && GL_RQ % 16 == 0 && GL_RG % 16 == 0 && GL_ST % 16 == 0, "GLA LDS map alignment");
__device__ __forceinline__ void phase_gla(const Params& p, int l, int* ctr, volatile LAS int* slot, unsigned char* lds) {
    bf16_t* qd = (bf16_t*)(lds + GL_QD); bf16_t* kd = (bf16_t*)(lds + GL_KD); bf16_t* keT = (bf16_t*)(lds + GL_KET); bf16_t* vT = (bf16_t*)(lds + GL_VT);
    bf16_t* att = (bf16_t*)(lds + GL_ATT); bf16_t* ST = (bf16_t*)(lds + GL_ST);
    float* oo = (float*)(lds + GL_OO); float* bc = (float*)(lds + GL_BC); float* seg = (float*)(lds + GL_SEG); float* ebl = (float*)(lds + GL_EBL);
    float* w2s = (float*)(lds + GL_W2); float* b2s = (float*)(lds + GL_B2); float* gains = (float*)(lds + GL_GAIN);
    bf16_t* rq = (bf16_t*)(lds + GL_RQ); bf16_t* rk = (bf16_t*)(lds + GL_RK); bf16_t* rv = (bf16_t*)(lds + GL_RV); bf16_t* ra = (bf16_t*)(lds + GL_RA); bf16_t* rg = (bf16_t*)(lds + GL_RG);
    const int tid = opaque_tid(), wave = tid >> 6, lane = tid & 63, r = lane & 31, hf = lane >> 5;
    for (int u = grab_unit(ctr, slot); u < NBATCH * 4; u = grab_unit(ctr, slot)) {
        const int b = u >> 2, h = u & 3;
        PROBE_UNIT_BEGIN(9, u == 0);
        for (int i = tid; i < 16 * 48; i += NT) w2s[i] = p.in[I_AW2][(size_t)l * 16 * 192 + (i / 48) * 192 + h * 48 + (i % 48)];
        if (tid < 48) b2s[tid] = p.in[I_AB2][l * 192 + h * 48 + tid];
        if (tid < 96) gains[tid] = p.in[I_AGAIN][l * 384 + h * 96 + tid];
        if (tid < 64) ebl[tid] = 1.0f;
        for (int i = tid; i < 96 * GQ; i += NT) ST[i] = 0;
        for (int i = tid; i < 64 * GS; i += NT) { keT[i] = 0; att[i] = 0; }
        const bf16_t* src[5]; int dsto[5];
#pragma unroll
        for (int j = 0; j < 5; ++j) {
            const int pid = tid + NT * j; int row = 0, col = 0, dst = -1;
            if (pid < 384) { row = pid / 6; col = C_AQ + h * 48 + (pid % 6) * 8; dst = GL_RQ + pid * 16; }
            else if (pid < 768) { const int q = pid - 384; row = q / 6; col = C_AK + h * 48 + (q % 6) * 8; dst = GL_RK + q * 16; }
            else if (pid < 1536) { const int q = pid - 768; row = q / 12; col = C_AV + h * 96 + (q % 12) * 8; dst = GL_RV + q * 16; }
            else if (pid < 2304) { const int q = pid - 1536; row = q / 12; col = C_AG + h * 96 + (q % 12) * 8; dst = GL_RG + q * 16; }
            else if (pid < 2432) { const int q = pid - 2304; row = q / 2; col = C_ALR + (q % 2) * 8; dst = GL_RA + q * 16; }
            src[j] = p.proj + ((size_t)b * TSEQ + row) * NP + col; dsto[j] = dst;
        }
        u32x4 pre[5];
#pragma unroll
        for (int j = 0; j < 5; ++j) pre[j] = dsto[j] >= 0 ? *(const u32x4*)src[j] : (u32x4){0u, 0u, 0u, 0u};
        f32x16 Sacc;
#pragma unroll
        for (int i = 0; i < 16; ++i) Sacc[i] = 0.f;
        const int kt = wave / 3, vt = wave % 3;
        __syncthreads();
        for (int n = 0; n < 32; ++n) {
            const size_t row0 = (size_t)b * TSEQ + n * 64;
            const int gsel = (n & 1) * (64 * 96 * 2);
#pragma unroll
            for (int j = 0; j < 5; ++j) if (dsto[j] >= 0) *(u32x4*)(lds + dsto[j] + (dsto[j] >= GL_RG ? gsel : 0)) = pre[j];
            if (n + 1 < 32) {
#pragma unroll
                for (int j = 0; j < 5; ++j) if (dsto[j] >= 0) pre[j] = *(const u32x4*)(src[j] + (size_t)(n + 1) * 64 * NP);
            }
            __syncthreads();
            for (int e = tid; e < 64 * 48; e += NT) {
                const int t = e / 48, k = e % 48;
                float z = b2s[k];
#pragma unroll
                for (int rr = 0; rr < 16; ++rr) z += bf2f(ra[t * 16 + rr]) * w2s[rr * 48 + k];
                bc[e] = (fminf(z, 0.f) - log1pf(__expf(-fabsf(z)))) * (1.0f / 16.0f);
            }
            __syncthreads();
            if (tid < 384) {
                const int k = tid % 48, sg = tid / 48; float run = 0.f;
#pragma unroll
                for (int i = 0; i < 8; ++i) { run += bc[(sg * 8 + i) * 48 + k]; bc[(sg * 8 + i) * 48 + k] = run; }
                seg[sg * 48 + k] = run;
            }
            __syncthreads();
            if (tid < 384) {
                const int k = tid % 48, sg = tid / 48; float pre_s = 0.f;
                for (int s2 = 0; s2 < sg; ++s2) pre_s += seg[s2 * 48 + k];
#pragma unroll
                for (int i = 0; i < 8; ++i) bc[(sg * 8 + i) * 48 + k] += pre_s;
            }
            __syncthreads();
            for (int e = tid; e < 64 * 48; e += NT) {
                const int t = e / 48, k = e % 48;
                const float bb = bc[e], bl = bc[63 * 48 + k];
                const float q = bf2f(rq[e]) * 0.14433756729740643f, kk = bf2f(rk[e]);
                qd[t * GQ + k] = f2bf(q * __expf(bb)); kd[t * GQ + k] = f2bf(kk * __expf(-bb)); keT[k * GS + t] = f2bf(kk * __expf(bl - bb));
                if (t == 63) ebl[k] = __expf(bl);
            }
            for (int e = tid; e < 64 * 96; e += NT) { const int t = e / 96, v = e % 96; vT[v * GS + t] = rv[e]; }
            __syncthreads();
            if (wave < 3) {
                const int si = wave == 2 ? 1 : 0, ci = wave >= 1 ? 1 : 0;
                f32x16 x;
#pragma unroll
                for (int i = 0; i < 16; ++i) x[i] = 0.f;
#pragma unroll
                for (int st = 0; st < 3; ++st)
                    x = __builtin_amdgcn_mfma_f32_32x32x16_bf16(*(const bf16x8*)(kd + (si * 32 + r) * GQ + 16 * st + 8 * hf), *(const bf16x8*)(qd + (ci * 32 + r) * GQ + 16 * st + 8 * hf), x, 0, 0, 0);
                const int cq = ci * 32 + r;
#pragma unroll
                for (int g = 0; g < 4; ++g) {
                    const int s0 = si * 32 + 8 * g + 4 * hf;
                    const float v0 = s0 <= cq ? x[4 * g] : 0.f, v1 = s0 + 1 <= cq ? x[4 * g + 1] : 0.f, v2 = s0 + 2 <= cq ? x[4 * g + 2] : 0.f, v3 = s0 + 3 <= cq ? x[4 * g + 3] : 0.f;
                    *(uint2*)(att + cq * GS + s0) = make_uint2(cvt_pk_bf16(v0, v1), cvt_pk_bf16(v2, v3));
                }
            }
            if (wave < 6) {
#pragma unroll
                for (int i = 0; i < 16; ++i) Sacc[i] *= ebl[kt * 32 + (i & 3) + 8 * (i >> 2) + 4 * hf];
#pragma unroll
                for (int st = 0; st < 4; ++st)
                    Sacc = __builtin_amdgcn_mfma_f32_32x32x16_bf16(*(const bf16x8*)(keT + (kt * 32 + r) * GS + 16 * st + 8 * hf), *(const bf16x8*)(vT + (vt * 32 + r) * GS + 16 * st + 8 * hf), Sacc, 0, 0, 0);
            }
            __syncthreads();
            if (wave < 6) {
                f32x16 o;
#pragma unroll
                for (int i = 0; i < 16; ++i) o[i] = 0.f;
#pragma unroll
                for (int st = 0; st < 4; ++st)
                    if (st < 2 || kt == 1)
                        o = __builtin_amdgcn_mfma_f32_32x32x16_bf16(*(const bf16x8*)(att + (kt * 32 + r) * GS + 16 * st + 8 * hf), *(const bf16x8*)(vT + (vt * 32 + r) * GS + 16 * st + 8 * hf), o, 0, 0, 0);
#pragma unroll
                for (int st = 0; st < 3; ++st)
                    o = __builtin_amdgcn_mfma_f32_32x32x16_bf16(*(const bf16x8*)(qd + (kt * 32 + r) * GQ + 16 * st + 8 * hf), *(const bf16x8*)(ST + (vt * 32 + r) * GQ + 16 * st + 8 * hf), o, 0, 0, 0);
#pragma unroll
                for (int i = 0; i < 16; ++i) oo[(kt * 32 + (i & 3) + 8 * (i >> 2) + 4 * hf) * GO + vt * 32 + r] = o[i];
            }
            __syncthreads();
            for (int t = wave; t < 64; t += 8) {
                const float o0 = oo[t * GO + lane], o1 = lane < 32 ? oo[t * GO + 64 + lane] : 0.f;
                const float ms = wave_sum(o0 * o0 + o1 * o1) * (1.0f / 96.0f);
                const float rs = rsqrtf(ms + EPS);
                const bf16_t* gr = (const bf16_t*)((const unsigned char*)rg + gsel) + t * 96;
                bf16_t* g = p.proj + (row0 + t) * NP + C_AG + h * 96;
                g[lane] = f2bf(o0 * rs * gains[lane] * siluf_(bf2f(gr[lane])));
                if (lane < 32) g[64 + lane] = f2bf(o1 * rs * gains[64 + lane] * siluf_(bf2f(gr[64 + lane])));
            }
            if (wave < 6) {
#pragma unroll
                for (int g = 0; g < 4; ++g) {
                    const int k0 = kt * 32 + 8 * g + 4 * hf;
                    if (k0 < 48) *(uint2*)(ST + (vt * 32 + r) * GQ + k0) = make_uint2(cvt_pk_bf16(Sacc[4 * g], Sacc[4 * g + 1]), cvt_pk_bf16(Sacc[4 * g + 2], Sacc[4 * g + 3]));
                }
            }
            __syncthreads();
        }
        PROBE_UNIT_END(9, u == 0);
    }
}

constexpr int LQ = 56;
constexpr int LR_XIN = 0, LR_XC = LR_XIN + 67 * 48 * 4, LR_XCB = LR_XC + 64 * 48 * 4, LR_WT = LR_XCB + 64 * LQ * 2, LR_AA = LR_WT + 128 * LQ * 2, LR_FF = LR_AA + 64 * 48 * 4,
              LR_GG = LR_FF + 64 * 48 * 4, LR_SEGA = LR_GG + 64 * 48 * 4, LR_SEGH = LR_SEGA + 8 * 48 * 4, LR_CAR = LR_SEGH + 8 * 48 * 4, LR_HS = LR_CAR + 8 * 48 * 4,
              LR_CONST = LR_HS + 64 * 4, LR_Y = LR_CONST + 8 * 48 * 4, LRU_LDS = LR_Y + 64 * 48 * 2;
static_assert(LR_XCB % 16 == 0 && LR_WT % 16 == 0 && LR_Y % 16 == 0, "LRU LDS map alignment");
__device__ __forceinline__ float gelu_tanh(float x) { const float u = 0.7978845608028654f * (x + 0.044715f * x * x * x); return 0.5f * x * (1.0f + tanhf(u)); }
__device__ __forceinline__ void phase_lru(const Params& p, int l, int* ctr, volatile LAS int* slot, unsigned char* lds) {
    float* xin = (float*)(lds + LR_XIN); float* xc = (float*)(lds + LR_XC); bf16_t* xcb = (bf16_t*)(lds + LR_XCB); bf16_t* WT = (bf16_t*)(lds + LR_WT);
    float* aa = (float*)(lds + LR_AA); float* ff = (float*)(lds + LR_FF); float* gg = (float*)(lds + LR_GG);
    float* segA = (float*)(lds + LR_SEGA); float* segH = (float*)(lds + LR_SEGH); float* car = (float*)(lds + LR_CAR); float* hs = (float*)(lds + LR_HS);
    float* cst = (float*)(lds + LR_CONST);
    bf16_t* yraw = (bf16_t*)(lds + LR_Y);
    const int tid = opaque_tid(), wave = tid >> 6, lane = tid & 63, r = lane & 31, hf = lane >> 5;
    for (int u = grab_unit(ctr, slot); u < NBATCH * 8; u = grab_unit(ctr, slot)) {
        const int b = u >> 3, nblk = u & 7, ch0 = nblk * 48;
        PROBE_UNIT_BEGIN(10, u == 0);
        for (int i = tid; i < 128 * LQ; i += NT) {
            const int n = i / LQ, cidx = i % LQ; float v = 0.f;
            if (cidx < 48) { if (n < 48) v = p.in[I_WR][((size_t)l * 8 + nblk) * 2304 + cidx * 48 + n]; else if (n >= 64 && n < 112) v = p.in[I_WI][((size_t)l * 8 + nblk) * 2304 + cidx * 48 + (n - 64)]; }
            WT[i] = f2bf(v);
        }
        if (tid < 48) {
            cst[tid] = p.in[I_BR][l * 384 + ch0 + tid]; cst[48 + tid] = p.in[I_BI][l * 384 + ch0 + tid];
            cst[96 + tid] = log1pf(__expf(-p.in[I_LAM][l * 384 + ch0 + tid])); cst[144 + tid] = p.in[I_CONVB][l * 384 + ch0 + tid];
#pragma unroll
            for (int j = 0; j < 4; ++j) cst[192 + j * 48 + tid] = p.in[I_CONVW][((size_t)l * 4 + j) * 384 + ch0 + tid];
            hs[tid] = 0.f;
        }
        if (tid < 144) xin[tid] = 0.f;
        const int xrow = tid / 6, xcol = (tid % 6) * 8, yid = tid - 128, yrow = yid / 6, ycol = (yid % 6) * 8;
        const bf16_t* xsrc = p.proj + ((size_t)b * TSEQ + xrow) * NP + C_DX + ch0 + xcol;
        const bf16_t* ysrc = p.proj + ((size_t)b * TSEQ + (yid >= 0 ? yrow : 0)) * NP + C_DY + ch0 + ycol;
        u32x4 px = {0u, 0u, 0u, 0u}, py = {0u, 0u, 0u, 0u};
        if (tid < 384) px = *(const u32x4*)xsrc;
        if (yid >= 0) py = *(const u32x4*)ysrc;
        __syncthreads();
        for (int tt = 0; tt < TSEQ / 64; ++tt) {
            if (tid < 384) {
#pragma unroll
                for (int q = 0; q < 4; ++q) { xin[(3 + xrow) * 48 + xcol + 2 * q] = __uint_as_float(px[q] << 16); xin[(3 + xrow) * 48 + xcol + 2 * q + 1] = __uint_as_float(px[q] & 0xFFFF0000u); }
            }
            if (yid >= 0) *(u32x4*)(yraw + yrow * 48 + ycol) = py;
            if (tt + 1 < TSEQ / 64) {
                if (tid < 384) px = *(const u32x4*)(xsrc + (size_t)(tt + 1) * 64 * NP);
                if (yid >= 0) py = *(const u32x4*)(ysrc + (size_t)(tt + 1) * 64 * NP);
            }
            __syncthreads();
            for (int e = tid; e < 64 * 48; e += NT) {
                const int t = e / 48, cidx = e % 48; float a = cst[144 + cidx];
#pragma unroll
                for (int j = 0; j < 4; ++j) a += cst[192 + j * 48 + cidx] * xin[(t + j) * 48 + cidx];
                xc[e] = a; xcb[t * LQ + cidx] = f2bf(a);
            }
            __syncthreads();
            {
                const int ci = wave >> 2, ni = wave & 3;
                f32x16 g;
#pragma unroll
                for (int i = 0; i < 16; ++i) g[i] = 0.f;
#pragma unroll
                for (int st = 0; st < 3; ++st)
                    g = __builtin_amdgcn_mfma_f32_32x32x16_bf16(*(const bf16x8*)(xcb + (ci * 32 + r) * LQ + 16 * st + 8 * hf), *(const bf16x8*)(WT + (ni * 32 + r) * LQ + 16 * st + 8 * hf), g, 0, 0, 0);
                const int d = (ni & 1) * 32 + r;
                if (d < 48) {
                    if (ni < 2) {
                        const float brv = cst[d], spv = cst[96 + d];
#pragma unroll
                        for (int i = 0; i < 16; ++i) {
                            const int t = ci * 32 + (i & 3) + 8 * (i >> 2) + 4 * hf;
                            const float la = -8.0f * sigmoidf_(g[i] + brv) * spv;
                            aa[t * 48 + d] = __expf(la); ff[t * 48 + d] = sqrtf(-expm1f(2.0f * la)) * xc[t * 48 + d];
                        }
                    } else {
                        const float biv = cst[48 + d];
#pragma unroll
                        for (int i = 0; i < 16; ++i) { const int t = ci * 32 + (i & 3) + 8 * (i >> 2) + 4 * hf; gg[t * 48 + d] = sigmoidf_(g[i] + biv); }
                    }
                }
                if (tid < 144) xin[tid] = xin[64 * 48 + tid];
            }
            __syncthreads();
            if (tid < 384) {
                const int d = tid % 48, sg = tid / 48; float ap = 1.f, hl = 0.f;
#pragma unroll
                for (int i = 0; i < 8; ++i) {
                    const int e = (sg * 8 + i) * 48 + d; const float av = aa[e];
                    hl = av * hl + ff[e] * gg[e]; ap *= av; aa[e] = ap; ff[e] = hl;
                }
                segA[sg * 48 + d] = ap; segH[sg * 48 + d] = hl;
            }
            __syncthreads();
            if (tid < 48) {
                float cin = hs[tid];
#pragma unroll
                for (int sg = 0; sg < 8; ++sg) { car[sg * 48 + tid] = cin; cin = segA[sg * 48 + tid] * cin + segH[sg * 48 + tid]; }
                hs[tid] = cin;
            }
            __syncthreads();
            if (tid < 384) {
                const int t = tid / 6, d0 = (tid % 6) * 8, sg = t >> 3;
                const u32x4 yv = *(const u32x4*)(yraw + t * 48 + d0);
                float o[8];
#pragma unroll
                for (int q = 0; q < 8; ++q) {
                    const int e = t * 48 + d0 + q;
                    const float h = ff[e] + aa[e] * car[sg * 48 + d0 + q];
                    const float y = (q & 1) ? __uint_as_float(yv[q >> 1] & 0xFFFF0000u) : __uint_as_float(yv[q >> 1] << 16);
                    o[q] = gelu_tanh(y) * h;
                }
                u32x4 ov; ov[0] = cvt_pk_bf16(o[0], o[1]); ov[1] = cvt_pk_bf16(o[2], o[3]); ov[2] = cvt_pk_bf16(o[4], o[5]); ov[3] = cvt_pk_bf16(o[6], o[7]);
                *(u32x4*)(p.proj + ((size_t)b * TSEQ + tt * 64 + t) * NP + C_DY + ch0 + d0) = ov;
            }
            __syncthreads();
        }
        PROBE_UNIT_END(10, u == 0);
    }
}

constexpr int AT_STAGE = 16384, AT_LDS = 3 * AT_STAGE;
template <bool MASKED>
__device__ __forceinline__ void attn_block(const bf16_t* __restrict__ proj, const bf16_t* __restrict__ Vt, int b, int qb, int cq, int ck, const float* tabAll,
                                           const unsigned* mask32, unsigned char* stage, bf16_t* __restrict__ outp, int tid) {
    const int wave = tid >> 6, lane = tid & 63, r = lane & 31, hf = lane >> 5, hh = wave >> 2, sb = wave & 3;
    const int q0 = qb * 128 + sb * 32, q = q0 + r, mykt = q0 >> 5, nkt = 4 * qb + 4;
    const int skey = (tid >> 3) & 31, sdim = (tid >> 2) & 63, shh = tid >> 8;
    const unsigned offK = (unsigned)(skey * NP + shh * 64 + (((tid & 7) ^ ((skey >> 1) & 7)) * 8));
    const unsigned offV = (unsigned)((shh * 64 + sdim) * TSEQ + (((tid & 3) ^ ((0 - (sdim >> 2)) & 3)) * 8));
    int kro[4], vro[2][2];
#pragma unroll
    for (int s = 0; s < 4; ++s) kro[s] = hh * 4096 + r * 128 + (((2 * s + hf) ^ ((r >> 1) & 7)) * 16);
#pragma unroll
    for (int db = 0; db < 2; ++db)
#pragma unroll
        for (int s = 0; s < 2; ++s) vro[db][s] = 8192 + hh * 4096 + (db * 32 + r) * 64 + (((2 * s + hf) ^ ((0 - (r >> 2)) & 3)) * 16);
    constexpr float C1 = 0.125f * LOG2E;
    const unsigned* maskq = MASKED ? mask32 + (sb * 32 + r) * 64 : nullptr;
#pragma unroll 1
    for (int rnd = 0; rnd < 3; ++rnd) {
        const int h = 2 * rnd + hh;
        const float* tab = tabAll + h * TABW;
        const bf16_t* qrow = proj + ((size_t)b * TSEQ + q) * NP + cq + h * 64 + 8 * hf;
        bf16x8 qf[4];
#pragma unroll
        for (int s = 0; s < 4; ++s) qf[s] = *(const bf16x8*)(qrow + 16 * s);
        f32x16 o0, o1;
#pragma unroll
        for (int i = 0; i < 16; ++i) { o0[i] = 0.f; o1[i] = 0.f; }
        float m = -1e30f, l = 0.f;
        const bf16_t* Kb = proj + (size_t)b * TSEQ * NP + ck + 2 * rnd * 64;
        const bf16_t* Vb = Vt + ((size_t)b * 384 + 2 * rnd * 64) * TSEQ;
#define AT_STAGE_TILE(kt_, buf_) do { \
        __builtin_amdgcn_global_load_lds((const unsigned*)(Kb + (size_t)(kt_) * 32 * NP + offK), (unsigned*)((buf_) + tid * 16), 16, 0, 0); \
        __builtin_amdgcn_global_load_lds((const unsigned*)(Vb + (kt_) * 32 + offV), (unsigned*)((buf_) + 8192 + tid * 16), 16, 0, 0); } while (0)
        AT_STAGE_TILE(0, stage);
        AT_STAGE_TILE(1, stage + AT_STAGE);
        int cur = 0;
#pragma unroll 1
        for (int kt = 0; kt < nkt; ++kt) {
            if (kt + 1 < nkt) asm volatile("s_waitcnt vmcnt(2)" ::: "memory"); else asm volatile("s_waitcnt vmcnt(0)" ::: "memory");
            __builtin_amdgcn_s_barrier();
            asm volatile("" ::: "memory");
            const int nxt = cur == 0 ? 2 : cur - 1;
            if (kt + 2 < nkt) AT_STAGE_TILE(kt + 2, stage + nxt * AT_STAGE);
            if (kt <= mykt) {
                const unsigned char* st = stage + cur * AT_STAGE;
                f32x16 sa;
#pragma unroll
                for (int i = 0; i < 16; ++i) sa[i] = 0.f;
#pragma unroll
                for (int s = 0; s < 4; ++s) sa = __builtin_amdgcn_mfma_f32_32x32x16_bf16(*(const bf16x8*)(st + kro[s]), qf[s], sa, 0, 0, 0);
                const float* tb = tab + (q - kt * 32 - 4 * hf + 32);
                unsigned w = 0u;
                if (MASKED) w = maskq[kt] >> (4 * hf);
                float sv[16]; float tmax = NEG_BIG;
#pragma unroll
                for (int i = 0; i < 16; ++i) {
                    const int ko = (i & 3) + 8 * (i >> 2);
                    float v = sa[i] * C1 + tb[-ko];
                    if (MASKED) v = ((w >> ko) & 1u) ? v : NEG_BIG;
                    sv[i] = v; tmax = fmaxf(tmax, v);
                }
                tmax = fmaxf(tmax, __shfl_xor(tmax, 32));
                const float mn = fmaxf(m, tmax);
                if (!__all(mn == m)) {
                    const float alpha = __builtin_amdgcn_exp2f(m - mn);
                    l *= alpha;
#pragma unroll
                    for (int i = 0; i < 16; ++i) { o0[i] *= alpha; o1[i] *= alpha; }
                    m = mn;
                }
                float ps = 0.f;
#pragma unroll
                for (int i = 0; i < 16; ++i) { sv[i] = __builtin_amdgcn_exp2f(sv[i] - m); ps += sv[i]; }
                l += ps;
                bf16x8 pf[2];
#pragma unroll
                for (int s = 0; s < 2; ++s) {
                    u32x4 t;
                    t[0] = cvt_pk_bf16(sv[8 * s + 0], sv[8 * s + 1]); t[1] = cvt_pk_bf16(sv[8 * s + 2], sv[8 * s + 3]);
                    t[2] = cvt_pk_bf16(sv[8 * s + 4], sv[8 * s + 5]); t[3] = cvt_pk_bf16(sv[8 * s + 6], sv[8 * s + 7]);
                    pf[s] = __builtin_bit_cast(bf16x8, t);
                }
#pragma unroll
                for (int s = 0; s < 2; ++s) {
                    o0 = __builtin_amdgcn_mfma_f32_32x32x16_bf16(*(const bf16x8*)(st + vro[0][s]), pf[s], o0, 0, 0, 0);
                    o1 = __builtin_amdgcn_mfma_f32_32x32x16_bf16(*(const bf16x8*)(st + vro[1][s]), pf[s], o1, 0, 0, 0);
                }
            }
            cur = cur == 2 ? 0 : cur + 1;
        }
#undef AT_STAGE_TILE
        __builtin_amdgcn_s_barrier();
        asm volatile("" ::: "memory");
        l += __shfl_xor(l, 32);
        const float inv = 1.0f / l;
        bf16_t* orow = outp + ((size_t)b * TSEQ + q) * NP + cq + h * 64 + 4 * hf;
#pragma unroll
        for (int g = 0; g < 4; ++g) {
            *(uint2*)(orow + 8 * g) = make_uint2(cvt_pk_bf16(o0[4 * g] * inv, o0[4 * g + 1] * inv), cvt_pk_bf16(o0[4 * g + 2] * inv, o0[4 * g + 3] * inv));
            *(uint2*)(orow + 32 + 8 * g) = make_uint2(cvt_pk_bf16(o1[4 * g] * inv, o1[4 * g + 1] * inv), cvt_pk_bf16(o1[4 * g + 2] * inv, o1[4 * g + 3] * inv));
        }
    }
}

constexpr int DIL_LDS = 6 * TABW * 4 + AT_LDS;
__device__ __forceinline__ void dil_unit(const Params& p, int b, int qb, unsigned char* lds) {
    float* tab = (float*)lds;
    const int tid = opaque_tid(), wave = tid >> 6, lane = tid & 63;
    for (int i = tid; i < 6 * TABW; i += NT) tab[i] = p.biasC[i];
    __syncthreads();
    attn_block<false>(p.proj, p.VtC, b, qb, C_CQ, C_CK, tab, nullptr, lds + 6 * TABW * 4, p.proj, tid);
    __syncthreads();
}
__device__ __forceinline__ void phase_dil(const Params& p, int* ctr, volatile LAS int* slot, unsigned char* lds) {
    for (int u = grab_unit(ctr, slot); u < NBATCH * 16; u = grab_unit(ctr, slot)) { PROBE_UNIT_BEGIN(12, u == 0); dil_unit(p, u & 15, 15 - (u >> 4), lds); PROBE_UNIT_END(12, u == 0); }
}

constexpr int DSA_LDS = 6 * TABW * 4 + 128 * 64 * 4 + AT_LDS;
__device__ __forceinline__ void cnt_ge(int& c, unsigned k, unsigned t) { asm("v_cmp_ge_u32 vcc, %1, %2\n\tv_addc_co_u32 %0, vcc, 0, %0, vcc" : "+v"(c) : "v"(k), "v"(t) : "vcc"); }
__device__ __forceinline__ void cnt_gt(int& c, unsigned k, unsigned t) { asm("v_cmp_gt_u32 vcc, %1, %2\n\tv_addc_co_u32 %0, vcc, 0, %0, vcc" : "+v"(c) : "v"(k), "v"(t) : "vcc"); }
__device__ __forceinline__ void cnt_eq(int& c, unsigned k, unsigned t) { asm("v_cmp_eq_u32 vcc, %1, %2\n\tv_addc_co_u32 %0, vcc, 0, %0, vcc" : "+v"(c) : "v"(k), "v"(t) : "vcc"); }
__device__ __forceinline__ int grp16_sum(int v) { v += __shfl_xor(v, 1); v += __shfl_xor(v, 2); v += __shfl_xor(v, 4); v += __shfl_xor(v, 8); return v; }
__device__ __forceinline__ void dsa_unit(const Params& p, int b, int qb, unsigned char* lds) {
    float* tab = (float*)lds;
    unsigned* mask32 = (unsigned*)(lds + 6 * TABW * 4);
    unsigned short* mask16 = (unsigned short*)mask32;
    const int tid = opaque_tid(), wave = tid >> 6, lane = tid & 63;
    for (int i = tid; i < 6 * TABW; i += NT) tab[i] = p.biasB[i];
    for (int i = tid; i < 128 * 64; i += NT) mask32[i] = 0u;
    __syncthreads();
    const int qi = lane >> 4, kl = lane & 15;
    PROBE_UNIT_BEGIN(13, qb == 15 && b == 0);
    for (int grp = wave; grp < 32; grp += 8) {
        const int qg = qb * 128 + grp * 4, myq = qg + qi, ntile = (qg + 3) / 16 + 1;
        const bf16x8 af = *(const bf16x8*)(p.proj + ((size_t)b * TSEQ + qg + (kl >> 2)) * NP + C_IQ + (kl & 3) * 32 + 8 * qi);
        float w[4];
        {
            const uint2 wv = *(const uint2*)(p.proj + ((size_t)b * TSEQ + myq) * NP + C_IW);
            constexpr float WS = 0.5f * 0.17677669529663687f;
            w[0] = __uint_as_float(wv.x << 16) * WS; w[1] = __uint_as_float(wv.x & 0xFFFF0000u) * WS; w[2] = __uint_as_float(wv.y << 16) * WS; w[3] = __uint_as_float(wv.y & 0xFFFF0000u) * WS;
        }
        const bf16_t* kp = p.proj + ((size_t)b * TSEQ + kl) * NP + C_IK + 8 * qi;
        unsigned key[128];
#pragma unroll
        for (int c4 = 0; c4 < 32; ++c4) {
            if (c4 * 4 < ntile) {
                bf16x8 bfr[4];
                const bf16_t* kc = kp + (size_t)(c4 * 4) * 16 * NP; asm volatile("" : "+v"(kc));
#pragma unroll
                for (int i = 0; i < 4; ++i) bfr[i] = *(const bf16x8*)(kc + (size_t)i * 16 * NP);
#pragma unroll
                for (int i = 0; i < 4; ++i) {
                    const int t = c4 * 4 + i;
                    f32x4 a4 = {0.f, 0.f, 0.f, 0.f};
                    a4 = __builtin_amdgcn_mfma_f32_16x16x32_bf16(af, bfr[i], a4, 0, 0, 0);
                    float sc = w[0] * fmaxf(a4[0], 0.f) + w[1] * fmaxf(a4[1], 0.f) + w[2] * fmaxf(a4[2], 0.f) + w[3] * fmaxf(a4[3], 0.f);
                    sc += 0.0f;
                    const unsigned u = __float_as_uint(sc);
                    unsigned kk = (u & 0x80000000u) ? ~u : (u | 0x80000000u);
                    kk = kk == 0u ? 1u : kk;
                    key[t] = (t * 16 + kl <= myq) ? kk : 0u;
                }
            } else {
#pragma unroll
                for (int i = 0; i < 4; ++i) key[c4 * 4 + i] = 0u;
            }
            asm volatile("" ::: "memory");
        }
        unsigned T = 1u; int need = 0x7fffffff;
        if (qg + 3 >= 256) {
            unsigned Tb = 0u;
#pragma unroll 1
            for (int bit = 31; bit >= 0; --bit) {
                const unsigned Tc = Tb | (1u << bit);
                int c = 0;
#pragma unroll
                for (int t = 0; t < 128; ++t) cnt_ge(c, key[t], Tc);
                c = grp16_sum(c);
                Tb = (c >= 256) ? Tc : Tb;
            }
            int cgt = 0;
#pragma unroll
            for (int t = 0; t < 128; ++t) cnt_gt(cgt, key[t], Tb);
            cgt = grp16_sum(cgt);
            if (myq >= 256) { T = Tb; need = 256 - cgt; }
        }
        int ceq = 0;
#pragma unroll
        for (int t = 0; t < 128; ++t) cnt_eq(ceq, key[t], T);
        ceq = grp16_sum(ceq);
        const bool slow = __any(need != 0x7fffffff && ceq != need);
        int run = 0;
        unsigned short* mrow = mask16 + (grp * 4 + qi) * 128;
#pragma unroll
        for (int t = 0; t < 128; ++t) {
            if (t < ntile) {
                const bool gt = key[t] > T, eq = key[t] == T;
                bool take = gt || eq;
                if (slow) {
                    const unsigned long long em = __ballot(eq);
                    const unsigned bits = (unsigned)(em >> (16 * qi)) & 0xFFFFu;
                    const int rank = run + __popc(bits & ((1u << kl) - 1u));
                    take = gt || (eq && rank < need);
                    run += __popc(bits);
                }
                const unsigned long long tm = __ballot(take);
                if (kl == 0) mrow[t] = (unsigned short)((tm >> (16 * qi)) & 0xFFFFull);
            }
        }
    }
    __syncthreads();
    PROBE_UNIT_END(13, qb == 15 && b == 0);
    attn_block<true>(p.proj, p.VtB, b, qb, C_BQ, C_BK, tab, mask32, lds + 6 * TABW * 4 + 128 * 64 * 4, p.proj, tid);
    __syncthreads();
}
__device__ __forceinline__ void phase_dsa(const Params& p, int* ctr, volatile LAS int* slot, unsigned char* lds) {
    for (int u = grab_unit(ctr, slot); u < NBATCH * 16; u = grab_unit(ctr, slot)) { PROBE_UNIT_BEGIN(11, u == 0); dsa_unit(p, u & 15, 15 - (u >> 4), lds); PROBE_UNIT_END(11, u == 0); }
}

constexpr int MG_LDS = MG_GLDS + 1024 + 16 * NT * 4;
__device__ __forceinline__ void phase_merge(const Params& p, int l, int bid, int nb, unsigned char* lds) {
    GemmCtx c = gemm_ctx();
    float* srstd = (float*)(lds + MG_NS * G_BUF);
    unsigned* sgate = (unsigned*)(lds + MG_NS * G_BUF + 1024);
    constexpr int NCT = DM / 128, NUX = (NTOK / 256 / 8) * NCT;
    const float* bg = p.in[I_BGATE] + (size_t)l * 4 * DM;
    const int xcd = bid & 7, nloc = nb >> 3;
    for (int k = bid >> 3; k < NUX; k += nloc) {
        const int rt = xcd * (NTOK / 256 / 8) + k / NCT, ct = k % NCT, brow = rt * 256, bcol = ct * 128;
        if (c.tid < 256) srstd[c.tid] = rstd_of(p.part, brow + c.tid);
        __syncthreads();
        f32x4 mg[4][4]; acc_zero(mg);
        const int r = c.tid >> 2;
        for (int i = 0; i < 4; ++i) {
            f32x4 acc[4][4]; acc_zero(acc);
            gemm_kloop_s<MG_NS, true>(acc, p.hb + (size_t)brow * DM, (unsigned)(r * DM + c.sc), (unsigned)((r + 128) * DM + c.sc), p.Bt_gate + ((size_t)i * DM + bcol) * DM, (unsigned)(r * DM + c.sc), DM / 32, lds, c);
            gemm_relane(c);
            int i2 = i; asm volatile("" : "+s"(i2));
            unsigned lcol = (unsigned)(c.wc * 64 + c.fq * 4); asm volatile("" : "+v"(lcol));
            unsigned gp[2][4][2];
#pragma unroll
            for (int m = 0; m < 4; ++m) {
                const float rs = srstd[c.wr * 64 + m * 16 + c.fr];
#pragma unroll
                for (int n = 0; n < 4; ++n) {
                    const f32x4 bv = *(const f32x4*)(bg + i2 * DM + bcol + n * 16 + lcol);
                    const unsigned g0 = cvt_pk_bf16(sigmoidf_(acc[m][n][0] * rs + bv[0]), sigmoidf_(acc[m][n][1] * rs + bv[1]));
                    const unsigned g1 = cvt_pk_bf16(sigmoidf_(acc[m][n][2] * rs + bv[2]), sigmoidf_(acc[m][n][3] * rs + bv[3]));
                    if (m < 2) { sgate[((m * 4 + n) * 2 + 0) * NT + c.tid] = g0; sgate[((m * 4 + n) * 2 + 1) * NT + c.tid] = g1; }
                    else { gp[m - 2][n][0] = g0; gp[m - 2][n][1] = g1; }
                }
            }
            acc_zero(acc);
            gemm_kloop_s<MG_NS, true>(acc, p.proj + (size_t)brow * NP + C_OB + i2 * 384, (unsigned)(r * NP + c.sc), (unsigned)((r + 128) * NP + c.sc),
                                     p.Bt_br + ((size_t)i2 * DM + bcol) * 384, (unsigned)(r * 384 + c.sc), 384 / 32, lds, c);
            gemm_relane(c);
#pragma unroll
            for (int m = 0; m < 4; ++m)
#pragma unroll
                for (int n = 0; n < 4; ++n) {
                    const unsigned g0 = m < 2 ? sgate[((m * 4 + n) * 2 + 0) * NT + c.tid] : gp[m < 2 ? 0 : m - 2][n][0];
                    const unsigned g1 = m < 2 ? sgate[((m * 4 + n) * 2 + 1) * NT + c.tid] : gp[m < 2 ? 0 : m - 2][n][1];
                    mg[m][n][0] += __uint_as_float(g0 << 16) * acc[m][n][0];
                    mg[m][n][1] += __uint_as_float(g0 & 0xFFFF0000u) * acc[m][n][1];
                    mg[m][n][2] += __uint_as_float(g1 << 16) * acc[m][n][2];
                    mg[m][n][3] += __uint_as_float(g1 & 0xFFFF0000u) * acc[m][n][3];
                }
        }
        unsigned orow = (unsigned)(c.wr * 64 + c.fr), ocol = (unsigned)(c.wc * 64 + c.fq * 4); asm volatile("" : "+v"(orow), "+v"(ocol));
#pragma unroll
        for (int m = 0; m < 4; ++m) {
            bf16_t* o = p.proj + (size_t)brow * NP + C_MG + bcol + (orow + m * 16) * NP + ocol;
#pragma unroll
            for (int n = 0; n < 4; ++n) *(uint2*)(o + n * 16) = make_uint2(cvt_pk_bf16(mg[m][n][0], mg[m][n][1]), cvt_pk_bf16(mg[m][n][2], mg[m][n][3]));
        }
        __syncthreads();
    }
}

__device__ __forceinline__ void phase_out(const Params& p, int l, int bid, int nb, unsigned char* lds) {
    Gemm2Ctx c = gemm2_ctx();
    constexpr int NCT = DM / 256, NUX = (NTOK / 256 / 8) * NCT;
    const float* hin = (l == 0) ? p.in[I_X] : p.h;
    const int xcd = bid & 7, nloc = nb >> 3;
    for (int k = bid >> 3; k < NUX; k += nloc) {
        const int rt = xcd * (NTOK / 256 / 8) + k / NCT, ct = k % NCT, brow = rt * 256, bcol = ct * 256;
        f32x4 acc[8][4]; acc2_zero(acc);
        const int r = c.tid >> 2;
        gemm2_kloop<true>(acc, p.proj + (size_t)brow * NP + C_MG, (unsigned)(r * NP + c.sc), (unsigned)((r + 128) * NP + c.sc), p.Bt_out + (size_t)bcol * DM,
                          (unsigned)(r * DM + c.sc), (unsigned)((r + 128) * DM + c.sc), DM / 32, lds, c);
        gemm2_relane(c);
#pragma unroll
        for (int m = 0; m < 8; ++m) {
            const int row = brow + c.wr * 128 + m * 16 + c.fr;
            const size_t off = (size_t)row * DM + bcol + c.wc * 64 + c.fq * 4;
            float ss = 0.f;
#pragma unroll
            for (int n = 0; n < 4; ++n) {
                const f32x4 v = *(const f32x4*)(hin + off + n * 16) + acc[m][n];
                *(f32x4*)(p.h + off + n * 16) = v;
                *(uint2*)(p.hb + off + n * 16) = make_uint2(cvt_pk_bf16(v[0], v[1]), cvt_pk_bf16(v[2], v[3]));
                ss += (v[0] * v[0] + v[1] * v[1]) + (v[2] * v[2] + v[3] * v[3]);
            }
            ss += __shfl_xor(ss, 16); ss += __shfl_xor(ss, 32);
            if (c.fq == 0) p.part[(size_t)row * 16 + ct * 4 + c.wc] = ss;
        }
    }
}

constexpr int RT_W_BYTES = 1024 * 20 * 4, RT_LDS = RT_W_BYTES + (64 + 2048) * 4;
__device__ __forceinline__ void phase_router(const Params& p, int l, int bid, int nb, unsigned char* lds) {
    float* W = (float*)lds;
    const int tid = opaque_tid(), wave = tid >> 6, lane = tid & 63;
    const float* n2 = p.in[I_N2] + l * DM;
    const float* wrg = p.in[I_WRG] + (size_t)l * DM * 4;
    const float* wre = p.in[I_WRE] + (size_t)l * DM * 16;
    for (int i = tid; i < 1024 * 20; i += NT) { const int k = i / 20, j = i % 20; W[j * 1024 + k] = n2[k] * (j < 4 ? wrg[k * 4 + j] : wre[k * 16 + (j - 4)]); }
    int* cnt = p.cnt + l * 32 * 32;
    int* lcnt = (int*)(lds + RT_W_BYTES); int* lbase = lcnt + 32; int* ltok = lbase + 32; int* lcls = ltok + 1024;
    if (tid < 32) lcnt[tid] = 0;
    __syncthreads();
    int nmine = 0;
    float hn[16]; float prn = 0.f;
    {
        const int row = bid * 8 + wave;
        if (row < NTOK) {
#pragma unroll
            for (int i = 0; i < 16; ++i) hn[i] = p.h[(size_t)row * DM + i * 64 + lane];
            prn = p.part[(size_t)row * 16 + (lane & 15)];
        }
    }
    for (int row = bid * 8 + wave; row < NTOK; row += nb * 8) {
        float hv[16]; float pr = prn;
#pragma unroll
        for (int i = 0; i < 16; ++i) hv[i] = hn[i];
        {
            const int rown = row + nb * 8;
            if (rown < NTOK) {
#pragma unroll
                for (int i = 0; i < 16; ++i) hn[i] = p.h[(size_t)rown * DM + i * 64 + lane];
                prn = p.part[(size_t)rown * 16 + (lane & 15)];
            }
        }
        pr += __shfl_xor(pr, 1); pr += __shfl_xor(pr, 2); pr += __shfl_xor(pr, 4); pr += __shfl_xor(pr, 8);
        const float rs = rsqrtf(pr * (1.0f / 1024.0f) + EPS);
        float a[20];
#pragma unroll
        for (int j = 0; j < 20; ++j) a[j] = 0.f;
#pragma unroll 1
        for (int i4 = 0; i4 < 4; ++i4) {
#pragma unroll
            for (int ii = 0; ii < 4; ++ii) {
                const float* w = W + (i4 * 4 + ii) * 64 + lane;
                const float h1 = ii == 0 ? hv[0] : (ii == 1 ? hv[1] : (ii == 2 ? hv[2] : hv[3]));
#pragma unroll
                for (int j = 0; j < 20; ++j) a[j] += h1 * w[j * 1024];
            }
#pragma unroll
            for (int q = 0; q < 12; ++q) hv[q] = hv[q + 4];
        }
#pragma unroll
        for (int j = 0; j < 20; ++j) a[j] = wave_sum(a[j]);
        if (lane == 0) {
            float gl[4];
#pragma unroll
            for (int j = 0; j < 4; ++j) gl[j] = a[j] * rs + p.in[I_BRG][l * 4 + j];
            int g = 0; float gm = gl[0];
#pragma unroll
            for (int j = 1; j < 4; ++j) if (gl[j] > gm) { gm = gl[j]; g = j; }
            float den = 0.f;
#pragma unroll
            for (int j = 0; j < 4; ++j) den += __expf(gl[j] - gm);
            const float gw = 1.0f / den;
            float el[4];
#pragma unroll
            for (int j = 0; j < 4; ++j) {
                float v = 0.f;
#pragma unroll
                for (int gg = 0; gg < 4; ++gg) v = (gg == g) ? (a[4 + gg * 4 + j] * rs + p.in[I_BRE][l * 16 + gg * 4 + j]) : v;
                el[j] = v;
            }
            int i1 = 0; float v1 = el[0];
#pragma unroll
            for (int j = 1; j < 4; ++j) if (el[j] > v1) { v1 = el[j]; i1 = j; }
            int i2 = -1; float v2 = -3.0e38f;
#pragma unroll
            for (int j = 0; j < 4; ++j) if (j != i1 && el[j] > v2) { v2 = el[j]; i2 = j; }
            const float e2 = __expf(v2 - v1);
            const float w1 = gw / (1.0f + e2), w2 = gw * e2 / (1.0f + e2);
            const int lo = i1 < i2 ? i1 : i2, hi = i1 < i2 ? i2 : i1;
            const float wlo = i1 < i2 ? w1 : w2, whi = i1 < i2 ? w2 : w1;
            const int pidx = lo == 0 ? (hi - 1) : (lo == 1 ? (hi + 1) : 5);
            const int cls = g * 6 + pidx;
            const int lr = __hip_atomic_fetch_add(&lcnt[cls], 1, __ATOMIC_RELAXED, __HIP_MEMORY_SCOPE_WORKGROUP);
            ltok[nmine * 8 + wave] = row; lcls[nmine * 8 + wave] = cls | (lr << 8);
            p.tokw[(size_t)row * 2] = wlo; p.tokw[(size_t)row * 2 + 1] = whi;
        }
        ++nmine;
    }
    __syncthreads();
    if (tid < NCLS) lbase[tid] = lcnt[tid] > 0 ? __hip_atomic_fetch_add(&cnt[tid * 32], lcnt[tid], __ATOMIC_RELAXED, __HIP_MEMORY_SCOPE_AGENT) : 0;
    __syncthreads();
    for (int i = tid; i < nmine * 8; i += NT) {
        const int cl = lcls[i] & 255, lr = lcls[i] >> 8;
        p.perm[(size_t)cl * NTOK + lbase[cl] + lr] = ltok[i];
    }
}

__device__ __forceinline__ void cls_experts(int cls, int& elo, int& ehi) {
    const int g = cls / 6, pi = cls % 6;
    const int lo = pi < 3 ? 0 : (pi < 5 ? 1 : 2), hi = pi < 3 ? pi + 1 : (pi < 5 ? pi - 1 : 3);
    elo = g * 4 + lo; ehi = g * 4 + hi;
}
__device__ __forceinline__ void moe_prefix(const int* cnt, int* spre, int* scnt) {
    if (opaque_tid() == 0) { int s = 0; for (int c = 0; c < NCLS; ++c) { const int n = cnt[c * 32]; scnt[c] = n; spre[c] = s; s += (n + 255) >> 8; } spre[NCLS] = s; }
    __syncthreads();
}

__device__ __forceinline__ void phase_moe1(const Params& p, int l, int bid, int nb, unsigned char* lds) {
    Gemm2Ctx c = gemm2_ctx();
    int* spre = (int*)(lds + G2_LDS); int* scnt = spre + 32;
    int* stok = scnt + 32; float* srs = (float*)(stok + 256); float* swl = srs + 256; float* swh = swl + 256;
    moe_prefix(p.cnt + l * 32 * 32, spre, scnt);
    const int nrt = spre[NCLS], nrtx = (nrt + 7) >> 3, xcd = bid & 7, nloc = nb >> 3;
    const int rt_lo = xcd * nrtx, rt_hi = rt_lo + nrtx < nrt ? rt_lo + nrtx : nrt;
    for (int k = bid >> 3; k < (rt_hi - rt_lo) * 8; k += nloc) {
        const int rt = rt_lo + (k >> 3), ct = k & 7;
        int cls = 0;
        for (int q = 1; q < NCLS; ++q) if (spre[q] <= rt) cls = q;
        int elo, ehi; cls_experts(cls, elo, ehi);
        const int lrow0 = (rt - spre[cls]) * 256, n = scnt[cls];
        if (c.tid < 256) {
            const int lr = lrow0 + c.tid; const bool ok = lr < n;
            const int tok = ok ? p.perm[(size_t)cls * NTOK + lr] : 0;
            stok[c.tid] = ok ? tok : -1; srs[c.tid] = rstd_of(p.part, tok);
            swl[c.tid] = p.tokw[(size_t)tok * 2]; swh[c.tid] = p.tokw[(size_t)tok * 2 + 1];
        }
        __syncthreads();
        const int r = c.tid >> 2;
        const int t0 = stok[r] < 0 ? 0 : stok[r], t1 = stok[r + 128] < 0 ? 0 : stok[r + 128];
        const int ex = ct < 4 ? elo : ehi;
        f32x4 acc[8][4]; acc2_zero(acc);
        gemm2_kloop<true>(acc, p.hb, (unsigned)(t0 * DM + c.sc), (unsigned)(t1 * DM + c.sc), p.Wgu + ((size_t)ex * DM + (ct & 3) * 256) * DM,
                          (unsigned)(r * DM + c.sc), (unsigned)((r + 128) * DM + c.sc), DM / 32, lds, c);
        gemm2_relane(c);
#pragma unroll
        for (int m = 0; m < 8; ++m) {
            const int rl = c.wr * 128 + m * 16 + c.fr; const float rs = srs[rl], w = ct < 4 ? swl[rl] : swh[rl];
            bf16_t* o = p.Hbuf + ((size_t)rt * 256 + rl) * DM + (ct < 4 ? 0 : 512) + (ct & 3) * 128 + c.wc * 32 + c.fq * 4;
#pragma unroll
            for (int n2 = 0; n2 < 2; ++n2) {
                float hv[4];
#pragma unroll
                for (int j = 0; j < 4; ++j) hv[j] = siluf_(acc[m][n2][j] * rs) * (acc[m][n2 + 2][j] * rs) * w;
                *(uint2*)(o + n2 * 16) = make_uint2(cvt_pk_bf16(hv[0], hv[1]), cvt_pk_bf16(hv[2], hv[3]));
            }
        }
        __syncthreads();
    }
}

__device__ __forceinline__ void phase_moe2(const Params& p, int l, int bid, int nb, unsigned char* lds) {
    Gemm2Ctx c = gemm2_ctx();
    int* spre = (int*)(lds + G2_LDS); int* scnt = spre + 32; int* stok = scnt + 32;
    moe_prefix(p.cnt + l * 32 * 32, spre, scnt);
    const int nrt = spre[NCLS], nrtx = (nrt + 7) >> 3, xcd = bid & 7, nloc = nb >> 3;
    const int rt_lo = xcd * nrtx, rt_hi = rt_lo + nrtx < nrt ? rt_lo + nrtx : nrt;
    for (int k = bid >> 3; k < (rt_hi - rt_lo) * 4; k += nloc) {
        const int rt = rt_lo + (k >> 2), ct = k & 3;
        int cls = 0;
        for (int q = 1; q < NCLS; ++q) if (spre[q] <= rt) cls = q;
        int elo, ehi; cls_experts(cls, elo, ehi);
        const int lrow0 = (rt - spre[cls]) * 256, n = scnt[cls];
        if (c.tid < 256) { const int lr = lrow0 + c.tid; stok[c.tid] = lr < n ? p.perm[(size_t)cls * NTOK + lr] : -1; }
        __syncthreads();
        const int r = c.tid >> 2;
        f32x4 acc[8][4]; acc2_zero(acc);
        const bf16_t* a0 = p.Hbuf + (size_t)rt * 256 * DM;
        const unsigned oa0 = (unsigned)(r * DM + c.sc), oa1 = (unsigned)((r + 128) * DM + c.sc), ob0 = (unsigned)(r * 512 + c.sc), ob1 = (unsigned)((r + 128) * 512 + c.sc);
        gemm2_kloop<true>(acc, a0, oa0, oa1, p.WdT + ((size_t)elo * DM + ct * 256) * 512, ob0, ob1, 16, lds, c);
        gemm2_relane(c);
        gemm2_kloop<true>(acc, a0 + 512, oa0, oa1, p.WdT + ((size_t)ehi * DM + ct * 256) * 512, ob0, ob1, 16, lds, c);
        gemm2_relane(c);
#pragma unroll
        for (int m = 0; m < 8; ++m) {
            const int rl = c.wr * 128 + m * 16 + c.fr; const int tok = stok[rl];
            const size_t off = (size_t)(tok < 0 ? 0 : tok) * DM + ct * 256 + c.wc * 64 + c.fq * 4;
            float ss = 0.f;
            if (tok >= 0) {
#pragma unroll
                for (int n2 = 0; n2 < 4; ++n2) {
                    const f32x4 v = *(const f32x4*)(p.h + off + n2 * 16) + acc[m][n2];
                    *(f32x4*)(p.h + off + n2 * 16) = v;
                    *(uint2*)(p.hb + off + n2 * 16) = make_uint2(cvt_pk_bf16(v[0], v[1]), cvt_pk_bf16(v[2], v[3]));
                    ss += (v[0] * v[0] + v[1] * v[1]) + (v[2] * v[2] + v[3] * v[3]);
                }
            }
            ss += __shfl_xor(ss, 16); ss += __shfl_xor(ss, 32);
            if (c.fq == 0 && tok >= 0) p.part[(size_t)tok * 16 + ct * 4 + c.wc] = ss;
        }
        __syncthreads();
    }
}

__device__ __forceinline__ void phase_final(const Params& p, int bid, int nb) {
    const int tid = opaque_tid(), wave = tid >> 6, lane = tid & 63;
    const float* nf = p.in[I_NF];
    for (int row = bid * 8 + wave; row < NTOK; row += nb * 8) {
        const float rs = rstd_of(p.part, row);
        float* hr = p.h + (size_t)row * DM;
#pragma unroll
        for (int i = 0; i < 4; ++i) {
            f32x4 v = *(const f32x4*)(hr + i * 256 + lane * 4);
            const f32x4 g = *(const f32x4*)(nf + i * 256 + lane * 4);
            v[0] *= rs * g[0]; v[1] *= rs * g[1]; v[2] *= rs * g[2]; v[3] *= rs * g[3];
            *(f32x4*)(hr + i * 256 + lane * 4) = v;
        }
    }
}

constexpr int cmax(int a, int b) { return a > b ? a : b; }
constexpr int MEGA_LDS_BODY = cmax(cmax(cmax(GLA_LDS, LRU_LDS), cmax(DSA_LDS, DIL_LDS)), cmax(cmax(MG_LDS, RT_LDS), G2_LDS + 8192));
constexpr int MEGA_LDS = PROBE_MASK ? 160 * 1024 : MEGA_LDS_BODY + 16;


__device__ __forceinline__ const Params& kparams() {
    const __attribute__((address_space(4))) Params* q = (const __attribute__((address_space(4))) Params*)__builtin_amdgcn_kernarg_segment_ptr();
    asm volatile("" : "+s"(q));
    return *(const Params*)q;
}
__global__ void __launch_bounds__(NT, 2) mega(Params p_kernarg) {
    (void)p_kernarg;
#define p kparams()
    unsigned char* lds = dyn_lds;
    volatile LAS unsigned* xbw = (volatile LAS unsigned*)(dyn_lds + MEGA_LDS_BODY);
    if (threadIdx.x == 0) { xbw[0] = 0u; xbw[1] = 0u; xbw[2] = 0u; xbw[3] = 0u; }
    __syncthreads();
    (void)xcd_barrier_post(p.bar, xbw);
#define PROBE_TICK(type) do { if (PROBE_MASK != 0 && blockIdx.x == 0 && threadIdx.x == 0) { volatile LAS unsigned long long* pw = (volatile LAS unsigned long long*)(dyn_lds + PROBE_OFF); \
        const unsigned long long now = __builtin_amdgcn_s_memrealtime(); if ((PROBE_MASK >> (type)) & 1) pw[1] += now - pw[0]; pw[0] = now; } } while (0)
#define PROBE_SINCE(bit) do { if (((PROBE_MASK >> (bit)) & 1) && blockIdx.x == 0 && threadIdx.x == 0) { volatile LAS unsigned long long* pw = (volatile LAS unsigned long long*)(dyn_lds + PROBE_OFF); \
        pw[1] += __builtin_amdgcn_s_memrealtime() - pw[0]; } } while (0)
#define GRID_SYNC() do { XcdBarrier _b; _b.bar = p.bar; _b.x = xb_xcc_id(); _b.st = (volatile LAS unsigned*)(dyn_lds + MEGA_LDS_BODY); xcd_barrier(_b); } while (0)
    const int bid = blockIdx.x, nb = gridDim.x;
    if (PROBE_MASK != 0 && threadIdx.x == 0) { volatile LAS unsigned long long* pw = (volatile LAS unsigned long long*)(dyn_lds + PROBE_OFF); pw[0] = __builtin_amdgcn_s_memrealtime(); pw[1] = 0ull; }
    phase_prep(p, bid, nb);
    GRID_SYNC(); PROBE_TICK(0);
#pragma unroll 1
    for (int l = 0; l < DEPTH; ++l) {
        phase_weights(p, l, bid, nb, lds);
        GRID_SYNC(); PROBE_TICK(1);
        phase_inproj(p, bid, nb, lds);
        GRID_SYNC(); PROBE_TICK(2);
        if (PROBE_GEMM_VAR >= 0 && l == 0) { phase_gemm_probe<PROBE_GEMM_VAR>(p, bid, nb, lds); GRID_SYNC(); }
        {
            volatile LAS int* slot = (volatile LAS int*)(dyn_lds + MEGA_LDS_BODY + 12);
            int* qc = p.cnt + (l * 32 + 24) * 32;
            phase_gla(p, l, qc + 0 * 32, slot, lds); PROBE_SINCE(14);
            phase_lru(p, l, qc + 1 * 32, slot, lds); PROBE_SINCE(15);
            phase_dsa(p, qc + 2 * 32, slot, lds); PROBE_SINCE(16);
            phase_dil(p, qc + 3 * 32, slot, lds); PROBE_SINCE(17);
        }
        GRID_SYNC(); PROBE_TICK(3);
        phase_merge(p, l, bid, nb, lds);
        GRID_SYNC(); PROBE_TICK(4);
        phase_out(p, l, bid, nb, lds);
        GRID_SYNC(); PROBE_TICK(5);
        phase_router(p, l, bid, nb, lds);
        GRID_SYNC(); PROBE_TICK(6);
        phase_moe1(p, l, bid, nb, lds);
        GRID_SYNC(); PROBE_TICK(7);
        phase_moe2(p, l, bid, nb, lds);
        GRID_SYNC(); PROBE_TICK(8);
    }
    phase_final(p, bid, nb);
    if (PROBE_MASK != 0 && threadIdx.x == 0) { volatile LAS unsigned long long* pw = (volatile LAS unsigned long long*)(dyn_lds + PROBE_OFF);
        const unsigned long long t0 = __builtin_amdgcn_s_memrealtime(), w = pw[1]; while (__builtin_amdgcn_s_memrealtime() - t0 < w) __builtin_amdgcn_s_sleep(8); }
#undef p
}

static size_t align_up(size_t v, size_t a) { return (v + a - 1) / a * a; }

extern "C" void kernel_launch(void* const* d_in, const int* in_sizes, int n_in, void* d_out, int out_size, void* d_ws, size_t ws_size, hipStream_t stream) {
    (void)in_sizes; (void)n_in; (void)out_size;
    Params p{};
    for (int i = 0; i < N_IN; ++i) p.in[i] = (const float*)d_in[i];
    p.h = (float*)d_out;
    unsigned char* w = (unsigned char*)d_ws; size_t off = 0;
    auto take = [&](size_t bytes) { unsigned char* r = w + off; off = align_up(off + bytes, 256); return r; };
    p.bar = (unsigned*)take(XCD_BAR_WORDS * 4);
    p.cnt = (int*)take(DEPTH * 32 * 32 * 4);
    p.Bt_in = (bf16_t*)take((size_t)NP * DM * 2);
    p.Bt_gate = (bf16_t*)take((size_t)4 * DM * DM * 2);
    p.Bt_br = (bf16_t*)take((size_t)4 * DM * 384 * 2);
    p.Bt_out = (bf16_t*)take((size_t)DM * DM * 2);
    p.Wgu = (bf16_t*)take((size_t)16 * DM * DM * 2);
    p.WdT = (bf16_t*)take((size_t)16 * DM * 512 * 2);
    p.hb = (bf16_t*)take((size_t)NTOK * DM * 2);
    p.part = (float*)take((size_t)NTOK * 16 * 4);
    p.biasB = (float*)take(6 * TABW * 4);
    p.biasC = (float*)take(6 * TABW * 4);
    p.VtB = (bf16_t*)take((size_t)NTOK * 384 * 2);
    p.VtC = (bf16_t*)take((size_t)NTOK * 384 * 2);
    p.tokw = (float*)take((size_t)NTOK * 2 * 4);
    p.perm = (int*)take((size_t)NCLS * NTOK * 4);
    p.proj = (bf16_t*)take((size_t)NTOK * NP * 2);
    p.Hbuf = p.proj;
    if (off > ws_size) return;

    static int grid = 0;
    if (grid == 0) {
        int dev = 0, cus = 0;
        (void)hipGetDevice(&dev);
        (void)hipDeviceGetAttribute(&cus, hipDeviceAttributeMultiprocessorCount, dev);
        if (hipFuncSetAttribute((const void*)mega, hipFuncAttributeMaxDynamicSharedMemorySize, MEGA_LDS) != hipSuccess) { grid = -1; return; }
        int per_cu = 0;
        (void)hipOccupancyMaxActiveBlocksPerMultiprocessor(&per_cu, (const void*)mega, NT, MEGA_LDS);
        (void)hipGetLastError();
        grid = cus > 0 ? cus : 256;
    }
    if (grid < 0) return;
    (void)hipMemsetAsync(p.bar, 0, XCD_BAR_WORDS * sizeof(unsigned), stream);
    mega<<<grid, NT, MEGA_LDS, stream>>>(p);
}
```

```cpp
#include <hip/hip_runtime.h>
#include <stdint.h>

typedef unsigned short bf16_t;
typedef short bf16x8 __attribute__((ext_vector_type(8)));
typedef float f32x4 __attribute__((ext_vector_type(4)));
typedef unsigned u32x4 __attribute__((ext_vector_type(4)));
typedef float f32x16 __attribute__((ext_vector_type(16)));

constexpr int NTOK = 32768, TSEQ = 2048, NBATCH = 16, DM = 1024, DEPTH = 2;
constexpr int NP = 4608;
constexpr int NT = 512;
constexpr int C_AQ = 0, C_AK = 192, C_AV = 384, C_AG = 768, C_BQ = 1152, C_CQ = 1536, C_DY = 1920, C_BK = 2304, C_CK = 2688,
              C_BV = 3072, C_CV = 3456, C_DX = 3840, C_IQ = 4224, C_IK = 4352, C_ALR = 4384, C_IW = 4400;
constexpr int C_OB = 768;
constexpr int C_MG = 2304;
constexpr float EPS = 1e-6f;
constexpr int NCLS = 24, MAXRT = 152;
constexpr int TABW = 2080;
constexpr float LOG2E = 1.4426950408889634f, NEG_BIG = -3.0e38f;

#ifndef PROBE_MASK
#define PROBE_MASK 0
#endif
extern __shared__ __attribute__((aligned(16))) unsigned char dyn_lds[];
constexpr int PROBE_OFF = 160 * 1024 - 64;
#define PROBE_UNIT_BEGIN(bit, cond) do { if (((PROBE_MASK >> (bit)) & 1) && (cond) && threadIdx.x == 0) { volatile __attribute__((address_space(3))) unsigned long long* pw = (volatile __attribute__((address_space(3))) unsigned long long*)(dyn_lds + PROBE_OFF); pw[2] = __builtin_amdgcn_s_memrealtime(); } } while (0)
#define PROBE_UNIT_END(bit, cond) do { if (((PROBE_MASK >> (bit)) & 1) && (cond) && threadIdx.x == 0) { volatile __attribute__((address_space(3))) unsigned long long* pw = (volatile __attribute__((address_space(3))) unsigned long long*)(dyn_lds + PROBE_OFF); pw[1] += 4ull * (__builtin_amdgcn_s_memrealtime() - pw[2]); } } while (0)

enum { I_X = 0, I_WIN, I_AW2, I_AB2, I_AGAIN, I_CONVW, I_CONVB, I_WR, I_BR, I_WI, I_BI, I_LAM, I_WGATE, I_BGATE, I_WBR, I_WOUT, I_RELB,
       I_N1, I_N2, I_NF, I_WRG, I_BRG, I_WRE, I_BRE, I_MWG, I_MWU, I_MWD, N_IN };

struct Params {
    const float* in[N_IN];
    float* h;
    bf16_t* Bt_in;
    bf16_t* Bt_gate;
    bf16_t* Bt_br;
    bf16_t* Bt_out;
    bf16_t* Wgu;
    bf16_t* WdT;
    bf16_t* hb;
    bf16_t* proj;
    bf16_t* Hbuf;
    float* part;
    float* biasB;
    float* biasC;
    bf16_t* VtB;
    bf16_t* VtC;
    float* tokw;
    int* perm;
    int* cnt;
    unsigned* bar;
};

__device__ __forceinline__ bf16_t f2bf(float f) { unsigned u = __float_as_uint(f); u += 0x7FFFu + ((u >> 16) & 1u); return (bf16_t)(u >> 16); }
__device__ __forceinline__ float bf2f(bf16_t b) { return __uint_as_float(((unsigned)b) << 16); }
__device__ __forceinline__ float wave_sum(float v) {
#pragma unroll
    for (int o = 32; o > 0; o >>= 1) v += __shfl_xor(v, o);
    return v;
}
__device__ __forceinline__ float wave_max(float v) {
#pragma unroll
    for (int o = 32; o > 0; o >>= 1) v = fmaxf(v, __shfl_xor(v, o));
    return v;
}
__device__ __forceinline__ int wave_sum_i(int v) {
#pragma unroll
    for (int o = 32; o > 0; o >>= 1) v += __shfl_xor(v, o);
    return v;
}
__device__ __forceinline__ int opaque_tid() { int t = threadIdx.x; asm volatile("" : "+v"(t)); return t; }
__device__ __forceinline__ unsigned cvt_pk_bf16(float lo, float hi) { unsigned r; asm volatile("v_cvt_pk_bf16_f32 %0, %1, %2" : "=v"(r) : "v"(lo), "v"(hi)); return r; }
__device__ __forceinline__ float sigmoidf_(float x) { return 1.0f / (1.0f + __expf(-x)); }
__device__ __forceinline__ float siluf_(float x) { return x / (1.0f + __expf(-x)); }
__device__ __forceinline__ float rstd_of(const float* part, int row) {
    const f32x4* p = (const f32x4*)(part + (size_t)row * 16);
    f32x4 a = p[0], b = p[1], c = p[2], d = p[3];
    float s = ((a[0] + a[1]) + (a[2] + a[3])) + ((b[0] + b[1]) + (b[2] + b[3])) + ((c[0] + c[1]) + (c[2] + c[3])) + ((d[0] + d[1]) + (d[2] + d[3]));
    return rsqrtf(s * (1.0f / 1024.0f) + EPS);
}
__device__ __forceinline__ int map_in_col(int c) {
    if (c < 1152) return c;
    if (c < 1536) return 1168 + (c - 1152);
    if (c < 1920) return 2484 + (c - 1536);
    if (c < 2304) return 3636 + (c - 1920);
    if (c < 2688) return 1552 + (c - 2304);
    if (c < 3072) return 2868 + (c - 2688);
    if (c < 3456) return 1936 + (c - 3072);
    if (c < 3840) return 3252 + (c - 3456);
    if (c < 4224) return 4020 + (c - 3840);
    if (c < 4352) return 2320 + (c - 4224);
    if (c < 4384) return 2448 + (c - 4352);
    if (c < 4400) return 1152 + (c - 4384);
    if (c < 4404) return 2480 + (c - 4400);
    return -1;
}
__device__ __forceinline__ int rel_bucket(int n) {
    if (n < 16) return n;
    float v = logf((float)n / 16.0f) / 4.852030263919617f * 16.0f;
    int b = 16 + (int)v;
    return b < 31 ? b : 31;
}

#define XB_TMO      128
#define XB_XCNT(j)  (256  + 64 * (j))
#define XB_XSUB(j)  (1280 + 64 * (j))
#define XB_XGEN(j)  (2304 + 64 * (j))
#define XB_TOP      3328
#define XB_TOPGEN   3392
#define XCD_BAR_WORDS 3456
#define XB_SPIN_CAP (1u << 18)
#define LAS __attribute__((address_space(3)))

__device__ __forceinline__ unsigned xb_ld(unsigned* p)              { return __hip_atomic_load(p, __ATOMIC_RELAXED, __HIP_MEMORY_SCOPE_AGENT); }
__device__ __forceinline__ unsigned xb_add(unsigned* p, unsigned v) { return __hip_atomic_fetch_add(p, v, __ATOMIC_RELAXED, __HIP_MEMORY_SCOPE_AGENT); }
__device__ __forceinline__ unsigned xb_xcc_id() { return (unsigned)__builtin_amdgcn_s_getreg((3 << 11) | 20) & 0xFu; }
#define XB_SPIN(cond, bar) do { unsigned _sp = 0; while (cond) { __builtin_amdgcn_s_sleep(1); \
    if ((++_sp & 255u) == 0u) { if (xb_ld(&(bar)[XB_TMO])) break; if (_sp > XB_SPIN_CAP) { atomicAdd(&(bar)[XB_TMO], 1u); break; } } } } while (0)

struct XcdBarrier {
    unsigned* bar; unsigned x;
    volatile LAS unsigned* st;
};

__device__ __forceinline__ XcdBarrier xcd_barrier_post(unsigned* bar, volatile LAS unsigned* st) {
    XcdBarrier b; b.bar = bar; b.x = xb_xcc_id(); b.st = st;
    if (threadIdx.x == 0) (void)xb_add(&bar[XB_XCNT(b.x)], 1u);
    return b;
}
__device__ __forceinline__ void xcd_barrier_complete(unsigned* bar, unsigned x, unsigned& nloc, unsigned& nx) {
    const unsigned G = gridDim.x * gridDim.y * gridDim.z;
    unsigned sum, cnt, mine, sp = 0u;
    for (;;) {
        sum = 0u; cnt = 0u; mine = 0u;
#pragma unroll
        for (unsigned j = 0; j < 16; ++j) { const unsigned c = xb_ld(&bar[XB_XCNT(j)]); sum += c; cnt += (c > 0u) ? 1u : 0u; mine = (j == x) ? c : mine; }
        if (sum == G) break;
        __builtin_amdgcn_s_sleep(1);
        if ((++sp & 255u) == 0u) { if (xb_ld(&bar[XB_TMO])) break; if (sp > XB_SPIN_CAP) { atomicAdd(&bar[XB_TMO], 1u); break; } }
    }
    nloc = mine > 0u ? mine : 1u; nx = cnt > 0u ? cnt : 1u;
}

__device__ __forceinline__ void xcd_barrier(const XcdBarrier& b) {
    asm volatile("s_waitcnt vmcnt(0)" ::: "memory");
    __syncthreads();
    if (threadIdx.x == 0) {
        unsigned* bar = b.bar;
        __builtin_amdgcn_s_waitcnt(0);
        unsigned nloc = b.st[0], nx = b.st[1];
        if (nloc == 0u) { xcd_barrier_complete(bar, b.x, nloc, nx); b.st[0] = nloc; b.st[1] = nx; }
        const unsigned old = xb_add(&bar[XB_XSUB(b.x)], 1u);
        const unsigned gen = old / nloc;
        if (old + 1u == (gen + 1u) * nloc) {
            __builtin_amdgcn_fence(__ATOMIC_RELEASE, "agent");
            asm volatile("s_waitcnt vmcnt(0)" ::: "memory");
            const unsigned og = xb_add(&bar[XB_TOP], 1u);
            const unsigned tg = og / nx;
            if (og + 1u == (tg + 1u) * nx) xb_add(&bar[XB_TOPGEN], 1u);
            else XB_SPIN(xb_ld(&bar[XB_TOPGEN]) == tg, bar);
            __builtin_amdgcn_fence(__ATOMIC_ACQUIRE, "agent");
            xb_add(&bar[XB_XGEN(b.x)], 1u);
            asm volatile("s_waitcnt vmcnt(0)" ::: "memory");
        } else {
            XB_SPIN(xb_ld(&bar[XB_XGEN(b.x)]) == gen, bar);
            __builtin_amdgcn_fence(__ATOMIC_ACQUIRE, "agent");
            asm volatile("s_waitcnt vmcnt(0)" ::: "memory");
        }
    }
    __syncthreads();
}


template <class MapF>
__device__ __forceinline__ void conv_wT(const float* __restrict__ src, int ldsrc, int K, bf16_t* __restrict__ dst, int nrows, MapF colmap,
                                        const float* __restrict__ scale, int bid, int nb, float* tile) {
    const int tid = opaque_tid(), nkt = K / 64, ntile = (nrows / 64) * nkt;
    for (int t = bid; t < ntile; t += nb) {
        const int r0 = (t / nkt) * 64, k0 = (t % nkt) * 64;
#pragma unroll
        for (int i = 0; i < 8; ++i) {
            const int e = tid + NT * i, kk = e >> 6, rr = e & 63;
            const int c = colmap(r0 + rr);
            float v = 0.f;
            if (c >= 0) { v = src[(size_t)(k0 + kk) * ldsrc + c]; if (scale) v *= scale[k0 + kk]; }
            tile[kk * 65 + rr] = v;
        }
        __syncthreads();
#pragma unroll
        for (int i = 0; i < 8; ++i) {
            const int e = tid + NT * i, rr = e >> 6, kk = e & 63;
            dst[(size_t)(r0 + rr) * K + k0 + kk] = f2bf(tile[kk * 65 + rr]);
        }
        __syncthreads();
    }
}

__device__ __forceinline__ void phase_weights(const Params& p, int l, int bid, int nb, unsigned char* lds) {
    float* tile = (float*)lds;
    const float* n1 = p.in[I_N1] + l * DM;
    const float* n2 = p.in[I_N2] + l * DM;
    conv_wT(p.in[I_WIN] + (size_t)l * DM * 4404, 4404, DM, p.Bt_in, NP, [](int r) { return map_in_col(r); }, n1, bid, nb, tile);
    for (int i = 0; i < 4; ++i) {
        conv_wT(p.in[I_WGATE] + ((size_t)l * 4 + i) * DM * DM, DM, DM, p.Bt_gate + (size_t)i * DM * DM, DM, [](int r) { return r; }, n1, bid, nb, tile);
        conv_wT(p.in[I_WBR] + ((size_t)l * 4 + i) * 384 * DM, DM, 384, p.Bt_br + (size_t)i * DM * 384, DM, [](int r) { return r; }, nullptr, bid, nb, tile);
    }
    conv_wT(p.in[I_WOUT] + (size_t)l * DM * DM, DM, DM, p.Bt_out, DM, [](int r) { return r; }, nullptr, bid, nb, tile);
    for (int e = 0; e < 16; ++e) {
        const float* wg = p.in[I_MWG] + ((size_t)l * 16 + e) * DM * 512;
        const float* wu = p.in[I_MWU] + ((size_t)l * 16 + e) * DM * 512;
        bf16_t* dst = p.Wgu + (size_t)e * DM * DM;
        {
            const int tid = opaque_tid();
            for (int t = bid; t < 16 * 16; t += nb) {
                const int r0 = (t / 16) * 64, k0 = (t % 16) * 64;
#pragma unroll
                for (int i = 0; i < 8; ++i) {
                    const int ee = tid + NT * i, kk = ee >> 6, rr = ee & 63, rho = r0 + rr;
                    const int T = rho >> 8, wc = (rho >> 6) & 3, q = (rho >> 5) & 1, ii = rho & 31, hcol = 128 * T + 32 * wc + ii;
                    const float* s = q ? wu : wg;
                    tile[kk * 65 + rr] = s[(size_t)(k0 + kk) * 512 + hcol] * n2[k0 + kk];
                }
                __syncthreads();
#pragma unroll
                for (int i = 0; i < 8; ++i) {
                    const int ee = tid + NT * i, rr = ee >> 6, kk = ee & 63;
                    dst[(size_t)(r0 + rr) * DM + k0 + kk] = f2bf(tile[kk * 65 + rr]);
                }
                __syncthreads();
            }
        }
        conv_wT(p.in[I_MWD] + ((size_t)l * 16 + e) * 512 * DM, DM, 512, p.WdT + (size_t)e * DM * 512, DM, [](int r) { return r; }, nullptr, bid, nb, tile);
    }
}

__device__ __forceinline__ void phase_prep(const Params& p, int bid, int nb) {
    const int tid = opaque_tid(), wave = tid >> 6, lane = tid & 63;
    const float* x = p.in[I_X];
    for (int row = bid * 8 + wave; row < NTOK; row += nb * 8) {
        const float* xr = x + (size_t)row * DM;
        float s = 0.f;
#pragma unroll
        for (int i = 0; i < 4; ++i) {
            const f32x4 v = *(const f32x4*)(xr + i * 256 + lane * 4);
            s += v[0] * v[0] + v[1] * v[1] + v[2] * v[2] + v[3] * v[3];
            const unsigned lo = (unsigned)f2bf(v[0]) | ((unsigned)f2bf(v[1]) << 16), hi = (unsigned)f2bf(v[2]) | ((unsigned)f2bf(v[3]) << 16);
            *(uint2*)(p.hb + (size_t)row * DM + i * 256 + lane * 4) = make_uint2(lo, hi);
        }
        s = wave_sum(s);
        if (lane < 16) p.part[(size_t)row * 16 + lane] = (lane == 0) ? s : 0.f;
    }
    const float* rb = p.in[I_RELB];
    for (int i = bid * NT + tid; i < 6 * TABW; i += nb * NT) {
        const int h = i / TABW, d = i % TABW - 32;
        float vb = NEG_BIG, vc = NEG_BIG;
        if (d >= 0) {
            const int bk = rel_bucket(d);
            vb = rb[bk * 12 + h] * LOG2E;
            const int m = (d <= 128 ? 1 : 0) + ((d % 4 == 0 && d <= 512) ? 1 : 0) + ((d % 16 == 0) ? 1 : 0);
            if (m > 0) vc = (rb[bk * 12 + 6 + h] + logf((float)m)) * LOG2E;
        }
        p.biasB[i] = vb; p.biasC[i] = vc;
    }
    for (int i = bid * NT + tid; i < DEPTH * 32 * 32; i += nb * NT) p.cnt[i] = 0;
}

constexpr int G_BUF = 256 * 32 * 2 + 128 * 32 * 2;
constexpr int G_NS = 6, G_LDS = G_NS * G_BUF;
constexpr int MG_NS = 5, MG_GLDS = MG_NS * G_BUF;
struct GemmCtx { int tid, wid, lane, wr, wc, fr, fq, sc, rdo; };
__device__ __forceinline__ GemmCtx gemm_ctx() {
    GemmCtx c; c.tid = opaque_tid(); c.wid = __builtin_amdgcn_readfirstlane(c.tid >> 6); c.lane = c.tid & 63; c.wr = c.wid >> 1; c.wc = c.wid & 1; c.fr = c.lane & 15; c.fq = c.lane >> 4;
    c.sc = (((c.tid & 3) ^ ((0 - (c.tid >> 4)) & 3))) * 8;
    c.rdo = c.fr * 64 + ((c.fq ^ ((0 - (c.fr >> 2)) & 3)) * 16);
    return c;
}
__device__ __forceinline__ void gemm_relane(GemmCtx& c) { int t = c.tid; asm volatile("" : "+v"(t)); c.lane = t & 63; c.fr = t & 15; c.fq = (t >> 4) & 3; }
__device__ __forceinline__ void acc_zero(f32x4 (&acc)[4][4]) {
#pragma unroll
    for (int m = 0; m < 4; ++m)
#pragma unroll
        for (int n = 0; n < 4; ++n) acc[m][n] = (f32x4){0.f, 0.f, 0.f, 0.f};
}
__device__ __forceinline__ unsigned lds_addr(const void* p) { return (unsigned)(size_t)(const LAS unsigned char*)p; }
__device__ __forceinline__ void glds16_s(const void* sbase, unsigned voff_bytes, unsigned lds_dst) {
    unsigned keep;
    asm volatile("s_mov_b32 %0, m0\n\ts_mov_b32 m0, %3\n\ts_nop 0\n\tglobal_load_lds_dwordx4 %1, %2\n\ts_mov_b32 m0, %0" : "=&s"(keep) : "v"(voff_bytes), "s"(sbase), "s"(lds_dst) : "memory");
}
__device__ __forceinline__ void gemm_stage(const bf16_t* A, unsigned oa0, unsigned oa1, const bf16_t* B, unsigned ob, int t, unsigned char* buf, const GemmCtx& c) {
    const bf16_t* At = A + t * 32; const bf16_t* Bt = B + t * 32;
    const unsigned l0 = lds_addr(buf) + c.wid * 1024;
    glds16_s(At, oa0 * 2u, l0);
    glds16_s(At, oa1 * 2u, l0 + 8192);
    glds16_s(Bt, ob * 2u, l0 + 16384);
}
template <int NS>
__device__ __forceinline__ void gemm_kloop(f32x4 (&acc)[4][4], const bf16_t* A, unsigned oa0, unsigned oa1, const bf16_t* B, unsigned ob, int nkt, unsigned char* lds, const GemmCtx& c) {
#pragma unroll
    for (int i = 0; i < NS - 1; ++i) gemm_stage(A, oa0, oa1, B, ob, i, lds + i * G_BUF, c);
    int cur = 0;
#pragma unroll 1
    for (int t = 0; t < nkt; ++t) {
        const int young = nkt - 1 - t;
        if (NS >= 6 && young >= 4) asm volatile("s_waitcnt vmcnt(12)" ::: "memory");
        else if (NS >= 5 && young >= 3) asm volatile("s_waitcnt vmcnt(9)" ::: "memory");
        else if (NS >= 4 && young >= 2) asm volatile("s_waitcnt vmcnt(6)" ::: "memory");
        else if (young >= 1) asm volatile("s_waitcnt vmcnt(3)" ::: "memory");
        else asm volatile("s_waitcnt vmcnt(0)" ::: "memory");
        __builtin_amdgcn_s_barrier();
        asm volatile("" ::: "memory");
        const int nxt = cur == 0 ? NS - 1 : cur - 1;
        if (t + NS - 1 < nkt) gemm_stage(A, oa0, oa1, B, ob, t + NS - 1, lds + nxt * G_BUF, c);
        const unsigned char* SA = lds + cur * G_BUF; const unsigned char* SB = SA + 16384;
        bf16x8 At[4], Bt[4];
#pragma unroll
        for (int m = 0; m < 4; ++m) At[m] = *reinterpret_cast<const bf16x8*>(SA + (c.wr * 64 + m * 16) * 64 + c.rdo);
#pragma unroll
        for (int n = 0; n < 4; ++n) Bt[n] = *reinterpret_cast<const bf16x8*>(SB + (c.wc * 64 + n * 16) * 64 + c.rdo);
        asm volatile("s_waitcnt lgkmcnt(0)" ::: "memory");
        __builtin_amdgcn_sched_barrier(0);
#pragma unroll
        for (int m = 0; m < 4; ++m)
#pragma unroll
            for (int n = 0; n < 4; ++n) acc[m][n] = __builtin_amdgcn_mfma_f32_16x16x32_bf16(At[m], Bt[n], acc[m][n], 0, 0, 0);
        cur = cur == NS - 1 ? 0 : cur + 1;
    }
    __builtin_amdgcn_s_barrier();
    asm volatile("" ::: "memory");
}

template <int NS>
__device__ __forceinline__ void gemm_kloop_p(f32x4 (&acc)[4][4], const bf16_t* A, unsigned oa0, unsigned oa1, const bf16_t* B, unsigned ob, int nkt, unsigned char* lds, const GemmCtx& c) {
#pragma unroll
    for (int i = 0; i < NS; ++i) gemm_stage(A, oa0, oa1, B, ob, i, lds + i * G_BUF, c);
    const int aoff = (c.wr * 64) * 64 + c.rdo, boff = 16384 + (c.wc * 64) * 64 + c.rdo;
    bf16x8 A0[4], B0[4], A1[4], B1[4];
#define GK_WAIT(young_) do { const int _y = (young_); \
        if (NS >= 6 && _y >= 4) asm volatile("s_waitcnt vmcnt(12)" ::: "memory"); \
        else if (NS >= 5 && _y >= 3) asm volatile("s_waitcnt vmcnt(9)" ::: "memory"); \
        else if (NS >= 4 && _y >= 2) asm volatile("s_waitcnt vmcnt(6)" ::: "memory"); \
        else if (_y >= 1) asm volatile("s_waitcnt vmcnt(3)" ::: "memory"); \
        else asm volatile("s_waitcnt vmcnt(0)" ::: "memory"); } while (0)
#define GK_READ(FA, FB, buf_) do { const unsigned char* _s = lds + (buf_) * G_BUF; \
        _Pragma("unroll") for (int m = 0; m < 4; ++m) FA[m] = *reinterpret_cast<const bf16x8*>(_s + aoff + m * 1024); \
        _Pragma("unroll") for (int n = 0; n < 4; ++n) FB[n] = *reinterpret_cast<const bf16x8*>(_s + boff + n * 1024); } while (0)
#define GK_MMA(FA, FB) do { _Pragma("unroll") for (int m = 0; m < 4; ++m) _Pragma("unroll") for (int n = 0; n < 4; ++n) \
        acc[m][n] = __builtin_amdgcn_mfma_f32_16x16x32_bf16(FA[m], FB[n], acc[m][n], 0, 0, 0); } while (0)
    GK_WAIT(NS - 1);
    __builtin_amdgcn_s_barrier(); asm volatile("" ::: "memory");
    GK_READ(A0, B0, 0);
    int cur = 0;
#pragma unroll 1
    for (int t = 0; t < nkt; t += 2) {
        {
            GK_WAIT(nkt - 2 - t < NS - 2 ? nkt - 2 - t : NS - 2);
            asm volatile("s_waitcnt lgkmcnt(0)" ::: "memory");
            __builtin_amdgcn_s_barrier(); asm volatile("" ::: "memory");
            if (t + NS < nkt) gemm_stage(A, oa0, oa1, B, ob, t + NS, lds + cur * G_BUF, c);
            const int n1 = cur == NS - 1 ? 0 : cur + 1;
            GK_READ(A1, B1, n1);
            GK_MMA(A0, B0);
            cur = n1;
        }
        {
            const bool more = t + 2 < nkt;
            if (more) GK_WAIT(nkt - 3 - t < NS - 2 ? nkt - 3 - t : NS - 2);
            asm volatile("s_waitcnt lgkmcnt(0)" ::: "memory");
            __builtin_amdgcn_s_barrier(); asm volatile("" ::: "memory");
            if (t + 1 + NS < nkt) gemm_stage(A, oa0, oa1, B, ob, t + 1 + NS, lds + cur * G_BUF, c);
            const int n1 = cur == NS - 1 ? 0 : cur + 1;
            if (more) GK_READ(A0, B0, n1);
            GK_MMA(A1, B1);
            cur = n1;
        }
    }
#undef GK_WAIT
#undef GK_READ
#undef GK_MMA
    __builtin_amdgcn_s_barrier(); asm volatile("" ::: "memory");
}

template <int NS, bool SWAP>
__device__ __forceinline__ void gemm_kloop_s(f32x4 (&acc)[4][4], const bf16_t* A, unsigned oa0, unsigned oa1, const bf16_t* B, unsigned ob, int nkt, unsigned char* lds, const GemmCtx& c) {
    constexpr int D = NS - 2;
#pragma unroll
    for (int i = 0; i < D; ++i) gemm_stage(A, oa0, oa1, B, ob, i, lds + i * G_BUF, c);
    const int aoff = (c.wr * 64) * 64 + c.rdo, boff = 16384 + (c.wc * 64) * 64 + c.rdo;
    const bool trailing = c.wid >= 4;
#define GS_WAIT(young_) do { const int _y = (young_); \
        if (D >= 5 && _y >= 3) asm volatile("s_waitcnt vmcnt(9)" ::: "memory"); \
        else if (D >= 4 && _y >= 2) asm volatile("s_waitcnt vmcnt(6)" ::: "memory"); \
        else if (_y >= 1) asm volatile("s_waitcnt vmcnt(3)" ::: "memory"); \
        else asm volatile("s_waitcnt vmcnt(0)" ::: "memory"); } while (0)
    GS_WAIT(D - 1);
    __builtin_amdgcn_s_barrier(); asm volatile("" ::: "memory");
    if (trailing) { __builtin_amdgcn_s_barrier(); asm volatile("" ::: "memory"); }
    int cur = 0, nxt = D % NS;
#pragma unroll 1
    for (int t = 0; t < nkt; ++t) {
        if (t + 1 < nkt) GS_WAIT(nkt - 2 - t < D - 2 ? nkt - 2 - t : D - 2);
        if (t + D < nkt) gemm_stage(A, oa0, oa1, B, ob, t + D, lds + nxt * G_BUF, c);
        const unsigned char* sb = lds + cur * G_BUF;
        bf16x8 At[4], Bt[4];
#pragma unroll
        for (int m = 0; m < 4; ++m) At[m] = *reinterpret_cast<const bf16x8*>(sb + aoff + m * 1024);
#pragma unroll
        for (int n = 0; n < 4; ++n) Bt[n] = *reinterpret_cast<const bf16x8*>(sb + boff + n * 1024);
        __builtin_amdgcn_s_barrier(); asm volatile("" ::: "memory");
        asm volatile("s_waitcnt lgkmcnt(0)" ::: "memory");
        __builtin_amdgcn_sched_barrier(0);
        __builtin_amdgcn_s_setprio(1);
#pragma unroll
        for (int m = 0; m < 4; ++m)
#pragma unroll
            for (int n = 0; n < 4; ++n) acc[m][n] = SWAP ? __builtin_amdgcn_mfma_f32_16x16x32_bf16(Bt[n], At[m], acc[m][n], 0, 0, 0) : __builtin_amdgcn_mfma_f32_16x16x32_bf16(At[m], Bt[n], acc[m][n], 0, 0, 0);
        __builtin_amdgcn_s_setprio(0);
        __builtin_amdgcn_s_barrier(); asm volatile("" ::: "memory");
        cur = cur == NS - 1 ? 0 : cur + 1; nxt = nxt == NS - 1 ? 0 : nxt + 1;
    }
#undef GS_WAIT
    if (!trailing) { __builtin_amdgcn_s_barrier(); asm volatile("" ::: "memory"); }
}

constexpr int G2_BUF = 2 * 256 * 32 * 2, G2_NS = 4, G2_LDS = G2_NS * G2_BUF;
struct Gemm2Ctx { int tid, wid, wr, wc, sc, aoff, boff, fr, fq; };
__device__ __forceinline__ Gemm2Ctx gemm2_ctx() {
    Gemm2Ctx c; c.tid = opaque_tid(); c.wid = __builtin_amdgcn_readfirstlane(c.tid >> 6); c.wr = c.wid >> 2; c.wc = c.wid & 3;
    const int lane = c.tid & 63; c.fr = lane & 15; c.fq = lane >> 4;
    c.sc = (((c.tid & 3) ^ ((0 - (c.tid >> 4)) & 3))) * 8;
    const int rdo = c.fr * 64 + ((c.fq ^ ((0 - (c.fr >> 2)) & 3)) * 16);
    c.aoff = (c.wr * 128) * 64 + rdo; c.boff = 16384 + (c.wc * 64) * 64 + rdo;
    return c;
}
__device__ __forceinline__ void gemm2_relane(Gemm2Ctx& c) { int t = c.tid; asm volatile("" : "+v"(t)); c.fr = t & 15; c.fq = (t >> 4) & 3; }
__device__ __forceinline__ void acc2_zero(f32x4 (&acc)[8][4]) {
#pragma unroll
    for (int m = 0; m < 8; ++m)
#pragma unroll
        for (int n = 0; n < 4; ++n) acc[m][n] = (f32x4){0.f, 0.f, 0.f, 0.f};
}
__device__ __forceinline__ void gemm2_stage(const bf16_t* A, unsigned oa0, unsigned oa1, const bf16_t* B, unsigned ob0, unsigned ob1, int t, unsigned char* buf, int tid) {
    const bf16_t* At = A + t * 32; const bf16_t* Bt = B + t * 32;
    __builtin_amdgcn_global_load_lds((const unsigned*)(At + oa0), (unsigned*)(buf + tid * 16), 16, 0, 0);
    __builtin_amdgcn_global_load_lds((const unsigned*)(At + oa1), (unsigned*)(buf + 8192 + tid * 16), 16, 0, 0);
    __builtin_amdgcn_global_load_lds((const unsigned*)(Bt + ob0), (unsigned*)(buf + 16384 + tid * 16), 16, 0, 0);
    __builtin_amdgcn_global_load_lds((const unsigned*)(Bt + ob1), (unsigned*)(buf + 24576 + tid * 16), 16, 0, 0);
}
template <bool SWAP>
__device__ __forceinline__ void gemm2_kloop(f32x4 (&acc)[8][4], const bf16_t* A, unsigned oa0, unsigned oa1, const bf16_t* B, unsigned ob0, unsigned ob1, int nkt, unsigned char* lds, const Gemm2Ctx& c) {
#pragma unroll
    for (int i = 0; i < 3; ++i) gemm2_stage(A, oa0, oa1, B, ob0, ob1, i, lds + i * G2_BUF, c.tid);
    const bool trailing = c.wid >= 4;
    asm volatile("s_waitcnt vmcnt(8)" ::: "memory");
    __builtin_amdgcn_s_barrier(); asm volatile("" ::: "memory");
    if (trailing) { __builtin_amdgcn_s_barrier(); asm volatile("" ::: "memory"); }
    int cur = 0;
#pragma unroll 1
    for (int t = 0; t < nkt; ++t) {
        if (t + 2 < nkt) asm volatile("s_waitcnt vmcnt(4)" ::: "memory"); else asm volatile("s_waitcnt vmcnt(0)" ::: "memory");
        const unsigned char* sb = lds + cur * G2_BUF;
        bf16x8 At[8], Bt[4];
#pragma unroll
        for (int n = 0; n < 4; ++n) Bt[n] = *reinterpret_cast<const bf16x8*>(sb + c.boff + n * 1024);
#pragma unroll
        for (int m = 0; m < 8; ++m) At[m] = *reinterpret_cast<const bf16x8*>(sb + c.aoff + m * 1024);
        __builtin_amdgcn_s_barrier(); asm volatile("" ::: "memory");
        asm volatile("s_waitcnt lgkmcnt(0)" ::: "memory");
        __builtin_amdgcn_sched_barrier(0);
#pragma unroll
        for (int m = 0; m < 4; ++m)
#pragma unroll
            for (int n = 0; n < 4; ++n) acc[m][n] = SWAP ? __builtin_amdgcn_mfma_f32_16x16x32_bf16(Bt[n], At[m], acc[m][n], 0, 0, 0) : __builtin_amdgcn_mfma_f32_16x16x32_bf16(At[m], Bt[n], acc[m][n], 0, 0, 0);
        __builtin_amdgcn_sched_barrier(0);
        if (t + 3 < nkt) gemm2_stage(A, oa0, oa1, B, ob0, ob1, t + 3, lds + (cur == 0 ? 3 : cur - 1) * G2_BUF, c.tid);
        __builtin_amdgcn_sched_barrier(0);
#pragma unroll
        for (int m = 4; m < 8; ++m)
#pragma unroll
            for (int n = 0; n < 4; ++n) acc[m][n] = SWAP ? __builtin_amdgcn_mfma_f32_16x16x32_bf16(Bt[n], At[m], acc[m][n], 0, 0, 0) : __builtin_amdgcn_mfma_f32_16x16x32_bf16(At[m], Bt[n], acc[m][n], 0, 0, 0);
        __builtin_amdgcn_s_barrier(); asm volatile("" ::: "memory");
        cur = cur == 3 ? 0 : cur + 1;
    }
    if (!trailing) { __builtin_amdgcn_s_barrier(); asm volatile("" ::: "memory"); }
}

__device__ __forceinline__ void phase_inproj(const Params& p, int bid, int nb, unsigned char* lds) {
    Gemm2Ctx c = gemm2_ctx();
    float* srstd = (float*)(lds + G2_LDS);
    constexpr int NCT = NP / 256, NUX = (NTOK / 256 / 8) * NCT;
    const int xcd = bid & 7, nloc = nb >> 3;
    for (int k = bid >> 3; k < NUX; k += nloc) {
        const int rt = xcd * (NTOK / 256 / 8) + k / NCT, ct = k % NCT, brow = rt * 256, bcol = ct * 256;
        if (c.tid < 256) srstd[c.tid] = rstd_of(p.part, brow + c.tid);
        f32x4 acc[8][4]; acc2_zero(acc);
        const int r = c.tid >> 2;
        const unsigned o0 = (unsigned)(r * DM + c.sc), o1 = (unsigned)((r + 128) * DM + c.sc);
        if (ct >= C_BV / 256 && ct < C_BV / 256 + 3) {
            gemm2_kloop<false>(acc, p.hb + (size_t)brow * DM, o0, o1, p.Bt_in + (size_t)bcol * DM, o0, o1, DM / 32, lds, c);
            gemm2_relane(c);
            const int vcol = bcol - C_BV + c.wc * 64;
            bf16_t* vt = (vcol < 384 ? p.VtB + ((size_t)(brow / TSEQ) * 384 + vcol + c.fr) * TSEQ : p.VtC + ((size_t)(brow / TSEQ) * 384 + (vcol - 384) + c.fr) * TSEQ)
                         + (brow % TSEQ) + c.wr * 128 + ((((c.fq & 1) << 1) | (c.fq >> 1)) * 4);
#pragma unroll
            for (int m = 0; m < 8; ++m) {
                const int rl = c.wr * 128 + m * 16 + c.fq * 4;
                const float r0 = srstd[rl], r1 = srstd[rl + 1], r2 = srstd[rl + 2], r3 = srstd[rl + 3];
#pragma unroll
                for (int n = 0; n < 4; ++n)
                    *(uint2*)(vt + (size_t)(n * 16) * TSEQ + m * 16) = make_uint2(cvt_pk_bf16(acc[m][n][0] * r0, acc[m][n][1] * r1), cvt_pk_bf16(acc[m][n][2] * r2, acc[m][n][3] * r3));
            }
        } else {
            gemm2_kloop<true>(acc, p.hb + (size_t)brow * DM, o0, o1, p.Bt_in + (size_t)bcol * DM, o0, o1, DM / 32, lds, c);
            gemm2_relane(c);
#pragma unroll
            for (int m = 0; m < 8; ++m) {
                const int rl = c.wr * 128 + m * 16 + c.fr; const float rs = srstd[rl];
                bf16_t* o = p.proj + (size_t)(brow + rl) * NP + bcol + c.wc * 64 + c.fq * 4;
#pragma unroll
                for (int n = 0; n < 4; ++n) *(uint2*)(o + n * 16) = make_uint2(cvt_pk_bf16(acc[m][n][0] * rs, acc[m][n][1] * rs), cvt_pk_bf16(acc[m][n][2] * rs, acc[m][n][3] * rs));
            }
        }
        __syncthreads();
    }
}

__device__ __forceinline__ int grab_unit(int* ctr, volatile LAS int* slot) {
    __syncthreads();
    if (opaque_tid() == 0) *slot = __hip_atomic_fetch_add(ctr, 1, __ATOMIC_RELAXED, __HIP_MEMORY_SCOPE_AGENT);
    __syncthreads();
    return *slot;
}

#ifndef PROBE_GEMM_VAR
#define PROBE_GEMM_VAR -1
#endif
template <int VAR>
__device__ __forceinline__ void phase_gemm_probe(const Params& p, int bid, int nb, unsigned char* lds) {
    const GemmCtx c = gemm_ctx();
    constexpr int NS = G_NS, NCT = NP / 128, NU = (NTOK / 256) * NCT;
    for (int u = bid; u < NU; u += nb) {
        const int rt = u / NCT, ct = u % NCT, brow = rt * 256, bcol = ct * 128;
        f32x4 acc[4][4]; acc_zero(acc);
        const int r = c.tid >> 2;
        const bf16_t* A = p.hb + (size_t)brow * DM; const bf16_t* B = p.Bt_in + (size_t)bcol * DM;
        const unsigned oa0 = (unsigned)(r * DM + c.sc), oa1 = (unsigned)((r + 128) * DM + c.sc), ob = (unsigned)(r * DM + c.sc);
        const int nkt = DM / 32;
#pragma unroll
        for (int i = 0; i < NS - 1; ++i) gemm_stage(A, oa0, oa1, B, ob, i, lds + i * G_BUF, c);
        int cur = 0;
        bf16x8 At[4], Bt[4];
        if (VAR == 2) {
            asm volatile("s_waitcnt vmcnt(0)" ::: "memory"); __builtin_amdgcn_s_barrier();
#pragma unroll
            for (int m = 0; m < 4; ++m) At[m] = *reinterpret_cast<const bf16x8*>(lds + (c.wr * 64 + m * 16) * 64 + c.rdo);
#pragma unroll
            for (int n = 0; n < 4; ++n) Bt[n] = *reinterpret_cast<const bf16x8*>(lds + 16384 + (c.wc * 64 + n * 16) * 64 + c.rdo);
        }
#pragma unroll 1
        for (int t = 0; t < nkt; ++t) {
            const int young = nkt - 1 - t;
            if (VAR == 1) { if (t == 0) asm volatile("s_waitcnt vmcnt(0)" ::: "memory"); }
            else if (young >= 4) asm volatile("s_waitcnt vmcnt(12)" ::: "memory");
            else if (young >= 3) asm volatile("s_waitcnt vmcnt(9)" ::: "memory");
            else if (young >= 2) asm volatile("s_waitcnt vmcnt(6)" ::: "memory");
            else if (young >= 1) asm volatile("s_waitcnt vmcnt(3)" ::: "memory");
            else asm volatile("s_waitcnt vmcnt(0)" ::: "memory");
            if (VAR != 3) __builtin_amdgcn_s_barrier();
            asm volatile("" ::: "memory");
            const int nxt = cur == 0 ? NS - 1 : cur - 1;
            if (VAR != 1 && t + NS - 1 < nkt) gemm_stage(A, oa0, oa1, B, ob, t + NS - 1, lds + nxt * G_BUF, c);
            const unsigned char* SA = lds + cur * G_BUF; const unsigned char* SB = SA + 16384;
            if (VAR != 2) {
#pragma unroll
                for (int m = 0; m < 4; ++m) At[m] = *reinterpret_cast<const bf16x8*>(SA + (c.wr * 64 + m * 16) * 64 + c.rdo);
#pragma unroll
                for (int n = 0; n < 4; ++n) Bt[n] = *reinterpret_cast<const bf16x8*>(SB + (c.wc * 64 + n * 16) * 64 + c.rdo);
                asm volatile("s_waitcnt lgkmcnt(0)" ::: "memory");
            }
            __builtin_amdgcn_sched_barrier(0);
            if (VAR != 4) {
#pragma unroll
                for (int m = 0; m < 4; ++m)
#pragma unroll
                    for (int n = 0; n < 4; ++n) acc[m][n] = __builtin_amdgcn_mfma_f32_16x16x32_bf16(At[m], Bt[n], acc[m][n], 0, 0, 0);
            } else {
#pragma unroll
                for (int m = 0; m < 4; ++m) asm volatile("" :: "v"(At[m]), "v"(Bt[m]));
            }
            cur = cur == NS - 1 ? 0 : cur + 1;
        }
        __builtin_amdgcn_s_barrier();
        asm volatile("" ::: "memory");
        float sacc = 0.f;
#pragma unroll
        for (int m = 0; m < 4; ++m)
#pragma unroll
            for (int n = 0; n < 4; ++n) sacc += acc[m][n][0] + acc[m][n][1] + acc[m][n][2] + acc[m][n][3];
        if (sacc == 1.2345e33f) p.part[0] = sacc;
    }
}

constexpr int GQ = 56, GS = 72, GO = 97;
constexpr int GL_QD = 0, GL_KD = GL_QD + 64 * GQ * 2, GL_KET = GL_KD + 64 * GQ * 2, GL_VT = GL_KET + 64 * GS * 2, GL_ATT = GL_VT + 96 * GS * 2, GL_ST = GL_ATT + 64 * GS * 2,
              GL_OO = GL_ST + 96 * GQ * 2, GL_BC = GL_OO + 64 * GO * 4, GL_SEG = GL_BC + 64 * 48 * 4, GL_EBL = GL_SEG + 8 * 48 * 4, GL_W2 = GL_EBL + 64 * 4, GL_B2 = GL_W2 + 16 * 48 * 4,
              GL_GAIN = GL_B2 + 48 * 4, GL_RQ = GL_GAIN + 96 * 4, GL_RK = GL_RQ + 64 * 48 * 2, GL_RV = GL_RK + 64 * 48 * 2, GL_RA = GL_RV + 64 * 96 * 2, GL_RG = GL_RA + 64 * 16 * 2,
              GLA_LDS = GL_RG + 2 * 64 * 96 * 2;
static_assert(GL_OO % 16 == 0 && GL_RQ % 16 == 0 && GL_RG % 16 == 0 && GL_ST % 16 == 0, "GLA LDS map alignment");
__device__ __forceinline__ void phase_gla(const Params& p, int l, int* ctr, volatile LAS int* slot, unsigned char* lds) {
    bf16_t* qd = (bf16_t*)(lds + GL_QD); bf16_t* kd = (bf16_t*)(lds + GL_KD); bf16_t* keT = (bf16_t*)(lds + GL_KET); bf16_t* vT = (bf16_t*)(lds + GL_VT);
    bf16_t* att = (bf16_t*)(lds + GL_ATT); bf16_t* ST = (bf16_t*)(lds + GL_ST);
    float* oo = (float*)(lds + GL_OO); float* bc = (float*)(lds + GL_BC); float* seg = (float*)(lds + GL_SEG); float* ebl = (float*)(lds + GL_EBL);
    float* w2s = (float*)(lds + GL_W2); float* b2s = (float*)(lds + GL_B2); float* gains = (float*)(lds + GL_GAIN);
    bf16_t* rq = (bf16_t*)(lds + GL_RQ); bf16_t* rk = (bf16_t*)(lds + GL_RK); bf16_t* rv = (bf16_t*)(lds + GL_RV); bf16_t* ra = (bf16_t*)(lds + GL_RA); bf16_t* rg = (bf16_t*)(lds + GL_RG);
    const int tid = opaque_tid(), wave = tid >> 6, lane = tid & 63, r = lane & 31, hf = lane >> 5;
    for (int u = grab_unit(ctr, slot); u < NBATCH * 4; u = grab_unit(ctr, slot)) {
        const int b = u >> 2, h = u & 3;
        PROBE_UNIT_BEGIN(9, u == 0);
        for (int i = tid; i < 16 * 48; i += NT) w2s[i] = p.in[I_AW2][(size_t)l * 16 * 192 + (i / 48) * 192 + h * 48 + (i % 48)];
        if (tid < 48) b2s[tid] = p.in[I_AB2][l * 192 + h * 48 + tid];
        if (tid < 96) gains[tid] = p.in[I_AGAIN][l * 384 + h * 96 + tid];
        if (tid < 64) ebl[tid] = 1.0f;
        for (int i = tid; i < 96 * GQ; i += NT) ST[i] = 0;
        for (int i = tid; i < 64 * GS; i += NT) { keT[i] = 0; att[i] = 0; }
        const bf16_t* src[5]; int dsto[5];
#pragma unroll
        for (int j = 0; j < 5; ++j) {
            const int pid = tid + NT * j; int row = 0, col = 0, dst = -1;
            if (pid < 384) { row = pid / 6; col = C_AQ + h * 48 + (pid % 6) * 8; dst = GL_RQ + pid * 16; }
            else if (pid < 768) { const int q = pid - 384; row = q / 6; col = C_AK + h * 48 + (q % 6) * 8; dst = GL_RK + q * 16; }
            else if (pid < 1536) { const int q = pid - 768; row = q / 12; col = C_AV + h * 96 + (q % 12) * 8; dst = GL_RV + q * 16; }
            else if (pid < 2304) { const int q = pid - 1536; row = q / 12; col = C_AG + h * 96 + (q % 12) * 8; dst = GL_RG + q * 16; }
            else if (pid < 2432) { const int q = pid - 2304; row = q / 2; col = C_ALR + (q % 2) * 8; dst = GL_RA + q * 16; }
            src[j] = p.proj + ((size_t)b * TSEQ + row) * NP + col; dsto[j] = dst;
        }
        u32x4 pre[5];
#pragma unroll
        for (int j = 0; j < 5; ++j) pre[j] = dsto[j] >= 0 ? *(const u32x4*)src[j] : (u32x4){0u, 0u, 0u, 0u};
        f32x16 Sacc;
#pragma unroll
        for (int i = 0; i < 16; ++i) Sacc[i] = 0.f;
        const int kt = wave / 3, vt = wave % 3;
        __syncthreads();
        for (int n = 0; n < 32; ++n) {
            const size_t row0 = (size_t)b * TSEQ + n * 64;
            const int gsel = (n & 1) * (64 * 96 * 2);
#pragma unroll
            for (int j = 0; j < 5; ++j) if (dsto[j] >= 0) *(u32x4*)(lds + dsto[j] + (dsto[j] >= GL_RG ? gsel : 0)) = pre[j];
            if (n + 1 < 32) {
#pragma unroll
                for (int j = 0; j < 5; ++j) if (dsto[j] >= 0) pre[j] = *(const u32x4*)(src[j] + (size_t)(n + 1) * 64 * NP);
            }
            __syncthreads();
            for (int e = tid; e < 64 * 48; e += NT) {
                const int t = e / 48, k = e % 48;
                float z = b2s[k];
#pragma unroll
                for (int rr = 0; rr < 16; ++rr) z += bf2f(ra[t * 16 + rr]) * w2s[rr * 48 + k];
                bc[e] = (fminf(z, 0.f) - log1pf(__expf(-fabsf(z)))) * (1.0f / 16.0f);
            }
            __syncthreads();
            if (tid < 384) {
                const int k = tid % 48, sg = tid / 48; float run = 0.f;
#pragma unroll
                for (int i = 0; i < 8; ++i) { run += bc[(sg * 8 + i) * 48 + k]; bc[(sg * 8 + i) * 48 + k] = run; }
                seg[sg * 48 + k] = run;
            }
            __syncthreads();
            if (tid < 384) {
                const int k = tid % 48, sg = tid / 48; float pre_s = 0.f;
                for (int s2 = 0; s2 < sg; ++s2) pre_s += seg[s2 * 48 + k];
#pragma unroll
                for (int i = 0; i < 8; ++i) bc[(sg * 8 + i) * 48 + k] += pre_s;
            }
            __syncthreads();
            for (int e = tid; e < 64 * 48; e += NT) {
                const int t = e / 48, k = e % 48;
                const float bb = bc[e], bl = bc[63 * 48 + k];
                const float q = bf2f(rq[e]) * 0.14433756729740643f, kk = bf2f(rk[e]);
                qd[t * GQ + k] = f2bf(q * __expf(bb)); kd[t * GQ + k] = f2bf(kk * __expf(-bb)); keT[k * GS + t] = f2bf(kk * __expf(bl - bb));
                if (t == 63) ebl[k] = __expf(bl);
            }
            for (int e = tid; e < 64 * 96; e += NT) { const int t = e / 96, v = e % 96; vT[v * GS + t] = rv[e]; }
            __syncthreads();
            if (wave < 3) {
                const int si = wave == 2 ? 1 : 0, ci = wave >= 1 ? 1 : 0;
                f32x16 x;
#pragma unroll
                for (int i = 0; i < 16; ++i) x[i] = 0.f;
#pragma unroll
                for (int st = 0; st < 3; ++st)
                    x = __builtin_amdgcn_mfma_f32_32x32x16_bf16(*(const bf16x8*)(kd + (si * 32 + r) * GQ + 16 * st + 8 * hf), *(const bf16x8*)(qd + (ci * 32 + r) * GQ + 16 * st + 8 * hf), x, 0, 0, 0);
                const int cq = ci * 32 + r;
#pragma unroll
                for (int g = 0; g < 4; ++g) {
                    const int s0 = si * 32 + 8 * g + 4 * hf;
                    const float v0 = s0 <= cq ? x[4 * g] : 0.f, v1 = s0 + 1 <= cq ? x[4 * g + 1] : 0.f, v2 = s0 + 2 <= cq ? x[4 * g + 2] : 0.f, v3 = s0 + 3 <= cq ? x[4 * g + 3] : 0.f;
                    *(uint2*)(att + cq * GS + s0) = make_uint2(cvt_pk_bf16(v0, v1), cvt_pk_bf16(v2, v3));
                }
            }
            if (wave < 6) {
#pragma unroll
                for (int i = 0; i < 16; ++i) Sacc[i] *= ebl[kt * 32 + (i & 3) + 8 * (i >> 2) + 4 * hf];
#pragma unroll
                for (int st = 0; st < 4; ++st)
                    Sacc = __builtin_amdgcn_mfma_f32_32x32x16_bf16(*(const bf16x8*)(keT + (kt * 32 + r) * GS + 16 * st + 8 * hf), *(const bf16x8*)(vT + (vt * 32 + r) * GS + 16 * st + 8 * hf), Sacc, 0, 0, 0);
            }
            __syncthreads();
            if (wave < 6) {
                f32x16 o;
#pragma unroll
                for (int i = 0; i < 16; ++i) o[i] = 0.f;
#pragma unroll
                for (int st = 0; st < 4; ++st)
                    if (st < 2 || kt == 1)
                        o = __builtin_amdgcn_mfma_f32_32x32x16_bf16(*(const bf16x8*)(att + (kt * 32 + r) * GS + 16 * st + 8 * hf), *(const bf16x8*)(vT + (vt * 32 + r) * GS + 16 * st + 8 * hf), o, 0, 0, 0);
#pragma unroll
                for (int st = 0; st < 3; ++st)
                    o = __builtin_amdgcn_mfma_f32_32x32x16_bf16(*(const bf16x8*)(qd + (kt * 32 + r) * GQ + 16 * st + 8 * hf), *(const bf16x8*)(ST + (vt * 32 + r) * GQ + 16 * st + 8 * hf), o, 0, 0, 0);
#pragma unroll
                for (int i = 0; i < 16; ++i) oo[(kt * 32 + (i & 3) + 8 * (i >> 2) + 4 * hf) * GO + vt * 32 + r] = o[i];
            }
            __syncthreads();
            for (int t = wave; t < 64; t += 8) {
                const float o0 = oo[t * GO + lane], o1 = lane < 32 ? oo[t * GO + 64 + lane] : 0.f;
                const float ms = wave_sum(o0 * o0 + o1 * o1) * (1.0f / 96.0f);
                const float rs = rsqrtf(ms + EPS);
                const bf16_t* gr = (const bf16_t*)((const unsigned char*)rg + gsel) + t * 96;
                bf16_t* g = p.proj + (row0 + t) * NP + C_AG + h * 96;
                g[lane] = f2bf(o0 * rs * gains[lane] * siluf_(bf2f(gr[lane])));
                if (lane < 32) g[64 + lane] = f2bf(o1 * rs * gains[64 + lane] * siluf_(bf2f(gr[64 + lane])));
            }
            if (wave < 6) {
#pragma unroll
                for (int g = 0; g < 4; ++g) {
                    const int k0 = kt * 32 + 8 * g + 4 * hf;
                    if (k0 < 48) *(uint2*)(ST + (vt * 32 + r) * GQ + k0) = make_uint2(cvt_pk_bf16(Sacc[4 * g], Sacc[4 * g + 1]), cvt_pk_bf16(Sacc[4 * g + 2], Sacc[4 * g + 3]));
                }
            }
            __syncthreads();
        }
        PROBE_UNIT_END(9, u == 0);
    }
}

constexpr int LQ = 56;
constexpr int LR_XIN = 0, LR_XC = LR_XIN + 67 * 48 * 4, LR_XCB = LR_XC + 64 * 48 * 4, LR_WT = LR_XCB + 64 * LQ * 2, LR_AA = LR_WT + 128 * LQ * 2, LR_FF = LR_AA + 64 * 48 * 4,
              LR_GG = LR_FF + 64 * 48 * 4, LR_SEGA = LR_GG + 64 * 48 * 4, LR_SEGH = LR_SEGA + 8 * 48 * 4, LR_CAR = LR_SEGH + 8 * 48 * 4, LR_HS = LR_CAR + 8 * 48 * 4,
              LR_CONST = LR_HS + 64 * 4, LR_Y = LR_CONST + 8 * 48 * 4, LRU_LDS = LR_Y + 64 * 48 * 2;
static_assert(LR_XCB % 16 == 0 && LR_WT % 16 == 0 && LR_Y % 16 == 0, "LRU LDS map alignment");
__device__ __forceinline__ float gelu_tanh(float x) { const float u = 0.7978845608028654f * (x + 0.044715f * x * x * x); return 0.5f * x * (1.0f + tanhf(u)); }
__device__ __forceinline__ void phase_lru(const Params& p, int l, int* ctr, volatile LAS int* slot, unsigned char* lds) {
    float* xin = (float*)(lds + LR_XIN); float* xc = (float*)(lds + LR_XC); bf16_t* xcb = (bf16_t*)(lds + LR_XCB); bf16_t* WT = (bf16_t*)(lds + LR_WT);
    float* aa = (float*)(lds + LR_AA); float* ff = (float*)(lds + LR_FF); float* gg = (float*)(lds + LR_GG);
    float* segA = (float*)(lds + LR_SEGA); float* segH = (float*)(lds + LR_SEGH); float* car = (float*)(lds + LR_CAR); float* hs = (float*)(lds + LR_HS);
    float* cst = (float*)(lds + LR_CONST);
    bf16_t* yraw = (bf16_t*)(lds + LR_Y);
    const int tid = opaque_tid(), wave = tid >> 6, lane = tid & 63, r = lane & 31, hf = lane >> 5;
    for (int u = grab_unit(ctr, slot); u < NBATCH * 8; u = grab_unit(ctr, slot)) {
        const int b = u >> 3, nblk = u & 7, ch0 = nblk * 48;
        PROBE_UNIT_BEGIN(10, u == 0);
        for (int i = tid; i < 128 * LQ; i += NT) {
            const int n = i / LQ, cidx = i % LQ; float v = 0.f;
            if (cidx < 48) { if (n < 48) v = p.in[I_WR][((size_t)l * 8 + nblk) * 2304 + cidx * 48 + n]; else if (n >= 64 && n < 112) v = p.in[I_WI][((size_t)l * 8 + nblk) * 2304 + cidx * 48 + (n - 64)]; }
            WT[i] = f2bf(v);
        }
        if (tid < 48) {
            cst[tid] = p.in[I_BR][l * 384 + ch0 + tid]; cst[48 + tid] = p.in[I_BI][l * 384 + ch0 + tid];
            cst[96 + tid] = log1pf(__expf(-p.in[I_LAM][l * 384 + ch0 + tid])); cst[144 + tid] = p.in[I_CONVB][l * 384 + ch0 + tid];
#pragma unroll
            for (int j = 0; j < 4; ++j) cst[192 + j * 48 + tid] = p.in[I_CONVW][((size_t)l * 4 + j) * 384 + ch0 + tid];
            hs[tid] = 0.f;
        }
        if (tid < 144) xin[tid] = 0.f;
        const int xrow = tid / 6, xcol = (tid % 6) * 8, yid = tid - 128, yrow = yid / 6, ycol = (yid % 6) * 8;
        const bf16_t* xsrc = p.proj + ((size_t)b * TSEQ + xrow) * NP + C_DX + ch0 + xcol;
        const bf16_t* ysrc = p.proj + ((size_t)b * TSEQ + (yid >= 0 ? yrow : 0)) * NP + C_DY + ch0 + ycol;
        u32x4 px = {0u, 0u, 0u, 0u}, py = {0u, 0u, 0u, 0u};
        if (tid < 384) px = *(const u32x4*)xsrc;
        if (yid >= 0) py = *(const u32x4*)ysrc;
        __syncthreads();
        for (int tt = 0; tt < TSEQ / 64; ++tt) {
            if (tid < 384) {
#pragma unroll
                for (int q = 0; q < 4; ++q) { xin[(3 + xrow) * 48 + xcol + 2 * q] = __uint_as_float(px[q] << 16); xin[(3 + xrow) * 48 + xcol + 2 * q + 1] = __uint_as_float(px[q] & 0xFFFF0000u); }
            }
            if (yid >= 0) *(u32x4*)(yraw + yrow * 48 + ycol) = py;
            if (tt + 1 < TSEQ / 64) {
                if (tid < 384) px = *(const u32x4*)(xsrc + (size_t)(tt + 1) * 64 * NP);
                if (yid >= 0) py = *(const u32x4*)(ysrc + (size_t)(tt + 1) * 64 * NP);
            }
            __syncthreads();
            for (int e = tid; e < 64 * 48; e += NT) {
                const int t = e / 48, cidx = e % 48; float a = cst[144 + cidx];
#pragma unroll
                for (int j = 0; j < 4; ++j) a += cst[192 + j * 48 + cidx] * xin[(t + j) * 48 + cidx];
                xc[e] = a; xcb[t * LQ + cidx] = f2bf(a);
            }
            __syncthreads();
            {
                const int ci = wave >> 2, ni = wave & 3;
                f32x16 g;
#pragma unroll
                for (int i = 0; i < 16; ++i) g[i] = 0.f;
#pragma unroll
                for (int st = 0; st < 3; ++st)
                    g = __builtin_amdgcn_mfma_f32_32x32x16_bf16(*(const bf16x8*)(xcb + (ci * 32 + r) * LQ + 16 * st + 8 * hf), *(const bf16x8*)(WT + (ni * 32 + r) * LQ + 16 * st + 8 * hf), g, 0, 0, 0);
                const int d = (ni & 1) * 32 + r;
                if (d < 48) {
                    if (ni < 2) {
                        const float brv = cst[d], spv = cst[96 + d];
#pragma unroll
                        for (int i = 0; i < 16; ++i) {
                            const int t = ci * 32 + (i & 3) + 8 * (i >> 2) + 4 * hf;
                            const float la = -8.0f * sigmoidf_(g[i] + brv) * spv;
                            aa[t * 48 + d] = __expf(la); ff[t * 48 + d] = sqrtf(-expm1f(2.0f * la)) * xc[t * 48 + d];
                        }
                    } else {
                        const float biv = cst[48 + d];
#pragma unroll
                        for (int i = 0; i < 16; ++i) { const int t = ci * 32 + (i & 3) + 8 * (i >> 2) + 4 * hf; gg[t * 48 + d] = sigmoidf_(g[i] + biv); }
                    }
                }
                if (tid < 144) xin[tid] = xin[64 * 48 + tid];
            }
            __syncthreads();
            if (tid < 384) {
                const int d = tid % 48, sg = tid / 48; float ap = 1.f, hl = 0.f;
#pragma unroll
                for (int i = 0; i < 8; ++i) {
                    const int e = (sg * 8 + i) * 48 + d; const float av = aa[e];
                    hl = av * hl + ff[e] * gg[e]; ap *= av; aa[e] = ap; ff[e] = hl;
                }
                segA[sg * 48 + d] = ap; segH[sg * 48 + d] = hl;
            }
            __syncthreads();
            if (tid < 48) {
                float cin = hs[tid];
#pragma unroll
                for (int sg = 0; sg < 8; ++sg) { car[sg * 48 + tid] = cin; cin = segA[sg * 48 + tid] * cin + segH[sg * 48 + tid]; }
                hs[tid] = cin;
            }
            __syncthreads();
            if (tid < 384) {
                const int t = tid / 6, d0 = (tid % 6) * 8, sg = t >> 3;
                const u32x4 yv = *(const u32x4*)(yraw + t * 48 + d0);
                float o[8];
#pragma unroll
                for (int q = 0; q < 8; ++q) {
                    const int e = t * 48 + d0 + q;
                    const float h = ff[e] + aa[e] * car[sg * 48 + d0 + q];
                    const float y = (q & 1) ? __uint_as_float(yv[q >> 1] & 0xFFFF0000u) : __uint_as_float(yv[q >> 1] << 16);
                    o[q] = gelu_tanh(y) * h;
                }
                u32x4 ov; ov[0] = cvt_pk_bf16(o[0], o[1]); ov[1] = cvt_pk_bf16(o[2], o[3]); ov[2] = cvt_pk_bf16(o[4], o[5]); ov[3] = cvt_pk_bf16(o[6], o[7]);
                *(u32x4*)(p.proj + ((size_t)b * TSEQ + tt * 64 + t) * NP + C_DY + ch0 + d0) = ov;
            }
            __syncthreads();
        }
        PROBE_UNIT_END(10, u == 0);
    }
}

constexpr int AT_STAGE = 16384, AT_LDS = 3 * AT_STAGE;
template <bool MASKED>
__device__ __forceinline__ void attn_block(const bf16_t* __restrict__ proj, const bf16_t* __restrict__ Vt, int b, int qb, int cq, int ck, const float* tabAll,
                                           const unsigned* mask32, unsigned char* stage, bf16_t* __restrict__ outp, int tid) {
    const int wave = tid >> 6, lane = tid & 63, r = lane & 31, hf = lane >> 5, hh = wave >> 2, sb = wave & 3;
    const int q0 = qb * 128 + sb * 32, q = q0 + r, mykt = q0 >> 5, nkt = 4 * qb + 4;
    const int skey = (tid >> 3) & 31, sdim = (tid >> 2) & 63, shh = tid >> 8;
    const unsigned offK = (unsigned)(skey * NP + shh * 64 + (((tid & 7) ^ ((skey >> 1) & 7)) * 8));
    const unsigned offV = (unsigned)((shh * 64 + sdim) * TSEQ + (((tid & 3) ^ ((0 - (sdim >> 2)) & 3)) * 8));
    int kro[4], vro[2][2];
#pragma unroll
    for (int s = 0; s < 4; ++s) kro[s] = hh * 4096 + r * 128 + (((2 * s + hf) ^ ((r >> 1) & 7)) * 16);
#pragma unroll
    for (int db = 0; db < 2; ++db)
#pragma unroll
        for (int s = 0; s < 2; ++s) vro[db][s] = 8192 + hh * 4096 + (db * 32 + r) * 64 + (((2 * s + hf) ^ ((0 - (r >> 2)) & 3)) * 16);
    constexpr float C1 = 0.125f * LOG2E;
    const unsigned* maskq = MASKED ? mask32 + (sb * 32 + r) * 64 : nullptr;
#pragma unroll 1
    for (int rnd = 0; rnd < 3; ++rnd) {
        const int h = 2 * rnd + hh;
        const float* tab = tabAll + h * TABW;
        const bf16_t* qrow = proj + ((size_t)b * TSEQ + q) * NP + cq + h * 64 + 8 * hf;
        bf16x8 qf[4];
#pragma unroll
        for (int s = 0; s < 4; ++s) qf[s] = *(const bf16x8*)(qrow + 16 * s);
        f32x16 o0, o1;
#pragma unroll
        for (int i = 0; i < 16; ++i) { o0[i] = 0.f; o1[i] = 0.f; }
        float m = -1e30f, l = 0.f;
        const bf16_t* Kb = proj + (size_t)b * TSEQ * NP + ck + 2 * rnd * 64;
        const bf16_t* Vb = Vt + ((size_t)b * 384 + 2 * rnd * 64) * TSEQ;
#define AT_STAGE_TILE(kt_, buf_) do { \
        __builtin_amdgcn_global_load_lds((const unsigned*)(Kb + (size_t)(kt_) * 32 * NP + offK), (unsigned*)((buf_) + tid * 16), 16, 0, 0); \
        __builtin_amdgcn_global_load_lds((const unsigned*)(Vb + (kt_) * 32 + offV), (unsigned*)((buf_) + 8192 + tid * 16), 16, 0, 0); } while (0)
        AT_STAGE_TILE(0, stage);
        AT_STAGE_TILE(1, stage + AT_STAGE);
        int cur = 0;
#pragma unroll 1
        for (int kt = 0; kt < nkt; ++kt) {
            if (kt + 1 < nkt) asm volatile("s_waitcnt vmcnt(2)" ::: "memory"); else asm volatile("s_waitcnt vmcnt(0)" ::: "memory");
            __builtin_amdgcn_s_barrier();
            asm volatile("" ::: "memory");
            const int nxt = cur == 0 ? 2 : cur - 1;
            if (kt + 2 < nkt) AT_STAGE_TILE(kt + 2, stage + nxt * AT_STAGE);
            if (kt <= mykt) {
                const unsigned char* st = stage + cur * AT_STAGE;
                f32x16 sa;
#pragma unroll
                for (int i = 0; i < 16; ++i) sa[i] = 0.f;
#pragma unroll
                for (int s = 0; s < 4; ++s) sa = __builtin_amdgcn_mfma_f32_32x32x16_bf16(*(const bf16x8*)(st + kro[s]), qf[s], sa, 0, 0, 0);
                const float* tb = tab + (q - kt * 32 - 4 * hf + 32);
                unsigned w = 0u;
                if (MASKED) w = maskq[kt] >> (4 * hf);
                float sv[16]; float tmax = NEG_BIG;
#pragma unroll
                for (int i = 0; i < 16; ++i) {
                    const int ko = (i & 3) + 8 * (i >> 2);
                    float v = sa[i] * C1 + tb[-ko];
                    if (MASKED) v = ((w >> ko) & 1u) ? v : NEG_BIG;
                    sv[i] = v; tmax = fmaxf(tmax, v);
                }
                tmax = fmaxf(tmax, __shfl_xor(tmax, 32));
                const float mn = fmaxf(m, tmax);
                if (!__all(mn == m)) {
                    const float alpha = __builtin_amdgcn_exp2f(m - mn);
                    l *= alpha;
#pragma unroll
                    for (int i = 0; i < 16; ++i) { o0[i] *= alpha; o1[i] *= alpha; }
                    m = mn;
                }
                float ps = 0.f;
#pragma unroll
                for (int i = 0; i < 16; ++i) { sv[i] = __builtin_amdgcn_exp2f(sv[i] - m); ps += sv[i]; }
                l += ps;
                bf16x8 pf[2];
#pragma unroll
                for (int s = 0; s < 2; ++s) {
                    u32x4 t;
                    t[0] = cvt_pk_bf16(sv[8 * s + 0], sv[8 * s + 1]); t[1] = cvt_pk_bf16(sv[8 * s + 2], sv[8 * s + 3]);
                    t[2] = cvt_pk_bf16(sv[8 * s + 4], sv[8 * s + 5]); t[3] = cvt_pk_bf16(sv[8 * s + 6], sv[8 * s + 7]);
                    pf[s] = __builtin_bit_cast(bf16x8, t);
                }
#pragma unroll
                for (int s = 0; s < 2; ++s) {
                    o0 = __builtin_amdgcn_mfma_f32_32x32x16_bf16(*(const bf16x8*)(st + vro[0][s]), pf[s], o0, 0, 0, 0);
                    o1 = __builtin_amdgcn_mfma_f32_32x32x16_bf16(*(const bf16x8*)(st + vro[1][s]), pf[s], o1, 0, 0, 0);
                }
            }
            cur = cur == 2 ? 0 : cur + 1;
        }
#undef AT_STAGE_TILE
        __builtin_amdgcn_s_barrier();
        asm volatile("" ::: "memory");
        l += __shfl_xor(l, 32);
        const float inv = 1.0f / l;
        bf16_t* orow = outp + ((size_t)b * TSEQ + q) * NP + cq + h * 64 + 4 * hf;
#pragma unroll
        for (int g = 0; g < 4; ++g) {
            *(uint2*)(orow + 8 * g) = make_uint2(cvt_pk_bf16(o0[4 * g] * inv, o0[4 * g + 1] * inv), cvt_pk_bf16(o0[4 * g + 2] * inv, o0[4 * g + 3] * inv));
            *(uint2*)(orow + 32 + 8 * g) = make_uint2(cvt_pk_bf16(o1[4 * g] * inv, o1[4 * g + 1] * inv), cvt_pk_bf16(o1[4 * g + 2] * inv, o1[4 * g + 3] * inv));
        }
    }
}

constexpr int DIL_LDS = 6 * TABW * 4 + AT_LDS;
__device__ __forceinline__ void dil_unit(const Params& p, int b, int qb, unsigned char* lds) {
    float* tab = (float*)lds;
    const int tid = opaque_tid(), wave = tid >> 6, lane = tid & 63;
    for (int i = tid; i < 6 * TABW; i += NT) tab[i] = p.biasC[i];
    __syncthreads();
    attn_block<false>(p.proj, p.VtC, b, qb, C_CQ, C_CK, tab, nullptr, lds + 6 * TABW * 4, p.proj, tid);
    __syncthreads();
}
__device__ __forceinline__ void phase_dil(const Params& p, int* ctr, volatile LAS int* slot, unsigned char* lds) {
    for (int u = grab_unit(ctr, slot); u < NBATCH * 16; u = grab_unit(ctr, slot)) { PROBE_UNIT_BEGIN(12, u == 0); dil_unit(p, u & 15, 15 - (u >> 4), lds); PROBE_UNIT_END(12, u == 0); }
}

constexpr int DSA_LDS = 128 * 64 * 4 + 1920 * 64;
__device__ __forceinline__ void cnt_ge(int& c, unsigned k, unsigned t) { asm("v_cmp_ge_u32 vcc, %1, %2\n\tv_addc_co_u32 %0, vcc, 0, %0, vcc" : "+v"(c) : "v"(k), "v"(t) : "vcc"); }
__device__ __forceinline__ void cnt_gt(int& c, unsigned k, unsigned t) { asm("v_cmp_gt_u32 vcc, %1, %2\n\tv_addc_co_u32 %0, vcc, 0, %0, vcc" : "+v"(c) : "v"(k), "v"(t) : "vcc"); }
__device__ __forceinline__ void cnt_eq(int& c, unsigned k, unsigned t) { asm("v_cmp_eq_u32 vcc, %1, %2\n\tv_addc_co_u32 %0, vcc, 0, %0, vcc" : "+v"(c) : "v"(k), "v"(t) : "vcc"); }
__device__ __forceinline__ int grp16_sum(int v) { v += __shfl_xor(v, 1); v += __shfl_xor(v, 2); v += __shfl_xor(v, 4); v += __shfl_xor(v, 8); return v; }
__device__ __forceinline__ void dsa_unit(const Params& p, int b, int qb, unsigned char* lds) {
    unsigned* mask32 = (unsigned*)lds;
    unsigned short* mask16 = (unsigned short*)mask32;
    unsigned char* ikb = lds + 128 * 64 * 4;
    float* tab = (float*)(lds + 128 * 64 * 4);
    const int tid = opaque_tid(), wave = tid >> 6, lane = tid & 63;
    const int nlt = 8 * qb;
    for (int pi = tid; pi < nlt * 64; pi += NT) {
        const int key = pi >> 2, cs = (pi & 3) ^ ((0 - (key >> 2)) & 3);
        __builtin_amdgcn_global_load_lds((const unsigned*)(p.proj + ((size_t)b * TSEQ + key) * NP + C_IK + cs * 8), (unsigned*)(ikb + pi * 16), 16, 0, 0);
    }
    for (int i = tid; i < 128 * 64; i += NT) mask32[i] = 0u;
    asm volatile("s_waitcnt vmcnt(0)" ::: "memory");
    __syncthreads();
    const int qi = lane >> 4, kl = lane & 15;
    PROBE_UNIT_BEGIN(13, qb == 15 && b == 0);
    for (int grp = wave; grp < 32; grp += 8) {
        const int qg = qb * 128 + grp * 4, myq = qg + qi;
        const bf16x8 af = *(const bf16x8*)(p.proj + ((size_t)b * TSEQ + qg + (kl >> 2)) * NP + C_IQ + (kl & 3) * 32 + 8 * qi);
        float w[4];
        {
            const uint2 wv = *(const uint2*)(p.proj + ((size_t)b * TSEQ + myq) * NP + C_IW);
            constexpr float WS = 0.5f * 0.17677669529663687f;
            w[0] = __uint_as_float(wv.x << 16) * WS; w[1] = __uint_as_float(wv.x & 0xFFFF0000u) * WS; w[2] = __uint_as_float(wv.y << 16) * WS; w[3] = __uint_as_float(wv.y & 0xFFFF0000u) * WS;
        }
        unsigned key[128];
#define SEL_SCORE(dst, frag, valid) do { f32x4 _a = {0.f, 0.f, 0.f, 0.f}; _a = __builtin_amdgcn_mfma_f32_16x16x32_bf16(af, (frag), _a, 0, 0, 0); \
            float _s = w[0] * fmaxf(_a[0], 0.f) + w[1] * fmaxf(_a[1], 0.f) + w[2] * fmaxf(_a[2], 0.f) + w[3] * fmaxf(_a[3], 0.f); _s += 0.0f; \
            const unsigned _u = __float_as_uint(_s); unsigned _k = (_u & 0x80000000u) ? ~_u : (_u | 0x80000000u); _k = _k == 0u ? 1u : _k; (dst) = (valid) ? _k : 0u; } while (0)
        {
            const bf16_t* kg = p.proj + ((size_t)b * TSEQ + nlt * 16 + kl) * NP + C_IK + 8 * qi;
#pragma unroll
            for (int c = 0; c < 4; ++c) {
                bf16x8 bfr[2];
#pragma unroll
                for (int i = 0; i < 2; ++i) bfr[i] = *(const bf16x8*)(kg + (size_t)(c * 2 + i) * 16 * NP);
#pragma unroll
                for (int i = 0; i < 2; ++i) SEL_SCORE(key[c * 2 + i], bfr[i], (nlt + c * 2 + i) * 16 + kl <= myq);
                asm volatile("" ::: "memory");
            }
        }
        const unsigned char* kp = ikb + kl * 64 + ((qi ^ ((0 - (kl >> 2)) & 3)) * 16);
#pragma unroll
        for (int c2 = 0; c2 < 60; ++c2) {
            if (c2 * 2 < nlt) {
                bf16x8 bfr[2];
#pragma unroll
                for (int i = 0; i < 2; ++i) bfr[i] = *(const bf16x8*)(kp + (c2 * 2 + i) * 1024);
#pragma unroll
                for (int i = 0; i < 2; ++i) SEL_SCORE(key[8 + c2 * 2 + i], bfr[i], true);
            } else {
#pragma unroll
                for (int i = 0; i < 2; ++i) key[8 + c2 * 2 + i] = 0u;
            }
            asm volatile("" ::: "memory");
        }
#undef SEL_SCORE
#define SEL_COUNT(FN, var, thr) do { \
            _Pragma("unroll") for (int t = 0; t < 32; ++t) FN(var, key[t], thr); \
            if (nlt > 24) { _Pragma("unroll") for (int t = 32; t < 64; ++t) FN(var, key[t], thr); } \
            if (nlt > 56) { _Pragma("unroll") for (int t = 64; t < 96; ++t) FN(var, key[t], thr); } \
            if (nlt > 88) { _Pragma("unroll") for (int t = 96; t < 128; ++t) FN(var, key[t], thr); } } while (0)
        unsigned T = 1u; int need = 0x7fffffff;
        if (qg + 3 >= 256) {
            unsigned Tb = 0u; bool done = false;
#pragma unroll 1
            for (int bit = 31; bit >= 0; --bit) {
                const unsigned Tc = Tb | (1u << bit);
                int c = 0;
                SEL_COUNT(cnt_ge, c, Tc);
                c = grp16_sum(c);
                Tb = (!done && c >= 256) ? Tc : Tb;
                done = done || (c == 256);
                if (__all(done || myq < 256)) break;
            }
            int cgt = 0;
            SEL_COUNT(cnt_gt, cgt, Tb);
            cgt = grp16_sum(cgt);
            if (myq >= 256) { T = Tb; need = 256 - cgt; }
        }
        int ceq = 0;
        SEL_COUNT(cnt_eq, ceq, T);
        ceq = grp16_sum(ceq);
#undef SEL_COUNT
        const bool slow = __any(need != 0x7fffffff && ceq != need);
        int run = 0;
        unsigned short* mrow = mask16 + (grp * 4 + qi) * 128;
#define SEL_EMIT(kv, tile) do { const bool _gt = (kv) > T, _eq = (kv) == T; bool _take = _gt || _eq; \
            if (slow) { const unsigned long long _em = __ballot(_eq); const unsigned _bits = (unsigned)(_em >> (16 * qi)) & 0xFFFFu; \
                const int _rank = run + __popc(_bits & ((1u << kl) - 1u)); _take = _gt || (_eq && _rank < need); run += __popc(_bits); } \
            const unsigned long long _tm = __ballot(_take); if (kl == 0) mrow[(tile)] = (unsigned short)((_tm >> (16 * qi)) & 0xFFFFull); } while (0)
#pragma unroll
        for (int t = 0; t < 120; ++t) { if (t < nlt) SEL_EMIT(key[8 + t], t); }
#pragma unroll
        for (int j = 0; j < 8; ++j) SEL_EMIT(key[j], nlt + j);
#undef SEL_EMIT
    }
    __syncthreads();
    PROBE_UNIT_END(13, qb == 15 && b == 0);
    for (int i = tid; i < 6 * TABW; i += NT) tab[i] = p.biasB[i];
    __syncthreads();
    attn_block<true>(p.proj, p.VtB, b, qb, C_BQ, C_BK, tab, mask32, lds + 128 * 64 * 4 + 6 * TABW * 4, p.proj, tid);
    __syncthreads();
}
__device__ __forceinline__ void phase_dsa(const Params& p, int* ctr, volatile LAS int* slot, unsigned char* lds) {
    for (int u = grab_unit(ctr, slot); u < NBATCH * 16; u = grab_unit(ctr, slot)) { PROBE_UNIT_BEGIN(11, u == 0); dsa_unit(p, u & 15, 15 - (u >> 4), lds); PROBE_UNIT_END(11, u == 0); }
}

constexpr int MG_LDS = MG_GLDS + 1024 + 16 * NT * 4;
__device__ __forceinline__ void phase_merge(const Params& p, int l, int bid, int nb, unsigned char* lds) {
    GemmCtx c = gemm_ctx();
    float* srstd = (float*)(lds + MG_NS * G_BUF);
    unsigned* sgate = (unsigned*)(lds + MG_NS * G_BUF + 1024);
    constexpr int NCT = DM / 128, NUX = (NTOK / 256 / 8) * NCT;
    const float* bg = p.in[I_BGATE] + (size_t)l * 4 * DM;
    const int xcd = bid & 7, nloc = nb >> 3;
    for (int k = bid >> 3; k < NUX; k += nloc) {
        const int rt = xcd * (NTOK / 256 / 8) + k / NCT, ct = k % NCT, brow = rt * 256, bcol = ct * 128;
        if (c.tid < 256) srstd[c.tid] = rstd_of(p.part, brow + c.tid);
        __syncthreads();
        f32x4 mg[4][4]; acc_zero(mg);
        const int r = c.tid >> 2;
        for (int i = 0; i < 4; ++i) {
            f32x4 acc[4][4]; acc_zero(acc);
            gemm_kloop_s<MG_NS, true>(acc, p.hb + (size_t)brow * DM, (unsigned)(r * DM + c.sc), (unsigned)((r + 128) * DM + c.sc), p.Bt_gate + ((size_t)i * DM + bcol) * DM, (unsigned)(r * DM + c.sc), DM / 32, lds, c);
            gemm_relane(c);
            int i2 = i; asm volatile("" : "+s"(i2));
            unsigned lcol = (unsigned)(c.wc * 64 + c.fq * 4); asm volatile("" : "+v"(lcol));
            unsigned gp[2][4][2];
#pragma unroll
            for (int m = 0; m < 4; ++m) {
                const float rs = srstd[c.wr * 64 + m * 16 + c.fr];
#pragma unroll
                for (int n = 0; n < 4; ++n) {
                    const f32x4 bv = *(const f32x4*)(bg + i2 * DM + bcol + n * 16 + lcol);
                    const unsigned g0 = cvt_pk_bf16(sigmoidf_(acc[m][n][0] * rs + bv[0]), sigmoidf_(acc[m][n][1] * rs + bv[1]));
                    const unsigned g1 = cvt_pk_bf16(sigmoidf_(acc[m][n][2] * rs + bv[2]), sigmoidf_(acc[m][n][3] * rs + bv[3]));
                    if (m < 2) { sgate[((m * 4 + n) * 2 + 0) * NT + c.tid] = g0; sgate[((m * 4 + n) * 2 + 1) * NT + c.tid] = g1; }
                    else { gp[m - 2][n][0] = g0; gp[m - 2][n][1] = g1; }
                }
            }
            acc_zero(acc);
            gemm_kloop_s<MG_NS, true>(acc, p.proj + (size_t)brow * NP + C_OB + i2 * 384, (unsigned)(r * NP + c.sc), (unsigned)((r + 128) * NP + c.sc),
                                     p.Bt_br + ((size_t)i2 * DM + bcol) * 384, (unsigned)(r * 384 + c.sc), 384 / 32, lds, c);
            gemm_relane(c);
#pragma unroll
            for (int m = 0; m < 4; ++m)
#pragma unroll
                for (int n = 0; n < 4; ++n) {
                    const unsigned g0 = m < 2 ? sgate[((m * 4 + n) * 2 + 0) * NT + c.tid] : gp[m < 2 ? 0 : m - 2][n][0];
                    const unsigned g1 = m < 2 ? sgate[((m * 4 + n) * 2 + 1) * NT + c.tid] : gp[m < 2 ? 0 : m - 2][n][1];
                    mg[m][n][0] += __uint_as_float(g0 << 16) * acc[m][n][0];
                    mg[m][n][1] += __uint_as_float(g0 & 0xFFFF0000u) * acc[m][n][1];
                    mg[m][n][2] += __uint_as_float(g1 << 16) * acc[m][n][2];
                    mg[m][n][3] += __uint_as_float(g1 & 0xFFFF0000u) * acc[m][n][3];
                }
        }
        unsigned orow = (unsigned)(c.wr * 64 + c.fr), ocol = (unsigned)(c.wc * 64 + c.fq * 4); asm volatile("" : "+v"(orow), "+v"(ocol));
#pragma unroll
        for (int m = 0; m < 4; ++m) {
            bf16_t* o = p.proj + (size_t)brow * NP + C_MG + bcol + (orow + m * 16) * NP + ocol;
#pragma unroll
            for (int n = 0; n < 4; ++n) *(uint2*)(o + n * 16) = make_uint2(cvt_pk_bf16(mg[m][n][0], mg[m][n][1]), cvt_pk_bf16(mg[m][n][2], mg[m][n][3]));
        }
        __syncthreads();
    }
}

__device__ __forceinline__ void phase_out(const Params& p, int l, int bid, int nb, unsigned char* lds) {
    Gemm2Ctx c = gemm2_ctx();
    constexpr int NCT = DM / 256, NUX = (NTOK / 256 / 8) * NCT;
    const float* hin = (l == 0) ? p.in[I_X] : p.h;
    const int xcd = bid & 7, nloc = nb >> 3;
    for (int k = bid >> 3; k < NUX; k += nloc) {
        const int rt = xcd * (NTOK / 256 / 8) + k / NCT, ct = k % NCT, brow = rt * 256, bcol = ct * 256;
        f32x4 acc[8][4]; acc2_zero(acc);
        const int r = c.tid >> 2;
        gemm2_kloop<true>(acc, p.proj + (size_t)brow * NP + C_MG, (unsigned)(r * NP + c.sc), (unsigned)((r + 128) * NP + c.sc), p.Bt_out + (size_t)bcol * DM,
                          (unsigned)(r * DM + c.sc), (unsigned)((r + 128) * DM + c.sc), DM / 32, lds, c);
        gemm2_relane(c);
#pragma unroll
        for (int m = 0; m < 8; ++m) {
            const int row = brow + c.wr * 128 + m * 16 + c.fr;
            const size_t off = (size_t)row * DM + bcol + c.wc * 64 + c.fq * 4;
            float ss = 0.f;
#pragma unroll
            for (int n = 0; n < 4; ++n) {
                const f32x4 v = *(const f32x4*)(hin + off + n * 16) + acc[m][n];
                *(f32x4*)(p.h + off + n * 16) = v;
                *(uint2*)(p.hb + off + n * 16) = make_uint2(cvt_pk_bf16(v[0], v[1]), cvt_pk_bf16(v[2], v[3]));
                ss += (v[0] * v[0] + v[1] * v[1]) + (v[2] * v[2] + v[3] * v[3]);
            }
            ss += __shfl_xor(ss, 16); ss += __shfl_xor(ss, 32);
            if (c.fq == 0) p.part[(size_t)row * 16 + ct * 4 + c.wc] = ss;
        }
    }
}

constexpr int RT_W_BYTES = 1024 * 20 * 4, RT_LDS = RT_W_BYTES + (64 + 2048) * 4;
__device__ __forceinline__ void phase_router(const Params& p, int l, int bid, int nb, unsigned char* lds) {
    float* W = (float*)lds;
    const int tid = opaque_tid(), wave = tid >> 6, lane = tid & 63;
    const float* n2 = p.in[I_N2] + l * DM;
    const float* wrg = p.in[I_WRG] + (size_t)l * DM * 4;
    const float* wre = p.in[I_WRE] + (size_t)l * DM * 16;
    for (int i = tid; i < 1024 * 20; i += NT) { const int k = i / 20, j = i % 20; W[j * 1024 + k] = n2[k] * (j < 4 ? wrg[k * 4 + j] : wre[k * 16 + (j - 4)]); }
    int* cnt = p.cnt + l * 32 * 32;
    int* lcnt = (int*)(lds + RT_W_BYTES); int* lbase = lcnt + 32; int* ltok = lbase + 32; int* lcls = ltok + 1024;
    if (tid < 32) lcnt[tid] = 0;
    __syncthreads();
    int nmine = 0;
    float hn[16]; float prn = 0.f;
    {
        const int row = bid * 8 + wave;
        if (row < NTOK) {
#pragma unroll
            for (int i = 0; i < 16; ++i) hn[i] = p.h[(size_t)row * DM + i * 64 + lane];
            prn = p.part[(size_t)row * 16 + (lane & 15)];
        }
    }
    for (int row = bid * 8 + wave; row < NTOK; row += nb * 8) {
        float hv[16]; float pr = prn;
#pragma unroll
        for (int i = 0; i < 16; ++i) hv[i] = hn[i];
        {
            const int rown = row + nb * 8;
            if (rown < NTOK) {
#pragma unroll
                for (int i = 0; i < 16; ++i) hn[i] = p.h[(size_t)rown * DM + i * 64 + lane];
                prn = p.part[(size_t)rown * 16 + (lane & 15)];
            }
        }
        pr += __shfl_xor(pr, 1); pr += __shfl_xor(pr, 2); pr += __shfl_xor(pr, 4); pr += __shfl_xor(pr, 8);
        const float rs = rsqrtf(pr * (1.0f / 1024.0f) + EPS);
        float a[20];
#pragma unroll
        for (int j = 0; j < 20; ++j) a[j] = 0.f;
#pragma unroll 1
        for (int i4 = 0; i4 < 4; ++i4) {
#pragma unroll
            for (int ii = 0; ii < 4; ++ii) {
                const float* w = W + (i4 * 4 + ii) * 64 + lane;
                const float h1 = ii == 0 ? hv[0] : (ii == 1 ? hv[1] : (ii == 2 ? hv[2] : hv[3]));
#pragma unroll
                for (int j = 0; j < 20; ++j) a[j] += h1 * w[j * 1024];
            }
#pragma unroll
            for (int q = 0; q < 12; ++q) hv[q] = hv[q + 4];
        }
#pragma unroll
        for (int j = 0; j < 20; ++j) a[j] = wave_sum(a[j]);
        if (lane == 0) {
            float gl[4];
#pragma unroll
            for (int j = 0; j < 4; ++j) gl[j] = a[j] * rs + p.in[I_BRG][l * 4 + j];
            int g = 0; float gm = gl[0];
#pragma unroll
            for (int j = 1; j < 4; ++j) if (gl[j] > gm) { gm = gl[j]; g = j; }
            float den = 0.f;
#pragma unroll
            for (int j = 0; j < 4; ++j) den += __expf(gl[j] - gm);
            const float gw = 1.0f / den;
            float el[4];
#pragma unroll
            for (int j = 0; j < 4; ++j) {
                float v = 0.f;
#pragma unroll
                for (int gg = 0; gg < 4; ++gg) v = (gg == g) ? (a[4 + gg * 4 + j] * rs + p.in[I_BRE][l * 16 + gg * 4 + j]) : v;
                el[j] = v;
            }
            int i1 = 0; float v1 = el[0];
#pragma unroll
            for (int j = 1; j < 4; ++j) if (el[j] > v1) { v1 = el[j]; i1 = j; }
            int i2 = -1; float v2 = -3.0e38f;
#pragma unroll
            for (int j = 0; j < 4; ++j) if (j != i1 && el[j] > v2) { v2 = el[j]; i2 = j; }
            const float e2 = __expf(v2 - v1);
            const float w1 = gw / (1.0f + e2), w2 = gw * e2 / (1.0f + e2);
            const int lo = i1 < i2 ? i1 : i2, hi = i1 < i2 ? i2 : i1;
            const float wlo = i1 < i2 ? w1 : w2, whi = i1 < i2 ? w2 : w1;
            const int pidx = lo == 0 ? (hi - 1) : (lo == 1 ? (hi + 1) : 5);
            const int cls = g * 6 + pidx;
            const int lr = __hip_atomic_fetch_add(&lcnt[cls], 1, __ATOMIC_RELAXED, __HIP_MEMORY_SCOPE_WORKGROUP);
            ltok[nmine * 8 + wave] = row; lcls[nmine * 8 + wave] = cls | (lr << 8);
            p.tokw[(size_t)row * 2] = wlo; p.tokw[(size_t)row * 2 + 1] = whi;
        }
        ++nmine;
    }
    __syncthreads();
    if (tid < NCLS) lbase[tid] = lcnt[tid] > 0 ? __hip_atomic_fetch_add(&cnt[tid * 32], lcnt[tid], __ATOMIC_RELAXED, __HIP_MEMORY_SCOPE_AGENT) : 0;
    __syncthreads();
    for (int i = tid; i < nmine * 8; i += NT) {
        const int cl = lcls[i] & 255, lr = lcls[i] >> 8;
        p.perm[(size_t)cl * NTOK + lbase[cl] + lr] = ltok[i];
    }
}

__device__ __forceinline__ void cls_experts(int cls, int& elo, int& ehi) {
    const int g = cls / 6, pi = cls % 6;
    const int lo = pi < 3 ? 0 : (pi < 5 ? 1 : 2), hi = pi < 3 ? pi + 1 : (pi < 5 ? pi - 1 : 3);
    elo = g * 4 + lo; ehi = g * 4 + hi;
}
__device__ __forceinline__ void moe_prefix(const int* cnt, int* spre, int* scnt) {
    if (opaque_tid() == 0) { int s = 0; for (int c = 0; c < NCLS; ++c) { const int n = cnt[c * 32]; scnt[c] = n; spre[c] = s; s += (n + 255) >> 8; } spre[NCLS] = s; }
    __syncthreads();
}

__device__ __forceinline__ void phase_moe1(const Params& p, int l, int bid, int nb, unsigned char* lds) {
    Gemm2Ctx c = gemm2_ctx();
    int* spre = (int*)(lds + G2_LDS); int* scnt = spre + 32;
    int* stok = scnt + 32; float* srs = (float*)(stok + 256); float* swl = srs + 256; float* swh = swl + 256;
    moe_prefix(p.cnt + l * 32 * 32, spre, scnt);
    const int nrt = spre[NCLS], nrtx = (nrt + 7) >> 3, xcd = bid & 7, nloc = nb >> 3;
    const int rt_lo = xcd * nrtx, rt_hi = rt_lo + nrtx < nrt ? rt_lo + nrtx : nrt;
    for (int k = bid >> 3; k < (rt_hi - rt_lo) * 8; k += nloc) {
        const int rt = rt_lo + (k >> 3), ct = k & 7;
        int cls = 0;
        for (int q = 1; q < NCLS; ++q) if (spre[q] <= rt) cls = q;
        int elo, ehi; cls_experts(cls, elo, ehi);
        const int lrow0 = (rt - spre[cls]) * 256, n = scnt[cls];
        if (c.tid < 256) {
            const int lr = lrow0 + c.tid; const bool ok = lr < n;
            const int tok = ok ? p.perm[(size_t)cls * NTOK + lr] : 0;
            stok[c.tid] = ok ? tok : -1; srs[c.tid] = rstd_of(p.part, tok);
            swl[c.tid] = p.tokw[(size_t)tok * 2]; swh[c.tid] = p.tokw[(size_t)tok * 2 + 1];
        }
        __syncthreads();
        const int r = c.tid >> 2;
        const int t0 = stok[r] < 0 ? 0 : stok[r], t1 = stok[r + 128] < 0 ? 0 : stok[r + 128];
        const int ex = ct < 4 ? elo : ehi;
        f32x4 acc[8][4]; acc2_zero(acc);
        gemm2_kloop<true>(acc, p.hb, (unsigned)(t0 * DM + c.sc), (unsigned)(t1 * DM + c.sc), p.Wgu + ((size_t)ex * DM + (ct & 3) * 256) * DM,
                          (unsigned)(r * DM + c.sc), (unsigned)((r + 128) * DM + c.sc), DM / 32, lds, c);
        gemm2_relane(c);
#pragma unroll
        for (int m = 0; m < 8; ++m) {
            const int rl = c.wr * 128 + m * 16 + c.fr; const float rs = srs[rl], w = ct < 4 ? swl[rl] : swh[rl];
            bf16_t* o = p.Hbuf + ((size_t)rt * 256 + rl) * DM + (ct < 4 ? 0 : 512) + (ct & 3) * 128 + c.wc * 32 + c.fq * 4;
#pragma unroll
            for (int n2 = 0; n2 < 2; ++n2) {
                float hv[4];
#pragma unroll
                for (int j = 0; j < 4; ++j) hv[j] = siluf_(acc[m][n2][j] * rs) * (acc[m][n2 + 2][j] * rs) * w;
                *(uint2*)(o + n2 * 16) = make_uint2(cvt_pk_bf16(hv[0], hv[1]), cvt_pk_bf16(hv[2], hv[3]));
            }
        }
        __syncthreads();
    }
}

__device__ __forceinline__ void phase_moe2(const Params& p, int l, int bid, int nb, unsigned char* lds) {
    Gemm2Ctx c = gemm2_ctx();
    int* spre = (int*)(lds + G2_LDS); int* scnt = spre + 32; int* stok = scnt + 32;
    moe_prefix(p.cnt + l * 32 * 32, spre, scnt);
    const int nrt = spre[NCLS], nrtx = (nrt + 7) >> 3, xcd = bid & 7, nloc = nb >> 3;
    const int rt_lo = xcd * nrtx, rt_hi = rt_lo + nrtx < nrt ? rt_lo + nrtx : nrt;
    for (int k = bid >> 3; k < (rt_hi - rt_lo) * 4; k += nloc) {
        const int rt = rt_lo + (k >> 2), ct = k & 3;
        int cls = 0;
        for (int q = 1; q < NCLS; ++q) if (spre[q] <= rt) cls = q;
        int elo, ehi; cls_experts(cls, elo, ehi);
        const int lrow0 = (rt - spre[cls]) * 256, n = scnt[cls];
        if (c.tid < 256) { const int lr = lrow0 + c.tid; stok[c.tid] = lr < n ? p.perm[(size_t)cls * NTOK + lr] : -1; }
        __syncthreads();
        const int r = c.tid >> 2;
        f32x4 acc[8][4]; acc2_zero(acc);
        const bf16_t* a0 = p.Hbuf + (size_t)rt * 256 * DM;
        const unsigned oa0 = (unsigned)(r * DM + c.sc), oa1 = (unsigned)((r + 128) * DM + c.sc), ob0 = (unsigned)(r * 512 + c.sc), ob1 = (unsigned)((r + 128) * 512 + c.sc);
        gemm2_kloop<true>(acc, a0, oa0, oa1, p.WdT + ((size_t)elo * DM + ct * 256) * 512, ob0, ob1, 16, lds, c);
        gemm2_relane(c);
        gemm2_kloop<true>(acc, a0 + 512, oa0, oa1, p.WdT + ((size_t)ehi * DM + ct * 256) * 512, ob0, ob1, 16, lds, c);
        gemm2_relane(c);
#pragma unroll
        for (int m = 0; m < 8; ++m) {
            const int rl = c.wr * 128 + m * 16 + c.fr; const int tok = stok[rl];
            const size_t off = (size_t)(tok < 0 ? 0 : tok) * DM + ct * 256 + c.wc * 64 + c.fq * 4;
            float ss = 0.f;
            if (tok >= 0) {
#pragma unroll
                for (int n2 = 0; n2 < 4; ++n2) {
                    const f32x4 v = *(const f32x4*)(p.h + off + n2 * 16) + acc[m][n2];
                    *(f32x4*)(p.h + off + n2 * 16) = v;
                    *(uint2*)(p.hb + off + n2 * 16) = make_uint2(cvt_pk_bf16(v[0], v[1]), cvt_pk_bf16(v[2], v[3]));
                    ss += (v[0] * v[0] + v[1] * v[1]) + (v[2] * v[2] + v[3] * v[3]);
                }
            }
            ss += __shfl_xor(ss, 16); ss += __shfl_xor(ss, 32);
            if (c.fq == 0 && tok >= 0) p.part[(size_t)tok * 16 + ct * 4 + c.wc] = ss;
        }
        __syncthreads();
    }
}

__device__ __forceinline__ void phase_final(const Params& p, int bid, int nb) {
    const int tid = opaque_tid(), wave = tid >> 6, lane = tid & 63;
    const float* nf = p.in[I_NF];
    for (int row = bid * 8 + wave; row < NTOK; row += nb * 8) {
        const float rs = rstd_of(p.part, row);
        float* hr = p.h + (size_t)row * DM;
#pragma unroll
        for (int i = 0; i < 4; ++i) {
            f32x4 v = *(const f32x4*)(hr + i * 256 + lane * 4);
            const f32x4 g = *(const f32x4*)(nf + i * 256 + lane * 4);
            v[0] *= rs * g[0]; v[1] *= rs * g[1]; v[2] *= rs * g[2]; v[3] *= rs * g[3];
            *(f32x4*)(hr + i * 256 + lane * 4) = v;
        }
    }
}

constexpr int cmax(int a, int b) { return a > b ? a : b; }
constexpr int MEGA_LDS_BODY = cmax(cmax(cmax(GLA_LDS, LRU_LDS), cmax(DSA_LDS, DIL_LDS)), cmax(cmax(MG_LDS, RT_LDS), G2_LDS + 8192));
constexpr int MEGA_LDS = PROBE_MASK ? 160 * 1024 : MEGA_LDS_BODY + 16;


__device__ __forceinline__ const Params& kparams() {
    const __attribute__((address_space(4))) Params* q = (const __attribute__((address_space(4))) Params*)__builtin_amdgcn_kernarg_segment_ptr();
    asm volatile("" : "+s"(q));
    return *(const Params*)q;
}
__global__ void __launch_bounds__(NT, 2) mega(Params p_kernarg) {
    (void)p_kernarg;
#define p kparams()
    unsigned char* lds = dyn_lds;
    volatile LAS unsigned* xbw = (volatile LAS unsigned*)(dyn_lds + MEGA_LDS_BODY);
    if (threadIdx.x == 0) { xbw[0] = 0u; xbw[1] = 0u; xbw[2] = 0u; xbw[3] = 0u; }
    __syncthreads();
    (void)xcd_barrier_post(p.bar, xbw);
#define PROBE_TICK(type) do { if (PROBE_MASK != 0 && blockIdx.x == 0 && threadIdx.x == 0) { volatile LAS unsigned long long* pw = (volatile LAS unsigned long long*)(dyn_lds + PROBE_OFF); \
        const unsigned long long now = __builtin_amdgcn_s_memrealtime(); if ((PROBE_MASK >> (type)) & 1) pw[1] += now - pw[0]; pw[0] = now; } } while (0)
#define PROBE_SINCE(bit) do { if (((PROBE_MASK >> (bit)) & 1) && blockIdx.x == 0 && threadIdx.x == 0) { volatile LAS unsigned long long* pw = (volatile LAS unsigned long long*)(dyn_lds + PROBE_OFF); \
        pw[1] += __builtin_amdgcn_s_memrealtime() - pw[0]; } } while (0)
#define GRID_SYNC() do { XcdBarrier _b; _b.bar = p.bar; _b.x = xb_xcc_id(); _b.st = (volatile LAS unsigned*)(dyn_lds + MEGA_LDS_BODY); xcd_barrier(_b); } while (0)
    const int bid = blockIdx.x, nb = gridDim.x;
    if (PROBE_MASK != 0 && threadIdx.x == 0) { volatile LAS unsigned long long* pw = (volatile LAS unsigned long long*)(dyn_lds + PROBE_OFF); pw[0] = __builtin_amdgcn_s_memrealtime(); pw[1] = 0ull; }
    phase_prep(p, bid, nb);
    GRID_SYNC(); PROBE_TICK(0);
#pragma unroll 1
    for (int l = 0; l < DEPTH; ++l) {
        phase_weights(p, l, bid, nb, lds);
        GRID_SYNC(); PROBE_TICK(1);
        phase_inproj(p, bid, nb, lds);
        GRID_SYNC(); PROBE_TICK(2);
        if (PROBE_GEMM_VAR >= 0 && l == 0) { phase_gemm_probe<PROBE_GEMM_VAR>(p, bid, nb, lds); GRID_SYNC(); }
        {
            volatile LAS int* slot = (volatile LAS int*)(dyn_lds + MEGA_LDS_BODY + 12);
            int* qc = p.cnt + (l * 32 + 24) * 32;
            phase_gla(p, l, qc + 0 * 32, slot, lds); PROBE_SINCE(14);
            phase_lru(p, l, qc + 1 * 32, slot, lds); PROBE_SINCE(15);
            phase_dsa(p, qc + 2 * 32, slot, lds); PROBE_SINCE(16);
            phase_dil(p, qc + 3 * 32, slot, lds); PROBE_SINCE(17);
        }
        GRID_SYNC(); PROBE_TICK(3);
        phase_merge(p, l, bid, nb, lds);
        GRID_SYNC(); PROBE_TICK(4);
        phase_out(p, l, bid, nb, lds);
        GRID_SYNC(); PROBE_TICK(5);
        phase_router(p, l, bid, nb, lds);
        GRID_SYNC(); PROBE_TICK(6);
        phase_moe1(p, l, bid, nb, lds);
        GRID_SYNC(); PROBE_TICK(7);
        phase_moe2(p, l, bid, nb, lds);
        GRID_SYNC(); PROBE_TICK(8);
    }
    phase_final(p, bid, nb);
    if (PROBE_MASK != 0 && threadIdx.x == 0) { volatile LAS unsigned long long* pw = (volatile LAS unsigned long long*)(dyn_lds + PROBE_OFF);
        const unsigned long long t0 = __builtin_amdgcn_s_memrealtime(), w = pw[1]; while (__builtin_amdgcn_s_memrealtime() - t0 < w) __builtin_amdgcn_s_sleep(8); }
#undef p
}

static size_t align_up(size_t v, size_t a) { return (v + a - 1) / a * a; }

extern "C" void kernel_launch(void* const* d_in, const int* in_sizes, int n_in, void* d_out, int out_size, void* d_ws, size_t ws_size, hipStream_t stream) {
    (void)in_sizes; (void)n_in; (void)out_size;
    Params p{};
    for (int i = 0; i < N_IN; ++i) p.in[i] = (const float*)d_in[i];
    p.h = (float*)d_out;
    unsigned char* w = (unsigned char*)d_ws; size_t off = 0;
    auto take = [&](size_t bytes) { unsigned char* r = w + off; off = align_up(off + bytes, 256); return r; };
    p.bar = (unsigned*)take(XCD_BAR_WORDS * 4);
    p.cnt = (int*)take(DEPTH * 32 * 32 * 4);
    p.Bt_in = (bf16_t*)take((size_t)NP * DM * 2);
    p.Bt_gate = (bf16_t*)take((size_t)4 * DM * DM * 2);
    p.Bt_br = (bf16_t*)take((size_t)4 * DM * 384 * 2);
    p.Bt_out = (bf16_t*)take((size_t)DM * DM * 2);
    p.Wgu = (bf16_t*)take((size_t)16 * DM * DM * 2);
    p.WdT = (bf16_t*)take((size_t)16 * DM * 512 * 2);
    p.hb = (bf16_t*)take((size_t)NTOK * DM * 2);
    p.part = (float*)take((size_t)NTOK * 16 * 4);
    p.biasB = (float*)take(6 * TABW * 4);
    p.biasC = (float*)take(6 * TABW * 4);
    p.VtB = (bf16_t*)take((size_t)NTOK * 384 * 2);
    p.VtC = (bf16_t*)take((size_t)NTOK * 384 * 2);
    p.tokw = (float*)take((size_t)NTOK * 2 * 4);
    p.perm = (int*)take((size_t)NCLS * NTOK * 4);
    p.proj = (bf16_t*)take((size_t)NTOK * NP * 2);
    p.Hbuf = p.proj;
    if (off > ws_size) return;

    static int grid = 0;
    if (grid == 0) {
        int dev = 0, cus = 0;
        (void)hipGetDevice(&dev);
        (void)hipDeviceGetAttribute(&cus, hipDeviceAttributeMultiprocessorCount, dev);
        if (hipFuncSetAttribute((const void*)mega, hipFuncAttributeMaxDynamicSharedMemorySize, MEGA_LDS) != hipSuccess) { grid = -1; return; }
        int per_cu = 0;
        (void)hipOccupancyMaxActiveBlocksPerMultiprocessor(&per_cu, (const void*)mega, NT, MEGA_LDS);
        (void)hipGetLastError();
        grid = cus > 0 ? cus : 256;
    }
    if (grid < 0) return;
    (void)hipMemsetAsync(p.bar, 0, XCD_BAR_WORDS * sizeof(unsigned), stream);
    mega<<<grid, NT, MEGA_LDS, stream>>>(p);
}
```

```cpp
#include <hip/hip_runtime.h>
#include <stdint.h>

typedef unsigned short bf16_t;
typedef short bf16x8 __attribute__((ext_vector_type(8)));
typedef float f32x4 __attribute__((ext_vector_type(4)));
typedef unsigned u32x4 __attribute__((ext_vector_type(4)));
typedef float f32x16 __attribute__((ext_vector_type(16)));

constexpr int NTOK = 32768, TSEQ = 2048, NBATCH = 16, DM = 1024, DEPTH = 2;
constexpr int NP = 4608;
constexpr int NT = 512;
constexpr int C_AQ = 0, C_AK = 192, C_AV = 384, C_AG = 768, C_BQ = 1152, C_CQ = 1536, C_DY = 1920, C_BK = 2304, C_CK = 2688,
              C_BV = 3072, C_CV = 3456, C_DX = 3840, C_IQ = 4224, C_IK = 4352, C_ALR = 4384, C_IW = 4400;
constexpr int C_OB = 768;
constexpr int C_MG = 2304;
constexpr float EPS = 1e-6f;
constexpr int NCLS = 24, MAXRT = 152;
constexpr int TABW = 2080;
constexpr float LOG2E = 1.4426950408889634f, NEG_BIG = -3.0e38f;

#ifndef PROBE_MASK
#define PROBE_MASK 0
#endif
extern __shared__ __attribute__((aligned(16))) unsigned char dyn_lds[];
constexpr int PROBE_OFF = 160 * 1024 - 64;
#define PROBE_UNIT_BEGIN(bit, cond) do { if (((PROBE_MASK >> (bit)) & 1) && (cond) && threadIdx.x == 0) { volatile __attribute__((address_space(3))) unsigned long long* pw = (volatile __attribute__((address_space(3))) unsigned long long*)(dyn_lds + PROBE_OFF); pw[2] = __builtin_amdgcn_s_memrealtime(); } } while (0)
#define PROBE_UNIT_END(bit, cond) do { if (((PROBE_MASK >> (bit)) & 1) && (cond) && threadIdx.x == 0) { volatile __attribute__((address_space(3))) unsigned long long* pw = (volatile __attribute__((address_space(3))) unsigned long long*)(dyn_lds + PROBE_OFF); pw[1] += 4ull * (__builtin_amdgcn_s_memrealtime() - pw[2]); } } while (0)

enum { I_X = 0, I_WIN, I_AW2, I_AB2, I_AGAIN, I_CONVW, I_CONVB, I_WR, I_BR, I_WI, I_BI, I_LAM, I_WGATE, I_BGATE, I_WBR, I_WOUT, I_RELB,
       I_N1, I_N2, I_NF, I_WRG, I_BRG, I_WRE, I_BRE, I_MWG, I_MWU, I_MWD, N_IN };

struct Params {
    const float* in[N_IN];
    float* h;
    bf16_t* Bt_in;
    bf16_t* Bt_gate;
    bf16_t* Bt_br;
    bf16_t* Bt_out;
    bf16_t* Wgu;
    bf16_t* WdT;
    bf16_t* hb;
    bf16_t* proj;
    bf16_t* Hbuf;
    float* part;
    float* biasB;
    float* biasC;
    bf16_t* VtB;
    bf16_t* VtC;
    float* tokw;
    int* perm;
    int* cnt;
    unsigned* bar;
};

__device__ __forceinline__ bf16_t f2bf(float f) { unsigned u = __float_as_uint(f); u += 0x7FFFu + ((u >> 16) & 1u); return (bf16_t)(u >> 16); }
__device__ __forceinline__ float bf2f(bf16_t b) { return __uint_as_float(((unsigned)b) << 16); }
__device__ __forceinline__ float wave_sum(float v) {
#pragma unroll
    for (int o = 32; o > 0; o >>= 1) v += __shfl_xor(v, o);
    return v;
}
__device__ __forceinline__ float wave_max(float v) {
#pragma unroll
    for (int o = 32; o > 0; o >>= 1) v = fmaxf(v, __shfl_xor(v, o));
    return v;
}
__device__ __forceinline__ int wave_sum_i(int v) {
#pragma unroll
    for (int o = 32; o > 0; o >>= 1) v += __shfl_xor(v, o);
    return v;
}
__device__ __forceinline__ int opaque_tid() { int t = threadIdx.x; asm volatile("" : "+v"(t)); return t; }
__device__ __forceinline__ unsigned cvt_pk_bf16(float lo, float hi) { unsigned r; asm volatile("v_cvt_pk_bf16_f32 %0, %1, %2" : "=v"(r) : "v"(lo), "v"(hi)); return r; }
__device__ __forceinline__ float sigmoidf_(float x) { return 1.0f / (1.0f + __expf(-x)); }
__device__ __forceinline__ float siluf_(float x) { return x / (1.0f + __expf(-x)); }
__device__ __forceinline__ float rstd_of(const float* part, int row) {
    const f32x4* p = (const f32x4*)(part + (size_t)row * 16);
    f32x4 a = p[0], b = p[1], c = p[2], d = p[3];
    float s = ((a[0] + a[1]) + (a[2] + a[3])) + ((b[0] + b[1]) + (b[2] + b[3])) + ((c[0] + c[1]) + (c[2] + c[3])) + ((d[0] + d[1]) + (d[2] + d[3]));
    return rsqrtf(s * (1.0f / 1024.0f) + EPS);
}
__device__ __forceinline__ int map_in_col(int c) {
    if (c < 1152) return c;
    if (c < 1536) return 1168 + (c - 1152);
    if (c < 1920) return 2484 + (c - 1536);
    if (c < 2304) return 3636 + (c - 1920);
    if (c < 2688) return 1552 + (c - 2304);
    if (c < 3072) return 2868 + (c - 2688);
    if (c < 3456) return 1936 + (c - 3072);
    if (c < 3840) return 3252 + (c - 3456);
    if (c < 4224) return 4020 + (c - 3840);
    if (c < 4352) return 2320 + (c - 4224);
    if (c < 4384) return 2448 + (c - 4352);
    if (c < 4400) return 1152 + (c - 4384);
    if (c < 4404) return 2480 + (c - 4400);
    return -1;
}
__device__ __forceinline__ int rel_bucket(int n) {
    if (n < 16) return n;
    float v = logf((float)n / 16.0f) / 4.852030263919617f * 16.0f;
    int b = 16 + (int)v;
    return b < 31 ? b : 31;
}

#define XB_TMO      128
#define XB_XCNT(j)  (256  + 64 * (j))
#define XB_XSUB(j)  (1280 + 64 * (j))
#define XB_XGEN(j)  (2304 + 64 * (j))
#define XB_TOP      3328
#define XB_TOPGEN   3392
#define XCD_BAR_WORDS 3456
#define XB_SPIN_CAP (1u << 18)
#define LAS __attribute__((address_space(3)))

__device__ __forceinline__ unsigned xb_ld(unsigned* p)              { return __hip_atomic_load(p, __ATOMIC_RELAXED, __HIP_MEMORY_SCOPE_AGENT); }
__device__ __forceinline__ unsigned xb_add(unsigned* p, unsigned v) { return __hip_atomic_fetch_add(p, v, __ATOMIC_RELAXED, __HIP_MEMORY_SCOPE_AGENT); }
__device__ __forceinline__ unsigned xb_xcc_id() { return (unsigned)__builtin_amdgcn_s_getreg((3 << 11) | 20) & 0xFu; }
#define XB_SPIN(cond, bar) do { unsigned _sp = 0; while (cond) { __builtin_amdgcn_s_sleep(1); \
    if ((++_sp & 255u) == 0u) { if (xb_ld(&(bar)[XB_TMO])) break; if (_sp > XB_SPIN_CAP) { atomicAdd(&(bar)[XB_TMO], 1u); break; } } } } while (0)

struct XcdBarrier {
    unsigned* bar; unsigned x;
    volatile LAS unsigned* st;
};

__device__ __forceinline__ XcdBarrier xcd_barrier_post(unsigned* bar, volatile LAS unsigned* st) {
    XcdBarrier b; b.bar = bar; b.x = xb_xcc_id(); b.st = st;
    if (threadIdx.x == 0) (void)xb_add(&bar[XB_XCNT(b.x)], 1u);
    return b;
}
__device__ __forceinline__ void xcd_barrier_complete(unsigned* bar, unsigned x, unsigned& nloc, unsigned& nx) {
    const unsigned G = gridDim.x * gridDim.y * gridDim.z;
    unsigned sum, cnt, mine, sp = 0u;
    for (;;) {
        sum = 0u; cnt = 0u; mine = 0u;
#pragma unroll
        for (unsigned j = 0; j < 16; ++j) { const unsigned c = xb_ld(&bar[XB_XCNT(j)]); sum += c; cnt += (c > 0u) ? 1u : 0u; mine = (j == x) ? c : mine; }
        if (sum == G) break;
        __builtin_amdgcn_s_sleep(1);
        if ((++sp & 255u) == 0u) { if (xb_ld(&bar[XB_TMO])) break; if (sp > XB_SPIN_CAP) { atomicAdd(&bar[XB_TMO], 1u); break; } }
    }
    nloc = mine > 0u ? mine : 1u; nx = cnt > 0u ? cnt : 1u;
}

__device__ __forceinline__ void xcd_barrier(const XcdBarrier& b) {
    asm volatile("s_waitcnt vmcnt(0)" ::: "memory");
    __syncthreads();
    if (threadIdx.x == 0) {
        unsigned* bar = b.bar;
        __builtin_amdgcn_s_waitcnt(0);
        unsigned nloc = b.st[0], nx = b.st[1];
        if (nloc == 0u) { xcd_barrier_complete(bar, b.x, nloc, nx); b.st[0] = nloc; b.st[1] = nx; }
        const unsigned old = xb_add(&bar[XB_XSUB(b.x)], 1u);
        const unsigned gen = old / nloc;
        if (old + 1u == (gen + 1u) * nloc) {
            __builtin_amdgcn_fence(__ATOMIC_RELEASE, "agent");
            asm volatile("s_waitcnt vmcnt(0)" ::: "memory");
            const unsigned og = xb_add(&bar[XB_TOP], 1u);
            const unsigned tg = og / nx;
            if (og + 1u == (tg + 1u) * nx) xb_add(&bar[XB_TOPGEN], 1u);
            else XB_SPIN(xb_ld(&bar[XB_TOPGEN]) == tg, bar);
            __builtin_amdgcn_fence(__ATOMIC_ACQUIRE, "agent");
            xb_add(&bar[XB_XGEN(b.x)], 1u);
            asm volatile("s_waitcnt vmcnt(0)" ::: "memory");
        } else {
            XB_SPIN(xb_ld(&bar[XB_XGEN(b.x)]) == gen, bar);
            __builtin_amdgcn_fence(__ATOMIC_ACQUIRE, "agent");
            asm volatile("s_waitcnt vmcnt(0)" ::: "memory");
        }
    }
    __syncthreads();
}


template <class MapF>
__device__ __forceinline__ void conv_wT(const float* __restrict__ src, int ldsrc, int K, bf16_t* __restrict__ dst, int nrows, MapF colmap,
                                        const float* __restrict__ scale, int bid, int nb, float* tile) {
    const int tid = opaque_tid(), nkt = K / 64, ntile = (nrows / 64) * nkt;
    for (int t = bid; t < ntile; t += nb) {
        const int r0 = (t / nkt) * 64, k0 = (t % nkt) * 64;
#pragma unroll
        for (int i = 0; i < 8; ++i) {
            const int e = tid + NT * i, kk = e >> 6, rr = e & 63;
            const int c = colmap(r0 + rr);
            float v = 0.f;
            if (c >= 0) { v = src[(size_t)(k0 + kk) * ldsrc + c]; if (scale) v *= scale[k0 + kk]; }
            tile[kk * 65 + rr] = v;
        }
        __syncthreads();
#pragma unroll
        for (int i = 0; i < 8; ++i) {
            const int e = tid + NT * i, rr = e >> 6, kk = e & 63;
            dst[(size_t)(r0 + rr) * K + k0 + kk] = f2bf(tile[kk * 65 + rr]);
        }
        __syncthreads();
    }
}

__device__ __forceinline__ void phase_weights(const Params& p, int l, int bid, int nb, unsigned char* lds) {
    float* tile = (float*)lds;
    const float* n1 = p.in[I_N1] + l * DM;
    const float* n2 = p.in[I_N2] + l * DM;
    conv_wT(p.in[I_WIN] + (size_t)l * DM * 4404, 4404, DM, p.Bt_in, NP, [](int r) { return map_in_col(r); }, n1, bid, nb, tile);
    for (int i = 0; i < 4; ++i) {
        conv_wT(p.in[I_WGATE] + ((size_t)l * 4 + i) * DM * DM, DM, DM, p.Bt_gate + (size_t)i * DM * DM, DM, [](int r) { return r; }, n1, bid, nb, tile);
        conv_wT(p.in[I_WBR] + ((size_t)l * 4 + i) * 384 * DM, DM, 384, p.Bt_br + (size_t)i * DM * 384, DM, [](int r) { return r; }, nullptr, bid, nb, tile);
    }
    conv_wT(p.in[I_WOUT] + (size_t)l * DM * DM, DM, DM, p.Bt_out, DM, [](int r) { return r; }, nullptr, bid, nb, tile);
    for (int e = 0; e < 16; ++e) {
        const float* wg = p.in[I_MWG] + ((size_t)l * 16 + e) * DM * 512;
        const float* wu = p.in[I_MWU] + ((size_t)l * 16 + e) * DM * 512;
        bf16_t* dst = p.Wgu + (size_t)e * DM * DM;
        {
            const int tid = opaque_tid();
            for (int t = bid; t < 16 * 16; t += nb) {
                const int r0 = (t / 16) * 64, k0 = (t % 16) * 64;
#pragma unroll
                for (int i = 0; i < 8; ++i) {
                    const int ee = tid + NT * i, kk = ee >> 6, rr = ee & 63, rho = r0 + rr;
                    const int T = rho >> 8, wc = (rho >> 6) & 3, q = (rho >> 5) & 1, ii = rho & 31, hcol = 128 * T + 32 * wc + ii;
                    const float* s = q ? wu : wg;
                    tile[kk * 65 + rr] = s[(size_t)(k0 + kk) * 512 + hcol] * n2[k0 + kk];
                }
                __syncthreads();
#pragma unroll
                for (int i = 0; i < 8; ++i) {
                    const int ee = tid + NT * i, rr = ee >> 6, kk = ee & 63;
                    dst[(size_t)(r0 + rr) * DM + k0 + kk] = f2bf(tile[kk * 65 + rr]);
                }
                __syncthreads();
            }
        }
        conv_wT(p.in[I_MWD] + ((size_t)l * 16 + e) * 512 * DM, DM, 512, p.WdT + (size_t)e * DM * 512, DM, [](int r) { return r; }, nullptr, bid, nb, tile);
    }
}

__device__ __forceinline__ void phase_prep(const Params& p, int bid, int nb) {
    const int tid = opaque_tid(), wave = tid >> 6, lane = tid & 63;
    const float* x = p.in[I_X];
    for (int row = bid * 8 + wave; row < NTOK; row += nb * 8) {
        const float* xr = x + (size_t)row * DM;
        float s = 0.f;
#pragma unroll
        for (int i = 0; i < 4; ++i) {
            const f32x4 v = *(const f32x4*)(xr + i * 256 + lane * 4);
            s += v[0] * v[0] + v[1] * v[1] + v[2] * v[2] + v[3] * v[3];
            const unsigned lo = (unsigned)f2bf(v[0]) | ((unsigned)f2bf(v[1]) << 16), hi = (unsigned)f2bf(v[2]) | ((unsigned)f2bf(v[3]) << 16);
            *(uint2*)(p.hb + (size_t)row * DM + i * 256 + lane * 4) = make_uint2(lo, hi);
        }
        s = wave_sum(s);
        if (lane < 16) p.part[(size_t)row * 16 + lane] = (lane == 0) ? s : 0.f;
    }
    const float* rb = p.in[I_RELB];
    for (int i = bid * NT + tid; i < 6 * TABW; i += nb * NT) {
        const int h = i / TABW, d = i % TABW - 32;
        float vb = NEG_BIG, vc = NEG_BIG;
        if (d >= 0) {
            const int bk = rel_bucket(d);
            vb = rb[bk * 12 + h] * LOG2E;
            const int m = (d <= 128 ? 1 : 0) + ((d % 4 == 0 && d <= 512) ? 1 : 0) + ((d % 16 == 0) ? 1 : 0);
            if (m > 0) vc = (rb[bk * 12 + 6 + h] + logf((float)m)) * LOG2E;
        }
        p.biasB[i] = vb; p.biasC[i] = vc;
    }
    for (int i = bid * NT + tid; i < DEPTH * 32 * 32; i += nb * NT) p.cnt[i] = 0;
}

constexpr int G_BUF = 256 * 32 * 2 + 128 * 32 * 2;
constexpr int G_NS = 6, G_LDS = G_NS * G_BUF;
constexpr int MG_NS = 5, MG_GLDS = MG_NS * G_BUF;
struct GemmCtx { int tid, wid, lane, wr, wc, fr, fq, sc, rdo; };
__device__ __forceinline__ GemmCtx gemm_ctx() {
    GemmCtx c; c.tid = opaque_tid(); c.wid = __builtin_amdgcn_readfirstlane(c.tid >> 6); c.lane = c.tid & 63; c.wr = c.wid >> 1; c.wc = c.wid & 1; c.fr = c.lane & 15; c.fq = c.lane >> 4;
    c.sc = (((c.tid & 3) ^ ((0 - (c.tid >> 4)) & 3))) * 8;
    c.rdo = c.fr * 64 + ((c.fq ^ ((0 - (c.fr >> 2)) & 3)) * 16);
    return c;
}
__device__ __forceinline__ void gemm_relane(GemmCtx& c) { int t = c.tid; asm volatile("" : "+v"(t)); c.lane = t & 63; c.fr = t & 15; c.fq = (t >> 4) & 3; }
__device__ __forceinline__ void acc_zero(f32x4 (&acc)[4][4]) {
#pragma unroll
    for (int m = 0; m < 4; ++m)
#pragma unroll
        for (int n = 0; n < 4; ++n) acc[m][n] = (f32x4){0.f, 0.f, 0.f, 0.f};
}
__device__ __forceinline__ unsigned lds_addr(const void* p) { return (unsigned)(size_t)(const LAS unsigned char*)p; }
__device__ __forceinline__ void glds16_s(const void* sbase, unsigned voff_bytes, unsigned lds_dst) {
    unsigned keep;
    asm volatile("s_mov_b32 %0, m0\n\ts_mov_b32 m0, %3\n\ts_nop 0\n\tglobal_load_lds_dwordx4 %1, %2\n\ts_mov_b32 m0, %0" : "=&s"(keep) : "v"(voff_bytes), "s"(sbase), "s"(lds_dst) : "memory");
}
__device__ __forceinline__ void gemm_stage(const bf16_t* A, unsigned oa0, unsigned oa1, const bf16_t* B, unsigned ob, int t, unsigned char* buf, const GemmCtx& c) {
    const bf16_t* At = A + t * 32; const bf16_t* Bt = B + t * 32;
    const unsigned l0 = lds_addr(buf) + c.wid * 1024;
    glds16_s(At, oa0 * 2u, l0);
    glds16_s(At, oa1 * 2u, l0 + 8192);
    glds16_s(Bt, ob * 2u, l0 + 16384);
}
template <int NS>
__device__ __forceinline__ void gemm_kloop(f32x4 (&acc)[4][4], const bf16_t* A, unsigned oa0, unsigned oa1, const bf16_t* B, unsigned ob, int nkt, unsigned char* lds, const GemmCtx& c) {
#pragma unroll
    for (int i = 0; i < NS - 1; ++i) gemm_stage(A, oa0, oa1, B, ob, i, lds + i * G_BUF, c);
    int cur = 0;
#pragma unroll 1
    for (int t = 0; t < nkt; ++t) {
        const int young = nkt - 1 - t;
        if (NS >= 6 && young >= 4) asm volatile("s_waitcnt vmcnt(12)" ::: "memory");
        else if (NS >= 5 && young >= 3) asm volatile("s_waitcnt vmcnt(9)" ::: "memory");
        else if (NS >= 4 && young >= 2) asm volatile("s_waitcnt vmcnt(6)" ::: "memory");
        else if (young >= 1) asm volatile("s_waitcnt vmcnt(3)" ::: "memory");
        else asm volatile("s_waitcnt vmcnt(0)" ::: "memory");
        __builtin_amdgcn_s_barrier();
        asm volatile("" ::: "memory");
        const int nxt = cur == 0 ? NS - 1 : cur - 1;
        if (t + NS - 1 < nkt) gemm_stage(A, oa0, oa1, B, ob, t + NS - 1, lds + nxt * G_BUF, c);
        const unsigned char* SA = lds + cur * G_BUF; const unsigned char* SB = SA + 16384;
        bf16x8 At[4], Bt[4];
#pragma unroll
        for (int m = 0; m < 4; ++m) At[m] = *reinterpret_cast<const bf16x8*>(SA + (c.wr * 64 + m * 16) * 64 + c.rdo);
#pragma unroll
        for (int n = 0; n < 4; ++n) Bt[n] = *reinterpret_cast<const bf16x8*>(SB + (c.wc * 64 + n * 16) * 64 + c.rdo);
        asm volatile("s_waitcnt lgkmcnt(0)" ::: "memory");
        __builtin_amdgcn_sched_barrier(0);
#pragma unroll
        for (int m = 0; m < 4; ++m)
#pragma unroll
            for (int n = 0; n < 4; ++n) acc[m][n] = __builtin_amdgcn_mfma_f32_16x16x32_bf16(At[m], Bt[n], acc[m][n], 0, 0, 0);
        cur = cur == NS - 1 ? 0 : cur + 1;
    }
    __builtin_amdgcn_s_barrier();
    asm volatile("" ::: "memory");
}

template <int NS>
__device__ __forceinline__ void gemm_kloop_p(f32x4 (&acc)[4][4], const bf16_t* A, unsigned oa0, unsigned oa1, const bf16_t* B, unsigned ob, int nkt, unsigned char* lds, const GemmCtx& c) {
#pragma unroll
    for (int i = 0; i < NS; ++i) gemm_stage(A, oa0, oa1, B, ob, i, lds + i * G_BUF, c);
    const int aoff = (c.wr * 64) * 64 + c.rdo, boff = 16384 + (c.wc * 64) * 64 + c.rdo;
    bf16x8 A0[4], B0[4], A1[4], B1[4];
#define GK_WAIT(young_) do { const int _y = (young_); \
        if (NS >= 6 && _y >= 4) asm volatile("s_waitcnt vmcnt(12)" ::: "memory"); \
        else if (NS >= 5 && _y >= 3) asm volatile("s_waitcnt vmcnt(9)" ::: "memory"); \
        else if (NS >= 4 && _y >= 2) asm volatile("s_waitcnt vmcnt(6)" ::: "memory"); \
        else if (_y >= 1) asm volatile("s_waitcnt vmcnt(3)" ::: "memory"); \
        else asm volatile("s_waitcnt vmcnt(0)" ::: "memory"); } while (0)
#define GK_READ(FA, FB, buf_) do { const unsigned char* _s = lds + (buf_) * G_BUF; \
        _Pragma("unroll") for (int m = 0; m < 4; ++m) FA[m] = *reinterpret_cast<const bf16x8*>(_s + aoff + m * 1024); \
        _Pragma("unroll") for (int n = 0; n < 4; ++n) FB[n] = *reinterpret_cast<const bf16x8*>(_s + boff + n * 1024); } while (0)
#define GK_MMA(FA, FB) do { _Pragma("unroll") for (int m = 0; m < 4; ++m) _Pragma("unroll") for (int n = 0; n < 4; ++n) \
        acc[m][n] = __builtin_amdgcn_mfma_f32_16x16x32_bf16(FA[m], FB[n], acc[m][n], 0, 0, 0); } while (0)
    GK_WAIT(NS - 1);
    __builtin_amdgcn_s_barrier(); asm volatile("" ::: "memory");
    GK_READ(A0, B0, 0);
    int cur = 0;
#pragma unroll 1
    for (int t = 0; t < nkt; t += 2) {
        {
            GK_WAIT(nkt - 2 - t < NS - 2 ? nkt - 2 - t : NS - 2);
            asm volatile("s_waitcnt lgkmcnt(0)" ::: "memory");
            __builtin_amdgcn_s_barrier(); asm volatile("" ::: "memory");
            if (t + NS < nkt) gemm_stage(A, oa0, oa1, B, ob, t + NS, lds + cur * G_BUF, c);
            const int n1 = cur == NS - 1 ? 0 : cur + 1;
            GK_READ(A1, B1, n1);
            GK_MMA(A0, B0);
            cur = n1;
        }
        {
            const bool more = t + 2 < nkt;
            if (more) GK_WAIT(nkt - 3 - t < NS - 2 ? nkt - 3 - t : NS - 2);
            asm volatile("s_waitcnt lgkmcnt(0)" ::: "memory");
            __builtin_amdgcn_s_barrier(); asm volatile("" ::: "memory");
            if (t + 1 + NS < nkt) gemm_stage(A, oa0, oa1, B, ob, t + 1 + NS, lds + cur * G_BUF, c);
            const int n1 = cur == NS - 1 ? 0 : cur + 1;
            if (more) GK_READ(A0, B0, n1);
            GK_MMA(A1, B1);
            cur = n1;
        }
    }
#undef GK_WAIT
#undef GK_READ
#undef GK_MMA
    __builtin_amdgcn_s_barrier(); asm volatile("" ::: "memory");
}

template <int NS, bool SWAP>
__device__ __forceinline__ void gemm_kloop_s(f32x4 (&acc)[4][4], const bf16_t* A, unsigned oa0, unsigned oa1, const bf16_t* B, unsigned ob, int nkt, unsigned char* lds, const GemmCtx& c) {
    constexpr int D = NS - 2;
#pragma unroll
    for (int i = 0; i < D; ++i) gemm_stage(A, oa0, oa1, B, ob, i, lds + i * G_BUF, c);
    const int aoff = (c.wr * 64) * 64 + c.rdo, boff = 16384 + (c.wc * 64) * 64 + c.rdo;
    const bool trailing = c.wid >= 4;
#define GS_WAIT(young_) do { const int _y = (young_); \
        if (D >= 5 && _y >= 3) asm volatile("s_waitcnt vmcnt(9)" ::: "memory"); \
        else if (D >= 4 && _y >= 2) asm volatile("s_waitcnt vmcnt(6)" ::: "memory"); \
        else if (_y >= 1) asm volatile("s_waitcnt vmcnt(3)" ::: "memory"); \
        else asm volatile("s_waitcnt vmcnt(0)" ::: "memory"); } while (0)
    GS_WAIT(D - 1);
    __builtin_amdgcn_s_barrier(); asm volatile("" ::: "memory");
    if (trailing) { __builtin_amdgcn_s_barrier(); asm volatile("" ::: "memory"); }
    int cur = 0, nxt = D % NS;
#pragma unroll 1
    for (int t = 0; t < nkt; ++t) {
        if (t + 1 < nkt) GS_WAIT(nkt - 2 - t < D - 2 ? nkt - 2 - t : D - 2);
        if (t + D < nkt) gemm_stage(A, oa0, oa1, B, ob, t + D, lds + nxt * G_BUF, c);
        const unsigned char* sb = lds + cur * G_BUF;
        bf16x8 At[4], Bt[4];
#pragma unroll
        for (int m = 0; m < 4; ++m) At[m] = *reinterpret_cast<const bf16x8*>(sb + aoff + m * 1024);
#pragma unroll
        for (int n = 0; n < 4; ++n) Bt[n] = *reinterpret_cast<const bf16x8*>(sb + boff + n * 1024);
        __builtin_amdgcn_s_barrier(); asm volatile("" ::: "memory");
        asm volatile("s_waitcnt lgkmcnt(0)" ::: "memory");
        __builtin_amdgcn_sched_barrier(0);
        __builtin_amdgcn_s_setprio(1);
#pragma unroll
        for (int m = 0; m < 4; ++m)
#pragma unroll
            for (int n = 0; n < 4; ++n) acc[m][n] = SWAP ? __builtin_amdgcn_mfma_f32_16x16x32_bf16(Bt[n], At[m], acc[m][n], 0, 0, 0) : __builtin_amdgcn_mfma_f32_16x16x32_bf16(At[m], Bt[n], acc[m][n], 0, 0, 0);
        __builtin_amdgcn_s_setprio(0);
        __builtin_amdgcn_s_barrier(); asm volatile("" ::: "memory");
        cur = cur == NS - 1 ? 0 : cur + 1; nxt = nxt == NS - 1 ? 0 : nxt + 1;
    }
#undef GS_WAIT
    if (!trailing) { __builtin_amdgcn_s_barrier(); asm volatile("" ::: "memory"); }
}

constexpr int G2_BUF = 2 * 256 * 32 * 2, G2_NS = 4, G2_LDS = G2_NS * G2_BUF;
struct Gemm2Ctx { int tid, wid, wr, wc, sc, aoff, boff, fr, fq; };
__device__ __forceinline__ Gemm2Ctx gemm2_ctx() {
    Gemm2Ctx c; c.tid = opaque_tid(); c.wid = __builtin_amdgcn_readfirstlane(c.tid >> 6); c.wr = c.wid >> 2; c.wc = c.wid & 3;
    const int lane = c.tid & 63; c.fr = lane & 15; c.fq = lane >> 4;
    c.sc = (((c.tid & 3) ^ ((0 - (c.tid >> 4)) & 3))) * 8;
    const int rdo = c.fr * 64 + ((c.fq ^ ((0 - (c.fr >> 2)) & 3)) * 16);
    c.aoff = (c.wr * 128) * 64 + rdo; c.boff = 16384 + (c.wc * 64) * 64 + rdo;
    return c;
}
__device__ __forceinline__ void gemm2_relane(Gemm2Ctx& c) { int t = c.tid; asm volatile("" : "+v"(t)); c.fr = t & 15; c.fq = (t >> 4) & 3; }
__device__ __forceinline__ void acc2_zero(f32x4 (&acc)[8][4]) {
#pragma unroll
    for (int m = 0; m < 8; ++m)
#pragma unroll
        for (int n = 0; n < 4; ++n) acc[m][n] = (f32x4){0.f, 0.f, 0.f, 0.f};
}
__device__ __forceinline__ void gemm2_stage(const bf16_t* A, unsigned oa0, unsigned oa1, const bf16_t* B, unsigned ob0, unsigned ob1, int t, unsigned char* buf, int wid) {
    const bf16_t* At = A + t * 32; const bf16_t* Bt = B + t * 32;
    const unsigned l0 = lds_addr(buf) + wid * 1024;
    glds16_s(At, oa0 * 2u, l0);
    glds16_s(At, oa1 * 2u, l0 + 8192);
    glds16_s(Bt, ob0 * 2u, l0 + 16384);
    glds16_s(Bt, ob1 * 2u, l0 + 24576);
}
template <bool SWAP>
__device__ __forceinline__ void gemm2_kloop(f32x4 (&acc)[8][4], const bf16_t* A, unsigned oa0, unsigned oa1, const bf16_t* B, unsigned ob0, unsigned ob1, int nkt, unsigned char* lds, const Gemm2Ctx& c) {
#pragma unroll
    for (int i = 0; i < 2; ++i) gemm2_stage(A, oa0, oa1, B, ob0, ob1, i, lds + i * G2_BUF, c.wid);
    const bool trailing = c.wid >= 4;
    asm volatile("s_waitcnt vmcnt(4)" ::: "memory");
    __builtin_amdgcn_s_barrier(); asm volatile("" ::: "memory");
    if (trailing) { __builtin_amdgcn_s_barrier(); asm volatile("" ::: "memory"); }
    int cur = 0;
#pragma unroll 1
    for (int t = 0; t < nkt; ++t) {
        if (t + 2 < nkt) gemm2_stage(A, oa0, oa1, B, ob0, ob1, t + 2, lds + (cur >= 2 ? cur - 2 : cur + 2) * G2_BUF, c.wid);
        const unsigned char* sb = lds + cur * G2_BUF;
        bf16x8 At[8], Bt[4];
#pragma unroll
        for (int n = 0; n < 4; ++n) Bt[n] = *reinterpret_cast<const bf16x8*>(sb + c.boff + n * 1024);
#pragma unroll
        for (int m = 0; m < 8; ++m) At[m] = *reinterpret_cast<const bf16x8*>(sb + c.aoff + m * 1024);
        if (trailing) { if (t + 2 < nkt) asm volatile("s_waitcnt vmcnt(4)" ::: "memory"); else asm volatile("s_waitcnt vmcnt(0)" ::: "memory"); }
        __builtin_amdgcn_s_barrier(); asm volatile("" ::: "memory");
        asm volatile("s_waitcnt lgkmcnt(0)" ::: "memory");
        __builtin_amdgcn_sched_barrier(0);
#pragma unroll
        for (int m = 0; m < 8; ++m)
#pragma unroll
            for (int n = 0; n < 4; ++n) acc[m][n] = SWAP ? __builtin_amdgcn_mfma_f32_16x16x32_bf16(Bt[n], At[m], acc[m][n], 0, 0, 0) : __builtin_amdgcn_mfma_f32_16x16x32_bf16(At[m], Bt[n], acc[m][n], 0, 0, 0);
        if (!trailing) { if (t + 2 < nkt) asm volatile("s_waitcnt vmcnt(4)" ::: "memory"); else asm volatile("s_waitcnt vmcnt(0)" ::: "memory"); }
        __builtin_amdgcn_s_barrier(); asm volatile("" ::: "memory");
        cur = cur == 3 ? 0 : cur + 1;
    }
    if (!trailing) { __builtin_amdgcn_s_barrier(); asm volatile("" ::: "memory"); }
}

__device__ __forceinline__ void phase_inproj(const Params& p, int bid, int nb, unsigned char* lds) {
    Gemm2Ctx c = gemm2_ctx();
    float* srstd = (float*)(lds + G2_LDS);
    constexpr int NCT = NP / 256, NUX = (NTOK / 256 / 8) * NCT;
    const int xcd = bid & 7, nloc = nb >> 3;
    for (int k = bid >> 3; k < NUX; k += nloc) {
        const int rt = xcd * (NTOK / 256 / 8) + k / NCT, ct = k % NCT, brow = rt * 256, bcol = ct * 256;
        if (c.tid < 256) srstd[c.tid] = rstd_of(p.part, brow + c.tid);
        f32x4 acc[8][4]; acc2_zero(acc);
        const int r = c.tid >> 2;
        const unsigned o0 = (unsigned)(r * DM + c.sc), o1 = (unsigned)((r + 128) * DM + c.sc);
        if (ct >= C_BV / 256 && ct < C_BV / 256 + 3) {
            gemm2_kloop<false>(acc, p.hb + (size_t)brow * DM, o0, o1, p.Bt_in + (size_t)bcol * DM, o0, o1, DM / 32, lds, c);
            gemm2_relane(c);
            const int vcol = bcol - C_BV + c.wc * 64;
            bf16_t* vt = (vcol < 384 ? p.VtB + ((size_t)(brow / TSEQ) * 384 + vcol + c.fr) * TSEQ : p.VtC + ((size_t)(brow / TSEQ) * 384 + (vcol - 384) + c.fr) * TSEQ)
                         + (brow % TSEQ) + c.wr * 128 + ((((c.fq & 1) << 1) | (c.fq >> 1)) * 4);
#pragma unroll
            for (int m = 0; m < 8; ++m) {
                const int rl = c.wr * 128 + m * 16 + c.fq * 4;
                const float r0 = srstd[rl], r1 = srstd[rl + 1], r2 = srstd[rl + 2], r3 = srstd[rl + 3];
#pragma unroll
                for (int n = 0; n < 4; ++n)
                    *(uint2*)(vt + (size_t)(n * 16) * TSEQ + m * 16) = make_uint2(cvt_pk_bf16(acc[m][n][0] * r0, acc[m][n][1] * r1), cvt_pk_bf16(acc[m][n][2] * r2, acc[m][n][3] * r3));
            }
        } else {
            gemm2_kloop<true>(acc, p.hb + (size_t)brow * DM, o0, o1, p.Bt_in + (size_t)bcol * DM, o0, o1, DM / 32, lds, c);
            gemm2_relane(c);
#pragma unroll
            for (int m = 0; m < 8; ++m) {
                const int rl = c.wr * 128 + m * 16 + c.fr; const float rs = srstd[rl];
                bf16_t* o = p.proj + (size_t)(brow + rl) * NP + bcol + c.wc * 64 + c.fq * 4;
#pragma unroll
                for (int n = 0; n < 4; ++n) *(uint2*)(o + n * 16) = make_uint2(cvt_pk_bf16(acc[m][n][0] * rs, acc[m][n][1] * rs), cvt_pk_bf16(acc[m][n][2] * rs, acc[m][n][3] * rs));
            }
        }
        __syncthreads();
    }
}

struct UnitSrc { int next, stride; };
__device__ __forceinline__ int grab_unit(UnitSrc& q) { __syncthreads(); const int u = q.next; q.next += q.stride; return u; }

#ifndef PROBE_GEMM_VAR
#define PROBE_GEMM_VAR -1
#endif
template <int VAR>
__device__ __forceinline__ void phase_gemm_probe(const Params& p, int bid, int nb, unsigned char* lds) {
    const GemmCtx c = gemm_ctx();
    constexpr int NS = G_NS, NCT = NP / 128, NU = (NTOK / 256) * NCT;
    for (int u = bid; u < NU; u += nb) {
        const int rt = u / NCT, ct = u % NCT, brow = rt * 256, bcol = ct * 128;
        f32x4 acc[4][4]; acc_zero(acc);
        const int r = c.tid >> 2;
        const bf16_t* A = p.hb + (size_t)brow * DM; const bf16_t* B = p.Bt_in + (size_t)bcol * DM;
        const unsigned oa0 = (unsigned)(r * DM + c.sc), oa1 = (unsigned)((r + 128) * DM + c.sc), ob = (unsigned)(r * DM + c.sc);
        const int nkt = DM / 32;
#pragma unroll
        for (int i = 0; i < NS - 1; ++i) gemm_stage(A, oa0, oa1, B, ob, i, lds + i * G_BUF, c);
        int cur = 0;
        bf16x8 At[4], Bt[4];
        if (VAR == 2) {
            asm volatile("s_waitcnt vmcnt(0)" ::: "memory"); __builtin_amdgcn_s_barrier();
#pragma unroll
            for (int m = 0; m < 4; ++m) At[m] = *reinterpret_cast<const bf16x8*>(lds + (c.wr * 64 + m * 16) * 64 + c.rdo);
#pragma unroll
            for (int n = 0; n < 4; ++n) Bt[n] = *reinterpret_cast<const bf16x8*>(lds + 16384 + (c.wc * 64 + n * 16) * 64 + c.rdo);
        }
#pragma unroll 1
        for (int t = 0; t < nkt; ++t) {
            const int young = nkt - 1 - t;
            if (VAR == 1) { if (t == 0) asm volatile("s_waitcnt vmcnt(0)" ::: "memory"); }
            else if (young >= 4) asm volatile("s_waitcnt vmcnt(12)" ::: "memory");
            else if (young >= 3) asm volatile("s_waitcnt vmcnt(9)" ::: "memory");
            else if (young >= 2) asm volatile("s_waitcnt vmcnt(6)" ::: "memory");
            else if (young >= 1) asm volatile("s_waitcnt vmcnt(3)" ::: "memory");
            else asm volatile("s_waitcnt vmcnt(0)" ::: "memory");
            if (VAR != 3) __builtin_amdgcn_s_barrier();
            asm volatile("" ::: "memory");
            const int nxt = cur == 0 ? NS - 1 : cur - 1;
            if (VAR != 1 && t + NS - 1 < nkt) gemm_stage(A, oa0, oa1, B, ob, t + NS - 1, lds + nxt * G_BUF, c);
            const unsigned char* SA = lds + cur * G_BUF; const unsigned char* SB = SA + 16384;
            if (VAR != 2) {
#pragma unroll
                for (int m = 0; m < 4; ++m) At[m] = *reinterpret_cast<const bf16x8*>(SA + (c.wr * 64 + m * 16) * 64 + c.rdo);
#pragma unroll
                for (int n = 0; n < 4; ++n) Bt[n] = *reinterpret_cast<const bf16x8*>(SB + (c.wc * 64 + n * 16) * 64 + c.rdo);
                asm volatile("s_waitcnt lgkmcnt(0)" ::: "memory");
            }
            __builtin_amdgcn_sched_barrier(0);
            if (VAR != 4) {
#pragma unroll
                for (int m = 0; m < 4; ++m)
#pragma unroll
                    for (int n = 0; n < 4; ++n) acc[m][n] = __builtin_amdgcn_mfma_f32_16x16x32_bf16(At[m], Bt[n], acc[m][n], 0, 0, 0);
            } else {
#pragma unroll
                for (int m = 0; m < 4; ++m) asm volatile("" :: "v"(At[m]), "v"(Bt[m]));
            }
            cur = cur == NS - 1 ? 0 : cur + 1;
        }
        __builtin_amdgcn_s_barrier();
        asm volatile("" ::: "memory");
        float sacc = 0.f;
#pragma unroll
        for (int m = 0; m < 4; ++m)
#pragma unroll
            for (int n = 0; n < 4; ++n) sacc += acc[m][n][0] + acc[m][n][1] + acc[m][n][2] + acc[m][n][3];
        if (sacc == 1.2345e33f) p.part[0] = sacc;
    }
}

constexpr int GQ = 56, GS = 72, GO = 97;
constexpr int GL_QD = 0, GL_KD = GL_QD + 64 * GQ * 2, GL_KET = GL_KD + 64 * GQ * 2, GL_VT = GL_KET + 64 * GS * 2, GL_ATT = GL_VT + 96 * GS * 2, GL_ST = GL_ATT + 64 * GS * 2,
              GL_OO = GL_ST + 96 * GQ * 2, GL_BC = GL_OO + 64 * GO * 4, GL_SEG = GL_BC + 64 * 48 * 4, GL_EBL = GL_SEG + 8 * 48 * 4, GL_W2 = GL_EBL + 64 * 4, GL_B2 = GL_W2 + 16 * 48 * 4,
              GL_GAIN = GL_B2 + 48 * 4, GL_RQ = GL_GAIN + 96 * 4, GL_RK = GL_RQ + 64 * 48 * 2, GL_RV = GL_RK + 64 * 48 * 2, GL_RA = GL_RV + 64 * 96 * 2, GL_RG = GL_RA + 64 * 16 * 2,
              GLA_LDS = GL_RG + 2 * 64 * 96 * 2;
static_assert(GL_OO % 16 == 0 && GL_RQ % 16 == 0 && GL_RG % 16 == 0 && GL_ST % 16 == 0, "GLA LDS map alignment");
__device__ __forceinline__ void phase_gla(const Params& p, int l, UnitSrc q, unsigned char* lds) {
    bf16_t* qd = (bf16_t*)(lds + GL_QD); bf16_t* kd = (bf16_t*)(lds + GL_KD); bf16_t* keT = (bf16_t*)(lds + GL_KET); bf16_t* vT = (bf16_t*)(lds + GL_VT);
    bf16_t* att = (bf16_t*)(lds + GL_ATT); bf16_t* ST = (bf16_t*)(lds + GL_ST);
    float* oo = (float*)(lds + GL_OO); float* bc = (float*)(lds + GL_BC); float* seg = (float*)(lds + GL_SEG); float* ebl = (float*)(lds + GL_EBL);
    float* w2s = (float*)(lds + GL_W2); float* b2s = (float*)(lds + GL_B2); float* gains = (float*)(lds + GL_GAIN);
    bf16_t* rq = (bf16_t*)(lds + GL_RQ); bf16_t* rk = (bf16_t*)(lds + GL_RK); bf16_t* rv = (bf16_t*)(lds + GL_RV); bf16_t* ra = (bf16_t*)(lds + GL_RA); bf16_t* rg = (bf16_t*)(lds + GL_RG);
    const int tid = opaque_tid(), wave = tid >> 6, lane = tid & 63, r = lane & 31, hf = lane >> 5;
    for (int u = grab_unit(q); u < NBATCH * 4; u = grab_unit(q)) {
        const int b = u >> 2, h = u & 3;
        PROBE_UNIT_BEGIN(9, u == 0);
        for (int i = tid; i < 16 * 48; i += NT) w2s[i] = p.in[I_AW2][(size_t)l * 16 * 192 + (i / 48) * 192 + h * 48 + (i % 48)];
        if (tid < 48) b2s[tid] = p.in[I_AB2][l * 192 + h * 48 + tid];
        if (tid < 96) gains[tid] = p.in[I_AGAIN][l * 384 + h * 96 + tid];
        if (tid < 64) ebl[tid] = 1.0f;
        for (int i = tid; i < 96 * GQ; i += NT) ST[i] = 0;
        for (int i = tid; i < 64 * GS; i += NT) { keT[i] = 0; att[i] = 0; }
        const bf16_t* src[5]; int dsto[5];
#pragma unroll
        for (int j = 0; j < 5; ++j) {
            const int pid = tid + NT * j; int row = 0, col = 0, dst = -1;
            if (pid < 384) { row = pid / 6; col = C_AQ + h * 48 + (pid % 6) * 8; dst = GL_RQ + pid * 16; }
            else if (pid < 768) { const int q = pid - 384; row = q / 6; col = C_AK + h * 48 + (q % 6) * 8; dst = GL_RK + q * 16; }
            else if (pid < 1536) { const int q = pid - 768; row = q / 12; col = C_AV + h * 96 + (q % 12) * 8; dst = GL_RV + q * 16; }
            else if (pid < 2304) { const int q = pid - 1536; row = q / 12; col = C_AG + h * 96 + (q % 12) * 8; dst = GL_RG + q * 16; }
            else if (pid < 2432) { const int q = pid - 2304; row = q / 2; col = C_ALR + (q % 2) * 8; dst = GL_RA + q * 16; }
            src[j] = p.proj + ((size_t)b * TSEQ + row) * NP + col; dsto[j] = dst;
        }
        u32x4 pre[5];
#pragma unroll
        for (int j = 0; j < 5; ++j) pre[j] = dsto[j] >= 0 ? *(const u32x4*)src[j] : (u32x4){0u, 0u, 0u, 0u};
        f32x16 Sacc;
#pragma unroll
        for (int i = 0; i < 16; ++i) Sacc[i] = 0.f;
        const int kt = wave / 3, vt = wave % 3;
        __syncthreads();
        for (int n = 0; n < 32; ++n) {
            const size_t row0 = (size_t)b * TSEQ + n * 64;
            const int gsel = (n & 1) * (64 * 96 * 2);
#pragma unroll
            for (int j = 0; j < 5; ++j) if (dsto[j] >= 0) *(u32x4*)(lds + dsto[j] + (dsto[j] >= GL_RG ? gsel : 0)) = pre[j];
            if (n + 1 < 32) {
#pragma unroll
                for (int j = 0; j < 5; ++j) if (dsto[j] >= 0) pre[j] = *(const u32x4*)(src[j] + (size_t)(n + 1) * 64 * NP);
            }
            __syncthreads();
            for (int e = tid; e < 64 * 48; e += NT) {
                const int t = e / 48, k = e % 48;
                float z = b2s[k];
#pragma unroll
                for (int rr = 0; rr < 16; ++rr) z += bf2f(ra[t * 16 + rr]) * w2s[rr * 48 + k];
                bc[e] = (fminf(z, 0.f) - log1pf(__expf(-fabsf(z)))) * (1.0f / 16.0f);
            }
            __syncthreads();
            if (tid < 384) {
                const int k = tid % 48, sg = tid / 48; float run = 0.f;
#pragma unroll
                for (int i = 0; i < 8; ++i) { run += bc[(sg * 8 + i) * 48 + k]; bc[(sg * 8 + i) * 48 + k] = run; }
                seg[sg * 48 + k] = run;
            }
            __syncthreads();
            if (tid < 384) {
                const int k = tid % 48, sg = tid / 48; float pre_s = 0.f;
                for (int s2 = 0; s2 < sg; ++s2) pre_s += seg[s2 * 48 + k];
#pragma unroll
                for (int i = 0; i < 8; ++i) bc[(sg * 8 + i) * 48 + k] += pre_s;
            }
            __syncthreads();
            for (int e = tid; e < 64 * 48; e += NT) {
                const int t = e / 48, k = e % 48;
                const float bb = bc[e], bl = bc[63 * 48 + k];
                const float q = bf2f(rq[e]) * 0.14433756729740643f, kk = bf2f(rk[e]);
                qd[t * GQ + k] = f2bf(q * __expf(bb)); kd[t * GQ + k] = f2bf(kk * __expf(-bb)); keT[k * GS + t] = f2bf(kk * __expf(bl - bb));
                if (t == 63) ebl[k] = __expf(bl);
            }
            for (int e = tid; e < 64 * 96; e += NT) { const int t = e / 96, v = e % 96; vT[v * GS + t] = rv[e]; }
            __syncthreads();
            if (wave < 3) {
                const int si = wave == 2 ? 1 : 0, ci = wave >= 1 ? 1 : 0;
                f32x16 x;
#pragma unroll
                for (int i = 0; i < 16; ++i) x[i] = 0.f;
#pragma unroll
                for (int st = 0; st < 3; ++st)
                    x = __builtin_amdgcn_mfma_f32_32x32x16_bf16(*(const bf16x8*)(kd + (si * 32 + r) * GQ + 16 * st + 8 * hf), *(const bf16x8*)(qd + (ci * 32 + r) * GQ + 16 * st + 8 * hf), x, 0, 0, 0);
                const int cq = ci * 32 + r;
#pragma unroll
                for (int g = 0; g < 4; ++g) {
                    const int s0 = si * 32 + 8 * g + 4 * hf;
                    const float v0 = s0 <= cq ? x[4 * g] : 0.f, v1 = s0 + 1 <= cq ? x[4 * g + 1] : 0.f, v2 = s0 + 2 <= cq ? x[4 * g + 2] : 0.f, v3 = s0 + 3 <= cq ? x[4 * g + 3] : 0.f;
                    *(uint2*)(att + cq * GS + s0) = make_uint2(cvt_pk_bf16(v0, v1), cvt_pk_bf16(v2, v3));
                }
            }
            if (wave < 6) {
#pragma unroll
                for (int i = 0; i < 16; ++i) Sacc[i] *= ebl[kt * 32 + (i & 3) + 8 * (i >> 2) + 4 * hf];
#pragma unroll
                for (int st = 0; st < 4; ++st)
                    Sacc = __builtin_amdgcn_mfma_f32_32x32x16_bf16(*(const bf16x8*)(keT + (kt * 32 + r) * GS + 16 * st + 8 * hf), *(const bf16x8*)(vT + (vt * 32 + r) * GS + 16 * st + 8 * hf), Sacc, 0, 0, 0);
            }
            __syncthreads();
            if (wave < 6) {
                f32x16 o;
#pragma unroll
                for (int i = 0; i < 16; ++i) o[i] = 0.f;
#pragma unroll
                for (int st = 0; st < 4; ++st)
                    if (st < 2 || kt == 1)
                        o = __builtin_amdgcn_mfma_f32_32x32x16_bf16(*(const bf16x8*)(att + (kt * 32 + r) * GS + 16 * st + 8 * hf), *(const bf16x8*)(vT + (vt * 32 + r) * GS + 16 * st + 8 * hf), o, 0, 0, 0);
#pragma unroll
                for (int st = 0; st < 3; ++st)
                    o = __builtin_amdgcn_mfma_f32_32x32x16_bf16(*(const bf16x8*)(qd + (kt * 32 + r) * GQ + 16 * st + 8 * hf), *(const bf16x8*)(ST + (vt * 32 + r) * GQ + 16 * st + 8 * hf), o, 0, 0, 0);
#pragma unroll
                for (int i = 0; i < 16; ++i) oo[(kt * 32 + (i & 3) + 8 * (i >> 2) + 4 * hf) * GO + vt * 32 + r] = o[i];
            }
            __syncthreads();
            for (int t = wave; t < 64; t += 8) {
                const float o0 = oo[t * GO + lane], o1 = lane < 32 ? oo[t * GO + 64 + lane] : 0.f;
                const float ms = wave_sum(o0 * o0 + o1 * o1) * (1.0f / 96.0f);
                const float rs = rsqrtf(ms + EPS);
                const bf16_t* gr = (const bf16_t*)((const unsigned char*)rg + gsel) + t * 96;
                bf16_t* g = p.proj + (row0 + t) * NP + C_AG + h * 96;
                g[lane] = f2bf(o0 * rs * gains[lane] * siluf_(bf2f(gr[lane])));
                if (lane < 32) g[64 + lane] = f2bf(o1 * rs * gains[64 + lane] * siluf_(bf2f(gr[64 + lane])));
            }
            if (wave < 6) {
#pragma unroll
                for (int g = 0; g < 4; ++g) {
                    const int k0 = kt * 32 + 8 * g + 4 * hf;
                    if (k0 < 48) *(uint2*)(ST + (vt * 32 + r) * GQ + k0) = make_uint2(cvt_pk_bf16(Sacc[4 * g], Sacc[4 * g + 1]), cvt_pk_bf16(Sacc[4 * g + 2], Sacc[4 * g + 3]));
                }
            }
            __syncthreads();
        }
        PROBE_UNIT_END(9, u == 0);
    }
}

constexpr int LQ = 56;
constexpr int LR_XIN = 0, LR_XC = LR_XIN + 67 * 48 * 4, LR_XCB = LR_XC + 64 * 48 * 4, LR_WT = LR_XCB + 64 * LQ * 2, LR_AA = LR_WT + 128 * LQ * 2, LR_FF = LR_AA + 64 * 48 * 4,
              LR_GG = LR_FF + 64 * 48 * 4, LR_SEGA = LR_GG + 64 * 48 * 4, LR_SEGH = LR_SEGA + 8 * 48 * 4, LR_CAR = LR_SEGH + 8 * 48 * 4, LR_HS = LR_CAR + 8 * 48 * 4,
              LR_CONST = LR_HS + 64 * 4, LR_Y = LR_CONST + 8 * 48 * 4, LRU_LDS = LR_Y + 64 * 48 * 2;
static_assert(LR_XCB % 16 == 0 && LR_WT % 16 == 0 && LR_Y % 16 == 0, "LRU LDS map alignment");
__device__ __forceinline__ float gelu_tanh(float x) { const float u = 0.7978845608028654f * (x + 0.044715f * x * x * x); return 0.5f * x * (1.0f + tanhf(u)); }
__device__ __forceinline__ void phase_lru(const Params& p, int l, UnitSrc q, unsigned char* lds) {
    float* xin = (float*)(lds + LR_XIN); float* xc = (float*)(lds + LR_XC); bf16_t* xcb = (bf16_t*)(lds + LR_XCB); bf16_t* WT = (bf16_t*)(lds + LR_WT);
    float* aa = (float*)(lds + LR_AA); float* ff = (float*)(lds + LR_FF); float* gg = (float*)(lds + LR_GG);
    float* segA = (float*)(lds + LR_SEGA); float* segH = (float*)(lds + LR_SEGH); float* car = (float*)(lds + LR_CAR); float* hs = (float*)(lds + LR_HS);
    float* cst = (float*)(lds + LR_CONST);
    bf16_t* yraw = (bf16_t*)(lds + LR_Y);
    const int tid = opaque_tid(), wave = tid >> 6, lane = tid & 63, r = lane & 31, hf = lane >> 5;
    for (int u = grab_unit(q); u < NBATCH * 8; u = grab_unit(q)) {
        const int b = u >> 3, nblk = u & 7, ch0 = nblk * 48;
        PROBE_UNIT_BEGIN(10, u == 0);
        for (int i = tid; i < 128 * LQ; i += NT) {
            const int n = i / LQ, cidx = i % LQ; float v = 0.f;
            if (cidx < 48) { if (n < 48) v = p.in[I_WR][((size_t)l * 8 + nblk) * 2304 + cidx * 48 + n]; else if (n >= 64 && n < 112) v = p.in[I_WI][((size_t)l * 8 + nblk) * 2304 + cidx * 48 + (n - 64)]; }
            WT[i] = f2bf(v);
        }
        if (tid < 48) {
            cst[tid] = p.in[I_BR][l * 384 + ch0 + tid]; cst[48 + tid] = p.in[I_BI][l * 384 + ch0 + tid];
            cst[96 + tid] = log1pf(__expf(-p.in[I_LAM][l * 384 + ch0 + tid])); cst[144 + tid] = p.in[I_CONVB][l * 384 + ch0 + tid];
#pragma unroll
            for (int j = 0; j < 4; ++j) cst[192 + j * 48 + tid] = p.in[I_CONVW][((size_t)l * 4 + j) * 384 + ch0 + tid];
            hs[tid] = 0.f;
        }
        if (tid < 144) xin[tid] = 0.f;
        const int xrow = tid / 6, xcol = (tid % 6) * 8, yid = tid - 128, yrow = yid / 6, ycol = (yid % 6) * 8;
        const bf16_t* xsrc = p.proj + ((size_t)b * TSEQ + xrow) * NP + C_DX + ch0 + xcol;
        const bf16_t* ysrc = p.proj + ((size_t)b * TSEQ + (yid >= 0 ? yrow : 0)) * NP + C_DY + ch0 + ycol;
        u32x4 px = {0u, 0u, 0u, 0u}, py = {0u, 0u, 0u, 0u};
        if (tid < 384) px = *(const u32x4*)xsrc;
        if (yid >= 0) py = *(const u32x4*)ysrc;
        __syncthreads();
        for (int tt = 0; tt < TSEQ / 64; ++tt) {
            if (tid < 384) {
#pragma unroll
                for (int q = 0; q < 4; ++q) { xin[(3 + xrow) * 48 + xcol + 2 * q] = __uint_as_float(px[q] << 16); xin[(3 + xrow) * 48 + xcol + 2 * q + 1] = __uint_as_float(px[q] & 0xFFFF0000u); }
            }
            if (yid >= 0) *(u32x4*)(yraw + yrow * 48 + ycol) = py;
            if (tt + 1 < TSEQ / 64) {
                if (tid < 384) px = *(const u32x4*)(xsrc + (size_t)(tt + 1) * 64 * NP);
                if (yid >= 0) py = *(const u32x4*)(ysrc + (size_t)(tt + 1) * 64 * NP);
            }
            __syncthreads();
            for (int e = tid; e < 64 * 48; e += NT) {
                const int t = e / 48, cidx = e % 48; float a = cst[144 + cidx];
#pragma unroll
                for (int j = 0; j < 4; ++j) a += cst[192 + j * 48 + cidx] * xin[(t + j) * 48 + cidx];
                xc[e] = a; xcb[t * LQ + cidx] = f2bf(a);
            }
            __syncthreads();
            {
                const int ci = wave >> 2, ni = wave & 3;
                f32x16 g;
#pragma unroll
                for (int i = 0; i < 16; ++i) g[i] = 0.f;
#pragma unroll
                for (int st = 0; st < 3; ++st)
                    g = __builtin_amdgcn_mfma_f32_32x32x16_bf16(*(const bf16x8*)(xcb + (ci * 32 + r) * LQ + 16 * st + 8 * hf), *(const bf16x8*)(WT + (ni * 32 + r) * LQ + 16 * st + 8 * hf), g, 0, 0, 0);
                const int d = (ni & 1) * 32 + r;
                if (d < 48) {
                    if (ni < 2) {
                        const float brv = cst[d], spv = cst[96 + d];
#pragma unroll
                        for (int i = 0; i < 16; ++i) {
                            const int t = ci * 32 + (i & 3) + 8 * (i >> 2) + 4 * hf;
                            const float la = -8.0f * sigmoidf_(g[i] + brv) * spv;
                            aa[t * 48 + d] = __expf(la); ff[t * 48 + d] = sqrtf(-expm1f(2.0f * la)) * xc[t * 48 + d];
                        }
                    } else {
                        const float biv = cst[48 + d];
#pragma unroll
                        for (int i = 0; i < 16; ++i) { const int t = ci * 32 + (i & 3) + 8 * (i >> 2) + 4 * hf; gg[t * 48 + d] = sigmoidf_(g[i] + biv); }
                    }
                }
                if (tid < 144) xin[tid] = xin[64 * 48 + tid];
            }
            __syncthreads();
            if (tid < 384) {
                const int d = tid % 48, sg = tid / 48; float ap = 1.f, hl = 0.f;
#pragma unroll
                for (int i = 0; i < 8; ++i) {
                    const int e = (sg * 8 + i) * 48 + d; const float av = aa[e];
                    hl = av * hl + ff[e] * gg[e]; ap *= av; aa[e] = ap; ff[e] = hl;
                }
                segA[sg * 48 + d] = ap; segH[sg * 48 + d] = hl;
            }
            __syncthreads();
            if (tid < 48) {
                float cin = hs[tid];
#pragma unroll
                for (int sg = 0; sg < 8; ++sg) { car[sg * 48 + tid] = cin; cin = segA[sg * 48 + tid] * cin + segH[sg * 48 + tid]; }
                hs[tid] = cin;
            }
            __syncthreads();
            if (tid < 384) {
                const int t = tid / 6, d0 = (tid % 6) * 8, sg = t >> 3;
                const u32x4 yv = *(const u32x4*)(yraw + t * 48 + d0);
                float o[8];
#pragma unroll
                for (int q = 0; q < 8; ++q) {
                    const int e = t * 48 + d0 + q;
                    const float h = ff[e] + aa[e] * car[sg * 48 + d0 + q];
                    const float y = (q & 1) ? __uint_as_float(yv[q >> 1] & 0xFFFF0000u) : __uint_as_float(yv[q >> 1] << 16);
                    o[q] = gelu_tanh(y) * h;
                }
                u32x4 ov; ov[0] = cvt_pk_bf16(o[0], o[1]); ov[1] = cvt_pk_bf16(o[2], o[3]); ov[2] = cvt_pk_bf16(o[4], o[5]); ov[3] = cvt_pk_bf16(o[6], o[7]);
                *(u32x4*)(p.proj + ((size_t)b * TSEQ + tt * 64 + t) * NP + C_DY + ch0 + d0) = ov;
            }
            __syncthreads();
        }
        PROBE_UNIT_END(10, u == 0);
    }
}

constexpr int AT_STAGE = 16384, AT_LDS = 3 * AT_STAGE;
template <bool MASKED>
__device__ __forceinline__ void attn_block(const bf16_t* __restrict__ proj, const bf16_t* __restrict__ Vt, int b, int qb, int cq, int ck, const float* tabAll,
                                           const unsigned* mask32, unsigned char* stage, bf16_t* __restrict__ outp, int tid) {
    const int wave = tid >> 6, lane = tid & 63, r = lane & 31, hf = lane >> 5, hh = wave >> 2, sb = wave & 3;
    const int q0 = qb * 128 + sb * 32, q = q0 + r, mykt = q0 >> 5, nkt = 4 * qb + 4;
    const int skey = (tid >> 3) & 31, sdim = (tid >> 2) & 63, shh = tid >> 8;
    const unsigned offK = (unsigned)(skey * NP + shh * 64 + (((tid & 7) ^ ((skey >> 1) & 7)) * 8));
    const unsigned offV = (unsigned)((shh * 64 + sdim) * TSEQ + (((tid & 3) ^ ((0 - (sdim >> 2)) & 3)) * 8));
    int kro[4], vro[2][2];
#pragma unroll
    for (int s = 0; s < 4; ++s) kro[s] = hh * 4096 + r * 128 + (((2 * s + hf) ^ ((r >> 1) & 7)) * 16);
#pragma unroll
    for (int db = 0; db < 2; ++db)
#pragma unroll
        for (int s = 0; s < 2; ++s) vro[db][s] = 8192 + hh * 4096 + (db * 32 + r) * 64 + (((2 * s + hf) ^ ((0 - (r >> 2)) & 3)) * 16);
    constexpr float C1 = 0.125f * LOG2E;
    const unsigned* maskq = MASKED ? mask32 + (sb * 32 + r) * 64 : nullptr;
#pragma unroll 1
    for (int rnd = 0; rnd < 3; ++rnd) {
        const int h = 2 * rnd + hh;
        const float* tab = tabAll + h * TABW;
        const bf16_t* qrow = proj + ((size_t)b * TSEQ + q) * NP + cq + h * 64 + 8 * hf;
        bf16x8 qf[4];
#pragma unroll
        for (int s = 0; s < 4; ++s) qf[s] = *(const bf16x8*)(qrow + 16 * s);
        f32x16 o0, o1;
#pragma unroll
        for (int i = 0; i < 16; ++i) { o0[i] = 0.f; o1[i] = 0.f; }
        float m = -1e30f, l = 0.f;
        const bf16_t* Kb = proj + (size_t)b * TSEQ * NP + ck + 2 * rnd * 64;
        const bf16_t* Vb = Vt + ((size_t)b * 384 + 2 * rnd * 64) * TSEQ;
#define AT_STAGE_TILE(kt_, buf_) do { \
        __builtin_amdgcn_global_load_lds((const unsigned*)(Kb + (size_t)(kt_) * 32 * NP + offK), (unsigned*)((buf_) + tid * 16), 16, 0, 0); \
        __builtin_amdgcn_global_load_lds((const unsigned*)(Vb + (kt_) * 32 + offV), (unsigned*)((buf_) + 8192 + tid * 16), 16, 0, 0); } while (0)
        AT_STAGE_TILE(0, stage);
        AT_STAGE_TILE(1, stage + AT_STAGE);
        int cur = 0;
#pragma unroll 1
        for (int kt = 0; kt < nkt; ++kt) {
            if (kt + 1 < nkt) asm volatile("s_waitcnt vmcnt(2)" ::: "memory"); else asm volatile("s_waitcnt vmcnt(0)" ::: "memory");
            __builtin_amdgcn_s_barrier();
            asm volatile("" ::: "memory");
            const int nxt = cur == 0 ? 2 : cur - 1;
            if (kt + 2 < nkt) AT_STAGE_TILE(kt + 2, stage + nxt * AT_STAGE);
            if (kt <= mykt) {
                const unsigned char* st = stage + cur * AT_STAGE;
                f32x16 sa;
#pragma unroll
                for (int i = 0; i < 16; ++i) sa[i] = 0.f;
#pragma unroll
                for (int s = 0; s < 4; ++s) sa = __builtin_amdgcn_mfma_f32_32x32x16_bf16(*(const bf16x8*)(st + kro[s]), qf[s], sa, 0, 0, 0);
                const float* tb = tab + (q - kt * 32 - 4 * hf + 32);
                unsigned w = 0u;
                if (MASKED) w = maskq[kt] >> (4 * hf);
                float sv[16]; float tmax = NEG_BIG;
#pragma unroll
                for (int i = 0; i < 16; ++i) {
                    const int ko = (i & 3) + 8 * (i >> 2);
                    float v = sa[i] * C1 + tb[-ko];
                    if (MASKED) v = ((w >> ko) & 1u) ? v : NEG_BIG;
                    sv[i] = v; tmax = fmaxf(tmax, v);
                }
                tmax = fmaxf(tmax, __shfl_xor(tmax, 32));
                const float mn = fmaxf(m, tmax);
                if (!__all(mn == m)) {
                    const float alpha = __builtin_amdgcn_exp2f(m - mn);
                    l *= alpha;
#pragma unroll
                    for (int i = 0; i < 16; ++i) { o0[i] *= alpha; o1[i] *= alpha; }
                    m = mn;
                }
                float ps = 0.f;
#pragma unroll
                for (int i = 0; i < 16; ++i) { sv[i] = __builtin_amdgcn_exp2f(sv[i] - m); ps += sv[i]; }
                l += ps;
                bf16x8 pf[2];
#pragma unroll
                for (int s = 0; s < 2; ++s) {
                    u32x4 t;
                    t[0] = cvt_pk_bf16(sv[8 * s + 0], sv[8 * s + 1]); t[1] = cvt_pk_bf16(sv[8 * s + 2], sv[8 * s + 3]);
                    t[2] = cvt_pk_bf16(sv[8 * s + 4], sv[8 * s + 5]); t[3] = cvt_pk_bf16(sv[8 * s + 6], sv[8 * s + 7]);
                    pf[s] = __builtin_bit_cast(bf16x8, t);
                }
#pragma unroll
                for (int s = 0; s < 2; ++s) {
                    o0 = __builtin_amdgcn_mfma_f32_32x32x16_bf16(*(const bf16x8*)(st + vro[0][s]), pf[s], o0, 0, 0, 0);
                    o1 = __builtin_amdgcn_mfma_f32_32x32x16_bf16(*(const bf16x8*)(st + vro[1][s]), pf[s], o1, 0, 0, 0);
                }
            }
            cur = cur == 2 ? 0 : cur + 1;
        }
#undef AT_STAGE_TILE
        __builtin_amdgcn_s_barrier();
        asm volatile("" ::: "memory");
        l += __shfl_xor(l, 32);
        const float inv = 1.0f / l;
        bf16_t* orow = outp + ((size_t)b * TSEQ + q) * NP + cq + h * 64 + 4 * hf;
#pragma unroll
        for (int g = 0; g < 4; ++g) {
            *(uint2*)(orow + 8 * g) = make_uint2(cvt_pk_bf16(o0[4 * g] * inv, o0[4 * g + 1] * inv), cvt_pk_bf16(o0[4 * g + 2] * inv, o0[4 * g + 3] * inv));
            *(uint2*)(orow + 32 + 8 * g) = make_uint2(cvt_pk_bf16(o1[4 * g] * inv, o1[4 * g + 1] * inv), cvt_pk_bf16(o1[4 * g + 2] * inv, o1[4 * g + 3] * inv));
        }
    }
}

constexpr int DIL_LDS = 6 * TABW * 4 + AT_LDS;
__device__ __forceinline__ void dil_unit(const Params& p, int b, int qb, unsigned char* lds) {
    float* tab = (float*)lds;
    const int tid = opaque_tid(), wave = tid >> 6, lane = tid & 63;
    for (int i = tid; i < 6 * TABW; i += NT) tab[i] = p.biasC[i];
    __syncthreads();
    attn_block<false>(p.proj, p.VtC, b, qb, C_CQ, C_CK, tab, nullptr, lds + 6 * TABW * 4, p.proj, tid);
    __syncthreads();
}
__device__ __forceinline__ void phase_dil(const Params& p, UnitSrc q, unsigned char* lds) {
    for (int u = grab_unit(q); u < NBATCH * 16; u = grab_unit(q)) { PROBE_UNIT_BEGIN(12, u == 0); dil_unit(p, u & 15, 15 - (u >> 4), lds); PROBE_UNIT_END(12, u == 0); }
}

constexpr int DSA_LDS = 128 * 64 * 4 + 1920 * 64;
__device__ __forceinline__ void cnt_ge(int& c, unsigned k, unsigned t) { asm("v_cmp_ge_u32 vcc, %1, %2\n\tv_addc_co_u32 %0, vcc, 0, %0, vcc" : "+v"(c) : "v"(k), "v"(t) : "vcc"); }
__device__ __forceinline__ void cnt_gt(int& c, unsigned k, unsigned t) { asm("v_cmp_gt_u32 vcc, %1, %2\n\tv_addc_co_u32 %0, vcc, 0, %0, vcc" : "+v"(c) : "v"(k), "v"(t) : "vcc"); }
__device__ __forceinline__ void cnt_eq(int& c, unsigned k, unsigned t) { asm("v_cmp_eq_u32 vcc, %1, %2\n\tv_addc_co_u32 %0, vcc, 0, %0, vcc" : "+v"(c) : "v"(k), "v"(t) : "vcc"); }
__device__ __forceinline__ int grp16_sum(int v) { v += __shfl_xor(v, 1); v += __shfl_xor(v, 2); v += __shfl_xor(v, 4); v += __shfl_xor(v, 8); return v; }
__device__ __forceinline__ void dsa_unit(const Params& p, int b, int qb, unsigned char* lds) {
    unsigned* mask32 = (unsigned*)lds;
    unsigned short* mask16 = (unsigned short*)mask32;
    unsigned char* ikb = lds + 128 * 64 * 4;
    float* tab = (float*)(lds + 128 * 64 * 4);
    const int tid = opaque_tid(), wave = tid >> 6, lane = tid & 63;
    const int nlt = 8 * qb;
    for (int pi = tid; pi < nlt * 64; pi += NT) {
        const int key = pi >> 2, cs = (pi & 3) ^ ((0 - (key >> 2)) & 3);
        __builtin_amdgcn_global_load_lds((const unsigned*)(p.proj + ((size_t)b * TSEQ + key) * NP + C_IK + cs * 8), (unsigned*)(ikb + pi * 16), 16, 0, 0);
    }
    for (int i = tid; i < 128 * 64; i += NT) mask32[i] = 0u;
    asm volatile("s_waitcnt vmcnt(0)" ::: "memory");
    __syncthreads();
    const int qi = lane >> 4, kl = lane & 15;
    PROBE_UNIT_BEGIN(13, qb == 15 && b == 0);
    for (int grp = wave; grp < 32; grp += 8) {
        const int qg = qb * 128 + grp * 4, myq = qg + qi;
        const bf16x8 af = *(const bf16x8*)(p.proj + ((size_t)b * TSEQ + qg + (kl >> 2)) * NP + C_IQ + (kl & 3) * 32 + 8 * qi);
        const uint2 wv = *(const uint2*)(p.proj + ((size_t)b * TSEQ + myq) * NP + C_IW);
        unsigned key[128];
#define SEL_SCORE(dst, frag, valid) do { f32x4 _a = {0.f, 0.f, 0.f, 0.f}; _a = __builtin_amdgcn_mfma_f32_16x16x32_bf16(af, (frag), _a, 0, 0, 0); \
            float _s = __uint_as_float(wv.x << 16) * fmaxf(_a[0], 0.f) + __uint_as_float(wv.x & 0xFFFF0000u) * fmaxf(_a[1], 0.f) + __uint_as_float(wv.y << 16) * fmaxf(_a[2], 0.f) + __uint_as_float(wv.y & 0xFFFF0000u) * fmaxf(_a[3], 0.f); _s += 0.0f; \
            const unsigned _u = __float_as_uint(_s); unsigned _k = (_u & 0x80000000u) ? ~_u : (_u | 0x80000000u); _k = _k == 0u ? 1u : _k; (dst) = (valid) ? _k : 0u; } while (0)
        {
            const bf16_t* kg = p.proj + ((size_t)b * TSEQ + nlt * 16 + kl) * NP + C_IK + 8 * qi;
#pragma unroll
            for (int c = 0; c < 4; ++c) {
                const bf16x8 b0 = *(const bf16x8*)(kg + (size_t)(c * 2) * 16 * NP);
                const bf16x8 b1 = *(const bf16x8*)(kg + (size_t)(c * 2 + 1) * 16 * NP);
                SEL_SCORE(key[c * 2], b0, (nlt + c * 2) * 16 + kl <= myq);
                SEL_SCORE(key[c * 2 + 1], b1, (nlt + c * 2 + 1) * 16 + kl <= myq);
                asm volatile("" ::: "memory");
            }
        }
        const unsigned char* kp = ikb + kl * 64 + ((qi ^ ((0 - (kl >> 2)) & 3)) * 16);
#pragma unroll
        for (int c1 = 0; c1 < 120; ++c1) {
            if (c1 < nlt) {
                const bf16x8 bfr = *(const bf16x8*)(kp + c1 * 1024);
                SEL_SCORE(key[8 + c1], bfr, true);
            } else key[8 + c1] = 0u;
            if (c1 & 1) asm volatile("" ::: "memory");
        }
#undef SEL_SCORE
#define SEL_COUNT(FN, var, thr) do { \
            _Pragma("unroll") for (int t = 0; t < 32; ++t) FN(var, key[t], thr); \
            if (nlt > 24) { _Pragma("unroll") for (int t = 32; t < 64; ++t) FN(var, key[t], thr); } \
            if (nlt > 56) { _Pragma("unroll") for (int t = 64; t < 96; ++t) FN(var, key[t], thr); } \
            if (nlt > 88) { _Pragma("unroll") for (int t = 96; t < 128; ++t) FN(var, key[t], thr); } } while (0)
        unsigned T = 1u; int need = 0x7fffffff;
        if (qg + 3 >= 256) {
            unsigned Tb = 0u; bool done = false;
#pragma unroll 1
            for (int bit = 31; bit >= 0; --bit) {
                const unsigned Tc = Tb | (1u << bit);
                int c = 0;
                SEL_COUNT(cnt_ge, c, Tc);
                c = grp16_sum(c);
                Tb = (!done && c >= 256) ? Tc : Tb;
                done = done || (c == 256);
                if (__all(done || myq < 256)) break;
            }
            int cgt = 0;
            SEL_COUNT(cnt_gt, cgt, Tb);
            cgt = grp16_sum(cgt);
            if (myq >= 256) { T = Tb; need = 256 - cgt; }
        }
        int ceq = 0;
        SEL_COUNT(cnt_eq, ceq, T);
        ceq = grp16_sum(ceq);
#undef SEL_COUNT
        const bool slow = __any(need != 0x7fffffff && ceq != need);
        int run = 0;
        unsigned short* mrow = mask16 + (grp * 4 + qi) * 128;
#define SEL_EMIT(kv, tile) do { const bool _gt = (kv) > T, _eq = (kv) == T; bool _take = _gt || _eq; \
            if (slow) { const unsigned long long _em = __ballot(_eq); const unsigned _bits = (unsigned)(_em >> (16 * qi)) & 0xFFFFu; \
                const int _rank = run + __popc(_bits & ((1u << kl) - 1u)); _take = _gt || (_eq && _rank < need); run += __popc(_bits); } \
            const unsigned long long _tm = __ballot(_take); if (kl == 0) mrow[(tile)] = (unsigned short)((_tm >> (16 * qi)) & 0xFFFFull); } while (0)
#pragma unroll
        for (int t = 0; t < 120; ++t) { if (t < nlt) SEL_EMIT(key[8 + t], t); }
#pragma unroll
        for (int j = 0; j < 8; ++j) SEL_EMIT(key[j], nlt + j);
#undef SEL_EMIT
    }
    __syncthreads();
    PROBE_UNIT_END(13, qb == 15 && b == 0);
    for (int i = tid; i < 6 * TABW; i += NT) tab[i] = p.biasB[i];
    __syncthreads();
    attn_block<true>(p.proj, p.VtB, b, qb, C_BQ, C_BK, tab, mask32, lds + 128 * 64 * 4 + 6 * TABW * 4, p.proj, tid);
    __syncthreads();
}
__device__ __forceinline__ void phase_dsa(const Params& p, UnitSrc q, unsigned char* lds) {
    for (int u = grab_unit(q); u < NBATCH * 16; u = grab_unit(q)) { PROBE_UNIT_BEGIN(11, u == 0); dsa_unit(p, u & 15, 15 - (u >> 4), lds); PROBE_UNIT_END(11, u == 0); }
}

constexpr int MG_LDS = MG_GLDS + 1024 + 16 * NT * 4;
__device__ __forceinline__ void phase_merge(const Params& p, int l, int bid, int nb, unsigned char* lds) {
    GemmCtx c = gemm_ctx();
    float* srstd = (float*)(lds + MG_NS * G_BUF);
    unsigned* sgate = (unsigned*)(lds + MG_NS * G_BUF + 1024);
    constexpr int NCT = DM / 128, NUX = (NTOK / 256 / 8) * NCT;
    const float* bg = p.in[I_BGATE] + (size_t)l * 4 * DM;
    const int xcd = bid & 7, nloc = nb >> 3;
    for (int k = bid >> 3; k < NUX; k += nloc) {
        const int rt = xcd * (NTOK / 256 / 8) + k / NCT, ct = k % NCT, brow = rt * 256, bcol = ct * 128;
        if (c.tid < 256) srstd[c.tid] = rstd_of(p.part, brow + c.tid);
        __syncthreads();
        f32x4 mg[4][4]; acc_zero(mg);
        const int r = c.tid >> 2;
        for (int i = 0; i < 4; ++i) {
            f32x4 acc[4][4]; acc_zero(acc);
            gemm_kloop_s<MG_NS, true>(acc, p.hb + (size_t)brow * DM, (unsigned)(r * DM + c.sc), (unsigned)((r + 128) * DM + c.sc), p.Bt_gate + ((size_t)i * DM + bcol) * DM, (unsigned)(r * DM + c.sc), DM / 32, lds, c);
            gemm_relane(c);
            int i2 = i; asm volatile("" : "+s"(i2));
            unsigned lcol = (unsigned)(c.wc * 64 + c.fq * 4); asm volatile("" : "+v"(lcol));
            unsigned gp[2][4][2];
#pragma unroll
            for (int m = 0; m < 4; ++m) {
                const float rs = srstd[c.wr * 64 + m * 16 + c.fr];
#pragma unroll
                for (int n = 0; n < 4; ++n) {
                    const f32x4 bv = *(const f32x4*)(bg + i2 * DM + bcol + n * 16 + lcol);
                    const unsigned g0 = cvt_pk_bf16(sigmoidf_(acc[m][n][0] * rs + bv[0]), sigmoidf_(acc[m][n][1] * rs + bv[1]));
                    const unsigned g1 = cvt_pk_bf16(sigmoidf_(acc[m][n][2] * rs + bv[2]), sigmoidf_(acc[m][n][3] * rs + bv[3]));
                    if (m < 2) { sgate[((m * 4 + n) * 2 + 0) * NT + c.tid] = g0; sgate[((m * 4 + n) * 2 + 1) * NT + c.tid] = g1; }
                    else { gp[m - 2][n][0] = g0; gp[m - 2][n][1] = g1; }
                }
            }
            acc_zero(acc);
            gemm_kloop_s<MG_NS, true>(acc, p.proj + (size_t)brow * NP + C_OB + i2 * 384, (unsigned)(r * NP + c.sc), (unsigned)((r + 128) * NP + c.sc),
                                     p.Bt_br + ((size_t)i2 * DM + bcol) * 384, (unsigned)(r * 384 + c.sc), 384 / 32, lds, c);
            gemm_relane(c);
#pragma unroll
            for (int m = 0; m < 4; ++m)
#pragma unroll
                for (int n = 0; n < 4; ++n) {
                    const unsigned g0 = m < 2 ? sgate[((m * 4 + n) * 2 + 0) * NT + c.tid] : gp[m < 2 ? 0 : m - 2][n][0];
                    const unsigned g1 = m < 2 ? sgate[((m * 4 + n) * 2 + 1) * NT + c.tid] : gp[m < 2 ? 0 : m - 2][n][1];
                    mg[m][n][0] += __uint_as_float(g0 << 16) * acc[m][n][0];
                    mg[m][n][1] += __uint_as_float(g0 & 0xFFFF0000u) * acc[m][n][1];
                    mg[m][n][2] += __uint_as_float(g1 << 16) * acc[m][n][2];
                    mg[m][n][3] += __uint_as_float(g1 & 0xFFFF0000u) * acc[m][n][3];
                }
        }
        unsigned orow = (unsigned)(c.wr * 64 + c.fr), ocol = (unsigned)(c.wc * 64 + c.fq * 4); asm volatile("" : "+v"(orow), "+v"(ocol));
#pragma unroll
        for (int m = 0; m < 4; ++m) {
            bf16_t* o = p.proj + (size_t)brow * NP + C_MG + bcol + (orow + m * 16) * NP + ocol;
#pragma unroll
            for (int n = 0; n < 4; ++n) *(uint2*)(o + n * 16) = make_uint2(cvt_pk_bf16(mg[m][n][0], mg[m][n][1]), cvt_pk_bf16(mg[m][n][2], mg[m][n][3]));
        }
        __syncthreads();
    }
}

__device__ __forceinline__ void phase_out(const Params& p, int l, int bid, int nb, unsigned char* lds) {
    Gemm2Ctx c = gemm2_ctx();
    constexpr int NCT = DM / 256, NUX = (NTOK / 256 / 8) * NCT;
    const float* hin = (l == 0) ? p.in[I_X] : p.h;
    const int xcd = bid & 7, nloc = nb >> 3;
    for (int k = bid >> 3; k < NUX; k += nloc) {
        const int rt = xcd * (NTOK / 256 / 8) + k / NCT, ct = k % NCT, brow = rt * 256, bcol = ct * 256;
        f32x4 acc[8][4]; acc2_zero(acc);
        const int r = c.tid >> 2;
        gemm2_kloop<true>(acc, p.proj + (size_t)brow * NP + C_MG, (unsigned)(r * NP + c.sc), (unsigned)((r + 128) * NP + c.sc), p.Bt_out + (size_t)bcol * DM,
                          (unsigned)(r * DM + c.sc), (unsigned)((r + 128) * DM + c.sc), DM / 32, lds, c);
        gemm2_relane(c);
#pragma unroll
        for (int m = 0; m < 8; ++m) {
            const int row = brow + c.wr * 128 + m * 16 + c.fr;
            const size_t off = (size_t)row * DM + bcol + c.wc * 64 + c.fq * 4;
            float ss = 0.f;
#pragma unroll
            for (int n = 0; n < 4; ++n) {
                const f32x4 v = *(const f32x4*)(hin + off + n * 16) + acc[m][n];
                *(f32x4*)(p.h + off + n * 16) = v;
                *(uint2*)(p.hb + off + n * 16) = make_uint2(cvt_pk_bf16(v[0], v[1]), cvt_pk_bf16(v[2], v[3]));
                ss += (v[0] * v[0] + v[1] * v[1]) + (v[2] * v[2] + v[3] * v[3]);
            }
            ss += __shfl_xor(ss, 16); ss += __shfl_xor(ss, 32);
            if (c.fq == 0) p.part[(size_t)row * 16 + ct * 4 + c.wc] = ss;
        }
    }
}

constexpr int RT_W_BYTES = 1024 * 20 * 4, RT_LDS = RT_W_BYTES + (64 + 2048) * 4;
__device__ __forceinline__ void phase_router(const Params& p, int l, int bid, int nb, unsigned char* lds) {
    float* W = (float*)lds;
    const int tid = opaque_tid(), wave = tid >> 6, lane = tid & 63;
    const float* n2 = p.in[I_N2] + l * DM;
    const float* wrg = p.in[I_WRG] + (size_t)l * DM * 4;
    const float* wre = p.in[I_WRE] + (size_t)l * DM * 16;
    for (int i = tid; i < 1024 * 20; i += NT) { const int k = i / 20, j = i % 20; W[j * 1024 + k] = n2[k] * (j < 4 ? wrg[k * 4 + j] : wre[k * 16 + (j - 4)]); }
    int* cnt = p.cnt + l * 32 * 32;
    int* lcnt = (int*)(lds + RT_W_BYTES); int* lbase = lcnt + 32; int* ltok = lbase + 32; int* lcls = ltok + 1024;
    if (tid < 32) lcnt[tid] = 0;
    __syncthreads();
    int nmine = 0;
    float hn[16]; float prn = 0.f;
    {
        const int row = bid * 8 + wave;
        if (row < NTOK) {
#pragma unroll
            for (int i = 0; i < 16; ++i) hn[i] = p.h[(size_t)row * DM + i * 64 + lane];
            prn = p.part[(size_t)row * 16 + (lane & 15)];
        }
    }
    for (int row = bid * 8 + wave; row < NTOK; row += nb * 8) {
        float hv[16]; float pr = prn;
#pragma unroll
        for (int i = 0; i < 16; ++i) hv[i] = hn[i];
        {
            const int rown = row + nb * 8;
            if (rown < NTOK) {
#pragma unroll
                for (int i = 0; i < 16; ++i) hn[i] = p.h[(size_t)rown * DM + i * 64 + lane];
                prn = p.part[(size_t)rown * 16 + (lane & 15)];
            }
        }
        pr += __shfl_xor(pr, 1); pr += __shfl_xor(pr, 2); pr += __shfl_xor(pr, 4); pr += __shfl_xor(pr, 8);
        const float rs = rsqrtf(pr * (1.0f / 1024.0f) + EPS);
        float a[20];
#pragma unroll
        for (int j = 0; j < 20; ++j) a[j] = 0.f;
#pragma unroll 1
        for (int i4 = 0; i4 < 4; ++i4) {
#pragma unroll
            for (int ii = 0; ii < 4; ++ii) {
                const float* w = W + (i4 * 4 + ii) * 64 + lane;
                const float h1 = ii == 0 ? hv[0] : (ii == 1 ? hv[1] : (ii == 2 ? hv[2] : hv[3]));
#pragma unroll
                for (int j = 0; j < 20; ++j) a[j] += h1 * w[j * 1024];
            }
#pragma unroll
            for (int q = 0; q < 12; ++q) hv[q] = hv[q + 4];
        }
#pragma unroll
        for (int j = 0; j < 20; ++j) a[j] = wave_sum(a[j]);
        if (lane == 0) {
            float gl[4];
#pragma unroll
            for (int j = 0; j < 4; ++j) gl[j] = a[j] * rs + p.in[I_BRG][l * 4 + j];
            int g = 0; float gm = gl[0];
#pragma unroll
            for (int j = 1; j < 4; ++j) if (gl[j] > gm) { gm = gl[j]; g = j; }
            float den = 0.f;
#pragma unroll
            for (int j = 0; j < 4; ++j) den += __expf(gl[j] - gm);
            const float gw = 1.0f / den;
            float el[4];
#pragma unroll
            for (int j = 0; j < 4; ++j) {
                float v = 0.f;
#pragma unroll
                for (int gg = 0; gg < 4; ++gg) v = (gg == g) ? (a[4 + gg * 4 + j] * rs + p.in[I_BRE][l * 16 + gg * 4 + j]) : v;
                el[j] = v;
            }
            int i1 = 0; float v1 = el[0];
#pragma unroll
            for (int j = 1; j < 4; ++j) if (el[j] > v1) { v1 = el[j]; i1 = j; }
            int i2 = -1; float v2 = -3.0e38f;
#pragma unroll
            for (int j = 0; j < 4; ++j) if (j != i1 && el[j] > v2) { v2 = el[j]; i2 = j; }
            const float e2 = __expf(v2 - v1);
            const float w1 = gw / (1.0f + e2), w2 = gw * e2 / (1.0f + e2);
            const int lo = i1 < i2 ? i1 : i2, hi = i1 < i2 ? i2 : i1;
            const float wlo = i1 < i2 ? w1 : w2, whi = i1 < i2 ? w2 : w1;
            const int pidx = lo == 0 ? (hi - 1) : (lo == 1 ? (hi + 1) : 5);
            const int cls = g * 6 + pidx;
            const int lr = __hip_atomic_fetch_add(&lcnt[cls], 1, __ATOMIC_RELAXED, __HIP_MEMORY_SCOPE_WORKGROUP);
            ltok[nmine * 8 + wave] = row; lcls[nmine * 8 + wave] = cls | (lr << 8);
            p.tokw[(size_t)row * 2] = wlo; p.tokw[(size_t)row * 2 + 1] = whi;
        }
        ++nmine;
    }
    __syncthreads();
    if (tid < NCLS) lbase[tid] = lcnt[tid] > 0 ? __hip_atomic_fetch_add(&cnt[tid * 32], lcnt[tid], __ATOMIC_RELAXED, __HIP_MEMORY_SCOPE_AGENT) : 0;
    __syncthreads();
    for (int i = tid; i < nmine * 8; i += NT) {
        const int cl = lcls[i] & 255, lr = lcls[i] >> 8;
        p.perm[(size_t)cl * NTOK + lbase[cl] + lr] = ltok[i];
    }
}

__device__ __forceinline__ void cls_experts(int cls, int& elo, int& ehi) {
    const int g = cls / 6, pi = cls % 6;
    const int lo = pi < 3 ? 0 : (pi < 5 ? 1 : 2), hi = pi < 3 ? pi + 1 : (pi < 5 ? pi - 1 : 3);
    elo = g * 4 + lo; ehi = g * 4 + hi;
}
__device__ __forceinline__ void moe_prefix(const int* cnt, int* spre, int* scnt) {
    if (opaque_tid() == 0) { int s = 0; for (int c = 0; c < NCLS; ++c) { const int n = cnt[c * 32]; scnt[c] = n; spre[c] = s; s += (n + 255) >> 8; } spre[NCLS] = s; }
    __syncthreads();
}

__device__ __forceinline__ void phase_moe1(const Params& p, int l, int bid, int nb, unsigned char* lds) {
    Gemm2Ctx c = gemm2_ctx();
    int* spre = (int*)(lds + G2_LDS); int* scnt = spre + 32;
    int* stok = scnt + 32; float* srs = (float*)(stok + 256); float* swl = srs + 256; float* swh = swl + 256;
    moe_prefix(p.cnt + l * 32 * 32, spre, scnt);
    const int nrt = spre[NCLS], nrtx = (nrt + 7) >> 3, xcd = bid & 7, nloc = nb >> 3;
    const int rt_lo = xcd * nrtx, rt_hi = rt_lo + nrtx < nrt ? rt_lo + nrtx : nrt;
    for (int k = bid >> 3; k < (rt_hi - rt_lo) * 8; k += nloc) {
        const int rt = rt_lo + (k >> 3), ct = k & 7;
        int cls = 0;
        for (int q = 1; q < NCLS; ++q) if (spre[q] <= rt) cls = q;
        int elo, ehi; cls_experts(cls, elo, ehi);
        const int lrow0 = (rt - spre[cls]) * 256, n = scnt[cls];
        if (c.tid < 256) {
            const int lr = lrow0 + c.tid; const bool ok = lr < n;
            const int tok = ok ? p.perm[(size_t)cls * NTOK + lr] : 0;
            stok[c.tid] = ok ? tok : -1; srs[c.tid] = rstd_of(p.part, tok);
            swl[c.tid] = p.tokw[(size_t)tok * 2]; swh[c.tid] = p.tokw[(size_t)tok * 2 + 1];
        }
        __syncthreads();
        const int r = c.tid >> 2;
        const int t0 = stok[r] < 0 ? 0 : stok[r], t1 = stok[r + 128] < 0 ? 0 : stok[r + 128];
        const int ex = ct < 4 ? elo : ehi;
        f32x4 acc[8][4]; acc2_zero(acc);
        gemm2_kloop<true>(acc, p.hb, (unsigned)(t0 * DM + c.sc), (unsigned)(t1 * DM + c.sc), p.Wgu + ((size_t)ex * DM + (ct & 3) * 256) * DM,
                          (unsigned)(r * DM + c.sc), (unsigned)((r + 128) * DM + c.sc), DM / 32, lds, c);
        gemm2_relane(c);
#pragma unroll
        for (int m = 0; m < 8; ++m) {
            const int rl = c.wr * 128 + m * 16 + c.fr; const float rs = srs[rl], w = ct < 4 ? swl[rl] : swh[rl];
            bf16_t* o = p.Hbuf + ((size_t)rt * 256 + rl) * DM + (ct < 4 ? 0 : 512) + (ct & 3) * 128 + c.wc * 32 + c.fq * 4;
#pragma unroll
            for (int n2 = 0; n2 < 2; ++n2) {
                float hv[4];
#pragma unroll
                for (int j = 0; j < 4; ++j) hv[j] = siluf_(acc[m][n2][j] * rs) * (acc[m][n2 + 2][j] * rs) * w;
                *(uint2*)(o + n2 * 16) = make_uint2(cvt_pk_bf16(hv[0], hv[1]), cvt_pk_bf16(hv[2], hv[3]));
            }
        }
        __syncthreads();
    }
}

__device__ __forceinline__ void phase_moe2(const Params& p, int l, int bid, int nb, unsigned char* lds) {
    Gemm2Ctx c = gemm2_ctx();
    int* spre = (int*)(lds + G2_LDS); int* scnt = spre + 32; int* stok = scnt + 32;
    moe_prefix(p.cnt + l * 32 * 32, spre, scnt);
    const int nrt = spre[NCLS], nrtx = (nrt + 7) >> 3, xcd = bid & 7, nloc = nb >> 3;
    const int rt_lo = xcd * nrtx, rt_hi = rt_lo + nrtx < nrt ? rt_lo + nrtx : nrt;
    for (int k = bid >> 3; k < (rt_hi - rt_lo) * 4; k += nloc) {
        const int rt = rt_lo + (k >> 2), ct = k & 3;
        int cls = 0;
        for (int q = 1; q < NCLS; ++q) if (spre[q] <= rt) cls = q;
        int elo, ehi; cls_experts(cls, elo, ehi);
        const int lrow0 = (rt - spre[cls]) * 256, n = scnt[cls];
        if (c.tid < 256) { const int lr = lrow0 + c.tid; stok[c.tid] = lr < n ? p.perm[(size_t)cls * NTOK + lr] : -1; }
        __syncthreads();
        const int r = c.tid >> 2;
        f32x4 acc[8][4]; acc2_zero(acc);
        const bf16_t* a0 = p.Hbuf + (size_t)rt * 256 * DM;
        const unsigned oa0 = (unsigned)(r * DM + c.sc), oa1 = (unsigned)((r + 128) * DM + c.sc), ob0 = (unsigned)(r * 512 + c.sc), ob1 = (unsigned)((r + 128) * 512 + c.sc);
        gemm2_kloop<true>(acc, a0, oa0, oa1, p.WdT + ((size_t)elo * DM + ct * 256) * 512, ob0, ob1, 16, lds, c);
        gemm2_relane(c);
        gemm2_kloop<true>(acc, a0 + 512, oa0, oa1, p.WdT + ((size_t)ehi * DM + ct * 256) * 512, ob0, ob1, 16, lds, c);
        gemm2_relane(c);
#pragma unroll
        for (int m = 0; m < 8; ++m) {
            const int rl = c.wr * 128 + m * 16 + c.fr; const int tok = stok[rl];
            const size_t off = (size_t)(tok < 0 ? 0 : tok) * DM + ct * 256 + c.wc * 64 + c.fq * 4;
            float ss = 0.f;
            if (tok >= 0) {
#pragma unroll
                for (int n2 = 0; n2 < 4; ++n2) {
                    const f32x4 v = *(const f32x4*)(p.h + off + n2 * 16) + acc[m][n2];
                    *(f32x4*)(p.h + off + n2 * 16) = v;
                    *(uint2*)(p.hb + off + n2 * 16) = make_uint2(cvt_pk_bf16(v[0], v[1]), cvt_pk_bf16(v[2], v[3]));
                    ss += (v[0] * v[0] + v[1] * v[1]) + (v[2] * v[2] + v[3] * v[3]);
                }
            }
            ss += __shfl_xor(ss, 16); ss += __shfl_xor(ss, 32);
            if (c.fq == 0 && tok >= 0) p.part[(size_t)tok * 16 + ct * 4 + c.wc] = ss;
        }
        __syncthreads();
    }
}

__device__ __forceinline__ void phase_final(const Params& p, int bid, int nb) {
    const int tid = opaque_tid(), wave = tid >> 6, lane = tid & 63;
    const float* nf = p.in[I_NF];
    for (int row = bid * 8 + wave; row < NTOK; row += nb * 8) {
        const float rs = rstd_of(p.part, row);
        float* hr = p.h + (size_t)row * DM;
#pragma unroll
        for (int i = 0; i < 4; ++i) {
            f32x4 v = *(const f32x4*)(hr + i * 256 + lane * 4);
            const f32x4 g = *(const f32x4*)(nf + i * 256 + lane * 4);
            v[0] *= rs * g[0]; v[1] *= rs * g[1]; v[2] *= rs * g[2]; v[3] *= rs * g[3];
            *(f32x4*)(hr + i * 256 + lane * 4) = v;
        }
    }
}

constexpr int cmax(int a, int b) { return a > b ? a : b; }
constexpr int MEGA_LDS_BODY = cmax(cmax(cmax(GLA_LDS, LRU_LDS), cmax(DSA_LDS, DIL_LDS)), cmax(cmax(MG_LDS, RT_LDS), G2_LDS + 8192));
constexpr int MEGA_LDS = PROBE_MASK ? 160 * 1024 : MEGA_LDS_BODY + 16;


__device__ __forceinline__ const Params& kparams() {
    const __attribute__((address_space(4))) Params* q = (const __attribute__((address_space(4))) Params*)__builtin_amdgcn_kernarg_segment_ptr();
    asm volatile("" : "+s"(q));
    return *(const Params*)q;
}
__global__ void __launch_bounds__(NT, 2) mega(Params p_kernarg) {
    (void)p_kernarg;
#define p kparams()
    unsigned char* lds = dyn_lds;
    volatile LAS unsigned* xbw = (volatile LAS unsigned*)(dyn_lds + MEGA_LDS_BODY);
    if (threadIdx.x == 0) { xbw[0] = 0u; xbw[1] = 0u; xbw[2] = 0u; xbw[3] = 0u; }
    __syncthreads();
    (void)xcd_barrier_post(p.bar, xbw);
#define PROBE_TICK(type) do { if (PROBE_MASK != 0 && blockIdx.x == 0 && threadIdx.x == 0) { volatile LAS unsigned long long* pw = (volatile LAS unsigned long long*)(dyn_lds + PROBE_OFF); \
        const unsigned long long now = __builtin_amdgcn_s_memrealtime(); if ((PROBE_MASK >> (type)) & 1) pw[1] += now - pw[0]; pw[0] = now; } } while (0)
#define PROBE_SINCE(bit) do { if (((PROBE_MASK >> (bit)) & 1) && blockIdx.x == 0 && threadIdx.x == 0) { volatile LAS unsigned long long* pw = (volatile LAS unsigned long long*)(dyn_lds + PROBE_OFF); \
        pw[1] += __builtin_amdgcn_s_memrealtime() - pw[0]; } } while (0)
#define GRID_SYNC() do { XcdBarrier _b; _b.bar = p.bar; _b.x = xb_xcc_id(); _b.st = (volatile LAS unsigned*)(dyn_lds + MEGA_LDS_BODY); xcd_barrier(_b); } while (0)
    const int bid = blockIdx.x, nb = gridDim.x;
    if (PROBE_MASK != 0 && threadIdx.x == 0) { volatile LAS unsigned long long* pw = (volatile LAS unsigned long long*)(dyn_lds + PROBE_OFF); pw[0] = __builtin_amdgcn_s_memrealtime(); pw[1] = 0ull; }
    phase_prep(p, bid, nb);
    GRID_SYNC(); PROBE_TICK(0);
#pragma unroll 1
    for (int l = 0; l < DEPTH; ++l) {
        phase_weights(p, l, bid, nb, lds);
        GRID_SYNC(); PROBE_TICK(1);
        phase_inproj(p, bid, nb, lds);
        GRID_SYNC(); PROBE_TICK(2);
        if (PROBE_GEMM_VAR >= 0 && l == 0) { phase_gemm_probe<PROBE_GEMM_VAR>(p, bid, nb, lds); GRID_SYNC(); }
        {
            const bool st = nb == 256;
            const int dsu = bid < 64 ? 192 + bid : (bid < 192 ? bid : bid - 192);
            const int dlq = (int)((0x7ACE02469BDF1358ull >> (4 * (15 - (dsu >> 4)))) & 15ull);
            constexpr int NONE = 1 << 20;
            UnitSrc qg{st ? (bid < 64 ? bid : NONE) : bid, st ? NONE : nb}, ql{st ? ((bid >= 64 && bid < 192) ? bid - 64 : NONE) : bid, st ? NONE : nb};
            UnitSrc qs{st ? dsu : bid, st ? NONE : nb}, qd{st ? (((15 - dlq) << 4) | (dsu & 15)) : bid, st ? NONE : nb};
            phase_gla(p, l, qg, lds); PROBE_SINCE(14);
            phase_lru(p, l, ql, lds); PROBE_SINCE(15);
            phase_dsa(p, qs, lds); PROBE_SINCE(16);
            phase_dil(p, qd, lds); PROBE_SINCE(17);
        }
        GRID_SYNC(); PROBE_TICK(3);
        phase_merge(p, l, bid, nb, lds);
        GRID_SYNC(); PROBE_TICK(4);
        phase_out(p, l, bid, nb, lds);
        GRID_SYNC(); PROBE_TICK(5);
        phase_router(p, l, bid, nb, lds);
        GRID_SYNC(); PROBE_TICK(6);
        phase_moe1(p, l, bid, nb, lds);
        GRID_SYNC(); PROBE_TICK(7);
        phase_moe2(p, l, bid, nb, lds);
        GRID_SYNC(); PROBE_TICK(8);
    }
    phase_final(p, bid, nb);
    if (PROBE_MASK != 0 && threadIdx.x == 0) { volatile LAS unsigned long long* pw = (volatile LAS unsigned long long*)(dyn_lds + PROBE_OFF);
        const unsigned long long t0 = __builtin_amdgcn_s_memrealtime(), w = pw[1]; while (__builtin_amdgcn_s_memrealtime() - t0 < w) __builtin_amdgcn_s_sleep(8); }
#undef p
}

static size_t align_up(size_t v, size_t a) { return (v + a - 1) / a * a; }

extern "C" void kernel_launch(void* const* d_in, const int* in_sizes, int n_in, void* d_out, int out_size, void* d_ws, size_t ws_size, hipStream_t stream) {
    (void)in_sizes; (void)n_in; (void)out_size;
    Params p{};
    for (int i = 0; i < N_IN; ++i) p.in[i] = (const float*)d_in[i];
    p.h = (float*)d_out;
    unsigned char* w = (unsigned char*)d_ws; size_t off = 0;
    auto take = [&](size_t bytes) { unsigned char* r = w + off; off = align_up(off + bytes, 256); return r; };
    p.bar = (unsigned*)take(XCD_BAR_WORDS * 4);
    p.cnt = (int*)take(DEPTH * 32 * 32 * 4);
    p.Bt_in = (bf16_t*)take((size_t)NP * DM * 2);
    p.Bt_gate = (bf16_t*)take((size_t)4 * DM * DM * 2);
    p.Bt_br = (bf16_t*)take((size_t)4 * DM * 384 * 2);
    p.Bt_out = (bf16_t*)take((size_t)DM * DM * 2);
    p.Wgu = (bf16_t*)take((size_t)16 * DM * DM * 2);
    p.WdT = (bf16_t*)take((size_t)16 * DM * 512 * 2);
    p.hb = (bf16_t*)take((size_t)NTOK * DM * 2);
    p.part = (float*)take((size_t)NTOK * 16 * 4);
    p.biasB = (float*)take(6 * TABW * 4);
    p.biasC = (float*)take(6 * TABW * 4);
    p.VtB = (bf16_t*)take((size_t)NTOK * 384 * 2);
    p.VtC = (bf16_t*)take((size_t)NTOK * 384 * 2);
    p.tokw = (float*)take((size_t)NTOK * 2 * 4);
    p.perm = (int*)take((size_t)NCLS * NTOK * 4);
    p.proj = (bf16_t*)take((size_t)NTOK * NP * 2);
    p.Hbuf = p.proj;
    if (off > ws_size) return;

    static int grid = 0;
    if (grid == 0) {
        int dev = 0, cus = 0;
        (void)hipGetDevice(&dev);
        (void)hipDeviceGetAttribute(&cus, hipDeviceAttributeMultiprocessorCount, dev);
        if (hipFuncSetAttribute((const void*)mega, hipFuncAttributeMaxDynamicSharedMemorySize, MEGA_LDS) != hipSuccess) { grid = -1; return; }
        int per_cu = 0;
        (void)hipOccupancyMaxActiveBlocksPerMultiprocessor(&per_cu, (const void*)mega, NT, MEGA_LDS);
        (void)hipGetLastError();
        grid = cus > 0 ? cus : 256;
    }
    if (grid < 0) return;
    (void)hipMemsetAsync(p.bar, 0, XCD_BAR_WORDS * sizeof(unsigned), stream);
    mega<<<grid, NT, MEGA_LDS, stream>>>(p);
}
```

```cpp
#include <hip/hip_runtime.h>
#include <stdint.h>

typedef unsigned short bf16_t;
typedef short bf16x8 __attribute__((ext_vector_type(8)));
typedef float f32x4 __attribute__((ext_vector_type(4)));
typedef unsigned u32x4 __attribute__((ext_vector_type(4)));
typedef float f32x16 __attribute__((ext_vector_type(16)));

constexpr int NTOK = 32768, TSEQ = 2048, NBATCH = 16, DM = 1024, DEPTH = 2;
constexpr int NP = 4608;
constexpr int NT = 512;
constexpr int C_AQ = 0, C_AK = 192, C_AV = 384, C_AG = 768, C_BQ = 1152, C_CQ = 1536, C_DY = 1920, C_BK = 2304, C_CK = 2688,
              C_BV = 3072, C_CV = 3456, C_DX = 3840, C_IQ = 4224, C_IK = 4352, C_ALR = 4384, C_IW = 4400;
constexpr int C_OB = 768;
constexpr int C_MG = 2304;
constexpr float EPS = 1e-6f;
constexpr int NCLS = 24, MAXRT = 152;
constexpr int TABW = 2080;
constexpr float LOG2E = 1.4426950408889634f, NEG_BIG = -3.0e38f;

#ifndef PROBE_MASK
#define PROBE_MASK 0
#endif
extern __shared__ __attribute__((aligned(16))) unsigned char dyn_lds[];
constexpr int PROBE_OFF = 160 * 1024 - 64;
#define PROBE_UNIT_BEGIN(bit, cond) do { if (((PROBE_MASK >> (bit)) & 1) && (cond) && threadIdx.x == 0) { volatile __attribute__((address_space(3))) unsigned long long* pw = (volatile __attribute__((address_space(3))) unsigned long long*)(dyn_lds + PROBE_OFF); pw[2] = __builtin_amdgcn_s_memrealtime(); } } while (0)
#define PROBE_UNIT_END(bit, cond) do { if (((PROBE_MASK >> (bit)) & 1) && (cond) && threadIdx.x == 0) { volatile __attribute__((address_space(3))) unsigned long long* pw = (volatile __attribute__((address_space(3))) unsigned long long*)(dyn_lds + PROBE_OFF); pw[1] += 4ull * (__builtin_amdgcn_s_memrealtime() - pw[2]); } } while (0)

enum { I_X = 0, I_WIN, I_AW2, I_AB2, I_AGAIN, I_CONVW, I_CONVB, I_WR, I_BR, I_WI, I_BI, I_LAM, I_WGATE, I_BGATE, I_WBR, I_WOUT, I_RELB,
       I_N1, I_N2, I_NF, I_WRG, I_BRG, I_WRE, I_BRE, I_MWG, I_MWU, I_MWD, N_IN };

struct Params {
    const float* in[N_IN];
    float* h;
    bf16_t* Bt_in;
    bf16_t* Bt_gate;
    bf16_t* Bt_br;
    bf16_t* Bt_out;
    bf16_t* Wgu;
    bf16_t* WdT;
    bf16_t* hb;
    bf16_t* mo;
    bf16_t* proj;
    bf16_t* Hbuf;
    float* part;
    float* biasB;
    float* biasC;
    bf16_t* VtB;
    bf16_t* VtC;
    float* tokw;
    u32x4* perm;
    int* cnt;
    int* qh;
    unsigned* bar;
};

__device__ __forceinline__ bf16_t f2bf(float f) { unsigned u = __float_as_uint(f); u += 0x7FFFu + ((u >> 16) & 1u); return (bf16_t)(u >> 16); }
__device__ __forceinline__ float bf2f(bf16_t b) { return __uint_as_float(((unsigned)b) << 16); }
__device__ __forceinline__ float wave_sum(float v) {
#pragma unroll
    for (int o = 32; o > 0; o >>= 1) v += __shfl_xor(v, o);
    return v;
}
__device__ __forceinline__ float wave_max(float v) {
#pragma unroll
    for (int o = 32; o > 0; o >>= 1) v = fmaxf(v, __shfl_xor(v, o));
    return v;
}
__device__ __forceinline__ int wave_sum_i(int v) {
#pragma unroll
    for (int o = 32; o > 0; o >>= 1) v += __shfl_xor(v, o);
    return v;
}
__device__ __forceinline__ int opaque_tid() { int t = threadIdx.x; asm volatile("" : "+v"(t)); return t; }
typedef __bf16 bf16x2_t __attribute__((ext_vector_type(2)));
typedef float f32x2_t __attribute__((ext_vector_type(2)));
__device__ __forceinline__ unsigned cvt_pk_bf16(float lo, float hi) { const f32x2_t v = {lo, hi}; return __builtin_bit_cast(unsigned, __builtin_convertvector(v, bf16x2_t)); }
__device__ __forceinline__ f32x4 bf4_to_f32(uint2 u) { f32x4 v; v[0] = __uint_as_float(u.x << 16); v[1] = __uint_as_float(u.x & 0xFFFF0000u); v[2] = __uint_as_float(u.y << 16); v[3] = __uint_as_float(u.y & 0xFFFF0000u); return v; }
__device__ __forceinline__ float sigmoidf_(float x) { return __builtin_amdgcn_rcpf(1.0f + __expf(-x)); }
__device__ __forceinline__ float siluf_(float x) { return x * __builtin_amdgcn_rcpf(1.0f + __expf(-x)); }
__device__ __forceinline__ float rstd_of(const float* part, int row) {
    const f32x4* p = (const f32x4*)(part + (size_t)row * 16);
    f32x4 a = p[0], b = p[1], c = p[2], d = p[3];
    float s = ((a[0] + a[1]) + (a[2] + a[3])) + ((b[0] + b[1]) + (b[2] + b[3])) + ((c[0] + c[1]) + (c[2] + c[3])) + ((d[0] + d[1]) + (d[2] + d[3]));
    return rsqrtf(s * (1.0f / 1024.0f) + EPS);
}
__device__ __forceinline__ int map_in_col(int c) {
    if (c < 1152) return c;
    if (c < 1536) return 1168 + (c - 1152);
    if (c < 1920) return 2484 + (c - 1536);
    if (c < 2304) return 3636 + (c - 1920);
    if (c < 2688) return 1552 + (c - 2304);
    if (c < 3072) return 2868 + (c - 2688);
    if (c < 3456) return 1936 + (c - 3072);
    if (c < 3840) return 3252 + (c - 3456);
    if (c < 4224) return 4020 + (c - 3840);
    if (c < 4352) return 2320 + (c - 4224);
    if (c < 4384) return 2448 + (c - 4352);
    if (c < 4400) return 1152 + (c - 4384);
    if (c < 4404) return 2480 + (c - 4400);
    return -1;
}
__device__ __forceinline__ int rel_bucket(int n) {
    if (n < 16) return n;
    float v = logf((float)n / 16.0f) / 4.852030263919617f * 16.0f;
    int b = 16 + (int)v;
    return b < 31 ? b : 31;
}

#define XB_TMO      128
#define XB_XCNT(j)  (256  + 64 * (j))
#define XB_XSUB(j)  (1280 + 64 * (j))
#define XB_XGEN(j)  (2304 + 64 * (j))
#define XB_TOP      3328
#define XB_TOPGEN   3392
#define XCD_BAR_WORDS 3456
#define XB_SPIN_CAP (1u << 18)
#define LAS __attribute__((address_space(3)))

__device__ __forceinline__ unsigned xb_ld(unsigned* p)              { return __hip_atomic_load(p, __ATOMIC_RELAXED, __HIP_MEMORY_SCOPE_AGENT); }
__device__ __forceinline__ unsigned xb_add(unsigned* p, unsigned v) { return __hip_atomic_fetch_add(p, v, __ATOMIC_RELAXED, __HIP_MEMORY_SCOPE_AGENT); }
__device__ __forceinline__ unsigned xb_xcc_id() { return (unsigned)__builtin_amdgcn_s_getreg((3 << 11) | 20) & 0xFu; }
#define XB_SPIN(cond, bar) do { unsigned _sp = 0; while (cond) { __builtin_amdgcn_s_sleep(1); \
    if ((++_sp & 255u) == 0u) { if (xb_ld(&(bar)[XB_TMO])) break; if (_sp > XB_SPIN_CAP) { atomicAdd(&(bar)[XB_TMO], 1u); break; } } } } while (0)

struct XcdBarrier {
    unsigned* bar; unsigned x;
    volatile LAS unsigned* st;
};

__device__ __forceinline__ XcdBarrier xcd_barrier_post(unsigned* bar, volatile LAS unsigned* st) {
    XcdBarrier b; b.bar = bar; b.x = xb_xcc_id(); b.st = st;
    if (threadIdx.x == 0) (void)xb_add(&bar[XB_XCNT(b.x)], 1u);
    return b;
}
__device__ __forceinline__ void xcd_barrier_complete(unsigned* bar, unsigned x, unsigned& nloc, unsigned& nx) {
    const unsigned G = gridDim.x * gridDim.y * gridDim.z;
    unsigned sum, cnt, mine, sp = 0u;
    for (;;) {
        sum = 0u; cnt = 0u; mine = 0u;
#pragma unroll
        for (unsigned j = 0; j < 16; ++j) { const unsigned c = xb_ld(&bar[XB_XCNT(j)]); sum += c; cnt += (c > 0u) ? 1u : 0u; mine = (j == x) ? c : mine; }
        if (sum == G) break;
        __builtin_amdgcn_s_sleep(1);
        if ((++sp & 255u) == 0u) { if (xb_ld(&bar[XB_TMO])) break; if (sp > XB_SPIN_CAP) { atomicAdd(&bar[XB_TMO], 1u); break; } }
    }
    nloc = mine > 0u ? mine : 1u; nx = cnt > 0u ? cnt : 1u;
}

__device__ __forceinline__ void xcd_barrier(const XcdBarrier& b) {
    asm volatile("s_waitcnt vmcnt(0)" ::: "memory");
    __syncthreads();
    if (threadIdx.x == 0) {
        unsigned* bar = b.bar;
        __builtin_amdgcn_s_waitcnt(0);
        unsigned nloc = b.st[0], nx = b.st[1];
        if (nloc == 0u) { xcd_barrier_complete(bar, b.x, nloc, nx); b.st[0] = nloc; b.st[1] = nx; }
        const unsigned old = xb_add(&bar[XB_XSUB(b.x)], 1u);
        const unsigned gen = old / nloc;
        if (old + 1u == (gen + 1u) * nloc) {
            __builtin_amdgcn_fence(__ATOMIC_RELEASE, "agent");
            asm volatile("s_waitcnt vmcnt(0)" ::: "memory");
            const unsigned og = xb_add(&bar[XB_TOP], 1u);
            const unsigned tg = og / nx;
            if (og + 1u == (tg + 1u) * nx) xb_add(&bar[XB_TOPGEN], 1u);
            else XB_SPIN(xb_ld(&bar[XB_TOPGEN]) == tg, bar);
            __builtin_amdgcn_fence(__ATOMIC_ACQUIRE, "agent");
            xb_add(&bar[XB_XGEN(b.x)], 1u);
            asm volatile("s_waitcnt vmcnt(0)" ::: "memory");
        } else {
            XB_SPIN(xb_ld(&bar[XB_XGEN(b.x)]) == gen, bar);
            __builtin_amdgcn_fence(__ATOMIC_ACQUIRE, "agent");
            asm volatile("s_waitcnt vmcnt(0)" ::: "memory");
        }
    }
    __syncthreads();
}


constexpr int WT_LDS = 128 * 65 * 4;
template <class PtrF>
__device__ __forceinline__ void conv_wT(PtrF colptr, int ldsrc, int K, bf16_t* __restrict__ dst, int nrows, const float* __restrict__ scale, int bid, int nb, float* tile) {
    const int tid = opaque_tid(), nkt = K / 128, nrt = nrows / 64, ntile = nrt * nkt;
    const int lk = tid >> 4, ln = (tid & 15) * 4;
    f32x4 cur[4], nxt[4];
    auto load = [&](int t, f32x4 (&v)[4]) {
        const int r0 = (t % nrt) * 64, k0 = (t / nrt) * 128;
        const float* s = colptr(r0 + ln);
#pragma unroll
        for (int i = 0; i < 4; ++i) {
            const int k = k0 + lk + 32 * i;
            f32x4 x = {0.f, 0.f, 0.f, 0.f};
            if (s) { x = *(const f32x4*)(s + (size_t)k * ldsrc); if (scale) { const float sc = scale[k]; x[0] *= sc; x[1] *= sc; x[2] *= sc; x[3] *= sc; } }
            v[i] = x;
        }
    };
    int t = bid;
    if (t < ntile) load(t, cur);
    for (; t < ntile; t += nb) {
        const bool more = t + nb < ntile;
        if (more) load(t + nb, nxt);
#pragma unroll
        for (int i = 0; i < 4; ++i) {
            float* d = tile + (lk + 32 * i) * 65 + ln;
            d[0] = cur[i][0]; d[1] = cur[i][1]; d[2] = cur[i][2]; d[3] = cur[i][3];
        }
        __syncthreads();
        const int r0 = (t % nrt) * 64, k0 = (t / nrt) * 128;
#pragma unroll
        for (int i = 0; i < 2; ++i) {
            const int q = tid + NT * i, kg = (q & 3) + 4 * (q >> 8), n = (q >> 2) & 63;
            const float* s = tile + (kg * 8) * 65 + n;
            u32x4 o;
            o[0] = cvt_pk_bf16(s[0], s[65]); o[1] = cvt_pk_bf16(s[130], s[195]); o[2] = cvt_pk_bf16(s[260], s[325]); o[3] = cvt_pk_bf16(s[390], s[455]);
            *(u32x4*)(dst + (size_t)(r0 + n) * K + k0 + kg * 8) = o;
        }
        __syncthreads();
        if (more) {
#pragma unroll
            for (int i = 0; i < 4; ++i) cur[i] = nxt[i];
        }
    }
}

__device__ __forceinline__ void phase_weights(const Params& p, int l, int what, int bid, int nb, unsigned char* lds) {
    float* tile = (float*)lds;
    const float* n1 = p.in[I_N1] + l * DM;
    const float* n2 = p.in[I_N2] + l * DM;
    if (what & 1) {
        const float* w = p.in[I_WIN] + (size_t)l * DM * 4404;
        conv_wT([=](int r) -> const float* { const int c = map_in_col(r); return c >= 0 ? w + c : nullptr; }, 4404, DM, p.Bt_in, NP, n1, bid, nb, tile);
    }
    if (what & 4) {
        for (int i = 0; i < 4; ++i) {
            const float* wg = p.in[I_WGATE] + ((size_t)l * 4 + i) * DM * DM;
            conv_wT([=](int r) -> const float* { return wg + r; }, DM, DM, p.Bt_gate + (size_t)i * DM * DM, DM, n1, bid, nb, tile);
            const float* wb = p.in[I_WBR] + ((size_t)l * 4 + i) * 384 * DM;
            conv_wT([=](int r) -> const float* { return wb + r; }, DM, 384, p.Bt_br + (size_t)i * DM * 384, DM, nullptr, bid, nb, tile);
        }
        { const float* wo = p.in[I_WOUT] + (size_t)l * DM * DM;
          conv_wT([=](int r) -> const float* { return wo + r; }, DM, DM, p.Bt_out, DM, nullptr, bid, nb, tile); }
    }
    if (what & 2)
    for (int e = 0; e < 16; ++e) {
        const float* wg = p.in[I_MWG] + ((size_t)l * 16 + e) * DM * 512;
        const float* wu = p.in[I_MWU] + ((size_t)l * 16 + e) * DM * 512;
        conv_wT([=](int rho) -> const float* { const int T = rho >> 8, q = (rho >> 7) & 1, cc = rho & 127; return (q ? wu : wg) + 128 * T + cc; },
                512, DM, p.Wgu + (size_t)e * DM * DM, DM, n2, bid, nb, tile);
        const float* wd = p.in[I_MWD] + ((size_t)l * 16 + e) * 512 * DM;
        conv_wT([=](int r) -> const float* { return wd + r; }, DM, 512, p.WdT + (size_t)e * DM * 512, DM, nullptr, bid, nb, tile);
    }
}

__device__ __forceinline__ void conv_queue(const Params& p, int l, int* head, unsigned char* lds) {
    float* tile = (float*)lds; volatile int* slot = (volatile int*)(lds + WT_LDS);
    const int tid = opaque_tid();
    const int lk = tid >> 4, ln = (tid & 15) * 4;
    const int ntot = 3904 + (l + 1 < DEPTH ? 576 : 0);
    const float* n2 = p.in[I_N2] + l * DM;
    const float* n1n = p.in[I_N1] + (l + 1 < DEPTH ? l + 1 : l) * DM;
    struct Job { const float* s; const float* scale; bf16_t* dst; int ldsrc, K, r0, k0; };
    auto job_of = [&](int t) {
        Job j;
        if (t < 3072) {
            const int e = t / 192, rem = t % 192;
            if (rem < 128) {
                j.r0 = (rem & 15) * 64; j.k0 = (rem >> 4) * 128;
                const int rho = j.r0 + ln, T = rho >> 8, q = (rho >> 7) & 1, cc = rho & 127;
                j.s = p.in[q ? I_MWU : I_MWG] + ((size_t)l * 16 + e) * DM * 512 + 128 * T + cc; j.ldsrc = 512; j.K = DM; j.dst = p.Wgu + (size_t)e * DM * DM; j.scale = n2;
            } else {
                const int r2 = rem - 128;
                j.r0 = (r2 & 15) * 64; j.k0 = (r2 >> 4) * 128;
                j.s = p.in[I_MWD] + ((size_t)l * 16 + e) * 512 * DM + j.r0 + ln; j.ldsrc = DM; j.K = 512; j.dst = p.WdT + (size_t)e * DM * 512; j.scale = nullptr;
            }
        } else if (t < 3072 + 512) {
            const int r2 = t - 3072, i = r2 >> 7, rem = r2 & 127;
            j.r0 = (rem & 15) * 64; j.k0 = (rem >> 4) * 128;
            j.s = p.in[I_WGATE] + ((size_t)l * 4 + i) * DM * DM + j.r0 + ln; j.ldsrc = DM; j.K = DM; j.dst = p.Bt_gate + (size_t)i * DM * DM; j.scale = p.in[I_N1] + l * DM;
        } else if (t < 3072 + 512 + 192) {
            const int r2 = t - 3072 - 512, i = r2 / 48, rem = r2 % 48;
            j.r0 = (rem & 15) * 64; j.k0 = (rem >> 4) * 128;
            j.s = p.in[I_WBR] + ((size_t)l * 4 + i) * 384 * DM + j.r0 + ln; j.ldsrc = DM; j.K = 384; j.dst = p.Bt_br + (size_t)i * DM * 384; j.scale = nullptr;
        } else if (t < 3072 + 832) {
            const int rem = t - 3072 - 704;
            j.r0 = (rem & 15) * 64; j.k0 = (rem >> 4) * 128;
            j.s = p.in[I_WOUT] + (size_t)l * DM * DM + j.r0 + ln; j.ldsrc = DM; j.K = DM; j.dst = p.Bt_out; j.scale = nullptr;
        } else {
            const int r2 = t - 3904;
            j.r0 = (r2 % 72) * 64; j.k0 = (r2 / 72) * 128;
            const int c = map_in_col(j.r0 + ln);
            j.s = c >= 0 ? p.in[I_WIN] + (size_t)(l + 1) * DM * 4404 + c : nullptr; j.ldsrc = 4404; j.K = DM; j.dst = p.Bt_in; j.scale = n1n;
        }
        return j;
    };
    auto load = [&](const Job& j, f32x4 (&v)[4]) {
#pragma unroll
        for (int i = 0; i < 4; ++i) {
            const int k = j.k0 + lk + 32 * i;
            f32x4 x = {0.f, 0.f, 0.f, 0.f};
            if (j.s) { x = *(const f32x4*)(j.s + (size_t)k * j.ldsrc); if (j.scale) { const float sc = j.scale[k]; x[0] *= sc; x[1] *= sc; x[2] *= sc; x[3] *= sc; } }
            v[i] = x;
        }
    };
    __syncthreads();
    if (tid == 0) slot[0] = __hip_atomic_fetch_add(head, 1, __ATOMIC_RELAXED, __HIP_MEMORY_SCOPE_AGENT);
    __syncthreads();
    int t = slot[0], par = 0;
    f32x4 cur[4], nxt[4];
    Job jc{};
    if (t < ntot) { jc = job_of(t); load(jc, cur); }
    while (t < ntot) {
        if (tid == 0) slot[par ^ 1] = __hip_atomic_fetch_add(head, 1, __ATOMIC_RELAXED, __HIP_MEMORY_SCOPE_AGENT);
#pragma unroll
        for (int i = 0; i < 4; ++i) {
            float* d = tile + (lk + 32 * i) * 65 + ln;
            d[0] = cur[i][0]; d[1] = cur[i][1]; d[2] = cur[i][2]; d[3] = cur[i][3];
        }
        __syncthreads();
        const int tn = slot[par ^ 1];
        Job jn{};
        if (tn < ntot) { jn = job_of(tn); load(jn, nxt); }
#pragma unroll
        for (int i = 0; i < 2; ++i) {
            const int q = tid + NT * i, kg = (q & 3) + 4 * (q >> 8), n = (q >> 2) & 63;
            const float* s = tile + (kg * 8) * 65 + n;
            u32x4 o;
            o[0] = cvt_pk_bf16(s[0], s[65]); o[1] = cvt_pk_bf16(s[130], s[195]); o[2] = cvt_pk_bf16(s[260], s[325]); o[3] = cvt_pk_bf16(s[390], s[455]);
            *(u32x4*)(jc.dst + (size_t)(jc.r0 + n) * jc.K + jc.k0 + kg * 8) = o;
        }
        __syncthreads();
#pragma unroll
        for (int i = 0; i < 4; ++i) cur[i] = nxt[i];
        jc = jn; t = tn; par ^= 1;
    }
}

__device__ __forceinline__ void phase_prep(const Params& p, int bid, int nb) {
    const int tid = opaque_tid(), wave = tid >> 6, lane = tid & 63;
    const float* x = p.in[I_X];
    f32x4 xv[4], xn[4];
    {
        const int row = bid * 8 + wave;
        if (row < NTOK) {
#pragma unroll
            for (int i = 0; i < 4; ++i) xv[i] = *(const f32x4*)(x + (size_t)row * DM + i * 256 + lane * 4);
        }
    }
    for (int row = bid * 8 + wave; row < NTOK; row += nb * 8) {
        const int rown = row + nb * 8;
        if (rown < NTOK) {
#pragma unroll
            for (int i = 0; i < 4; ++i) xn[i] = *(const f32x4*)(x + (size_t)rown * DM + i * 256 + lane * 4);
        }
        float s = 0.f;
#pragma unroll
        for (int i = 0; i < 4; ++i) {
            const f32x4 v = xv[i];
            s += v[0] * v[0] + v[1] * v[1] + v[2] * v[2] + v[3] * v[3];
            const unsigned lo = (unsigned)f2bf(v[0]) | ((unsigned)f2bf(v[1]) << 16), hi = (unsigned)f2bf(v[2]) | ((unsigned)f2bf(v[3]) << 16);
            *(uint2*)(p.hb + (size_t)row * DM + i * 256 + lane * 4) = make_uint2(lo, hi);
        }
        s = wave_sum(s);
        if (lane < 16) p.part[(size_t)row * 16 + lane] = (lane == 0) ? s : 0.f;
#pragma unroll
        for (int i = 0; i < 4; ++i) xv[i] = xn[i];
    }
    const float* rb = p.in[I_RELB];
    for (int i = bid * NT + tid; i < 6 * TABW; i += nb * NT) {
        const int h = i / TABW, d = i % TABW - 32;
        float vb = NEG_BIG, vc = NEG_BIG;
        if (d >= 0) {
            const int bk = rel_bucket(d);
            vb = rb[bk * 12 + h] * LOG2E;
            const int m = (d <= 128 ? 1 : 0) + ((d % 4 == 0 && d <= 512) ? 1 : 0) + ((d % 16 == 0) ? 1 : 0);
            if (m > 0) vc = (rb[bk * 12 + 6 + h] + logf((float)m)) * LOG2E;
        }
        p.biasB[i] = vb; p.biasC[i] = vc;
    }
    for (int i = bid * NT + tid; i < DEPTH * 32 * 32; i += nb * NT) { p.cnt[i] = 0; p.qh[i] = 0; }
}

constexpr int G_BUF = 256 * 32 * 2 + 128 * 32 * 2;
constexpr int G_NS = 6, G_LDS = G_NS * G_BUF;
constexpr int MG_NS = 5, MG_GLDS = MG_NS * G_BUF;
struct GemmCtx { int tid, wid, lane, wr, wc, fr, fq, sc, rdo; };
__device__ __forceinline__ GemmCtx gemm_ctx() {
    GemmCtx c; c.tid = opaque_tid(); c.wid = __builtin_amdgcn_readfirstlane(c.tid >> 6); c.lane = c.tid & 63; c.wr = c.wid >> 1; c.wc = c.wid & 1; c.fr = c.lane & 15; c.fq = c.lane >> 4;
    c.sc = (((c.tid & 3) ^ ((0 - (c.tid >> 4)) & 3))) * 8;
    c.rdo = c.fr * 64 + ((c.fq ^ ((0 - (c.fr >> 2)) & 3)) * 16);
    return c;
}
__device__ __forceinline__ void gemm_relane(GemmCtx& c) { int t = c.tid; asm volatile("" : "+v"(t)); c.lane = t & 63; c.fr = t & 15; c.fq = (t >> 4) & 3; }
__device__ __forceinline__ void acc_zero(f32x4 (&acc)[4][4]) {
#pragma unroll
    for (int m = 0; m < 4; ++m)
#pragma unroll
        for (int n = 0; n < 4; ++n) acc[m][n] = (f32x4){0.f, 0.f, 0.f, 0.f};
}
__device__ __forceinline__ unsigned lds_addr(const void* p) { return (unsigned)(size_t)(const LAS unsigned char*)p; }
__device__ __forceinline__ void glds16_s(const void* sbase, unsigned voff_bytes, unsigned lds_dst) {
    unsigned keep;
    asm volatile("s_mov_b32 %0, m0\n\ts_mov_b32 m0, %3\n\ts_nop 0\n\tglobal_load_lds_dwordx4 %1, %2\n\ts_mov_b32 m0, %0" : "=&s"(keep) : "v"(voff_bytes), "s"(sbase), "s"(lds_dst) : "memory");
}
__device__ __forceinline__ void gemm_stage(const bf16_t* A, unsigned oa0, unsigned oa1, const bf16_t* B, unsigned ob, int t, unsigned char* buf, const GemmCtx& c) {
    const bf16_t* At = A + t * 32; const bf16_t* Bt = B + t * 32;
    const unsigned l0 = lds_addr(buf) + c.wid * 1024;
    glds16_s(At, oa0 * 2u, l0);
    glds16_s(At, oa1 * 2u, l0 + 8192);
    glds16_s(Bt, ob * 2u, l0 + 16384);
}
template <int NS>
__device__ __forceinline__ void gemm_kloop(f32x4 (&acc)[4][4], const bf16_t* A, unsigned oa0, unsigned oa1, const bf16_t* B, unsigned ob, int nkt, unsigned char* lds, const GemmCtx& c) {
#pragma unroll
    for (int i = 0; i < NS - 1; ++i) gemm_stage(A, oa0, oa1, B, ob, i, lds + i * G_BUF, c);
    int cur = 0;
#pragma unroll 1
    for (int t = 0; t < nkt; ++t) {
        const int young = nkt - 1 - t;
        if (NS >= 6 && young >= 4) asm volatile("s_waitcnt vmcnt(12)" ::: "memory");
        else if (NS >= 5 && young >= 3) asm volatile("s_waitcnt vmcnt(9)" ::: "memory");
        else if (NS >= 4 && young >= 2) asm volatile("s_waitcnt vmcnt(6)" ::: "memory");
        else if (young >= 1) asm volatile("s_waitcnt vmcnt(3)" ::: "memory");
        else asm volatile("s_waitcnt vmcnt(0)" ::: "memory");
        __builtin_amdgcn_s_barrier();
        asm volatile("" ::: "memory");
        const int nxt = cur == 0 ? NS - 1 : cur - 1;
        if (t + NS - 1 < nkt) gemm_stage(A, oa0, oa1, B, ob, t + NS - 1, lds + nxt * G_BUF, c);
        const unsigned char* SA = lds + cur * G_BUF; const unsigned char* SB = SA + 16384;
        bf16x8 At[4], Bt[4];
#pragma unroll
        for (int m = 0; m < 4; ++m) At[m] = *reinterpret_cast<const bf16x8*>(SA + (c.wr * 64 + m * 16) * 64 + c.rdo);
#pragma unroll
        for (int n = 0; n < 4; ++n) Bt[n] = *reinterpret_cast<const bf16x8*>(SB + (c.wc * 64 + n * 16) * 64 + c.rdo);
        asm volatile("s_waitcnt lgkmcnt(0)" ::: "memory");
        __builtin_amdgcn_sched_barrier(0);
#pragma unroll
        for (int m = 0; m < 4; ++m)
#pragma unroll
            for (int n = 0; n < 4; ++n) acc[m][n] = __builtin_amdgcn_mfma_f32_16x16x32_bf16(At[m], Bt[n], acc[m][n], 0, 0, 0);
        cur = cur == NS - 1 ? 0 : cur + 1;
    }
    __builtin_amdgcn_s_barrier();
    asm volatile("" ::: "memory");
}

template <int NS>
__device__ __forceinline__ void gemm_kloop_p(f32x4 (&acc)[4][4], const bf16_t* A, unsigned oa0, unsigned oa1, const bf16_t* B, unsigned ob, int nkt, unsigned char* lds, const GemmCtx& c) {
#pragma unroll
    for (int i = 0; i < NS; ++i) gemm_stage(A, oa0, oa1, B, ob, i, lds + i * G_BUF, c);
    const int aoff = (c.wr * 64) * 64 + c.rdo, boff = 16384 + (c.wc * 64) * 64 + c.rdo;
    bf16x8 A0[4], B0[4], A1[4], B1[4];
#define GK_WAIT(young_) do { const int _y = (young_); \
        if (NS >= 6 && _y >= 4) asm volatile("s_waitcnt vmcnt(12)" ::: "memory"); \
        else if (NS >= 5 && _y >= 3) asm volatile("s_waitcnt vmcnt(9)" ::: "memory"); \
        else if (NS >= 4 && _y >= 2) asm volatile("s_waitcnt vmcnt(6)" ::: "memory"); \
        else if (_y >= 1) asm volatile("s_waitcnt vmcnt(3)" ::: "memory"); \
        else asm volatile("s_waitcnt vmcnt(0)" ::: "memory"); } while (0)
#define GK_READ(FA, FB, buf_) do { const unsigned char* _s = lds + (buf_) * G_BUF; \
        _Pragma("unroll") for (int m = 0; m < 4; ++m) FA[m] = *reinterpret_cast<const bf16x8*>(_s + aoff + m * 1024); \
        _Pragma("unroll") for (int n = 0; n < 4; ++n) FB[n] = *reinterpret_cast<const bf16x8*>(_s + boff + n * 1024); } while (0)
#define GK_MMA(FA, FB) do { _Pragma("unroll") for (int m = 0; m < 4; ++m) _Pragma("unroll") for (int n = 0; n < 4; ++n) \
        acc[m][n] = __builtin_amdgcn_mfma_f32_16x16x32_bf16(FA[m], FB[n], acc[m][n], 0, 0, 0); } while (0)
    GK_WAIT(NS - 1);
    __builtin_amdgcn_s_barrier(); asm volatile("" ::: "memory");
    GK_READ(A0, B0, 0);
    int cur = 0;
#pragma unroll 1
    for (int t = 0; t < nkt; t += 2) {
        {
            GK_WAIT(nkt - 2 - t < NS - 2 ? nkt - 2 - t : NS - 2);
            asm volatile("s_waitcnt lgkmcnt(0)" ::: "memory");
            __builtin_amdgcn_s_barrier(); asm volatile("" ::: "memory");
            if (t + NS < nkt) gemm_stage(A, oa0, oa1, B, ob, t + NS, lds + cur * G_BUF, c);
            const int n1 = cur == NS - 1 ? 0 : cur + 1;
            GK_READ(A1, B1, n1);
            GK_MMA(A0, B0);
            cur = n1;
        }
        {
            const bool more = t + 2 < nkt;
            if (more) GK_WAIT(nkt - 3 - t < NS - 2 ? nkt - 3 - t : NS - 2);
            asm volatile("s_waitcnt lgkmcnt(0)" ::: "memory");
            __builtin_amdgcn_s_barrier(); asm volatile("" ::: "memory");
            if (t + 1 + NS < nkt) gemm_stage(A, oa0, oa1, B, ob, t + 1 + NS, lds + cur * G_BUF, c);
            const int n1 = cur == NS - 1 ? 0 : cur + 1;
            if (more) GK_READ(A0, B0, n1);
            GK_MMA(A1, B1);
            cur = n1;
        }
    }
#undef GK_WAIT
#undef GK_READ
#undef GK_MMA
    __builtin_amdgcn_s_barrier(); asm volatile("" ::: "memory");
}

template <int NS, bool SWAP>
__device__ __forceinline__ void gemm_kloop_s(f32x4 (&acc)[4][4], const bf16_t* A, unsigned oa0, unsigned oa1, const bf16_t* B, unsigned ob, int nkt, unsigned char* lds, const GemmCtx& c) {
    constexpr int D = NS - 2;
#pragma unroll
    for (int i = 0; i < D; ++i) gemm_stage(A, oa0, oa1, B, ob, i, lds + i * G_BUF, c);
    const int aoff = (c.wr * 64) * 64 + c.rdo, boff = 16384 + (c.wc * 64) * 64 + c.rdo;
    const bool trailing = c.wid >= 4;
#define GS_WAIT(young_) do { const int _y = (young_); \
        if (D >= 5 && _y >= 3) asm volatile("s_waitcnt vmcnt(9)" ::: "memory"); \
        else if (D >= 4 && _y >= 2) asm volatile("s_waitcnt vmcnt(6)" ::: "memory"); \
        else if (_y >= 1) asm volatile("s_waitcnt vmcnt(3)" ::: "memory"); \
        else asm volatile("s_waitcnt vmcnt(0)" ::: "memory"); } while (0)
    GS_WAIT(D - 1);
    __builtin_amdgcn_s_barrier(); asm volatile("" ::: "memory");
    if (trailing) { __builtin_amdgcn_s_barrier(); asm volatile("" ::: "memory"); }
    int cur = 0, nxt = D % NS;
#pragma unroll 1
    for (int t = 0; t < nkt; ++t) {
        if (t + 1 < nkt) GS_WAIT(nkt - 2 - t < D - 2 ? nkt - 2 - t : D - 2);
        if (t + D < nkt) gemm_stage(A, oa0, oa1, B, ob, t + D, lds + nxt * G_BUF, c);
        const unsigned char* sb = lds + cur * G_BUF;
        bf16x8 At[4], Bt[4];
#pragma unroll
        for (int m = 0; m < 4; ++m) At[m] = *reinterpret_cast<const bf16x8*>(sb + aoff + m * 1024);
#pragma unroll
        for (int n = 0; n < 4; ++n) Bt[n] = *reinterpret_cast<const bf16x8*>(sb + boff + n * 1024);
        __builtin_amdgcn_s_barrier(); asm volatile("" ::: "memory");
        __builtin_amdgcn_s_setprio(1);
#pragma unroll
        for (int m = 0; m < 4; ++m)
#pragma unroll
            for (int n = 0; n < 4; ++n) acc[m][n] = SWAP ? __builtin_amdgcn_mfma_f32_16x16x32_bf16(Bt[n], At[m], acc[m][n], 0, 0, 0) : __builtin_amdgcn_mfma_f32_16x16x32_bf16(At[m], Bt[n], acc[m][n], 0, 0, 0);
        __builtin_amdgcn_s_setprio(0);
        __builtin_amdgcn_s_barrier(); asm volatile("" ::: "memory");
        cur = cur == NS - 1 ? 0 : cur + 1; nxt = nxt == NS - 1 ? 0 : nxt + 1;
    }
#undef GS_WAIT
    if (!trailing) { __builtin_amdgcn_s_barrier(); asm volatile("" ::: "memory"); }
}

template <int NS, bool SWAP>
__device__ __forceinline__ void gemm_kloop_sc(f32x4 (&acc)[4][4], const bf16_t* A, unsigned oa0, unsigned oa1, const bf16_t* B, unsigned ob, int nkt,
                                              const bf16_t* A2, unsigned oa0n, unsigned oa1n, const bf16_t* B2, unsigned obn, bool has_next, bool primed,
                                              int& cur, unsigned char* lds, const GemmCtx& c, const unsigned char* gsrc, unsigned char* gbuf) {
    constexpr int D = NS - 2;
    static_assert(D == 3, "wait counts below are written for three tiles in flight");
    if (!primed) {
#pragma unroll
        for (int i = 0; i < D; ++i) { const int sl = cur + i >= NS ? cur + i - NS : cur + i; gemm_stage(A, oa0, oa1, B, ob, i, lds + sl * G_BUF, c); }
    }
    const int aoff = (c.wr * 64) * 64 + c.rdo, boff = 16384 + (c.wc * 64) * 64 + c.rdo;
    const bool trailing = c.wid >= 4;
    asm volatile("s_waitcnt vmcnt(6)" ::: "memory");
    __builtin_amdgcn_s_barrier(); asm volatile("" ::: "memory");
    if (trailing) { __builtin_amdgcn_s_barrier(); asm volatile("" ::: "memory"); }
    if (gsrc) {
        const unsigned gl0 = lds_addr(gbuf) + c.wid * 1024;
#pragma unroll
        for (int j = 0; j < 4; ++j) glds16_s(gsrc, (unsigned)(j * 512 + c.tid) * 16u, gl0 + j * 8192);
    }
    int nxt = cur + D >= NS ? cur + D - NS : cur + D;
#pragma unroll 1
    for (int t = 0; t < nkt; ++t) {
        if (t + 1 < nkt) { if (gsrc && t < 2) asm volatile("s_waitcnt vmcnt(7)" ::: "memory"); else if (has_next || t + 2 < nkt) asm volatile("s_waitcnt vmcnt(3)" ::: "memory"); else asm volatile("s_waitcnt vmcnt(0)" ::: "memory"); }
        if (t + D < nkt) gemm_stage(A, oa0, oa1, B, ob, t + D, lds + nxt * G_BUF, c);
        else if (has_next) gemm_stage(A2, oa0n, oa1n, B2, obn, t + D - nkt, lds + nxt * G_BUF, c);
        const unsigned char* sb = lds + cur * G_BUF;
        bf16x8 At[4], Bt[4];
#pragma unroll
        for (int m = 0; m < 4; ++m) At[m] = *reinterpret_cast<const bf16x8*>(sb + aoff + m * 1024);
#pragma unroll
        for (int n = 0; n < 4; ++n) Bt[n] = *reinterpret_cast<const bf16x8*>(sb + boff + n * 1024);
        __builtin_amdgcn_s_barrier(); asm volatile("" ::: "memory");
        __builtin_amdgcn_s_setprio(1);
#pragma unroll
        for (int m = 0; m < 4; ++m)
#pragma unroll
            for (int n = 0; n < 4; ++n) acc[m][n] = SWAP ? __builtin_amdgcn_mfma_f32_16x16x32_bf16(Bt[n], At[m], acc[m][n], 0, 0, 0) : __builtin_amdgcn_mfma_f32_16x16x32_bf16(At[m], Bt[n], acc[m][n], 0, 0, 0);
        __builtin_amdgcn_s_setprio(0);
        __builtin_amdgcn_s_barrier(); asm volatile("" ::: "memory");
        cur = cur == NS - 1 ? 0 : cur + 1; nxt = nxt == NS - 1 ? 0 : nxt + 1;
    }
    if (!trailing) { __builtin_amdgcn_s_barrier(); asm volatile("" ::: "memory"); }
}

constexpr int G2_BUF = 2 * 256 * 32 * 2, G2_NS = 4, G2_LDS = G2_NS * G2_BUF;
struct Gemm2Ctx { int tid, wid, wr, wc, sc, aoff, boff, fr, fq; };
__device__ __forceinline__ Gemm2Ctx gemm2_ctx() {
    Gemm2Ctx c; c.tid = opaque_tid(); c.wid = __builtin_amdgcn_readfirstlane(c.tid >> 6); c.wr = c.wid >> 2; c.wc = c.wid & 3;
    const int lane = c.tid & 63; c.fr = lane & 15; c.fq = lane >> 4;
    c.sc = (((c.tid & 3) ^ ((0 - (c.tid >> 4)) & 3))) * 8;
    const int rdo = c.fr * 64 + ((c.fq ^ ((0 - (c.fr >> 2)) & 3)) * 16);
    c.aoff = (c.wr * 128) * 64 + rdo; c.boff = 16384 + (c.wc * 64) * 64 + rdo;
    return c;
}
__device__ __forceinline__ void gemm2_relane(Gemm2Ctx& c) { int t = c.tid; asm volatile("" : "+v"(t)); c.fr = t & 15; c.fq = (t >> 4) & 3; }
__device__ __forceinline__ void acc2_zero(f32x4 (&acc)[8][4]) {
#pragma unroll
    for (int m = 0; m < 8; ++m)
#pragma unroll
        for (int n = 0; n < 4; ++n) acc[m][n] = (f32x4){0.f, 0.f, 0.f, 0.f};
}
__device__ __forceinline__ void gemm2_stage(const bf16_t* A, unsigned oa0, unsigned oa1, const bf16_t* B, unsigned ob0, unsigned ob1, int t, unsigned char* buf, int wid) {
    const bf16_t* At = A + t * 32; const bf16_t* Bt = B + t * 32;
    const unsigned l0 = lds_addr(buf) + wid * 1024;
    glds16_s(At, oa0 * 2u, l0);
    glds16_s(At, oa1 * 2u, l0 + 8192);
    glds16_s(Bt, ob0 * 2u, l0 + 16384);
    glds16_s(Bt, ob1 * 2u, l0 + 24576);
}
template <bool SWAP>
__device__ __forceinline__ void gemm2_kloop(f32x4 (&acc)[8][4], const bf16_t* A, unsigned oa0, unsigned oa1, const bf16_t* B, unsigned ob0, unsigned ob1, int nkt, unsigned char* lds, const Gemm2Ctx& c) {
#pragma unroll
    for (int i = 0; i < 2; ++i) gemm2_stage(A, oa0, oa1, B, ob0, ob1, i, lds + i * G2_BUF, c.wid);
    const bool trailing = c.wid >= 4;
    asm volatile("s_waitcnt vmcnt(4)" ::: "memory");
    __builtin_amdgcn_s_barrier(); asm volatile("" ::: "memory");
    if (trailing) { __builtin_amdgcn_s_barrier(); asm volatile("" ::: "memory"); }
    int cur = 0;
#pragma unroll 1
    for (int t = 0; t < nkt; ++t) {
        if (t + 2 < nkt) gemm2_stage(A, oa0, oa1, B, ob0, ob1, t + 2, lds + (cur >= 2 ? cur - 2 : cur + 2) * G2_BUF, c.wid);
        const unsigned char* sb = lds + cur * G2_BUF;
        bf16x8 At[8], Bt[4];
#pragma unroll
        for (int n = 0; n < 4; ++n) Bt[n] = *reinterpret_cast<const bf16x8*>(sb + c.boff + n * 1024);
#pragma unroll
        for (int m = 0; m < 8; ++m) At[m] = *reinterpret_cast<const bf16x8*>(sb + c.aoff + m * 1024);
        if (trailing) { if (t + 2 < nkt) asm volatile("s_waitcnt vmcnt(4)" ::: "memory"); else asm volatile("s_waitcnt vmcnt(0)" ::: "memory"); }
        __builtin_amdgcn_s_barrier(); asm volatile("" ::: "memory");
#pragma unroll
        for (int m = 0; m < 8; ++m)
#pragma unroll
            for (int n = 0; n < 4; ++n) acc[m][n] = SWAP ? __builtin_amdgcn_mfma_f32_16x16x32_bf16(Bt[n], At[m], acc[m][n], 0, 0, 0) : __builtin_amdgcn_mfma_f32_16x16x32_bf16(At[m], Bt[n], acc[m][n], 0, 0, 0);
        if (!trailing) { if (t + 2 < nkt) asm volatile("s_waitcnt vmcnt(4)" ::: "memory"); else asm volatile("s_waitcnt vmcnt(0)" ::: "memory"); }
        __builtin_amdgcn_s_barrier(); asm volatile("" ::: "memory");
        cur = cur == 3 ? 0 : cur + 1;
    }
    if (!trailing) { __builtin_amdgcn_s_barrier(); asm volatile("" ::: "memory"); }
}

constexpr int P8_HTB = 128 * 64 * 2, P8_LDS = 8 * P8_HTB;
struct P8Unit { int pm, pn; };
__device__ __forceinline__ int p8_lds_byte(int r, int c) { const int st = (r >> 4) * 2 + (c >> 5), rr = r & 15, cc = c & 31, ob = rr * 64 + cc * 2; return st * 1024 + (ob ^ (((ob >> 9) & 1) << 5)); }
__device__ __forceinline__ void p8_stage_rc(int b, int& R, int& C) { const int st = b / 1024, sb = b % 1024, swz = sb ^ (((sb >> 9) & 1) << 5); R = (st >> 1) * 16 + swz / 64; C = (st & 1) * 32 + (swz % 64) / 2; }
template <class Sched, class Epi>
__device__ __forceinline__ void p8_gemm_phase(LAS unsigned char* lds, const Sched& S, const Epi& E) {
    const int tid = opaque_tid(), wid = __builtin_amdgcn_readfirstlane(tid >> 6), wr = wid >> 2, wc = wid & 3;
    const int nt = S.nt;
    unsigned voffA[2], voffB[2];
#pragma unroll
    for (int i = 0; i < 2; ++i) { int R, C; p8_stage_rc(tid * 16 + i * 8192, R, C); voffA[i] = (unsigned)(R * S.lda + C) * 2u;
        const int Rb = Sched::PERMB ? (R & ~31) + 8 * ((R & 15) >> 2) + 4 * ((R >> 4) & 1) + (R & 3) : R;
        voffB[i] = (unsigned)(Rb * S.ldb + C) * 2u; }
    const size_t kstep = 128;
    const size_t hstepA = (size_t)128 * S.lda * 2, hstepB = (size_t)128 * S.ldb * 2;
    const unsigned ldsw = (unsigned)wid * 1024u;
    const int aoff = p8_lds_byte(wr * 64 + (tid & 15), ((tid >> 4) & 3) * 8), boff = p8_lds_byte(wc * 32 + (tid & 15), ((tid >> 4) & 3) * 8);
#define PG8_SA(b, h) (((b) * 2 + (h)) * P8_HTB)
#define PG8_SB(b, h) ((4 + (b) * 2 + (h)) * P8_HTB)
#define PG8_STAGE(bufoff, gbase, voff) do { _Pragma("unroll") for (int _i = 0; _i < 2; ++_i) \
        __builtin_amdgcn_global_load_lds((const unsigned*)((const char*)(gbase) + (voff)[_i]), (LAS unsigned*)(lds + (bufoff) + ldsw + _i * 8192), 16, 0, 0); } while (0)
#define PG8_LDA(dst, b, h) do { _Pragma("unroll") for (int m = 0; m < 4; ++m) _Pragma("unroll") for (int k = 0; k < 2; ++k) dst[m][k] = *(const LAS bf16x8*)(lds + PG8_SA(b, h) + aoff + m * 2048 + k * 1024); } while (0)
#define PG8_LDB(dst, b, h) do { _Pragma("unroll") for (int n = 0; n < 2; ++n) _Pragma("unroll") for (int k = 0; k < 2; ++k) dst[n][k] = *(const LAS bf16x8*)(lds + PG8_SB(b, h) + boff + n * 2048 + k * 1024); } while (0)
#define PG8_MMA(ai, bj, At, Bt) do { __builtin_amdgcn_s_setprio(1); _Pragma("unroll") for (int m = 0; m < 4; ++m) _Pragma("unroll") for (int n = 0; n < 2; ++n) _Pragma("unroll") for (int k = 0; k < 2; ++k) \
        acc[ai][bj][m][n] = __builtin_amdgcn_mfma_f32_16x16x32_bf16(Bt[n][k], At[m][k], acc[ai][bj][m][n], 0, 0, 0); __builtin_amdgcn_s_setprio(0); } while (0)
#define PG8_WAIT_V(n) asm volatile("s_waitcnt vmcnt(" #n ")" ::: "memory")
#define PG8_WAIT_L(n) asm volatile("s_waitcnt lgkmcnt(" #n ")" ::: "memory")
#define PG8_BAR __builtin_amdgcn_s_barrier()
#define PG8_SCHED __builtin_amdgcn_sched_barrier(0)
    P8Unit cur, nxt; int ui = 0;
    if (!S.next(0, cur)) return;
    f32x4 acc[2][2][4][2];
#pragma unroll
    for (int a = 0; a < 2; ++a)
#pragma unroll
        for (int b = 0; b < 2; ++b)
#pragma unroll
            for (int m = 0; m < 4; ++m)
#pragma unroll
                for (int n = 0; n < 2; ++n) acc[a][b][m][n] = (f32x4){0.f, 0.f, 0.f, 0.f};
    bf16x8 At[4][2], B0[2][2], B1[2][2];
    const char* cA; const char* cB; S.ptrs(cur, cA, cB);
    S.a_ready(cur, 0);
    PG8_STAGE(PG8_SB(0, 0), cB, voffB); PG8_STAGE(PG8_SA(0, 0), cA, voffA); PG8_STAGE(PG8_SB(0, 1), cB + hstepB, voffB); PG8_STAGE(PG8_SA(0, 1), cA + hstepA, voffA);
    if (wr == 1) PG8_BAR;
    PG8_WAIT_V(4); PG8_BAR;
    PG8_STAGE(PG8_SB(1, 0), cB + kstep, voffB); PG8_STAGE(PG8_SA(1, 0), cA + kstep, voffA); PG8_STAGE(PG8_SB(1, 1), cB + hstepB + kstep, voffB);
    PG8_WAIT_V(6); PG8_BAR;
    for (;;) {
        const bool has_next = S.next(ui + 1, nxt);
        const char* nA = cA; const char* nB = cB;
        if (has_next) S.ptrs(nxt, nA, nB);
#pragma unroll 1
        for (int t = 0; t < nt; t += 2) {
            const bool last = (t == nt - 2);
            const char* a1 = cA + (size_t)(t + 1) * kstep;
            const char* a2 = last ? nA : cA + (size_t)(t + 2) * kstep; const char* b2 = last ? nB : cB + (size_t)(t + 2) * kstep;
            const char* a3 = a2 + kstep; const char* b3 = b2 + kstep;
            if (last && has_next) S.a_ready(nxt, ui + 1);
            PG8_LDB(B0, 0, 0); PG8_SCHED; PG8_LDA(At, 0, 0); PG8_STAGE(PG8_SA(1, 1), a1 + hstepA, voffA);
            PG8_WAIT_L(8); PG8_BAR; PG8_WAIT_L(0); PG8_MMA(0, 0, At, B0); PG8_BAR; PG8_SCHED;
            PG8_LDB(B1, 0, 1); PG8_STAGE(PG8_SB(0, 0), b2, voffB);
            PG8_BAR; PG8_WAIT_L(0); PG8_MMA(0, 1, At, B1); PG8_BAR;
            PG8_LDA(At, 0, 1); PG8_STAGE(PG8_SA(0, 0), a2, voffA);
            PG8_BAR; PG8_WAIT_L(0); PG8_MMA(1, 0, At, B0); PG8_BAR; PG8_SCHED;
            PG8_STAGE(PG8_SB(0, 1), b2 + hstepB, voffB);
            PG8_WAIT_V(6); PG8_BAR; PG8_MMA(1, 1, At, B1); PG8_BAR;
            PG8_LDB(B0, 1, 0); PG8_SCHED; PG8_LDA(At, 1, 0); PG8_STAGE(PG8_SA(0, 1), a2 + hstepA, voffA);
            PG8_WAIT_L(8); PG8_BAR; PG8_WAIT_L(0); PG8_MMA(0, 0, At, B0); PG8_BAR; PG8_SCHED;
            PG8_LDB(B1, 1, 1); PG8_STAGE(PG8_SB(1, 0), b3, voffB);
            PG8_BAR; PG8_WAIT_L(0); PG8_MMA(0, 1, At, B1); PG8_BAR;
            PG8_LDA(At, 1, 1); PG8_STAGE(PG8_SA(1, 0), a3, voffA);
            PG8_BAR; PG8_WAIT_L(0); PG8_MMA(1, 0, At, B0); PG8_BAR; PG8_SCHED;
            PG8_STAGE(PG8_SB(1, 1), b3 + hstepB, voffB);
            PG8_WAIT_V(6); PG8_BAR; PG8_MMA(1, 1, At, B1); PG8_BAR;
        }
        { int t2 = tid; asm volatile("" : "+v"(t2)); E(acc, cur, ui, wr, wc, t2 & 15, (t2 >> 4) & 3); }
        if (!has_next) break;
#pragma unroll
        for (int a = 0; a < 2; ++a)
#pragma unroll
            for (int b = 0; b < 2; ++b)
#pragma unroll
                for (int m = 0; m < 4; ++m)
#pragma unroll
                    for (int n = 0; n < 2; ++n) acc[a][b][m][n] = (f32x4){0.f, 0.f, 0.f, 0.f};
        cur = nxt; cA = nA; cB = nB; ++ui;
    }
    PG8_WAIT_V(0);
    if (wr == 0) PG8_BAR;
    PG8_BAR;
#undef PG8_SA
#undef PG8_SB
#undef PG8_STAGE
#undef PG8_LDA
#undef PG8_LDB
#undef PG8_MMA
#undef PG8_WAIT_V
#undef PG8_WAIT_L
#undef PG8_BAR
#undef PG8_SCHED
}

template <class Sched, class Epi>
__device__ __forceinline__ void p8_gemm_phase_g(LAS unsigned char* lds, const Sched& S, const Epi& E) {
    const int tid = opaque_tid(), wid = __builtin_amdgcn_readfirstlane(tid >> 6), wr = wid >> 2, wc = wid & 3;
    const int nt = S.nt;
    unsigned voffB[2], vA0[2], vA1[2], nA0[2], nA1[2];
    int stR[2], stC[2];
#pragma unroll
    for (int i = 0; i < 2; ++i) { p8_stage_rc(tid * 16 + i * 8192, stR[i], stC[i]);
        const int Rb = Sched::PERMB ? (stR[i] & ~31) + 8 * ((stR[i] & 15) >> 2) + 4 * ((stR[i] >> 4) & 1) + (stR[i] & 3) : stR[i];
        voffB[i] = (unsigned)(Rb * S.ldb + stC[i]) * 2u; }
    const size_t kstep = 128;
    const size_t hstepB = (size_t)128 * S.ldb * 2;
    const unsigned ldsw = (unsigned)wid * 1024u;
    const int aoff = p8_lds_byte(wr * 64 + (tid & 15), ((tid >> 4) & 3) * 8), boff = p8_lds_byte(wc * 32 + (tid & 15), ((tid >> 4) & 3) * 8);
#define PG8_SA(b, h) (((b) * 2 + (h)) * P8_HTB)
#define PG8_SB(b, h) ((4 + (b) * 2 + (h)) * P8_HTB)
#define PG8_STAGE(bufoff, gbase, voff) do { _Pragma("unroll") for (int _i = 0; _i < 2; ++_i) \
        __builtin_amdgcn_global_load_lds((const unsigned*)((const char*)(gbase) + (voff)[_i]), (LAS unsigned*)(lds + (bufoff) + ldsw + _i * 8192), 16, 0, 0); } while (0)
#define PG8_LDA(dst, b, h) do { _Pragma("unroll") for (int m = 0; m < 4; ++m) _Pragma("unroll") for (int k = 0; k < 2; ++k) dst[m][k] = *(const LAS bf16x8*)(lds + PG8_SA(b, h) + aoff + m * 2048 + k * 1024); } while (0)
#define PG8_LDB(dst, b, h) do { _Pragma("unroll") for (int n = 0; n < 2; ++n) _Pragma("unroll") for (int k = 0; k < 2; ++k) dst[n][k] = *(const LAS bf16x8*)(lds + PG8_SB(b, h) + boff + n * 2048 + k * 1024); } while (0)
#define PG8_MMA(ai, bj, At, Bt) do { __builtin_amdgcn_s_setprio(1); _Pragma("unroll") for (int m = 0; m < 4; ++m) _Pragma("unroll") for (int n = 0; n < 2; ++n) _Pragma("unroll") for (int k = 0; k < 2; ++k) \
        acc[ai][bj][m][n] = __builtin_amdgcn_mfma_f32_16x16x32_bf16(Bt[n][k], At[m][k], acc[ai][bj][m][n], 0, 0, 0); __builtin_amdgcn_s_setprio(0); } while (0)
#define PG8_WAIT_V(n) asm volatile("s_waitcnt vmcnt(" #n ")" ::: "memory")
#define PG8_WAIT_L(n) asm volatile("s_waitcnt lgkmcnt(" #n ")" ::: "memory")
#define PG8_BAR __builtin_amdgcn_s_barrier()
#define PG8_SCHED __builtin_amdgcn_sched_barrier(0)
    typename Sched::Unit cur, nxt; int ui = 0;
    if (!S.next(0, cur)) return;
    f32x4 acc[2][2][4][2];
#pragma unroll
    for (int a = 0; a < 2; ++a)
#pragma unroll
        for (int b = 0; b < 2; ++b)
#pragma unroll
            for (int m = 0; m < 4; ++m)
#pragma unroll
                for (int n = 0; n < 2; ++n) acc[a][b][m][n] = (f32x4){0.f, 0.f, 0.f, 0.f};
    bf16x8 At[4][2], B0[2][2], B1[2][2];
    const char* cA; const char* cB; S.ptrs(cur, cA, cB);
    S.a_ready(cur, 0);
    __syncthreads();
    S.a_offs(cur, 0, stR, stC, vA0, vA1);
#pragma unroll
    for (int i = 0; i < 2; ++i) { nA0[i] = vA0[i]; nA1[i] = vA1[i]; }
    PG8_STAGE(PG8_SB(0, 0), cB, voffB); PG8_STAGE(PG8_SA(0, 0), cA, vA0); PG8_STAGE(PG8_SB(0, 1), cB + hstepB, voffB); PG8_STAGE(PG8_SA(0, 1), cA, vA1);
    if (wr == 1) PG8_BAR;
    PG8_WAIT_V(4); PG8_BAR;
    PG8_STAGE(PG8_SB(1, 0), cB + kstep, voffB); PG8_STAGE(PG8_SA(1, 0), cA + kstep, vA0); PG8_STAGE(PG8_SB(1, 1), cB + hstepB + kstep, voffB);
    PG8_WAIT_V(6); PG8_BAR;
    for (;;) {
        const bool has_next = S.next(ui + 1, nxt);
        const char* nA = cA; const char* nB = cB;
        if (has_next) S.ptrs(nxt, nA, nB);
#pragma unroll 1
        for (int t = 0; t < nt; t += 2) {
            const bool last = (t == nt - 2);
            const char* a1 = cA + (size_t)(t + 1) * kstep;
            const char* a2 = last ? nA : cA + (size_t)(t + 2) * kstep; const char* b2 = last ? nB : cB + (size_t)(t + 2) * kstep;
            const char* a3 = a2 + kstep; const char* b3 = b2 + kstep;
            if (last && has_next) S.a_ready(nxt, ui + 1);
            PG8_LDB(B0, 0, 0); PG8_SCHED; PG8_LDA(At, 0, 0); PG8_STAGE(PG8_SA(1, 1), a1, vA1);
            PG8_WAIT_L(8); PG8_BAR; PG8_WAIT_L(0); PG8_MMA(0, 0, At, B0);
            if (last && has_next) S.a_offs(nxt, ui + 1, stR, stC, nA0, nA1);
            PG8_BAR; PG8_SCHED;
            PG8_LDB(B1, 0, 1); PG8_STAGE(PG8_SB(0, 0), b2, voffB);
            PG8_BAR; PG8_WAIT_L(0); PG8_MMA(0, 1, At, B1); PG8_BAR;
            PG8_LDA(At, 0, 1); { unsigned o_[2] = {last ? nA0[0] : vA0[0], last ? nA0[1] : vA0[1]}; PG8_STAGE(PG8_SA(0, 0), a2, o_); }
            PG8_BAR; PG8_WAIT_L(0); PG8_MMA(1, 0, At, B0); PG8_BAR; PG8_SCHED;
            PG8_STAGE(PG8_SB(0, 1), b2 + hstepB, voffB);
            PG8_WAIT_V(6); PG8_BAR; PG8_MMA(1, 1, At, B1); PG8_BAR;
            PG8_LDB(B0, 1, 0); PG8_SCHED; PG8_LDA(At, 1, 0); { unsigned o_[2] = {last ? nA1[0] : vA1[0], last ? nA1[1] : vA1[1]}; PG8_STAGE(PG8_SA(0, 1), a2, o_); }
            PG8_WAIT_L(8); PG8_BAR; PG8_WAIT_L(0); PG8_MMA(0, 0, At, B0); PG8_BAR; PG8_SCHED;
            PG8_LDB(B1, 1, 1); PG8_STAGE(PG8_SB(1, 0), b3, voffB);
            PG8_BAR; PG8_WAIT_L(0); PG8_MMA(0, 1, At, B1); PG8_BAR;
            PG8_LDA(At, 1, 1); { unsigned o_[2] = {last ? nA0[0] : vA0[0], last ? nA0[1] : vA0[1]}; PG8_STAGE(PG8_SA(1, 0), a3, o_); }
            PG8_BAR; PG8_WAIT_L(0); PG8_MMA(1, 0, At, B0); PG8_BAR; PG8_SCHED;
            PG8_STAGE(PG8_SB(1, 1), b3 + hstepB, voffB);
            PG8_WAIT_V(6); PG8_BAR; PG8_MMA(1, 1, At, B1); PG8_BAR;
        }
        { int t2 = tid; asm volatile("" : "+v"(t2)); E(acc, cur, ui, wr, wc, t2 & 15, (t2 >> 4) & 3); }
        if (!has_next) break;
#pragma unroll
        for (int a = 0; a < 2; ++a)
#pragma unroll
            for (int b = 0; b < 2; ++b)
#pragma unroll
                for (int m = 0; m < 4; ++m)
#pragma unroll
                    for (int n = 0; n < 2; ++n) acc[a][b][m][n] = (f32x4){0.f, 0.f, 0.f, 0.f};
        cur = nxt; cA = nA; cB = nB; ++ui;
#pragma unroll
        for (int i = 0; i < 2; ++i) { vA0[i] = nA0[i]; vA1[i] = nA1[i]; }
    }
    PG8_WAIT_V(0);
    if (wr == 0) PG8_BAR;
    PG8_BAR;
#undef PG8_SA
#undef PG8_SB
#undef PG8_STAGE
#undef PG8_LDA
#undef PG8_LDB
#undef PG8_MMA
#undef PG8_WAIT_V
#undef PG8_WAIT_L
#undef PG8_BAR
#undef PG8_SCHED
}


struct InprojSched {
    static constexpr bool PERMB = true;
    const bf16_t* hb; const bf16_t* W; const bf16_t* Wg; const float* part; float* srstd; int kb, nloc, xcd, nct, pn0;
    static constexpr int NPT = NP / 256, lda = DM, ldb = DM, nt = DM / 64;
    __device__ __forceinline__ bool next(int i, P8Unit& u) const { const int k = kb + i * nloc; if (k >= (NTOK / 256 / 8) * nct) return false; u.pm = xcd * (NTOK / 256 / 8) + k / nct; u.pn = pn0 + k % nct; return true; }
    __device__ __forceinline__ void ptrs(const P8Unit& u, const char*& a, const char*& b) const {
        const char* t = (const char*)hb + (size_t)u.pm * 256 * DM * 2; const char* w = u.pn < NPT ? (const char*)W + (size_t)u.pn * 256 * DM * 2 : (const char*)Wg + (size_t)(u.pn - NPT) * 256 * DM * 2;
        const bool sw = u.pn >= C_BV / 256 && u.pn < C_BV / 256 + 3;
        a = sw ? w : t; b = sw ? t : w;
    }
    __device__ __forceinline__ void a_ready(const P8Unit& u, int ui) const { const int tid = opaque_tid(); if (tid < 256) srstd[(ui & 1) * 256 + tid] = rstd_of(part, u.pm * 256 + tid); }
};
struct InprojEpi {
    bf16_t* proj; bf16_t* VtB; bf16_t* VtC; const float* srstd; unsigned char* G2; const float* bg;
    __device__ __forceinline__ void operator()(const f32x4 (&acc)[2][2][4][2], const P8Unit& u, int ui, int wr, int wc, int fr, int fq) const {
        const float* rs = srstd + (ui & 1) * 256;
        const int brow = u.pm * 256, bcol = u.pn * 256;
        if (u.pn >= NP / 256) {
            const int gc0 = (u.pn - NP / 256) * 256, gi = gc0 >> 10, ct0 = (gc0 & 1023) >> 7;
            f32x4 bv[2][2];
#pragma unroll
            for (int bj = 0; bj < 2; ++bj)
#pragma unroll
                for (int n = 0; n < 2; ++n) bv[bj][n] = *(const f32x4*)(bg + gc0 + bj * 128 + wc * 32 + 8 * fq + 4 * n);
            unsigned char* gt = G2 + ((size_t)(u.pm * 4 + gi) * 8 + ct0) * 32768 + 8 * (fq & 1);
#pragma unroll
            for (int ai = 0; ai < 2; ++ai)
#pragma unroll
                for (int m = 0; m < 4; ++m) {
                    const int rl = ai * 128 + wr * 64 + m * 16 + fr; const float r1 = rs[rl];
                    const float r1n = -LOG2E * r1;
#pragma unroll
                    for (int bj = 0; bj < 2; ++bj) {
                        unsigned q[2] = {0u, 0u};
#pragma unroll
                        for (int n = 0; n < 2; ++n)
#pragma unroll
                            for (int j = 0; j < 4; ++j) {
                                const float e = __builtin_amdgcn_exp2f(acc[ai][bj][m][n][j] * r1n - LOG2E * bv[bj][n][j]);
                                q[n] = __builtin_amdgcn_cvt_pk_u8_f32(__builtin_amdgcn_rcpf(e * (1.0f / 255.0f) + (1.0f / 255.0f)), j, q[n]);
                            }
                        *(uint2*)(gt + (size_t)bj * 32768 + ((wc * 2 + (fq >> 1)) * 256 + rl) * 16) = make_uint2(q[0], q[1]);
                    }
                }
        } else if (u.pn >= C_BV / 256 && u.pn < C_BV / 256 + 3) {
            const int b = brow / TSEQ, tok0 = (brow % TSEQ) + wc * 32 + (fq >> 1) * 16 + (fq & 1) * 4;
            f32x4 rv[2][2];
#pragma unroll
            for (int bj = 0; bj < 2; ++bj)
#pragma unroll
                for (int n = 0; n < 2; ++n) rv[bj][n] = *(const f32x4*)(rs + bj * 128 + wc * 32 + 8 * fq + 4 * n);
#pragma unroll
            for (int ai = 0; ai < 2; ++ai)
#pragma unroll
                for (int m = 0; m < 4; ++m) {
                    const int vcol = bcol - C_BV + ai * 128 + wr * 64 + m * 16 + fr;
                    bf16_t* vt = (vcol < 384 ? VtB + ((size_t)b * 384 + vcol) * TSEQ : VtC + ((size_t)b * 384 + (vcol - 384)) * TSEQ) + tok0;
#pragma unroll
                    for (int bj = 0; bj < 2; ++bj)
#pragma unroll
                        for (int n = 0; n < 2; ++n) {
                            const f32x4 v = acc[ai][bj][m][n] * rv[bj][n];
                            *(uint2*)(vt + bj * 128 + n * 8) = make_uint2(cvt_pk_bf16(v[0], v[1]), cvt_pk_bf16(v[2], v[3]));
                        }
                }
        } else {
#pragma unroll
            for (int ai = 0; ai < 2; ++ai)
#pragma unroll
                for (int m = 0; m < 4; ++m) {
                    const int rl = ai * 128 + wr * 64 + m * 16 + fr; const float r1 = rs[rl];
                    bf16_t* o = proj + (size_t)(brow + rl) * NP + bcol + wc * 32 + fq * 8;
#pragma unroll
                    for (int bj = 0; bj < 2; ++bj) {
                        const f32x4 v0 = acc[ai][bj][m][0] * r1, v1 = acc[ai][bj][m][1] * r1;
                        u32x4 w; w[0] = cvt_pk_bf16(v0[0], v0[1]); w[1] = cvt_pk_bf16(v0[2], v0[3]); w[2] = cvt_pk_bf16(v1[0], v1[1]); w[3] = cvt_pk_bf16(v1[2], v1[3]);
                        *(u32x4*)(o + bj * 128) = w;
                    }
                }
        }
    }
};
__device__ __forceinline__ void phase_inproj8(const Params& p, int l, bool gates, int bid, int nb, unsigned char* lds) {
    float* srstd = (float*)(lds + P8_LDS);
    InprojSched S{p.hb, p.Bt_in, p.Bt_gate, p.part, srstd, bid >> 3, nb >> 3, bid & 7, gates ? 16 : NP / 256, gates ? NP / 256 : 0};
    InprojEpi E{p.proj, p.VtB, p.VtC, srstd, (unsigned char*)p.h, p.in[I_BGATE] + (size_t)l * 4 * DM};
    p8_gemm_phase((LAS unsigned char*)lds, S, E);
}

__device__ __forceinline__ void phase_inproj(const Params& p, int bid, int nb, unsigned char* lds) {
    Gemm2Ctx c = gemm2_ctx();
    float* srstd = (float*)(lds + G2_LDS);
    constexpr int NCT = NP / 256, NUX = (NTOK / 256 / 8) * NCT;
    const int xcd = bid & 7, nloc = nb >> 3;
    for (int k = bid >> 3; k < NUX; k += nloc) {
        const int rt = xcd * (NTOK / 256 / 8) + k / NCT, ct = k % NCT, brow = rt * 256, bcol = ct * 256;
        if (c.tid < 256) srstd[c.tid] = rstd_of(p.part, brow + c.tid);
        f32x4 acc[8][4]; acc2_zero(acc);
        const int r = c.tid >> 2;
        const unsigned o0 = (unsigned)(r * DM + c.sc), o1 = (unsigned)((r + 128) * DM + c.sc);
        if (ct >= C_BV / 256 && ct < C_BV / 256 + 3) {
            gemm2_kloop<false>(acc, p.hb + (size_t)brow * DM, o0, o1, p.Bt_in + (size_t)bcol * DM, o0, o1, DM / 32, lds, c);
            gemm2_relane(c);
            const int vcol = bcol - C_BV + c.wc * 64;
            bf16_t* vt = (vcol < 384 ? p.VtB + ((size_t)(brow / TSEQ) * 384 + vcol + c.fr) * TSEQ : p.VtC + ((size_t)(brow / TSEQ) * 384 + (vcol - 384) + c.fr) * TSEQ)
                         + (brow % TSEQ) + c.wr * 128 + ((((c.fq & 1) << 1) | (c.fq >> 1)) * 4);
#pragma unroll
            for (int m = 0; m < 8; ++m) {
                const int rl = c.wr * 128 + m * 16 + c.fq * 4;
                const float r0 = srstd[rl], r1 = srstd[rl + 1], r2 = srstd[rl + 2], r3 = srstd[rl + 3];
#pragma unroll
                for (int n = 0; n < 4; ++n)
                    *(uint2*)(vt + (size_t)(n * 16) * TSEQ + m * 16) = make_uint2(cvt_pk_bf16(acc[m][n][0] * r0, acc[m][n][1] * r1), cvt_pk_bf16(acc[m][n][2] * r2, acc[m][n][3] * r3));
            }
        } else {
            gemm2_kloop<true>(acc, p.hb + (size_t)brow * DM, o0, o1, p.Bt_in + (size_t)bcol * DM, o0, o1, DM / 32, lds, c);
            gemm2_relane(c);
#pragma unroll
            for (int m = 0; m < 8; ++m) {
                const int rl = c.wr * 128 + m * 16 + c.fr; const float rs = srstd[rl];
                bf16_t* o = p.proj + (size_t)(brow + rl) * NP + bcol + c.wc * 64 + c.fq * 4;
#pragma unroll
                for (int n = 0; n < 4; ++n) *(uint2*)(o + n * 16) = make_uint2(cvt_pk_bf16(acc[m][n][0] * rs, acc[m][n][1] * rs), cvt_pk_bf16(acc[m][n][2] * rs, acc[m][n][3] * rs));
            }
        }
        __syncthreads();
    }
}

struct UnitSrc { int a, b, c, stride; int* head; int base, lim; volatile int* word; int bt; __device__ __forceinline__ int enc(int s) const { return bt >= 0 ? (s << 4) | bt : s; } };
constexpr int UNIT_NONE = 1 << 20;
__device__ __forceinline__ int grab_unit(UnitSrc& q) {
    __syncthreads();
    const int u = q.a;
    if (q.stride > 0) { q.a += q.stride; return u; }
    if (u != UNIT_NONE || q.head == nullptr) { q.a = q.b; q.b = q.c; q.c = UNIT_NONE; return u; }
    if (threadIdx.x == 0) *q.word = __hip_atomic_fetch_add(q.head, 1, __ATOMIC_RELAXED, __HIP_MEMORY_SCOPE_AGENT);
    __syncthreads();
    const int t = *q.word;
    return t < q.lim ? q.enc(q.base + t) : UNIT_NONE;
}

#ifndef PROBE_GEMM_VAR
#define PROBE_GEMM_VAR -1
#endif
template <int VAR>
__device__ __forceinline__ void phase_gemm_probe(const Params& p, int bid, int nb, unsigned char* lds) {
    const GemmCtx c = gemm_ctx();
    constexpr int NS = G_NS, NCT = NP / 128, NU = (NTOK / 256) * NCT;
    for (int u = bid; u < NU; u += nb) {
        const int rt = u / NCT, ct = u % NCT, brow = rt * 256, bcol = ct * 128;
        f32x4 acc[4][4]; acc_zero(acc);
        const int r = c.tid >> 2;
        const bf16_t* A = p.hb + (size_t)brow * DM; const bf16_t* B = p.Bt_in + (size_t)bcol * DM;
        const unsigned oa0 = (unsigned)(r * DM + c.sc), oa1 = (unsigned)((r + 128) * DM + c.sc), ob = (unsigned)(r * DM + c.sc);
        const int nkt = DM / 32;
#pragma unroll
        for (int i = 0; i < NS - 1; ++i) gemm_stage(A, oa0, oa1, B, ob, i, lds + i * G_BUF, c);
        int cur = 0;
        bf16x8 At[4], Bt[4];
        if (VAR == 2) {
            asm volatile("s_waitcnt vmcnt(0)" ::: "memory"); __builtin_amdgcn_s_barrier();
#pragma unroll
            for (int m = 0; m < 4; ++m) At[m] = *reinterpret_cast<const bf16x8*>(lds + (c.wr * 64 + m * 16) * 64 + c.rdo);
#pragma unroll
            for (int n = 0; n < 4; ++n) Bt[n] = *reinterpret_cast<const bf16x8*>(lds + 16384 + (c.wc * 64 + n * 16) * 64 + c.rdo);
        }
#pragma unroll 1
        for (int t = 0; t < nkt; ++t) {
            const int young = nkt - 1 - t;
            if (VAR == 1) { if (t == 0) asm volatile("s_waitcnt vmcnt(0)" ::: "memory"); }
            else if (young >= 4) asm volatile("s_waitcnt vmcnt(12)" ::: "memory");
            else if (young >= 3) asm volatile("s_waitcnt vmcnt(9)" ::: "memory");
            else if (young >= 2) asm volatile("s_waitcnt vmcnt(6)" ::: "memory");
            else if (young >= 1) asm volatile("s_waitcnt vmcnt(3)" ::: "memory");
            else asm volatile("s_waitcnt vmcnt(0)" ::: "memory");
            if (VAR != 3) __builtin_amdgcn_s_barrier();
            asm volatile("" ::: "memory");
            const int nxt = cur == 0 ? NS - 1 : cur - 1;
            if (VAR != 1 && t + NS - 1 < nkt) gemm_stage(A, oa0, oa1, B, ob, t + NS - 1, lds + nxt * G_BUF, c);
            const unsigned char* SA = lds + cur * G_BUF; const unsigned char* SB = SA + 16384;
            if (VAR != 2) {
#pragma unroll
                for (int m = 0; m < 4; ++m) At[m] = *reinterpret_cast<const bf16x8*>(SA + (c.wr * 64 + m * 16) * 64 + c.rdo);
#pragma unroll
                for (int n = 0; n < 4; ++n) Bt[n] = *reinterpret_cast<const bf16x8*>(SB + (c.wc * 64 + n * 16) * 64 + c.rdo);
                asm volatile("s_waitcnt lgkmcnt(0)" ::: "memory");
            }
            __builtin_amdgcn_sched_barrier(0);
            if (VAR != 4) {
#pragma unroll
                for (int m = 0; m < 4; ++m)
#pragma unroll
                    for (int n = 0; n < 4; ++n) acc[m][n] = __builtin_amdgcn_mfma_f32_16x16x32_bf16(At[m], Bt[n], acc[m][n], 0, 0, 0);
            } else {
#pragma unroll
                for (int m = 0; m < 4; ++m) asm volatile("" :: "v"(At[m]), "v"(Bt[m]));
            }
            cur = cur == NS - 1 ? 0 : cur + 1;
        }
        __builtin_amdgcn_s_barrier();
        asm volatile("" ::: "memory");
        float sacc = 0.f;
#pragma unroll
        for (int m = 0; m < 4; ++m)
#pragma unroll
            for (int n = 0; n < 4; ++n) sacc += acc[m][n][0] + acc[m][n][1] + acc[m][n][2] + acc[m][n][3];
        if (sacc == 1.2345e33f) p.part[0] = sacc;
    }
}

constexpr int GQ = 56, GS = 72, GO = 97;
constexpr int GL_QD = 0, GL_KD = GL_QD + 64 * GQ * 2, GL_KET = GL_KD + 64 * GQ * 2, GL_VT = GL_KET + 64 * GS * 2, GL_ATT = GL_VT + 96 * GS * 2, GL_ST = GL_ATT + 64 * GS * 2,
              GL_OO = GL_ST + 96 * GQ * 2, GL_BC = GL_OO + 64 * GO * 4, GL_SEG = GL_BC + 64 * 48 * 4, GL_EBL = GL_SEG + 8 * 48 * 4, GL_W2 = GL_EBL + 64 * 4, GL_B2 = GL_W2 + 16 * 48 * 4,
              GL_GAIN = GL_B2 + 48 * 4, GL_RQ = GL_GAIN + 96 * 4, GL_RK = GL_RQ + 64 * 48 * 2, GL_RV = GL_RK + 64 * 48 * 2, GL_RA = GL_RV + 64 * 96 * 2, GL_RG = GL_RA + 64 * 16 * 2,
              GLA_LDS = GL_RG + 2 * 64 * 96 * 2;
static_assert(GL_OO % 16 == 0 && GL_RQ % 16 == 0 && GL_RG % 16 == 0 && GL_ST % 16 == 0, "GLA LDS map alignment");
__device__ __forceinline__ void phase_gla(const Params& p, int l, UnitSrc q, unsigned char* lds) {
    bf16_t* qd = (bf16_t*)(lds + GL_QD); bf16_t* kd = (bf16_t*)(lds + GL_KD); bf16_t* keT = (bf16_t*)(lds + GL_KET); bf16_t* vT = (bf16_t*)(lds + GL_VT);
    bf16_t* att = (bf16_t*)(lds + GL_ATT); bf16_t* ST = (bf16_t*)(lds + GL_ST);
    float* oo = (float*)(lds + GL_OO); float* bc = (float*)(lds + GL_BC); float* seg = (float*)(lds + GL_SEG); float* ebl = (float*)(lds + GL_EBL);
    float* w2s = (float*)(lds + GL_W2); float* b2s = (float*)(lds + GL_B2); float* gains = (float*)(lds + GL_GAIN);
    bf16_t* rq = (bf16_t*)(lds + GL_RQ); bf16_t* rk = (bf16_t*)(lds + GL_RK); bf16_t* rv = (bf16_t*)(lds + GL_RV); bf16_t* ra = (bf16_t*)(lds + GL_RA); bf16_t* rg = (bf16_t*)(lds + GL_RG);
    const int tid = opaque_tid(), wave = tid >> 6, lane = tid & 63, r = lane & 31, hf = lane >> 5;
    for (int u = grab_unit(q); u < NBATCH * 4; u = grab_unit(q)) {
        const int b = u >> 2, h = u & 3;
        PROBE_UNIT_BEGIN(9, u == 0);
        for (int i = tid; i < 16 * 48; i += NT) w2s[i] = p.in[I_AW2][(size_t)l * 16 * 192 + (i / 48) * 192 + h * 48 + (i % 48)];
        if (tid < 48) b2s[tid] = p.in[I_AB2][l * 192 + h * 48 + tid];
        if (tid < 96) gains[tid] = p.in[I_AGAIN][l * 384 + h * 96 + tid];
        if (tid < 64) ebl[tid] = 1.0f;
        for (int i = tid; i < 96 * GQ; i += NT) ST[i] = 0;
        for (int i = tid; i < 64 * GS; i += NT) { keT[i] = 0; att[i] = 0; }
        const bf16_t* src[5]; int dsto[5];
#pragma unroll
        for (int j = 0; j < 5; ++j) {
            const int pid = tid + NT * j; int row = 0, col = 0, dst = -1;
            if (pid < 384) { row = pid / 6; col = C_AQ + h * 48 + (pid % 6) * 8; dst = GL_RQ + pid * 16; }
            else if (pid < 768) { const int q = pid - 384; row = q / 6; col = C_AK + h * 48 + (q % 6) * 8; dst = GL_RK + q * 16; }
            else if (pid < 1536) { const int q = pid - 768; row = q / 12; col = C_AV + h * 96 + (q % 12) * 8; dst = GL_RV + q * 16; }
            else if (pid < 2304) { const int q = pid - 1536; row = q / 12; col = C_AG + h * 96 + (q % 12) * 8; dst = GL_RG + q * 16; }
            else if (pid < 2432) { const int q = pid - 2304; row = q / 2; col = C_ALR + (q % 2) * 8; dst = GL_RA + q * 16; }
            src[j] = p.proj + ((size_t)b * TSEQ + row) * NP + col; dsto[j] = dst;
        }
        u32x4 pre[5];
#pragma unroll
        for (int j = 0; j < 5; ++j) pre[j] = dsto[j] >= 0 ? *(const u32x4*)src[j] : (u32x4){0u, 0u, 0u, 0u};
        f32x16 Sacc;
#pragma unroll
        for (int i = 0; i < 16; ++i) Sacc[i] = 0.f;
        const int kt = wave / 3, vt = wave % 3;
        __syncthreads();
        for (int n = 0; n < 32; ++n) {
            const size_t row0 = (size_t)b * TSEQ + n * 64;
            const int gsel = (n & 1) * (64 * 96 * 2);
#pragma unroll
            for (int j = 0; j < 5; ++j) if (dsto[j] >= 0) *(u32x4*)(lds + dsto[j] + (dsto[j] >= GL_RG ? gsel : 0)) = pre[j];
            if (n + 1 < 32) {
#pragma unroll
                for (int j = 0; j < 5; ++j) if (dsto[j] >= 0) pre[j] = *(const u32x4*)(src[j] + (size_t)(n + 1) * 64 * NP);
            }
            __syncthreads();
            if (tid < 480) {
                const int k = tid % 48, tg = tid / 48;
                float wk[16];
#pragma unroll
                for (int rr = 0; rr < 16; ++rr) wk[rr] = w2s[rr * 48 + k];
                const float bk = b2s[k];
                for (int t = tg; t < 64; t += 10) {
                    const u32x4 a0 = *(const u32x4*)(ra + t * 16), a1 = *(const u32x4*)(ra + t * 16 + 8);
                    float z = bk;
#pragma unroll
                    for (int q = 0; q < 4; ++q) {
                        z += __uint_as_float(a0[q] << 16) * wk[2 * q] + __uint_as_float(a0[q] & 0xFFFF0000u) * wk[2 * q + 1];
                        z += __uint_as_float(a1[q] << 16) * wk[8 + 2 * q] + __uint_as_float(a1[q] & 0xFFFF0000u) * wk[8 + 2 * q + 1];
                    }
                    bc[t * 48 + k] = (fminf(z, 0.f) - __logf(1.0f + __expf(-fabsf(z)))) * (1.0f / 16.0f);
                }
            }
            __syncthreads();
            if (tid < 384) {
                const int k = tid % 48, sg = tid / 48; float run = 0.f;
                float bv[8];
#pragma unroll
                for (int i = 0; i < 8; ++i) bv[i] = bc[(sg * 8 + i) * 48 + k];
#pragma unroll
                for (int i = 0; i < 8; ++i) { run += bv[i]; bv[i] = run; }
#pragma unroll
                for (int i = 0; i < 8; ++i) bc[(sg * 8 + i) * 48 + k] = bv[i];
                seg[sg * 48 + k] = run;
            }
            __syncthreads();
            if (tid < 384) {
                const int k = tid % 48, sg = tid / 48; float pre_s = 0.f;
                for (int s2 = 0; s2 < sg; ++s2) pre_s += seg[s2 * 48 + k];
                float bv[8];
#pragma unroll
                for (int i = 0; i < 8; ++i) bv[i] = bc[(sg * 8 + i) * 48 + k];
#pragma unroll
                for (int i = 0; i < 8; ++i) bc[(sg * 8 + i) * 48 + k] = bv[i] + pre_s;
            }
            __syncthreads();
            for (int e = tid; e < 64 * 48; e += NT) {
                const int t = e / 48, k = e % 48;
                const float bb = bc[e], bl = bc[63 * 48 + k];
                const float q = bf2f(rq[e]) * 0.14433756729740643f, kk = bf2f(rk[e]);
                qd[t * GQ + k] = f2bf(q * __expf(bb)); kd[t * GQ + k] = f2bf(kk * __expf(-bb)); keT[k * GS + t] = f2bf(kk * __expf(bl - bb));
                if (t == 63) ebl[k] = __expf(bl);
            }
            for (int e = tid; e < 64 * 96; e += NT) { const int t = e / 96, v = e % 96; vT[v * GS + t] = rv[e]; }
            __syncthreads();
            if (wave < 3) {
                const int si = wave == 2 ? 1 : 0, ci = wave >= 1 ? 1 : 0;
                f32x16 x;
#pragma unroll
                for (int i = 0; i < 16; ++i) x[i] = 0.f;
#pragma unroll
                for (int st = 0; st < 3; ++st)
                    x = __builtin_amdgcn_mfma_f32_32x32x16_bf16(*(const bf16x8*)(kd + (si * 32 + r) * GQ + 16 * st + 8 * hf), *(const bf16x8*)(qd + (ci * 32 + r) * GQ + 16 * st + 8 * hf), x, 0, 0, 0);
                const int cq = ci * 32 + r;
#pragma unroll
                for (int g = 0; g < 4; ++g) {
                    const int s0 = si * 32 + 8 * g + 4 * hf;
                    const float v0 = s0 <= cq ? x[4 * g] : 0.f, v1 = s0 + 1 <= cq ? x[4 * g + 1] : 0.f, v2 = s0 + 2 <= cq ? x[4 * g + 2] : 0.f, v3 = s0 + 3 <= cq ? x[4 * g + 3] : 0.f;
                    *(uint2*)(att + cq * GS + s0) = make_uint2(cvt_pk_bf16(v0, v1), cvt_pk_bf16(v2, v3));
                }
            }
            if (wave < 6) {
#pragma unroll
                for (int i = 0; i < 16; ++i) Sacc[i] *= ebl[kt * 32 + (i & 3) + 8 * (i >> 2) + 4 * hf];
#pragma unroll
                for (int st = 0; st < 4; ++st)
                    Sacc = __builtin_amdgcn_mfma_f32_32x32x16_bf16(*(const bf16x8*)(keT + (kt * 32 + r) * GS + 16 * st + 8 * hf), *(const bf16x8*)(vT + (vt * 32 + r) * GS + 16 * st + 8 * hf), Sacc, 0, 0, 0);
            }
            __syncthreads();
            if (wave < 6) {
                f32x16 o;
#pragma unroll
                for (int i = 0; i < 16; ++i) o[i] = 0.f;
#pragma unroll
                for (int st = 0; st < 4; ++st)
                    if (st < 2 || kt == 1)
                        o = __builtin_amdgcn_mfma_f32_32x32x16_bf16(*(const bf16x8*)(att + (kt * 32 + r) * GS + 16 * st + 8 * hf), *(const bf16x8*)(vT + (vt * 32 + r) * GS + 16 * st + 8 * hf), o, 0, 0, 0);
#pragma unroll
                for (int st = 0; st < 3; ++st)
                    o = __builtin_amdgcn_mfma_f32_32x32x16_bf16(*(const bf16x8*)(qd + (kt * 32 + r) * GQ + 16 * st + 8 * hf), *(const bf16x8*)(ST + (vt * 32 + r) * GQ + 16 * st + 8 * hf), o, 0, 0, 0);
#pragma unroll
                for (int i = 0; i < 16; ++i) oo[(kt * 32 + (i & 3) + 8 * (i >> 2) + 4 * hf) * GO + vt * 32 + r] = o[i];
            }
            __syncthreads();
            {
                float o0[8], o1[8], ms[8];
#pragma unroll
                for (int i = 0; i < 8; ++i) { const int t = wave + 8 * i; o0[i] = oo[t * GO + lane]; o1[i] = lane < 32 ? oo[t * GO + 64 + lane] : 0.f; ms[i] = o0[i] * o0[i] + o1[i] * o1[i]; }
#pragma unroll
                for (int off = 32; off > 0; off >>= 1) {
#pragma unroll
                    for (int i = 0; i < 8; ++i) ms[i] += __shfl_xor(ms[i], off);
                }
                const float g0 = gains[lane], g1 = lane < 32 ? gains[64 + lane] : 0.f;
#pragma unroll
                for (int i = 0; i < 8; ++i) {
                    const int t = wave + 8 * i;
                    const float rs = rsqrtf(ms[i] * (1.0f / 96.0f) + EPS);
                    const bf16_t* gr = (const bf16_t*)((const unsigned char*)rg + gsel) + t * 96;
                    bf16_t* g = p.proj + (row0 + t) * NP + C_AG + h * 96;
                    g[lane] = f2bf(o0[i] * rs * g0 * siluf_(bf2f(gr[lane])));
                    if (lane < 32) g[64 + lane] = f2bf(o1[i] * rs * g1 * siluf_(bf2f(gr[64 + lane])));
                }
            }
            if (wave < 6) {
#pragma unroll
                for (int g = 0; g < 4; ++g) {
                    const int k0 = kt * 32 + 8 * g + 4 * hf;
                    if (k0 < 48) *(uint2*)(ST + (vt * 32 + r) * GQ + k0) = make_uint2(cvt_pk_bf16(Sacc[4 * g], Sacc[4 * g + 1]), cvt_pk_bf16(Sacc[4 * g + 2], Sacc[4 * g + 3]));
                }
            }
            __syncthreads();
        }
        PROBE_UNIT_END(9, u == 0);
    }
}

constexpr int LQ = 56;
constexpr int LR_XIN = 0, LR_XC = LR_XIN + 67 * 48 * 4, LR_XCB = LR_XC + 64 * 48 * 4, LR_WT = LR_XCB + 64 * LQ * 2, LR_AA = LR_WT + 128 * LQ * 2, LR_FF = LR_AA + 64 * 48 * 4,
              LR_GG = LR_FF + 64 * 48 * 4, LR_SEGA = LR_GG + 64 * 48 * 4, LR_SEGH = LR_SEGA + 8 * 48 * 4, LR_CAR = LR_SEGH + 8 * 48 * 4, LR_HS = LR_CAR + 8 * 48 * 4,
              LR_CONST = LR_HS + 64 * 4, LR_Y = LR_CONST + 8 * 48 * 4, LRU_LDS = LR_Y + 64 * 48 * 2;
static_assert(LR_XCB % 16 == 0 && LR_WT % 16 == 0 && LR_Y % 16 == 0, "LRU LDS map alignment");
__device__ __forceinline__ float gelu_tanh(float x) { const float u = 0.7978845608028654f * (x + 0.044715f * x * x * x); return x * __builtin_amdgcn_rcpf(1.0f + __expf(-2.0f * u)); }
__device__ __forceinline__ void phase_lru(const Params& p, int l, UnitSrc q, unsigned char* lds) {
    float* xin = (float*)(lds + LR_XIN); float* xc = (float*)(lds + LR_XC); bf16_t* xcb = (bf16_t*)(lds + LR_XCB); bf16_t* WT = (bf16_t*)(lds + LR_WT);
    float* aa = (float*)(lds + LR_AA); float* ff = (float*)(lds + LR_FF); float* gg = (float*)(lds + LR_GG);
    float* segA = (float*)(lds + LR_SEGA); float* segH = (float*)(lds + LR_SEGH); float* car = (float*)(lds + LR_CAR); float* hs = (float*)(lds + LR_HS);
    float* cst = (float*)(lds + LR_CONST);
    bf16_t* yraw = (bf16_t*)(lds + LR_Y);
    const int tid = opaque_tid(), wave = tid >> 6, lane = tid & 63, r = lane & 31, hf = lane >> 5;
    for (int u = grab_unit(q); u < NBATCH * 8; u = grab_unit(q)) {
        const int b = u >> 3, nblk = u & 7, ch0 = nblk * 48;
        PROBE_UNIT_BEGIN(10, u == 0);
        for (int i = tid; i < 128 * LQ; i += NT) {
            const int n = i / LQ, cidx = i % LQ; float v = 0.f;
            if (cidx < 48) { if (n < 48) v = p.in[I_WR][((size_t)l * 8 + nblk) * 2304 + cidx * 48 + n]; else if (n >= 64 && n < 112) v = p.in[I_WI][((size_t)l * 8 + nblk) * 2304 + cidx * 48 + (n - 64)]; }
            WT[i] = f2bf(v);
        }
        if (tid < 48) {
            cst[tid] = p.in[I_BR][l * 384 + ch0 + tid]; cst[48 + tid] = p.in[I_BI][l * 384 + ch0 + tid];
            cst[96 + tid] = log1pf(__expf(-p.in[I_LAM][l * 384 + ch0 + tid])); cst[144 + tid] = p.in[I_CONVB][l * 384 + ch0 + tid];
#pragma unroll
            for (int j = 0; j < 4; ++j) cst[192 + j * 48 + tid] = p.in[I_CONVW][((size_t)l * 4 + j) * 384 + ch0 + tid];
            hs[tid] = 0.f;
        }
        if (tid < 144) xin[tid] = 0.f;
        const int xrow = tid / 6, xcol = (tid % 6) * 8, yid = tid - 128, yrow = yid / 6, ycol = (yid % 6) * 8;
        const bf16_t* xsrc = p.proj + ((size_t)b * TSEQ + xrow) * NP + C_DX + ch0 + xcol;
        const bf16_t* ysrc = p.proj + ((size_t)b * TSEQ + (yid >= 0 ? yrow : 0)) * NP + C_DY + ch0 + ycol;
        u32x4 px = {0u, 0u, 0u, 0u}, py = {0u, 0u, 0u, 0u};
        if (tid < 384) px = *(const u32x4*)xsrc;
        if (yid >= 0) py = *(const u32x4*)ysrc;
        __syncthreads();
        for (int tt = 0; tt < TSEQ / 64; ++tt) {
            if (tid < 384) {
#pragma unroll
                for (int q = 0; q < 4; ++q) { xin[(3 + xrow) * 48 + xcol + 2 * q] = __uint_as_float(px[q] << 16); xin[(3 + xrow) * 48 + xcol + 2 * q + 1] = __uint_as_float(px[q] & 0xFFFF0000u); }
            }
            if (yid >= 0) *(u32x4*)(yraw + yrow * 48 + ycol) = py;
            if (tt + 1 < TSEQ / 64) {
                if (tid < 384) px = *(const u32x4*)(xsrc + (size_t)(tt + 1) * 64 * NP);
                if (yid >= 0) py = *(const u32x4*)(ysrc + (size_t)(tt + 1) * 64 * NP);
            }
            __syncthreads();
            for (int e = tid; e < 64 * 48; e += NT) {
                const int t = e / 48, cidx = e % 48; float a = cst[144 + cidx];
#pragma unroll
                for (int j = 0; j < 4; ++j) a += cst[192 + j * 48 + cidx] * xin[(t + j) * 48 + cidx];
                xc[e] = a; xcb[t * LQ + cidx] = f2bf(a);
            }
            __syncthreads();
            {
                const int ci = wave >> 2, ni = wave & 3;
                f32x16 g;
#pragma unroll
                for (int i = 0; i < 16; ++i) g[i] = 0.f;
#pragma unroll
                for (int st = 0; st < 3; ++st)
                    g = __builtin_amdgcn_mfma_f32_32x32x16_bf16(*(const bf16x8*)(xcb + (ci * 32 + r) * LQ + 16 * st + 8 * hf), *(const bf16x8*)(WT + (ni * 32 + r) * LQ + 16 * st + 8 * hf), g, 0, 0, 0);
                const int d = (ni & 1) * 32 + r;
                if (d < 48) {
                    if (ni < 2) {
                        const float brv = cst[d], spv = cst[96 + d];
#pragma unroll
                        for (int i = 0; i < 16; ++i) {
                            const int t = ci * 32 + (i & 3) + 8 * (i >> 2) + 4 * hf;
                            const float la = -8.0f * sigmoidf_(g[i] + brv) * spv;
                            aa[t * 48 + d] = __expf(la); ff[t * 48 + d] = __builtin_amdgcn_sqrtf(1.0f - __expf(2.0f * la)) * xc[t * 48 + d];
                        }
                    } else {
                        const float biv = cst[48 + d];
#pragma unroll
                        for (int i = 0; i < 16; ++i) { const int t = ci * 32 + (i & 3) + 8 * (i >> 2) + 4 * hf; gg[t * 48 + d] = sigmoidf_(g[i] + biv); }
                    }
                }
                if (tid < 144) xin[tid] = xin[64 * 48 + tid];
            }
            __syncthreads();
            if (tid < 384) {
                const int d = tid % 48, sg = tid / 48; float ap = 1.f, hl = 0.f;
                float av[8], fv[8];
#pragma unroll
                for (int i = 0; i < 8; ++i) { const int e = (sg * 8 + i) * 48 + d; av[i] = aa[e]; fv[i] = ff[e] * gg[e]; }
#pragma unroll
                for (int i = 0; i < 8; ++i) { hl = av[i] * hl + fv[i]; ap *= av[i]; av[i] = ap; fv[i] = hl; }
#pragma unroll
                for (int i = 0; i < 8; ++i) { const int e = (sg * 8 + i) * 48 + d; aa[e] = av[i]; ff[e] = fv[i]; }
                segA[sg * 48 + d] = ap; segH[sg * 48 + d] = hl;
            }
            __syncthreads();
            if (tid < 48) {
                float cin = hs[tid];
                float sa8[8], sh8[8];
#pragma unroll
                for (int sg = 0; sg < 8; ++sg) { sa8[sg] = segA[sg * 48 + tid]; sh8[sg] = segH[sg * 48 + tid]; }
#pragma unroll
                for (int sg = 0; sg < 8; ++sg) { car[sg * 48 + tid] = cin; cin = sa8[sg] * cin + sh8[sg]; }
                hs[tid] = cin;
            }
            __syncthreads();
            if (tid < 384) {
                const int t = tid / 6, d0 = (tid % 6) * 8, sg = t >> 3;
                const u32x4 yv = *(const u32x4*)(yraw + t * 48 + d0);
                float o[8];
#pragma unroll
                for (int q = 0; q < 8; ++q) {
                    const int e = t * 48 + d0 + q;
                    const float h = ff[e] + aa[e] * car[sg * 48 + d0 + q];
                    const float y = (q & 1) ? __uint_as_float(yv[q >> 1] & 0xFFFF0000u) : __uint_as_float(yv[q >> 1] << 16);
                    o[q] = gelu_tanh(y) * h;
                }
                u32x4 ov; ov[0] = cvt_pk_bf16(o[0], o[1]); ov[1] = cvt_pk_bf16(o[2], o[3]); ov[2] = cvt_pk_bf16(o[4], o[5]); ov[3] = cvt_pk_bf16(o[6], o[7]);
                *(u32x4*)(p.proj + ((size_t)b * TSEQ + tt * 64 + t) * NP + C_DY + ch0 + d0) = ov;
            }
            __syncthreads();
        }
        PROBE_UNIT_END(10, u == 0);
    }
}

constexpr int MASK_ROW = 65, MASK_BYTES = 128 * MASK_ROW * 4 + 128;
constexpr int AT_STAGE = 16384, AT_NS = 6, AT_LDS = AT_NS * AT_STAGE;
constexpr int AT_TAB = 2 * TABW * 4;
template <bool MASKED>
__device__ __forceinline__ void attn_block(const bf16_t* __restrict__ proj, const bf16_t* __restrict__ Vt, int b, int qb, int cq, int ck, const float* __restrict__ tabG, float* tab2,
                                           const unsigned* mask32, unsigned char* stage, bf16_t* __restrict__ outp, int tid) {
    const int wave = tid >> 6, lane = tid & 63, r = lane & 31, hf = lane >> 5, hh = wave >> 2, sb = wave & 3;
    const int q0 = qb * 128 + sb * 32, q = q0 + r, mykt = q0 >> 5, nkt = 4 * qb + 4;
    const int skey = (tid >> 3) & 31, sdim = (tid >> 2) & 63, shh = tid >> 8;
    const unsigned offK = (unsigned)(skey * NP + shh * 64 + (((tid & 7) ^ ((skey >> 1) & 7)) * 8));
    const unsigned offV = (unsigned)((shh * 64 + sdim) * TSEQ + (((tid & 3) ^ ((0 - (sdim >> 2)) & 3)) * 8));
    int kro[4], vro[2][2];
#pragma unroll
    for (int s = 0; s < 4; ++s) kro[s] = hh * 4096 + r * 128 + (((2 * s + hf) ^ ((r >> 1) & 7)) * 16);
#pragma unroll
    for (int db = 0; db < 2; ++db)
#pragma unroll
        for (int s = 0; s < 2; ++s) vro[db][s] = 8192 + hh * 4096 + (db * 32 + r) * 64 + (((2 * s + hf) ^ ((0 - (r >> 2)) & 3)) * 16);
    constexpr float C1 = 0.125f * LOG2E;
    const unsigned* maskq = MASKED ? mask32 + (sb * 32 + r) * MASK_ROW : nullptr;
    const int q0s = __builtin_amdgcn_readfirstlane(q0);
    const int fz = (q - 4 * hf) & 15, fi0 = (fz & 3) + 4 * (fz >> 3), fj = (fi0 >> 1) & 3;
    const bool fact = (fz & 4) == 0, fb0 = (fi0 & 1) != 0, fb1 = (fi0 & 2) != 0, fb2 = (fi0 & 4) != 0;
#pragma unroll 1
    for (int rnd = 0; rnd < 3; ++rnd) {
        const int h = 2 * rnd + hh;
        {
            const int n4 = (qb * 128 + 128 + 32) / 4;
            for (int i = tid; i < 2 * n4; i += NT) { const int hd = i >= n4 ? 1 : 0, j = i - hd * n4; ((f32x4*)(tab2 + hd * TABW))[j] = ((const f32x4*)(tabG + (2 * rnd + hd) * TABW))[j]; }
        }
        const float* tab = tab2 + hh * TABW;
        const bf16_t* qrow = proj + ((size_t)b * TSEQ + q) * NP + cq + h * 64 + 8 * hf;
        bf16x8 qf[4];
#pragma unroll
        for (int s = 0; s < 4; ++s) qf[s] = *(const bf16x8*)(qrow + 16 * s);
        f32x16 o0, o1;
#pragma unroll
        for (int i = 0; i < 16; ++i) { o0[i] = 0.f; o1[i] = 0.f; }
        float m = -1e30f, l = 0.f;
        const bf16_t* Kb = proj + (size_t)b * TSEQ * NP + ck + 2 * rnd * 64;
        const bf16_t* Vb = Vt + ((size_t)b * 384 + 2 * rnd * 64) * TSEQ;
#define AT_STAGE_TILE(kt_, buf_) do { \
        __builtin_amdgcn_global_load_lds((const unsigned*)(Kb + (size_t)(kt_) * 32 * NP + offK), (unsigned*)((buf_) + tid * 16), 16, 0, 0); \
        __builtin_amdgcn_global_load_lds((const unsigned*)(Vb + (kt_) * 32 + offV), (unsigned*)((buf_) + 8192 + tid * 16), 16, 0, 0); } while (0)
#pragma unroll
        for (int i = 0; i < AT_NS - 1; ++i) if (i < nkt) AT_STAGE_TILE(i, stage + i * AT_STAGE);
        __syncthreads();
        int cur = 0;
#pragma unroll 1
        for (int kt = 0; kt < nkt; ++kt) {
            {
                const int young = nkt - 1 - kt;
                if (young >= 4) asm volatile("s_waitcnt vmcnt(8)" ::: "memory");
                else if (young == 3) asm volatile("s_waitcnt vmcnt(6)" ::: "memory");
                else if (young == 2) asm volatile("s_waitcnt vmcnt(4)" ::: "memory");
                else if (young == 1) asm volatile("s_waitcnt vmcnt(2)" ::: "memory");
                else asm volatile("s_waitcnt vmcnt(0)" ::: "memory");
            }
            __builtin_amdgcn_s_barrier();
            asm volatile("" ::: "memory");
            const int nxt = cur == 0 ? AT_NS - 1 : cur - 1;
            if (kt + AT_NS - 1 < nkt) AT_STAGE_TILE(kt + AT_NS - 1, stage + nxt * AT_STAGE);
            if (kt <= mykt) {
                const unsigned char* st = stage + cur * AT_STAGE;
                f32x16 sa;
#pragma unroll
                for (int i = 0; i < 16; ++i) sa[i] = 0.f;
                __builtin_amdgcn_s_setprio(1);
#pragma unroll
                for (int s = 0; s < 4; ++s) sa = __builtin_amdgcn_mfma_f32_32x32x16_bf16(*(const bf16x8*)(st + kro[s]), qf[s], sa, 0, 0, 0);
                __builtin_amdgcn_s_setprio(0);
                const float* tb = tab + (q - kt * 32 - 4 * hf + 32);
                bf16x8 pf[2];
                if (!MASKED && kt * 32 + 31 + 512 < q0s) {
                    const float t0 = fb0 ? sa[1] : sa[0], t1 = fb0 ? sa[3] : sa[2], t2 = fb0 ? sa[5] : sa[4], t3 = fb0 ? sa[7] : sa[6];
                    const float u0 = fb1 ? t1 : t0, u1 = fb1 ? t3 : t2;
                    const float s0 = fb2 ? u1 : u0;
                    const float t4 = fb0 ? sa[9] : sa[8], t5 = fb0 ? sa[11] : sa[10], t6 = fb0 ? sa[13] : sa[12], t7 = fb0 ? sa[15] : sa[14];
                    const float u2 = fb1 ? t5 : t4, u3 = fb1 ? t7 : t6;
                    const float s1 = fb2 ? u3 : u2;
                    const float x0 = fact ? s0 * C1 + tb[-fz] : NEG_BIG, x1 = fact ? s1 * C1 + tb[-fz - 16] : NEG_BIG;
                    float tmax = fmaxf(x0, x1);
                    tmax = fmaxf(tmax, __shfl_xor(tmax, 32));
                    const float mn = fmaxf(m, tmax);
                    if (__any(tmax > m + 8.0f)) {
                        const float alpha = __builtin_amdgcn_exp2f(m - mn);
                        l *= alpha;
#pragma unroll
                        for (int i = 0; i < 16; ++i) { o0[i] *= alpha; o1[i] *= alpha; }
                        m = mn;
                    }
                    const float e0 = __builtin_amdgcn_exp2f(x0 - m), e1 = __builtin_amdgcn_exp2f(x1 - m);
                    l += e0 + e1;
                    const unsigned w0 = fb0 ? cvt_pk_bf16(0.f, e0) : cvt_pk_bf16(e0, 0.f), w1 = fb0 ? cvt_pk_bf16(0.f, e1) : cvt_pk_bf16(e1, 0.f);
                    u32x4 ta, tc;
#pragma unroll
                    for (int j = 0; j < 4; ++j) { ta[j] = (fj == j) ? w0 : 0u; tc[j] = (fj == j) ? w1 : 0u; }
                    pf[0] = __builtin_bit_cast(bf16x8, ta); pf[1] = __builtin_bit_cast(bf16x8, tc);
                } else {
                    unsigned w = 0u;
                    if (MASKED) w = maskq[kt] >> (4 * hf);
                    f32x2_t sv2[8]; float tmax = NEG_BIG;
    #pragma unroll
                    for (int pq = 0; pq < 8; ++pq) {
                        const int i = 2 * pq, ko = (i & 3) + 8 * (i >> 2);
                        const f32x2_t s2 = {sa[i], sa[i + 1]}, b2 = {tb[-ko], tb[-ko - 1]}, c2 = {C1, C1};
                        f32x2_t v2 = s2 * c2 + b2;
                        if (MASKED) { v2[0] = ((w >> ko) & 1u) ? v2[0] : NEG_BIG; v2[1] = ((w >> (ko + 1)) & 1u) ? v2[1] : NEG_BIG; }
                        sv2[pq] = v2; tmax = fmaxf(tmax, fmaxf(v2[0], v2[1]));
                    }
                    tmax = fmaxf(tmax, __shfl_xor(tmax, 32));
                    const float mn = fmaxf(m, tmax);
                    if (__any(tmax > m + 8.0f)) {
                        const float alpha = __builtin_amdgcn_exp2f(m - mn);
                        l *= alpha;
    #pragma unroll
                        for (int i = 0; i < 16; ++i) { o0[i] *= alpha; o1[i] *= alpha; }
                        m = mn;
                    }
                    f32x2_t ps2 = {0.f, 0.f}; const f32x2_t m2 = {m, m};
                    float sv[16];
    #pragma unroll
                    for (int pq = 0; pq < 8; ++pq) {
                        const f32x2_t d = sv2[pq] - m2;
                        f32x2_t e; e[0] = __builtin_amdgcn_exp2f(d[0]); e[1] = __builtin_amdgcn_exp2f(d[1]);
                        ps2 += e; sv[2 * pq] = e[0]; sv[2 * pq + 1] = e[1];
                    }
                    l += ps2[0] + ps2[1];
    #pragma unroll
                    for (int s = 0; s < 2; ++s) {
                        u32x4 t;
                        t[0] = cvt_pk_bf16(sv[8 * s + 0], sv[8 * s + 1]); t[1] = cvt_pk_bf16(sv[8 * s + 2], sv[8 * s + 3]);
                        t[2] = cvt_pk_bf16(sv[8 * s + 4], sv[8 * s + 5]); t[3] = cvt_pk_bf16(sv[8 * s + 6], sv[8 * s + 7]);
                        pf[s] = __builtin_bit_cast(bf16x8, t);
                    }
                }
                __builtin_amdgcn_s_setprio(1);
#pragma unroll
                for (int s = 0; s < 2; ++s) {
                    o0 = __builtin_amdgcn_mfma_f32_32x32x16_bf16(*(const bf16x8*)(st + vro[0][s]), pf[s], o0, 0, 0, 0);
                    o1 = __builtin_amdgcn_mfma_f32_32x32x16_bf16(*(const bf16x8*)(st + vro[1][s]), pf[s], o1, 0, 0, 0);
                }
                __builtin_amdgcn_s_setprio(0);
            }
            cur = cur == AT_NS - 1 ? 0 : cur + 1;
        }
#undef AT_STAGE_TILE
        __builtin_amdgcn_s_barrier();
        asm volatile("" ::: "memory");
        l += __shfl_xor(l, 32);
        const float inv = 1.0f / l;
        bf16_t* orow = outp + ((size_t)b * TSEQ + q) * NP + cq + h * 64 + 4 * hf;
#pragma unroll
        for (int g = 0; g < 4; ++g) {
            *(uint2*)(orow + 8 * g) = make_uint2(cvt_pk_bf16(o0[4 * g] * inv, o0[4 * g + 1] * inv), cvt_pk_bf16(o0[4 * g + 2] * inv, o0[4 * g + 3] * inv));
            *(uint2*)(orow + 32 + 8 * g) = make_uint2(cvt_pk_bf16(o1[4 * g] * inv, o1[4 * g + 1] * inv), cvt_pk_bf16(o1[4 * g + 2] * inv, o1[4 * g + 3] * inv));
        }
    }
}

constexpr int DIL_LDS = AT_TAB + AT_LDS;
__device__ __forceinline__ void dil_unit(const Params& p, int b, int qb, unsigned char* lds) {
    const int tid = opaque_tid();
    attn_block<false>(p.proj, p.VtC, b, qb, C_CQ, C_CK, p.biasC, (float*)lds, nullptr, lds + AT_TAB, p.proj, tid);
    __syncthreads();
}
__device__ __forceinline__ void phase_dil(const Params& p, UnitSrc q, unsigned char* lds) {
    for (int u = grab_unit(q); u < NBATCH * 16; u = grab_unit(q)) { PROBE_UNIT_BEGIN(12, u == 0); dil_unit(p, u & 15, 15 - (u >> 4), lds); PROBE_UNIT_END(12, u == 0); }
}

constexpr int DSA_LDS = MASK_BYTES + 1920 * 64;
__device__ __forceinline__ void cnt_ge(int& c, unsigned k, unsigned t) { asm("v_cmp_ge_u32 vcc, %1, %2\n\tv_addc_co_u32 %0, vcc, 0, %0, vcc" : "+v"(c) : "v"(k), "v"(t) : "vcc"); }
__device__ __forceinline__ void cnt_gt(int& c, unsigned k, unsigned t) { asm("v_cmp_gt_u32 vcc, %1, %2\n\tv_addc_co_u32 %0, vcc, 0, %0, vcc" : "+v"(c) : "v"(k), "v"(t) : "vcc"); }
__device__ __forceinline__ void cnt_eq(int& c, unsigned k, unsigned t) { asm("v_cmp_eq_u32 vcc, %1, %2\n\tv_addc_co_u32 %0, vcc, 0, %0, vcc" : "+v"(c) : "v"(k), "v"(t) : "vcc"); }
__device__ __forceinline__ int grp16_sum(int v) { v += __shfl_xor(v, 1); v += __shfl_xor(v, 2); v += __shfl_xor(v, 4); v += __shfl_xor(v, 8); return v; }
__device__ __forceinline__ void dsa_unit(const Params& p, int b, int qb, unsigned char* lds) {
    unsigned* mask32 = (unsigned*)lds;
    unsigned short* mask16 = (unsigned short*)mask32;
    unsigned char* ikb = lds + MASK_BYTES;
    float* tab = (float*)(lds + MASK_BYTES);
    const int tid = opaque_tid(), wave = tid >> 6, lane = tid & 63;
    const int nlt = 8 * qb;
    for (int pi = tid; pi < nlt * 64; pi += NT) {
        const int key = pi >> 2, cs = (pi & 3) ^ ((0 - (key >> 2)) & 3);
        __builtin_amdgcn_global_load_lds((const unsigned*)(p.proj + ((size_t)b * TSEQ + key) * NP + C_IK + cs * 8), (unsigned*)(ikb + pi * 16), 16, 0, 0);
    }
    for (int i = tid; i < 128 * MASK_ROW; i += NT) mask32[i] = 0u;
    asm volatile("s_waitcnt vmcnt(0)" ::: "memory");
    __syncthreads();
    const int qi = lane >> 4, kl = lane & 15;
    PROBE_UNIT_BEGIN(13, qb == 15 && b == 0);
    bf16x8 af_n = *(const bf16x8*)(p.proj + ((size_t)b * TSEQ + qb * 128 + wave * 4 + (kl >> 2)) * NP + C_IQ + (kl & 3) * 32 + 8 * qi);
    uint2 wv_n = *(const uint2*)(p.proj + ((size_t)b * TSEQ + qb * 128 + wave * 4 + qi) * NP + C_IW);
    for (int grp = wave; grp < 32; grp += 8) {
        const int qg = qb * 128 + grp * 4, myq = qg + qi;
        const bf16x8 af = af_n;
        const uint2 wv = wv_n;
        unsigned key[128];
        unsigned kmx = 0u, kmn = 0xFFFFFFFFu;
#define SEL_SCORE(dst, frag, valid) do { f32x4 _a = {0.f, 0.f, 0.f, 0.f}; _a = __builtin_amdgcn_mfma_f32_16x16x32_bf16(af, (frag), _a, 0, 0, 0); \
            float _s = __uint_as_float(wv.x << 16) * fmaxf(_a[0], 0.f) + __uint_as_float(wv.x & 0xFFFF0000u) * fmaxf(_a[1], 0.f) + __uint_as_float(wv.y << 16) * fmaxf(_a[2], 0.f) + __uint_as_float(wv.y & 0xFFFF0000u) * fmaxf(_a[3], 0.f); _s += 0.0f; \
            const unsigned _u = __float_as_uint(_s); unsigned _k = (_u & 0x80000000u) ? ~_u : (_u | 0x80000000u); _k = _k == 0u ? 1u : _k; (dst) = (valid) ? _k : 0u; \
            kmx = max(kmx, (valid) ? _k : 0u); kmn = min(kmn, (valid) ? _k : 0xFFFFFFFFu); } while (0)
        {
            const bf16_t* kg = p.proj + ((size_t)b * TSEQ + nlt * 16 + kl) * NP + C_IK + 8 * qi;
            bf16x8 bo[8];
#pragma unroll
            for (int c = 0; c < 8; ++c) bo[c] = *(const bf16x8*)(kg + (size_t)c * 16 * NP);
            if (grp + 8 < 32) {
                af_n = *(const bf16x8*)(p.proj + ((size_t)b * TSEQ + qg + 32 + (kl >> 2)) * NP + C_IQ + (kl & 3) * 32 + 8 * qi);
                wv_n = *(const uint2*)(p.proj + ((size_t)b * TSEQ + myq + 32) * NP + C_IW);
            }
#pragma unroll
            for (int c = 0; c < 8; ++c) SEL_SCORE(key[c], bo[c], (nlt + c) * 16 + kl <= myq);
            asm volatile("" ::: "memory");
        }
        const unsigned char* kp = ikb + kl * 64 + ((qi ^ ((0 - (kl >> 2)) & 3)) * 16);
#pragma unroll
        for (int c1 = 0; c1 < 120; ++c1) {
            if (c1 < nlt) {
                const bf16x8 bfr = *(const bf16x8*)(kp + c1 * 1024);
                SEL_SCORE(key[8 + c1], bfr, true);
            } else key[8 + c1] = 0u;
            if (c1 & 1) asm volatile("" ::: "memory");
        }
#undef SEL_SCORE
#define SEL_COUNT(FN, var, thr) do { \
            _Pragma("unroll") for (int t = 0; t < 32; ++t) FN(var, key[t], thr); \
            if (nlt > 24) { _Pragma("unroll") for (int t = 32; t < 64; ++t) FN(var, key[t], thr); } \
            if (nlt > 56) { _Pragma("unroll") for (int t = 64; t < 96; ++t) FN(var, key[t], thr); } \
            if (nlt > 88) { _Pragma("unroll") for (int t = 96; t < 128; ++t) FN(var, key[t], thr); } } while (0)
        unsigned T = 1u; int need = 0x7fffffff; bool slow = false;
        if (qg + 3 >= 256) {
#pragma unroll
            for (int o = 1; o < 16; o <<= 1) { kmx = max(kmx, (unsigned)__shfl_xor((int)kmx, o)); kmn = min(kmn, (unsigned)__shfl_xor((int)kmn, o)); }
            const unsigned Z = 0x80000000u;
            const bool act = myq >= 256;
            unsigned lo = act ? kmn : 1u, hi = act ? kmx + 1u : 2u;
            if (hi <= lo) hi = lo + 1u;
            float wlo = (float)(myq + 1) - 255.5f, whi = 255.5f;
            int side = 0; bool done = !act || (hi - lo == 1u), exact = false;
#pragma unroll 1
            for (int it = 0; it < 100; ++it) {
                if (__all(done)) break;
                unsigned mid;
                if (it == 0) mid = Z + 1u;
                else if (it == 1 && hi == Z + 1u) mid = Z;
                else if (it >= 36) mid = lo + ((hi - lo) >> 1);
                else {
                    const float flo = __uint_as_float((lo & 0x80000000u) ? (lo & 0x7FFFFFFFu) : ~lo), fhi = __uint_as_float((hi & 0x80000000u) ? (hi & 0x7FFFFFFFu) : ~hi);
                    float mf = flo + (fhi - flo) * (wlo * __builtin_amdgcn_rcpf(wlo + whi)); mf += 0.0f;
                    const unsigned mu = __float_as_uint(mf); mid = (mu & 0x80000000u) ? ~mu : (mu | 0x80000000u);
                }
                mid = mid <= lo ? lo + 1u : mid; mid = mid >= hi ? hi - 1u : mid;
                int c = 0;
                SEL_COUNT(cnt_ge, c, mid);
                c = grp16_sum(c);
                if (!done) {
                    if (c >= 256) { lo = mid; wlo = (float)c - 255.5f; if (side > 0) whi *= 0.5f; side = 1; }
                    else { hi = mid; whi = 255.5f - (float)c; if (side < 0) wlo *= 0.5f; side = -1; }
                    if (it < 2) side = 0;
                    exact = c == 256;
                    done = exact || (hi - lo == 1u);
                }
            }
            if (act) T = lo;
            if (__any(act && !exact)) {
                int cgt = 0;
                SEL_COUNT(cnt_gt, cgt, T);
                cgt = grp16_sum(cgt);
                if (act) need = 256 - cgt;
                int ceq = 0;
                SEL_COUNT(cnt_eq, ceq, T);
                ceq = grp16_sum(ceq);
                slow = __any(need != 0x7fffffff && ceq != need);
            }
        }
#undef SEL_COUNT
        int run = 0;
        unsigned short* mrow = mask16 + (grp * 4 + qi) * (2 * MASK_ROW);
#define SEL_EMIT(kv, tile) do { const bool _gt = (kv) > T, _eq = (kv) == T; bool _take = _gt || _eq; \
            if (slow) { const unsigned long long _em = __ballot(_eq); const unsigned _bits = (unsigned)(_em >> (16 * qi)) & 0xFFFFu; \
                const int _rank = run + __popc(_bits & ((1u << kl) - 1u)); _take = _gt || (_eq && _rank < need); run += __popc(_bits); } \
            const unsigned long long _tm = __ballot(_take); if (kl == 0) mrow[(tile)] = (unsigned short)((_tm >> (16 * qi)) & 0xFFFFull); } while (0)
#pragma unroll
        for (int t = 0; t < 120; ++t) { if (t < nlt) SEL_EMIT(key[8 + t], t); }
#pragma unroll
        for (int j = 0; j < 8; ++j) SEL_EMIT(key[j], nlt + j);
#undef SEL_EMIT
    }
    __syncthreads();
    PROBE_UNIT_END(13, qb == 15 && b == 0);
    attn_block<true>(p.proj, p.VtB, b, qb, C_BQ, C_BK, p.biasB, tab, mask32, lds + MASK_BYTES + AT_TAB, p.proj, tid);
    __syncthreads();
}
__device__ __forceinline__ void phase_dsa(const Params& p, UnitSrc q, unsigned char* lds) {
    for (int u = grab_unit(q); u < NBATCH * 16; u = grab_unit(q)) { PROBE_UNIT_BEGIN(11, u == 0); dsa_unit(p, u & 15, 15 - (u >> 4), lds); PROBE_UNIT_END(11, u == 0); }
}

constexpr int MG_LDS = MG_GLDS + 32768;
__device__ __forceinline__ void phase_merge(const Params& p, int l, int bid, int nb, unsigned char* lds) {
    (void)l;
    GemmCtx c = gemm_ctx();
    unsigned char* gbuf = lds + MG_GLDS;
    const unsigned char* G2 = (const unsigned char*)p.h;
    constexpr int NCT = DM / 128, NUX = (NTOK / 256 / 8) * NCT;
    const int xcd = bid & 7, nloc = nb >> 3;
    int ring = 0; bool primed = false;
    for (int k = bid >> 3; k < NUX; k += nloc) {
        const int rt = xcd * (NTOK / 256 / 8) + k / NCT, ct = k % NCT, brow = rt * 256, bcol = ct * 128;
        const bool more = k + nloc < NUX;
        const int k2 = k + nloc, brow2 = (xcd * (NTOK / 256 / 8) + k2 / NCT) * 256, bcol2 = (k2 % NCT) * 128;
        f32x4 mg[4][4]; acc_zero(mg);
        for (int i = 0; i < 4; ++i) {
            f32x4 acc[4][4]; acc_zero(acc);
            int i2 = i; asm volatile("" : "+s"(i2));
            {
                const int r2 = c.tid >> 2;
                const int rb = (r2 & ~31) + 8 * ((r2 & 15) >> 2) + 4 * ((r2 >> 4) & 1) + (r2 & 3);
                const unsigned ob0 = (unsigned)(r2 * NP + c.sc), ob1 = (unsigned)((r2 + 128) * NP + c.sc), obw = (unsigned)(rb * 384 + c.sc);
                const bool last = i2 == 3;
                const bf16_t* An = p.proj + (size_t)(last ? brow2 : brow) * NP + C_OB + (last ? 0 : i2 + 1) * 384;
                const bf16_t* Bn = p.Bt_br + ((size_t)(last ? 0 : i2 + 1) * DM + (last ? bcol2 : bcol)) * 384;
                gemm_kloop_sc<MG_NS, true>(acc, p.proj + (size_t)brow * NP + C_OB + i2 * 384, ob0, ob1, p.Bt_br + ((size_t)i2 * DM + bcol) * 384, obw, 384 / 32,
                                           An, ob0, ob1, Bn, obw, !last || more, primed, ring, lds, c, G2 + ((size_t)(rt * 4 + i2) * 8 + ct) * 32768, gbuf);
            }
            primed = true;
            gemm_relane(c);
            const unsigned char* gp = gbuf + ((c.wc * 4 + (c.fq >> 1)) * 256 + c.wr * 64 + c.fr) * 16 + (c.fq & 1) * 8;
#pragma unroll
            for (int m = 0; m < 4; ++m)
#pragma unroll
                for (int n = 0; n < 4; ++n) {
                    const uint2 u2 = *(const uint2*)(gp + ((n >> 1) * 2 * 256 + m * 16) * 16);
                    const unsigned u = (n & 1) ? u2.y : u2.x;
                    mg[m][n][0] += (float)(u & 255u) * (1.0f / 255.0f) * acc[m][n][0];
                    mg[m][n][1] += (float)((u >> 8) & 255u) * (1.0f / 255.0f) * acc[m][n][1];
                    mg[m][n][2] += (float)((u >> 16) & 255u) * (1.0f / 255.0f) * acc[m][n][2];
                    mg[m][n][3] += (float)(u >> 24) * (1.0f / 255.0f) * acc[m][n][3];
                }
        }
        unsigned orow = (unsigned)(c.wr * 64 + c.fr), ocol = (unsigned)(c.wc * 64 + c.fq * 8); asm volatile("" : "+v"(orow), "+v"(ocol));
#pragma unroll
        for (int m = 0; m < 4; ++m) {
            bf16_t* o = p.proj + (size_t)brow * NP + C_MG + bcol + (orow + m * 16) * NP + ocol;
#pragma unroll
            for (int np = 0; np < 2; ++np) {
                u32x4 w; w[0] = cvt_pk_bf16(mg[m][2 * np][0], mg[m][2 * np][1]); w[1] = cvt_pk_bf16(mg[m][2 * np][2], mg[m][2 * np][3]);
                w[2] = cvt_pk_bf16(mg[m][2 * np + 1][0], mg[m][2 * np + 1][1]); w[3] = cvt_pk_bf16(mg[m][2 * np + 1][2], mg[m][2 * np + 1][3]);
                *(u32x4*)(o + np * 32) = w;
            }
        }
        __syncthreads();
    }
}

__device__ __forceinline__ void phase_out(const Params& p, int l, int bid, int nb, unsigned char* lds) {
    Gemm2Ctx c = gemm2_ctx();
    constexpr int NCT = DM / 256, NUX = (NTOK / 256 / 8) * NCT;
    const int xcd = bid & 7, nloc = nb >> 3;
    for (int k = bid >> 3; k < NUX; k += nloc) {
        const int rt = xcd * (NTOK / 256 / 8) + k / NCT, ct = k % NCT, brow = rt * 256, bcol = ct * 256;
        f32x4 acc[8][4]; acc2_zero(acc);
        const int r = c.tid >> 2;
        gemm2_kloop<true>(acc, p.proj + (size_t)brow * NP + C_MG, (unsigned)(r * NP + c.sc), (unsigned)((r + 128) * NP + c.sc), p.Bt_out + (size_t)bcol * DM,
                          (unsigned)(r * DM + c.sc), (unsigned)((r + 128) * DM + c.sc), DM / 32, lds, c);
        gemm2_relane(c);
#pragma unroll
        for (int m = 0; m < 8; ++m) {
            const int row = brow + c.wr * 128 + m * 16 + c.fr;
            const size_t off = (size_t)row * DM + bcol + c.wc * 64 + c.fq * 4;
            float ss = 0.f;
#pragma unroll
            for (int n = 0; n < 4; ++n) {
                const f32x4 v = bf4_to_f32(*(const uint2*)(p.hb + off + n * 16)) + acc[m][n];
                *(uint2*)(p.hb + off + n * 16) = make_uint2(cvt_pk_bf16(v[0], v[1]), cvt_pk_bf16(v[2], v[3]));
                ss += (v[0] * v[0] + v[1] * v[1]) + (v[2] * v[2] + v[3] * v[3]);
            }
            ss += __shfl_xor(ss, 16); ss += __shfl_xor(ss, 32);
            if (c.fq == 0) p.part[(size_t)row * 16 + ct * 4 + c.wc] = ss;
        }
    }
}

struct OutSched {
    static constexpr bool PERMB = true;
    const bf16_t* A; const bf16_t* W; int kb, nloc, xcd;
    static constexpr int NCT = DM / 256, NUX = (NTOK / 256 / 8) * NCT, lda = NP, ldb = DM, nt = DM / 64;
    __device__ __forceinline__ bool next(int i, P8Unit& u) const { const int k = kb + i * nloc; if (k >= NUX) return false; u.pm = xcd * (NTOK / 256 / 8) + k / NCT; u.pn = k % NCT; return true; }
    __device__ __forceinline__ void ptrs(const P8Unit& u, const char*& a, const char*& b) const { a = (const char*)A + (size_t)u.pm * 256 * NP * 2; b = (const char*)W + (size_t)u.pn * 256 * DM * 2; }
    __device__ __forceinline__ void a_ready(const P8Unit&, int) const {}
};
struct OutEpi {
    bf16_t* hb; float* part;
    __device__ __forceinline__ void operator()(const f32x4 (&acc)[2][2][4][2], const P8Unit& u, int, int wr, int wc, int fr, int fq) const {
#pragma unroll
        for (int ai = 0; ai < 2; ++ai)
#pragma unroll
            for (int m = 0; m < 4; ++m) {
                const int row = u.pm * 256 + ai * 128 + wr * 64 + m * 16 + fr;
                const size_t off = (size_t)row * DM + u.pn * 256 + wc * 32 + fq * 8;
                float ss = 0.f;
#pragma unroll
                for (int bj = 0; bj < 2; ++bj) {
                    const u32x4 hw = *(const u32x4*)(hb + off + bj * 128);
                    const f32x4 v0 = bf4_to_f32(make_uint2(hw[0], hw[1])) + acc[ai][bj][m][0], v1 = bf4_to_f32(make_uint2(hw[2], hw[3])) + acc[ai][bj][m][1];
                    u32x4 ow; ow[0] = cvt_pk_bf16(v0[0], v0[1]); ow[1] = cvt_pk_bf16(v0[2], v0[3]); ow[2] = cvt_pk_bf16(v1[0], v1[1]); ow[3] = cvt_pk_bf16(v1[2], v1[3]);
                    *(u32x4*)(hb + off + bj * 128) = ow;
                    ss += (v0[0] * v0[0] + v0[1] * v0[1]) + (v0[2] * v0[2] + v0[3] * v0[3]) + (v1[0] * v1[0] + v1[1] * v1[1]) + (v1[2] * v1[2] + v1[3] * v1[3]);
                }
                ss += __shfl_xor(ss, 16); ss += __shfl_xor(ss, 32);
                if (fq == 0) part[(size_t)row * 16 + u.pn * 4 + wc] = ss;
            }
    }
};
__device__ __forceinline__ void phase_out8(const Params& p, int l, int bid, int nb, unsigned char* lds) {
    OutSched S{p.proj + C_MG, p.Bt_out, bid >> 3, nb >> 3, bid & 7};
    OutEpi E{p.hb, p.part};
    p8_gemm_phase((LAS unsigned char*)lds, S, E);
}

constexpr int RT_W_BYTES = 1024 * 20 * 4, RT_LDS = RT_W_BYTES + (64 + 2048 + 8 * 84 + 3072) * 4;
template <int N>
__device__ __forceinline__ void halve_reduce(const float (&v)[N], float (&o)[N / 2], int off, bool upper) {
#pragma unroll
    for (int i = 0; i < N / 2; ++i) { const float keep = upper ? v[2 * i + 1] : v[2 * i], send = upper ? v[2 * i] : v[2 * i + 1]; o[i] = keep + __shfl_xor(send, off); }
}
__device__ __forceinline__ void phase_router(const Params& p, int l, int bid, int nb, unsigned char* lds) {
    float* W = (float*)lds;
    const int tid = opaque_tid(), wave = tid >> 6, lane = tid & 63;
    const float* n2 = p.in[I_N2] + l * DM;
    const float* wrg = p.in[I_WRG] + (size_t)l * DM * 4;
    const float* wre = p.in[I_WRE] + (size_t)l * DM * 16;
#pragma unroll 8
    for (int it = 0; it < 40; ++it) {
        const int id = tid + NT * it, j = id >> 10, k = id & 1023;
        const float v = n2[k] * (j < 4 ? wrg[k * 4 + j] : wre[k * 16 + (j - 4)]);
        const int jp = j >> 1, jl = j & 1, i = k >> 8, ln = (k & 255) >> 2, e = k & 3;
        W[((((jp * 4 + i) * 2 + (e >> 1)) * 64 + ln) * 4) + (e & 1) * 2 + jl] = v;
    }
    int* cnt = p.cnt + l * 32 * 32;
    int* lcnt = (int*)(lds + RT_W_BYTES); int* lbase = lcnt + 32; int* ltok = lbase + 32; int* lcls = ltok + 1024;
    float* res = (float*)(lcls + 1024) + wave * 84;
    float* lrs = (float*)(lcls + 1024) + 8 * 84; float* lwl = lrs + 1024; float* lwh = lwl + 1024;
    if (tid < 32) lcnt[tid] = 0;
    __syncthreads();
    int nmine = 0;
    const int stride = nb * 8;
    f32x4 hv[4][4];
    float prv = 0.f;
    auto load_rows = [&](int row0) {
#pragma unroll
        for (int r = 0; r < 4; ++r)
#pragma unroll
            for (int i = 0; i < 4; ++i) { const int rw = row0 + r * stride < NTOK ? row0 + r * stride : row0; hv[r][i] = bf4_to_f32(*(const uint2*)(p.hb + (size_t)rw * DM + i * 256 + lane * 4)); }
        { const int rw = row0 + (lane >> 4) * stride < NTOK ? row0 + (lane >> 4) * stride : row0; prv = p.part[(size_t)rw * 16 + (lane & 15)]; }
    };
    int row0 = bid * 8 + wave;
    if (row0 < NTOK) load_rows(row0);
    for (; row0 < NTOK; row0 += 4 * stride) {
        f32x2_t acc[4][10];
#pragma unroll
        for (int r = 0; r < 4; ++r)
#pragma unroll
            for (int jp = 0; jp < 10; ++jp) acc[r][jp] = (f32x2_t){0.f, 0.f};
        const f32x4* Wl = (const f32x4*)W + lane;
#pragma unroll
        for (int jp = 0; jp < 10; ++jp)
#pragma unroll
            for (int i = 0; i < 4; ++i)
#pragma unroll
                for (int h = 0; h < 2; ++h) {
                    const f32x4 w4 = Wl[((jp * 4 + i) * 2 + h) * 64];
                    const f32x2_t w0 = {w4[0], w4[1]}, w1 = {w4[2], w4[3]};
#pragma unroll
                    for (int r = 0; r < 4; ++r) {
                        const float h0 = hv[r][i][2 * h], h1 = hv[r][i][2 * h + 1];
                        acc[r][jp] += (f32x2_t){h0, h0} * w0;
                        acc[r][jp] += (f32x2_t){h1, h1} * w1;
                    }
                    if (h == 1 && (i & 1)) asm volatile("" ::: "memory");
                }
        float pr = prv;
        float v80[80], v40[40], v20[20], v10[10], v[5];
#pragma unroll
        for (int r = 0; r < 4; ++r)
#pragma unroll
            for (int jp = 0; jp < 10; ++jp) { v80[r * 20 + 2 * jp] = acc[r][jp][0]; v80[r * 20 + 2 * jp + 1] = acc[r][jp][1]; }
        halve_reduce<80>(v80, v40, 32, (lane & 32) != 0);
        halve_reduce<40>(v40, v20, 16, (lane & 16) != 0);
        asm volatile("" ::: "memory");
        { const int rown = row0 + 4 * stride; if (rown < NTOK) load_rows(rown); }
        halve_reduce<20>(v20, v10, 8, (lane & 8) != 0);
        halve_reduce<10>(v10, v, 4, (lane & 4) != 0);
#pragma unroll
        for (int i = 0; i < 5; ++i) { v[i] += __shfl_xor(v[i], 2); v[i] += __shfl_xor(v[i], 1); }
        pr += __shfl_xor(pr, 1); pr += __shfl_xor(pr, 2); pr += __shfl_xor(pr, 4); pr += __shfl_xor(pr, 8);
        if ((lane & 3) == 0) {
            const int lo = ((lane >> 5) & 1) | (((lane >> 4) & 1) << 1) | (((lane >> 3) & 1) << 2) | (((lane >> 2) & 1) << 3);
#pragma unroll
            for (int i = 0; i < 5; ++i) res[i * 16 + lo] = v[i];
        }
        if ((lane & 15) == 0) res[80 + (lane >> 4)] = rsqrtf(pr * (1.0f / 1024.0f) + EPS);
        asm volatile("s_waitcnt lgkmcnt(0)" ::: "memory");
        if (lane < 4) {
            const int row = row0 + lane * stride;
            const float rs = res[80 + lane];
            float a[20];
#pragma unroll
            for (int j = 0; j < 20; ++j) a[j] = res[lane * 20 + j];
            float gl[4];
#pragma unroll
            for (int j = 0; j < 4; ++j) gl[j] = a[j] * rs + p.in[I_BRG][l * 4 + j];
            int g = 0; float gm = gl[0];
#pragma unroll
            for (int j = 1; j < 4; ++j) if (gl[j] > gm) { gm = gl[j]; g = j; }
            float den = 0.f;
#pragma unroll
            for (int j = 0; j < 4; ++j) den += __expf(gl[j] - gm);
            const float gw = 1.0f / den;
            float el[4];
#pragma unroll
            for (int j = 0; j < 4; ++j) {
                float vv = 0.f;
#pragma unroll
                for (int gg = 0; gg < 4; ++gg) vv = (gg == g) ? (a[4 + gg * 4 + j] * rs + p.in[I_BRE][l * 16 + gg * 4 + j]) : vv;
                el[j] = vv;
            }
            int i1 = 0; float v1 = el[0];
#pragma unroll
            for (int j = 1; j < 4; ++j) if (el[j] > v1) { v1 = el[j]; i1 = j; }
            int i2 = -1; float v2 = -3.0e38f;
#pragma unroll
            for (int j = 0; j < 4; ++j) if (j != i1 && el[j] > v2) { v2 = el[j]; i2 = j; }
            const float e2 = __expf(v2 - v1);
            const float w1 = gw / (1.0f + e2), w2 = gw * e2 / (1.0f + e2);
            const int lo = i1 < i2 ? i1 : i2, hi = i1 < i2 ? i2 : i1;
            const float wlo = i1 < i2 ? w1 : w2, whi = i1 < i2 ? w2 : w1;
            const int pidx = lo == 0 ? (hi - 1) : (lo == 1 ? (hi + 1) : 5);
            const int cls = g * 6 + pidx;
            if (row < NTOK) {
                const int lr = __hip_atomic_fetch_add(&lcnt[cls], 1, __ATOMIC_RELAXED, __HIP_MEMORY_SCOPE_WORKGROUP);
                const int li = (nmine + lane) * 8 + wave;
                ltok[li] = row; lcls[li] = cls | (lr << 8); lrs[li] = rs; lwl[li] = wlo; lwh[li] = whi;
            } else lcls[(nmine + lane) * 8 + wave] = -1;
        }
        nmine += 4;
    }
    __syncthreads();
    if (tid < NCLS) lbase[tid] = lcnt[tid] > 0 ? __hip_atomic_fetch_add(&cnt[tid * 32], lcnt[tid], __ATOMIC_RELAXED, __HIP_MEMORY_SCOPE_AGENT) : 0;
    __syncthreads();
    for (int i = tid; i < nmine * 8; i += NT) {
        if (lcls[i] < 0) continue;
        const int cl = lcls[i] & 255, lr = lcls[i] >> 8;
        u32x4 e; e[0] = (unsigned)ltok[i]; e[1] = __float_as_uint(lrs[i]); e[2] = __float_as_uint(lwl[i]); e[3] = __float_as_uint(lwh[i]);
        p.perm[(size_t)cl * NTOK + lbase[cl] + lr] = e;
    }
}

__device__ __forceinline__ void cls_experts(int cls, int& elo, int& ehi) {
    const int g = cls / 6, pi = cls % 6;
    const int lo = pi < 3 ? 0 : (pi < 5 ? 1 : 2), hi = pi < 3 ? pi + 1 : (pi < 5 ? pi - 1 : 3);
    elo = g * 4 + lo; ehi = g * 4 + hi;
}
__device__ __forceinline__ void moe_prefix(const int* cnt, int* spre, int* scnt) {
    const int tid = opaque_tid();
    if (tid < 64) {
        const int n = tid < NCLS ? cnt[tid * 32] : 0;
        int inc = (n + 255) >> 8, run = inc;
#pragma unroll
        for (int o = 1; o < 32; o <<= 1) { const int v = __shfl_up(run, o); if ((tid & 63) >= o) run += v; }
        if (tid < NCLS) { scnt[tid] = n; spre[tid] = run - inc; }
        if (tid == NCLS - 1) spre[NCLS] = run;
    }
    __syncthreads();
}

__device__ __forceinline__ void phase_moe1(const Params& p, int l, int bid, int nb, unsigned char* lds) {
    Gemm2Ctx c = gemm2_ctx();
    int* spre = (int*)(lds + G2_LDS); int* scnt = spre + 32;
    int* stok = scnt + 32; float* srs = (float*)(stok + 256); float* swl = srs + 256; float* swh = swl + 256;
    moe_prefix(p.cnt + l * 32 * 32, spre, scnt);
    const int nrt = spre[NCLS], nrtx = (nrt + 7) >> 3, xcd = bid & 7, nloc = nb >> 3;
    const int rt_lo = xcd * nrtx, rt_hi = rt_lo + nrtx < nrt ? rt_lo + nrtx : nrt;
    for (int k = bid >> 3; k < (rt_hi - rt_lo) * 8; k += nloc) {
        const int rt = rt_lo + (k >> 3), ct = k & 7;
        int cls = 0;
        for (int q = 1; q < NCLS; ++q) if (spre[q] <= rt) cls = q;
        int elo, ehi; cls_experts(cls, elo, ehi);
        const int lrow0 = (rt - spre[cls]) * 256, n = scnt[cls];
        if (c.tid < 256) {
            const int lr = lrow0 + c.tid; const bool ok = lr < n;
            const int tok = ok ? (int)p.perm[(size_t)cls * NTOK + lr][0] : 0;
            stok[c.tid] = ok ? tok : -1; srs[c.tid] = rstd_of(p.part, tok);
            swl[c.tid] = p.tokw[(size_t)tok * 2]; swh[c.tid] = p.tokw[(size_t)tok * 2 + 1];
        }
        __syncthreads();
        const int r = c.tid >> 2;
        const int t0 = stok[r] < 0 ? 0 : stok[r], t1 = stok[r + 128] < 0 ? 0 : stok[r + 128];
        const int ex = ct < 4 ? elo : ehi;
        f32x4 acc[8][4]; acc2_zero(acc);
        gemm2_kloop<true>(acc, p.hb, (unsigned)(t0 * DM + c.sc), (unsigned)(t1 * DM + c.sc), p.Wgu + ((size_t)ex * DM + (ct & 3) * 256) * DM,
                          (unsigned)(r * DM + c.sc), (unsigned)((r + 128) * DM + c.sc), DM / 32, lds, c);
        gemm2_relane(c);
#pragma unroll
        for (int m = 0; m < 8; ++m) {
            const int rl = c.wr * 128 + m * 16 + c.fr; const float rs = srs[rl], w = ct < 4 ? swl[rl] : swh[rl];
            bf16_t* o = p.Hbuf + ((size_t)rt * 256 + rl) * DM + (ct < 4 ? 0 : 512) + (ct & 3) * 128 + c.wc * 32 + c.fq * 4;
#pragma unroll
            for (int n2 = 0; n2 < 2; ++n2) {
                float hv[4];
#pragma unroll
                for (int j = 0; j < 4; ++j) hv[j] = siluf_(acc[m][n2][j] * rs) * (acc[m][n2 + 2][j] * rs) * w;
                *(uint2*)(o + n2 * 16) = make_uint2(cvt_pk_bf16(hv[0], hv[1]), cvt_pk_bf16(hv[2], hv[3]));
            }
        }
        __syncthreads();
    }
}

struct Moe1Unit { int pm, pn, cls, lrow0, n, ex; };
struct Moe1Sched {
    typedef Moe1Unit Unit;
    static constexpr bool PERMB = true;
    const bf16_t* hb; const bf16_t* Wgu; const u32x4* perm; const int* spre; const int* scnt; int* stok; float* srs; float* sw; int kb, nloc, rt_lo, nun;
    static constexpr int ldb = DM, nt = DM / 64;
    __device__ __forceinline__ bool next(int i, Moe1Unit& u) const {
        const int k = kb + i * nloc; if (k >= nun) return false;
        u.pm = rt_lo + (k >> 3); u.pn = k & 7;
        int cls = 0;
        for (int q = 1; q < NCLS; ++q) if (spre[q] <= u.pm) cls = q;
        int elo, ehi; cls_experts(cls, elo, ehi);
        u.cls = cls; u.lrow0 = (u.pm - spre[cls]) * 256; u.n = scnt[cls]; u.ex = u.pn < 4 ? elo : ehi;
        return true;
    }
    __device__ __forceinline__ void ptrs(const Moe1Unit& u, const char*& a, const char*& b) const { a = (const char*)hb; b = (const char*)(Wgu + ((size_t)u.ex * DM + (u.pn & 3) * 256) * DM); }
    __device__ __forceinline__ void a_ready(const Moe1Unit& u, int ui) const {
        const int tid = opaque_tid();
        if (tid < 256) {
            const int lr = u.lrow0 + tid; const bool ok = lr < u.n;
            const u32x4 e = p_load(perm + (size_t)u.cls * NTOK + (ok ? lr : u.lrow0));
            const int o = (ui & 1) * 256 + tid;
            stok[o] = ok ? (int)e[0] : -1; srs[o] = __uint_as_float(e[1]); sw[o] = __uint_as_float(u.pn < 4 ? e[2] : e[3]);
        }
    }
    static __device__ __forceinline__ u32x4 p_load(const u32x4* q) { return *q; }
    __device__ __forceinline__ void a_offs(const Moe1Unit&, int ui, const int (&R)[2], const int (&C)[2], unsigned (&o0)[2], unsigned (&o1)[2]) const {
#pragma unroll
        for (int i = 0; i < 2; ++i) {
            const int t0 = stok[(ui & 1) * 256 + R[i]], t1 = stok[(ui & 1) * 256 + 128 + R[i]];
            o0[i] = (unsigned)((t0 < 0 ? 0 : t0) * DM + C[i]) * 2u; o1[i] = (unsigned)((t1 < 0 ? 0 : t1) * DM + C[i]) * 2u;
        }
    }
};
struct Moe1Epi {
    bf16_t* Hbuf; const float* srs; const float* sw;
    __device__ __forceinline__ void operator()(const f32x4 (&acc)[2][2][4][2], const Moe1Unit& u, int ui, int wr, int wc, int fr, int fq) const {
#pragma unroll
        for (int ai = 0; ai < 2; ++ai)
#pragma unroll
            for (int m = 0; m < 4; ++m) {
                const int rl = ai * 128 + wr * 64 + m * 16 + fr; const float rs = srs[(ui & 1) * 256 + rl], w = sw[(ui & 1) * 256 + rl];
                bf16_t* o = Hbuf + ((size_t)u.pm * 256 + rl) * DM + (u.pn < 4 ? 0 : 512) + (u.pn & 3) * 128 + wc * 32 + fq * 8;
                u32x4 hw;
#pragma unroll
                for (int n = 0; n < 2; ++n) {
                    float hv[4];
#pragma unroll
                    for (int j = 0; j < 4; ++j) hv[j] = siluf_(acc[ai][0][m][n][j] * rs) * (acc[ai][1][m][n][j] * rs) * w;
                    hw[2 * n] = cvt_pk_bf16(hv[0], hv[1]); hw[2 * n + 1] = cvt_pk_bf16(hv[2], hv[3]);
                }
                *(u32x4*)o = hw;
            }
    }
};
__device__ __forceinline__ void phase_moe1_8(const Params& p, int l, int bid, int nb, unsigned char* lds) {
    int* spre = (int*)(lds + P8_LDS); int* scnt = spre + 32;
    int* stok = scnt + 32; float* srs = (float*)(stok + 512); float* sw = srs + 512;
    moe_prefix(p.cnt + l * 32 * 32, spre, scnt);
    const int nrt = spre[NCLS], nrtx = (nrt + 7) >> 3, xcd = bid & 7;
    const int rt_lo = xcd * nrtx, rt_hi = rt_lo + nrtx < nrt ? rt_lo + nrtx : nrt;
    Moe1Sched S{p.hb, p.Wgu, p.perm, spre, scnt, stok, srs, sw, bid >> 3, nb >> 3, rt_lo, (rt_hi - rt_lo) * 8};
    Moe1Epi E{p.Hbuf, srs, sw};
    p8_gemm_phase_g((LAS unsigned char*)lds, S, E);
}

__device__ __forceinline__ void phase_moe2(const Params& p, int l, bool last_layer, int bid, int nb, unsigned char* lds) {
    Gemm2Ctx c = gemm2_ctx();
    int* spre = (int*)(lds + G2_LDS); int* scnt = spre + 32; int* stok = scnt + 32;
    moe_prefix(p.cnt + l * 32 * 32, spre, scnt);
    const int nrt = spre[NCLS], nrtx = (nrt + 7) >> 3, xcd = bid & 7, nloc = nb >> 3;
    const int rt_lo = xcd * nrtx, rt_hi = rt_lo + nrtx < nrt ? rt_lo + nrtx : nrt;
    const int U = (rt_hi - rt_lo) * 4, nfull = (U / nloc) * nloc, nleft = U - nfull;
    const bool split = 2 * nleft <= nloc;
    for (int k = bid >> 3; k < (split ? nfull : U); k += nloc) {
        const int rt = rt_lo + (k >> 2), ct = k & 3;
        int cls = 0;
        for (int q = 1; q < NCLS; ++q) if (spre[q] <= rt) cls = q;
        int elo, ehi; cls_experts(cls, elo, ehi);
        const int lrow0 = (rt - spre[cls]) * 256, n = scnt[cls];
        if (c.tid < 256) { const int lr = lrow0 + c.tid; stok[c.tid] = lr < n ? (int)p.perm[(size_t)cls * NTOK + lr][0] : -1; }
        __syncthreads();
        const int r = c.tid >> 2;
        f32x4 acc[8][4]; acc2_zero(acc);
        const bf16_t* a0 = p.Hbuf + (size_t)rt * 256 * DM;
        const unsigned oa0 = (unsigned)(r * DM + c.sc), oa1 = (unsigned)((r + 128) * DM + c.sc), rbp = (r & ~31) + 8 * ((r & 15) >> 2) + 4 * ((r >> 4) & 1) + (r & 3),
                       ob0 = (unsigned)(rbp * 512 + c.sc), ob1 = (unsigned)((rbp + 128) * 512 + c.sc);
        gemm2_kloop<true>(acc, a0, oa0, oa1, p.WdT + ((size_t)elo * DM + ct * 256) * 512, ob0, ob1, 16, lds, c);
        gemm2_relane(c);
        gemm2_kloop<true>(acc, a0 + 512, oa0, oa1, p.WdT + ((size_t)ehi * DM + ct * 256) * 512, ob0, ob1, 16, lds, c);
        gemm2_relane(c);
#pragma unroll
        for (int m = 0; m < 8; ++m) {
            const int rl = c.wr * 128 + m * 16 + c.fr; const int tok = stok[rl];
            const size_t off = (size_t)(tok < 0 ? 0 : tok) * DM + ct * 256 + c.wc * 64 + c.fq * 8;
            float ss = 0.f;
            if (last_layer) {
                if (tok >= 0) {
#pragma unroll
                    for (int np = 0; np < 2; ++np) { u32x4 w; w[0] = cvt_pk_bf16(acc[m][2 * np][0], acc[m][2 * np][1]); w[1] = cvt_pk_bf16(acc[m][2 * np][2], acc[m][2 * np][3]); w[2] = cvt_pk_bf16(acc[m][2 * np + 1][0], acc[m][2 * np + 1][1]); w[3] = cvt_pk_bf16(acc[m][2 * np + 1][2], acc[m][2 * np + 1][3]); *(u32x4*)(p.mo + off + np * 32) = w; }
                }
                continue;
            }
            if (tok >= 0) {
#pragma unroll
                for (int np = 0; np < 2; ++np) {
                    const u32x4 hw = *(const u32x4*)(p.hb + off + np * 32);
                    const f32x4 v0 = bf4_to_f32(make_uint2(hw[0], hw[1])) + acc[m][2 * np], v1 = bf4_to_f32(make_uint2(hw[2], hw[3])) + acc[m][2 * np + 1];
                    u32x4 ow; ow[0] = cvt_pk_bf16(v0[0], v0[1]); ow[1] = cvt_pk_bf16(v0[2], v0[3]); ow[2] = cvt_pk_bf16(v1[0], v1[1]); ow[3] = cvt_pk_bf16(v1[2], v1[3]);
                    *(u32x4*)(p.hb + off + np * 32) = ow;
                    ss += (v0[0] * v0[0] + v0[1] * v0[1]) + (v0[2] * v0[2] + v0[3] * v0[3]) + (v1[0] * v1[0] + v1[1] * v1[1]) + (v1[2] * v1[2] + v1[3] * v1[3]);
                }
            }
            ss += __shfl_xor(ss, 16); ss += __shfl_xor(ss, 32);
            if (c.fq == 0 && tok >= 0) p.part[(size_t)tok * 16 + ct * 4 + c.wc] = ss;
        }
        __syncthreads();
    }
    if (split && (bid >> 4) < nleft) {
        const int k = nfull + (bid >> 4), half = (bid >> 3) & 1;
        const int rt = rt_lo + (k >> 2), ct = k & 3;
        int cls = 0;
        for (int q = 1; q < NCLS; ++q) if (spre[q] <= rt) cls = q;
        int elo, ehi; cls_experts(cls, elo, ehi);
        const int lrow0 = (rt - spre[cls]) * 256, n = scnt[cls];
        GemmCtx c4 = gemm_ctx();
        if (c4.tid < 256) { const int lr = lrow0 + c4.tid; stok[c4.tid] = lr < n ? (int)p.perm[(size_t)cls * NTOK + lr][0] : -1; }
        __syncthreads();
        const int r = c4.tid >> 2;
        f32x4 acc[4][4]; acc_zero(acc);
        const bf16_t* a0 = p.Hbuf + (size_t)rt * 256 * DM;
        const unsigned oa0 = (unsigned)(r * DM + c4.sc), oa1 = (unsigned)((r + 128) * DM + c4.sc), ob = (unsigned)(((r & ~31) + 8 * ((r & 15) >> 2) + 4 * ((r >> 4) & 1) + (r & 3)) * 512 + c4.sc);
        gemm_kloop_s<MG_NS, true>(acc, a0, oa0, oa1, p.WdT + ((size_t)elo * DM + ct * 256 + half * 128) * 512, ob, 16, lds, c4);
        gemm_relane(c4);
        gemm_kloop_s<MG_NS, true>(acc, a0 + 512, oa0, oa1, p.WdT + ((size_t)ehi * DM + ct * 256 + half * 128) * 512, ob, 16, lds, c4);
        gemm_relane(c4);
#pragma unroll
        for (int m = 0; m < 4; ++m) {
            const int rl = c4.wr * 64 + m * 16 + c4.fr; const int tok = stok[rl];
            const size_t off = (size_t)(tok < 0 ? 0 : tok) * DM + ct * 256 + half * 128 + c4.wc * 64 + c4.fq * 8;
            float ss = 0.f;
            if (last_layer) {
                if (tok >= 0) {
#pragma unroll
                    for (int np = 0; np < 2; ++np) { u32x4 w; w[0] = cvt_pk_bf16(acc[m][2 * np][0], acc[m][2 * np][1]); w[1] = cvt_pk_bf16(acc[m][2 * np][2], acc[m][2 * np][3]); w[2] = cvt_pk_bf16(acc[m][2 * np + 1][0], acc[m][2 * np + 1][1]); w[3] = cvt_pk_bf16(acc[m][2 * np + 1][2], acc[m][2 * np + 1][3]); *(u32x4*)(p.mo + off + np * 32) = w; }
                }
                continue;
            }
            if (tok >= 0) {
#pragma unroll
                for (int np = 0; np < 2; ++np) {
                    const u32x4 hw = *(const u32x4*)(p.hb + off + np * 32);
                    const f32x4 v0 = bf4_to_f32(make_uint2(hw[0], hw[1])) + acc[m][2 * np], v1 = bf4_to_f32(make_uint2(hw[2], hw[3])) + acc[m][2 * np + 1];
                    u32x4 ow; ow[0] = cvt_pk_bf16(v0[0], v0[1]); ow[1] = cvt_pk_bf16(v0[2], v0[3]); ow[2] = cvt_pk_bf16(v1[0], v1[1]); ow[3] = cvt_pk_bf16(v1[2], v1[3]);
                    *(u32x4*)(p.hb + off + np * 32) = ow;
                    ss += (v0[0] * v0[0] + v0[1] * v0[1]) + (v0[2] * v0[2] + v0[3] * v0[3]) + (v1[0] * v1[0] + v1[1] * v1[1]) + (v1[2] * v1[2] + v1[3] * v1[3]);
                }
            }
            ss += __shfl_xor(ss, 16); ss += __shfl_xor(ss, 32);
            if (c4.fq == 0 && tok >= 0) p.part[(size_t)tok * 16 + ct * 4 + half * 2 + c4.wc] = ss;
        }
        __syncthreads();
    }
}

__device__ __forceinline__ void phase_final(const Params& p, int bid, int nb) {
    const int tid = opaque_tid(), wave = tid >> 6, lane = tid & 63;
    const float* nf = p.in[I_NF];
    f32x4 g[4];
#pragma unroll
    for (int i = 0; i < 4; ++i) g[i] = *(const f32x4*)(nf + i * 256 + lane * 4);
    f32x4 v[4], vn[4]; uint2 mv[4], mn[4];
    auto load = [&](int row, f32x4 (&a)[4], uint2 (&b)[4]) {
#pragma unroll
        for (int i = 0; i < 4; ++i) { a[i] = bf4_to_f32(*(const uint2*)(p.hb + (size_t)row * DM + i * 256 + lane * 4)); b[i] = *(const uint2*)(p.mo + (size_t)row * DM + i * 256 + lane * 4); }
    };
    int row = bid * 8 + wave;
    if (row < NTOK) load(row, v, mv);
    for (; row < NTOK; row += nb * 8) {
        const int rown = row + nb * 8;
        if (rown < NTOK) load(rown, vn, mn);
        float ss = 0.f;
#pragma unroll
        for (int i = 0; i < 4; ++i) {
            v[i][0] += __uint_as_float(mv[i].x << 16); v[i][1] += __uint_as_float(mv[i].x & 0xFFFF0000u); v[i][2] += __uint_as_float(mv[i].y << 16); v[i][3] += __uint_as_float(mv[i].y & 0xFFFF0000u);
            ss += (v[i][0] * v[i][0] + v[i][1] * v[i][1]) + (v[i][2] * v[i][2] + v[i][3] * v[i][3]);
        }
        ss = wave_sum(ss);
        const float rs = rsqrtf(ss * (1.0f / 1024.0f) + EPS);
        float* hr = p.h + (size_t)row * DM;
#pragma unroll
        for (int i = 0; i < 4; ++i) {
            f32x4 o; o[0] = v[i][0] * rs * g[i][0]; o[1] = v[i][1] * rs * g[i][1]; o[2] = v[i][2] * rs * g[i][2]; o[3] = v[i][3] * rs * g[i][3];
            *(f32x4*)(hr + i * 256 + lane * 4) = o;
        }
        if (rown < NTOK) {
#pragma unroll
            for (int i = 0; i < 4; ++i) { v[i] = vn[i]; mv[i] = mn[i]; }
        }
    }
}

constexpr int cmax(int a, int b) { return a > b ? a : b; }
constexpr int MEGA_LDS_BODY = cmax(cmax(cmax(GLA_LDS, LRU_LDS), cmax(DSA_LDS, DIL_LDS)), cmax(cmax(MG_LDS, RT_LDS), G2_LDS + 8192));
constexpr int MEGA_LDS = PROBE_MASK ? 160 * 1024 : MEGA_LDS_BODY + 16;


__device__ __forceinline__ const Params& kparams() {
    const __attribute__((address_space(4))) Params* q = (const __attribute__((address_space(4))) Params*)__builtin_amdgcn_kernarg_segment_ptr();
    asm volatile("" : "+s"(q));
    return *(const Params*)q;
}
__global__ void __launch_bounds__(NT, 2) mega(Params p_kernarg) {
    (void)p_kernarg;
#define p kparams()
    unsigned char* lds = dyn_lds;
    volatile LAS unsigned* xbw = (volatile LAS unsigned*)(dyn_lds + MEGA_LDS_BODY);
    if (threadIdx.x == 0) { xbw[0] = 0u; xbw[1] = 0u; xbw[2] = 0u; xbw[3] = 0u; }
    __syncthreads();
    (void)xcd_barrier_post(p.bar, xbw);
#define PROBE_TICK(type) do { if (PROBE_MASK != 0 && blockIdx.x == 0 && threadIdx.x == 0) { volatile LAS unsigned long long* pw = (volatile LAS unsigned long long*)(dyn_lds + PROBE_OFF); \
        const unsigned long long now = __builtin_amdgcn_s_memrealtime(); if ((PROBE_MASK >> (type)) & 1) pw[1] += now - pw[0]; pw[0] = now; } } while (0)
#define PROBE_SINCE(bit) do { if (((PROBE_MASK >> (bit)) & 1) && blockIdx.x == 0 && threadIdx.x == 0) { volatile LAS unsigned long long* pw = (volatile LAS unsigned long long*)(dyn_lds + PROBE_OFF); \
        pw[1] += __builtin_amdgcn_s_memrealtime() - pw[0]; } } while (0)
#define GRID_SYNC() do { XcdBarrier _b; _b.bar = p.bar; _b.x = xb_xcc_id(); _b.st = (volatile LAS unsigned*)(dyn_lds + MEGA_LDS_BODY); xcd_barrier(_b); } while (0)
    const int bid = blockIdx.x, nb = gridDim.x;
    if (PROBE_MASK != 0 && threadIdx.x == 0) { volatile LAS unsigned long long* pw = (volatile LAS unsigned long long*)(dyn_lds + PROBE_OFF); pw[0] = __builtin_amdgcn_s_memrealtime(); pw[1] = 0ull; }
    phase_prep(p, bid, nb);
    phase_weights(p, 0, 1, bid, nb, lds);
    GRID_SYNC(); PROBE_TICK(0);
#pragma unroll 1
    for (int l = 0; l < DEPTH; ++l) {
        phase_inproj8(p, l, false, bid, nb, lds);
        GRID_SYNC(); PROBE_TICK(2);
        if (PROBE_GEMM_VAR >= 0 && l == 0) { phase_gemm_probe<PROBE_GEMM_VAR>(p, bid, nb, lds); GRID_SYNC(); }
        {
            const bool st = nb == 256;
            UnitSrc qg, ql, qs, qd;
            if (st) {
#define MK_SLOT(d0, d1, l0, l1, lr, gl) ((unsigned)(d0) | ((unsigned)(d1) << 5) | ((unsigned)(l0) << 10) | ((unsigned)(l1) << 15) | ((unsigned)(lr) << 20) | ((unsigned)(gl) << 24))
                constexpr unsigned SLOT[16] = {
                    MK_SLOT(0, 0, 6, 0, 1, 1), MK_SLOT(0, 0, 5, 0, 2, 2), MK_SLOT(0, 0, 4, 0, 3, 3), MK_SLOT(1, 0, 11, 0, 0, 4),
                    MK_SLOT(0, 0, 15, 13, 4, 0), MK_SLOT(9, 0, 7, 0, 5, 0), MK_SLOT(11, 0, 2, 1, 6, 0), MK_SLOT(13, 0, 0, 0, 7, 0),
                    MK_SLOT(3, 0, 16, 0, 8, 0), MK_SLOT(7, 2, 14, 0, 0, 0), MK_SLOT(8, 4, 9, 0, 0, 0), MK_SLOT(14, 0, 12, 0, 0, 0),
                    MK_SLOT(15, 0, 10, 0, 0, 0), MK_SLOT(16, 0, 8, 0, 0, 0), MK_SLOT(10, 6, 3, 0, 0, 0), MK_SLOT(12, 5, 0, 0, 0, 0)};
#undef MK_SLOT
                const int sl = bid >> 4, bt = bid & 15;
                const unsigned e = SLOT[sl];
                auto au = [&](unsigned f) { return f ? (int)(((16u - f) << 4) | (unsigned)bt) : UNIT_NONE; };
                (void)au;
                int* heads = p.qh + (l * 2 * 16 + bt) * 32;
                volatile int* word = (volatile int*)(dyn_lds + MEGA_LDS_BODY + 8);
                qs = UnitSrc{sl >= 9 ? ((sl - 9) << 4) | bt : UNIT_NONE, UNIT_NONE, UNIT_NONE, 0, heads, 7, 9, word, bt};
                qd = UnitSrc{UNIT_NONE, UNIT_NONE, UNIT_NONE, 0, heads + 16 * 32, 0, 16, word, bt};
                ql = UnitSrc{((e >> 20) & 15u) ? bt * 8 + (int)((e >> 20) & 15u) - 1 : UNIT_NONE, UNIT_NONE, UNIT_NONE, 0, nullptr, 0, 0, nullptr, -1};
                qg = UnitSrc{((e >> 24) & 7u) ? bt * 4 + (int)((e >> 24) & 7u) - 1 : UNIT_NONE, UNIT_NONE, UNIT_NONE, 0, nullptr, 0, 0, nullptr, -1};
            } else { qg = ql = qs = qd = UnitSrc{bid, UNIT_NONE, UNIT_NONE, nb, nullptr, 0, 0, nullptr, -1}; }
            phase_gla(p, l, qg, lds); PROBE_SINCE(14);
            phase_lru(p, l, ql, lds); PROBE_SINCE(15);
            phase_dsa(p, qs, lds); PROBE_SINCE(16);
            phase_dil(p, qd, lds); PROBE_SINCE(17);
            conv_queue(p, l, p.cnt + l * 32 * 32 + 24 * 32, lds);
        }
        GRID_SYNC(); PROBE_TICK(3);
        phase_inproj8(p, l, true, bid, nb, lds);
        GRID_SYNC(); PROBE_TICK(4);
        phase_merge(p, l, bid, nb, lds);
        GRID_SYNC(); PROBE_TICK(4);
        phase_out8(p, l, bid, nb, lds);
        GRID_SYNC(); PROBE_TICK(5);
        phase_router(p, l, bid, nb, lds);
        GRID_SYNC(); PROBE_TICK(6);
        phase_moe1_8(p, l, bid, nb, lds);
        GRID_SYNC(); PROBE_TICK(7);
        phase_moe2(p, l, l == DEPTH - 1, bid, nb, lds);
        GRID_SYNC(); PROBE_TICK(8);
    }
    phase_final(p, bid, nb);
    if (PROBE_MASK != 0 && threadIdx.x == 0) { volatile LAS unsigned long long* pw = (volatile LAS unsigned long long*)(dyn_lds + PROBE_OFF);
        const unsigned long long t0 = __builtin_amdgcn_s_memrealtime(), w = pw[1]; while (__builtin_amdgcn_s_memrealtime() - t0 < w) __builtin_amdgcn_s_sleep(8); }
#undef p
}

static size_t align_up(size_t v, size_t a) { return (v + a - 1) / a * a; }

extern "C" void kernel_launch(void* const* d_in, const int* in_sizes, int n_in, void* d_out, int out_size, void* d_ws, size_t ws_size, hipStream_t stream) {
    (void)in_sizes; (void)n_in; (void)out_size;
    Params p{};
    for (int i = 0; i < N_IN; ++i) p.in[i] = (const float*)d_in[i];
    p.h = (float*)d_out;
    unsigned char* w = (unsigned char*)d_ws; size_t off = 0;
    auto take = [&](size_t bytes) { unsigned char* r = w + off; off = align_up(off + bytes, 256); return r; };
    p.bar = (unsigned*)take(XCD_BAR_WORDS * 4);
    p.cnt = (int*)take(DEPTH * 32 * 32 * 4);
    p.qh = (int*)take(DEPTH * 2 * 16 * 32 * 4);
    p.Bt_in = (bf16_t*)take((size_t)NP * DM * 2);
    p.Bt_gate = (bf16_t*)take((size_t)4 * DM * DM * 2);
    p.Bt_br = (bf16_t*)take((size_t)4 * DM * 384 * 2);
    p.Bt_out = (bf16_t*)take((size_t)DM * DM * 2);
    p.Wgu = (bf16_t*)take((size_t)16 * DM * DM * 2);
    p.WdT = (bf16_t*)take((size_t)16 * DM * 512 * 2);
    p.hb = (bf16_t*)take((size_t)NTOK * DM * 2);
    p.part = (float*)take((size_t)NTOK * 16 * 4);
    p.biasB = (float*)take(6 * TABW * 4);
    p.biasC = (float*)take(6 * TABW * 4);
    p.VtB = (bf16_t*)take((size_t)NTOK * 384 * 2);
    p.VtC = (bf16_t*)take((size_t)NTOK * 384 * 2);
    p.tokw = (float*)take((size_t)NTOK * 2 * 4);
    p.perm = (u32x4*)take((size_t)NCLS * NTOK * 16);
    p.proj = (bf16_t*)take((size_t)NTOK * NP * 2);
    p.Hbuf = p.proj;
    p.mo = p.proj + (size_t)MAXRT * 256 * DM;
    if (off > ws_size) return;

    static int grid = 0;
    if (grid == 0) {
        int dev = 0, cus = 0;
        (void)hipGetDevice(&dev);
        (void)hipDeviceGetAttribute(&cus, hipDeviceAttributeMultiprocessorCount, dev);
        if (hipFuncSetAttribute((const void*)mega, hipFuncAttributeMaxDynamicSharedMemorySize, MEGA_LDS) != hipSuccess) { grid = -1; return; }
        int per_cu = 0;
        (void)hipOccupancyMaxActiveBlocksPerMultiprocessor(&per_cu, (const void*)mega, NT, MEGA_LDS);
        (void)hipGetLastError();
        grid = cus > 0 ? cus : 256;
    }
    if (grid < 0) return;
    (void)hipMemsetAsync(p.bar, 0, XCD_BAR_WORDS * sizeof(unsigned), stream);
    mega<<<grid, NT, MEGA_LDS, stream>>>(p);
}
```
